# Optimizing an MI355X kernel written in HIP

```python
import jax, jax.numpy as jnp
from jax import lax
import numpy as np

D_MODEL = 1024
BATCH = 4
SEQ = 4096
DEPTH = 4

CTX_LEN = 256
GRID_W = 64

POOL_GROUPS = 4
POOL_WINDOWS = (2, 4, 8, 16)
POOL_GROUP_DIM = 64
POOL_WIDTH = POOL_GROUPS * POOL_GROUP_DIM
NA_HEADS = 4
NA_HEAD_DIM = 64
NA_WIDTH = NA_HEADS * NA_HEAD_DIM
NA_WIN_ROWS = 8
NA_WIN_COLS = 16
NA_QCOLS = 16
NA_KCOLS = NA_QCOLS + NA_WIN_COLS
SGU_GROUPS = 4
SGU_GROUP_DIM = 64
SGU_WIDTH = SGU_GROUPS * SGU_GROUP_DIM
SGU_CHUNK = 128
MLA_HEADS = 4
MLA_Q_RANK = 256
MLA_KV_RANK = 128
MLA_NOPE_DIM = 64
MLA_ROPE_DIM = 32
MLA_V_DIM = 64
MLA_WIDTH = MLA_HEADS * MLA_V_DIM
MLA_SCALE = (MLA_NOPE_DIM + MLA_ROPE_DIM) ** -0.5
ROPE_BASE = 10000.0
ATTN_Q_BLOCK = 128

MIX_WIDTH = POOL_WIDTH + NA_WIDTH + SGU_WIDTH + MLA_WIDTH
IN_A = POOL_WIDTH
IN_B = 3 * NA_WIDTH
IN_C = 2 * SGU_WIDTH
IN_D = MLA_Q_RANK + MLA_KV_RANK + MLA_ROPE_DIM
OFF_B = IN_A
OFF_C = OFF_B + IN_B
OFF_D = OFF_C + IN_C
IN_WIDTH = OFF_D + IN_D

N_EXPERTS = 16
N_EXPERT_GROUPS = 4
EXPERTS_PER_GROUP = N_EXPERTS // N_EXPERT_GROUPS
TOP_K = 2
D_EXPERT = 256

N_MOD = 6
EPS = 1e-6
NEG_INF = -1e30

kernel_name = 'hybrid_parallel_group_diffusion_block'


def rms_norm(x, g):
    xf = x.astype(jnp.float32)
    y = xf * lax.rsqrt(jnp.mean(xf * xf, axis=-1, keepdims=True) + EPS)
    return (y * g.astype(jnp.float32)).astype(x.dtype)


def modulate(h, shift, scale):
    return h * (1 + scale) + shift


def axial_rope_tables(S):
    t = jnp.arange(S)
    row = (t // GRID_W).astype(jnp.float32)
    col = (t % GRID_W).astype(jnp.float32)
    nf = MLA_ROPE_DIM // 4
    inv = ROPE_BASE ** (-jnp.arange(nf, dtype=jnp.float32) / nf)
    ang = jnp.concatenate([row[:, None] * inv, col[:, None] * inv], axis=-1)
    return jnp.cos(ang), jnp.sin(ang)


def rope_2d(x, cos, sin):
    r1, r2, c1, c2 = jnp.split(x, 4, axis=-1)
    x1 = jnp.concatenate([r1, c1], axis=-1)
    x2 = jnp.concatenate([r2, c2], axis=-1)
    cos = cos.astype(x.dtype)
    sin = sin.astype(x.dtype)
    o1 = x1 * cos - x2 * sin
    o2 = x1 * sin + x2 * cos
    nf = o1.shape[-1] // 2
    return jnp.concatenate([o1[..., :nf], o2[..., :nf], o1[..., nf:], o2[..., nf:]], axis=-1)


def multiscale_pool(u, w, s):
    B, L, _ = u.shape
    ug = u.reshape(B, L, POOL_GROUPS, POOL_GROUP_DIM).astype(jnp.float32)
    csum = jnp.concatenate([jnp.zeros_like(ug[:, :1]), jnp.cumsum(ug, axis=1)], axis=1)
    t = jnp.arange(L)
    diffs = []
    for g, win in enumerate(POOL_WINDOWS):
        lo = jnp.clip(t - win // 2, 0, L)
        hi = jnp.clip(t - win // 2 + win, 0, L)
        cg = csum[:, :, g]
        mean = (cg[:, hi] - cg[:, lo]) / (hi - lo).astype(jnp.float32)[:, None]
        diffs.append(mean - ug[:, :, g])
    d = jnp.stack(diffs, axis=2).astype(u.dtype)
    y = jnp.einsum('blgc,gcd->blgd', d, w).reshape(B, L, POOL_WIDTH)
    return y * s


def spatial_gating(uv, g_norm, w_s, b_s):
    B, L, _ = uv.shape
    uv = jax.nn.gelu(uv)
    u, v = uv[..., :SGU_WIDTH], uv[..., SGU_WIDTH:]
    n = L // SGU_CHUNK
    vg = rms_norm(v.reshape(B, n, SGU_CHUNK, SGU_GROUPS, SGU_GROUP_DIM),
                  g_norm.reshape(SGU_GROUPS, SGU_GROUP_DIM))
    mixed = jnp.einsum('gpq,bnqgc->bnpgc', w_s, vg) + b_s.T[:, :, None]
    return u * mixed.reshape(B, L, SGU_WIDTH)


def dense_attention(q, k, v):
    s = jnp.einsum('bqhe,bkhe->bhqk', q, k).astype(jnp.float32) * (q.shape[-1] ** -0.5)
    p = jax.nn.softmax(s, axis=-1).astype(v.dtype)
    return jnp.einsum('bhqk,bkhe->bqhe', p, v)


def neighborhood_attention(q, k, v, kc, vc, rpb, rows):
    B, S, H, E = q.shape
    kr = min(NA_WIN_ROWS, rows)
    ncb = GRID_W // NA_QCOLS
    r = jnp.arange(rows)
    row_idx = jnp.clip(r - kr // 2, 0, rows - kr)[:, None] + jnp.arange(kr)
    qcol = (jnp.arange(ncb) * NA_QCOLS)[:, None] + jnp.arange(NA_QCOLS)
    ws = jnp.clip(qcol - NA_WIN_COLS // 2, 0, GRID_W - NA_WIN_COLS)
    cs = jnp.minimum(ws[:, 0], GRID_W - NA_KCOLS)
    col_idx = cs[:, None] + jnp.arange(NA_KCOLS)
    key_tok = (row_idx[:, None, :, None] * GRID_W + col_idx[None, :, None, :]).reshape(rows, ncb, kr * NA_KCOLS)
    kcol = col_idx[:, None, :]
    valid = (kcol >= ws[:, :, None]) & (kcol < ws[:, :, None] + NA_WIN_COLS)
    valid = jnp.broadcast_to(valid[:, :, None, :], (ncb, NA_QCOLS, kr, NA_KCOLS)).reshape(ncb, NA_QCOLS, kr * NA_KCOLS)
    dr = row_idx - r[:, None] + NA_WIN_ROWS - 1
    dc = jnp.clip(kcol - qcol[:, :, None] + NA_WIN_COLS - 1, 0, 2 * NA_WIN_COLS - 2)
    bias = rpb[:, dr[:, :, None, None, None], dc[None, None]]
    bias = bias.transpose(0, 1, 3, 4, 2, 5).reshape(H, rows, ncb, NA_QCOLS, kr * NA_KCOLS).astype(jnp.float32)

    scale = E ** -0.5
    qg = q.reshape(B, rows, ncb, NA_QCOLS, H, E)
    kg = jnp.take(k, key_tok, axis=1)
    vg = jnp.take(v, key_tok, axis=1)
    s_win = jnp.einsum('brjqhe,brjkhe->bhrjqk', qg, kg).astype(jnp.float32) * scale + bias
    s_win = jnp.where(valid, s_win, NEG_INF)
    s_ctx = jnp.einsum('brjqhe,bche->bhrjqc', qg, kc).astype(jnp.float32) * scale
    p = jax.nn.softmax(jnp.concatenate([s_win, s_ctx], axis=-1), axis=-1).astype(v.dtype)
    nw = kr * NA_KCOLS
    o = (jnp.einsum('bhrjqk,brjkhe->brjqhe', p[..., :nw], vg)
         + jnp.einsum('bhrjqc,bche->brjqhe', p[..., nw:], vc))
    return o.reshape(B, S, H * E)


def mla_queries(part, gq, w_uq):
    B, L, _ = part.shape
    q = (rms_norm(part[..., :MLA_Q_RANK], gq) @ w_uq).reshape(B, L, MLA_HEADS, MLA_NOPE_DIM + MLA_ROPE_DIM)
    return q[..., :MLA_NOPE_DIM], q[..., MLA_NOPE_DIM:]


def mla_keys(part, gkv, w_ukv):
    B, L, _ = part.shape
    ckv = part[..., MLA_Q_RANK:MLA_Q_RANK + MLA_KV_RANK]
    k_rope = part[..., MLA_Q_RANK + MLA_KV_RANK:]
    kv = (rms_norm(ckv, gkv) @ w_ukv).reshape(B, L, MLA_HEADS, MLA_NOPE_DIM + MLA_V_DIM)
    return kv[..., :MLA_NOPE_DIM], k_rope, kv[..., MLA_NOPE_DIM:]


def mla_attend(q_nope, q_rope, k_nope, k_rope, v):
    s = (jnp.einsum('bqhd,bkhd->bhqk', q_nope, k_nope)
         + jnp.einsum('bqhr,bkr->bhqk', q_rope, k_rope)).astype(jnp.float32) * MLA_SCALE
    p = jax.nn.softmax(s, axis=-1).astype(v.dtype)
    return jnp.einsum('bhqk,bkhd->bqhd', p, v)


def blocked_mla(q_nope, q_rope, k_nope, k_rope, v):
    B, S, H, _ = q_nope.shape
    nb = S // ATTN_Q_BLOCK

    def to_blocks(a):
        return jnp.moveaxis(a.reshape(B, nb, ATTN_Q_BLOCK, *a.shape[2:]), 1, 0)

    out = lax.map(lambda qb: mla_attend(qb[0], qb[1], k_nope, k_rope, v),
                  (to_blocks(q_nope), to_blocks(q_rope)))
    return jnp.moveaxis(out, 0, 1).reshape(B, S, H * MLA_V_DIM)


def split_na(part):
    B, L, _ = part.shape
    return [t.reshape(B, L, NA_HEADS, NA_HEAD_DIM) for t in jnp.split(part, 3, axis=-1)]


def token_mixing(pl, pc, cos, sin, rows, pool_w, pool_s, rpb, sgu_g, sgu_w, sgu_b,
                 gq, w_uq, gkv, w_ukv, ctx_out):
    B = pl.shape[0]
    Lc = pc.shape[1]
    y_a = multiscale_pool(pl[..., :OFF_B], pool_w, pool_s)
    ql, kl, vl = split_na(pl[..., OFF_B:OFF_C])
    qc, kc, vc = split_na(pc[..., OFF_B:OFF_C])
    y_b = neighborhood_attention(ql, kl, vl, kc, vc, rpb, rows)
    y_c = spatial_gating(pl[..., OFF_C:OFF_D], sgu_g, sgu_w, sgu_b)
    dl, dc = pl[..., OFF_D:], pc[..., OFF_D:]
    qn_l, qr_l = mla_queries(dl, gq, w_uq)
    kn_l, kr_l, v_l = mla_keys(dl, gkv, w_ukv)
    kn_c, kr_c, v_c = mla_keys(dc, gkv, w_ukv)
    qr_l = rope_2d(qr_l, cos[:, None, :], sin[:, None, :])
    kr_l = rope_2d(kr_l, cos, sin)
    y_d = blocked_mla(qn_l, qr_l,
                      jnp.concatenate([kn_c, kn_l], axis=1),
                      jnp.concatenate([kr_c, kr_l], axis=1),
                      jnp.concatenate([v_c, v_l], axis=1))
    ml = jnp.concatenate([y_a, y_b, y_c, y_d], axis=-1)
    if not ctx_out:
        return ml, None
    yc_a = multiscale_pool(pc[..., :OFF_B], pool_w, pool_s)
    yc_b = dense_attention(qc, kc, vc).reshape(B, Lc, NA_WIDTH)
    yc_c = spatial_gating(pc[..., OFF_C:OFF_D], sgu_g, sgu_w, sgu_b)
    qn_c, qr_c = mla_queries(dc, gq, w_uq)
    yc_d = mla_attend(qn_c, qr_c, kn_c, kr_c, v_c).reshape(B, Lc, MLA_WIDTH)
    mc = jnp.concatenate([yc_a, yc_b, yc_c, yc_d], axis=-1)
    return ml, mc


def grouped_moe(h, router_w, router_b, w_gate, w_up, w_down):
    shp = h.shape
    ht = h.reshape(-1, shp[-1])
    scores = jax.nn.sigmoid((ht @ router_w).astype(jnp.float32))
    biased = scores + router_b.astype(jnp.float32)
    grp_score = lax.top_k(biased.reshape(-1, N_EXPERT_GROUPS, EXPERTS_PER_GROUP), TOP_K)[0].sum(-1)
    sel_group = jnp.argmax(grp_score, axis=-1)
    in_group = (jnp.arange(N_EXPERTS) // EXPERTS_PER_GROUP)[None, :] == sel_group[:, None]
    _, idx = lax.top_k(jnp.where(in_group, biased, NEG_INF), TOP_K)
    w = jnp.take_along_axis(scores, idx, axis=-1)
    w = w / jnp.sum(w, axis=-1, keepdims=True)
    gates = jnp.sum(jax.nn.one_hot(idx, N_EXPERTS, dtype=jnp.float32) * w[..., None], axis=1).astype(h.dtype)
    hid = jax.nn.silu(jnp.einsum('td,edf->tef', ht, w_gate)) * jnp.einsum('td,edf->tef', ht, w_up)
    y = jnp.einsum('tef,efd->td', hid * gates[:, :, None], w_down)
    return y.reshape(shp)


def setup_inputs(seed: int = 0) -> dict:
    key = jax.random.key(seed)
    ks = jax.random.split(key, 32)
    D = D_MODEL
    L = DEPTH

    def nrm(k, shape, s):
        return jax.random.normal(k, shape, jnp.float32) * s

    return {
        'x': nrm(ks[0], (BATCH, SEQ, D), 1.0),
        'c': nrm(ks[1], (BATCH, D), 1.0),
        'ctx': nrm(ks[2], (BATCH, CTX_LEN, D), 1.0),
        'c_ctx': nrm(ks[3], (D,), 1.0),
        'ada_w': nrm(ks[4], (L, D, N_MOD * D), 0.5 * D ** -0.5),
        'ada_b': nrm(ks[5], (L, N_MOD * D), 0.02),
        'norm1_g': 1.0 + nrm(ks[6], (L, D), 0.02),
        'norm2_g': 1.0 + nrm(ks[7], (L, D), 0.02),
        'w_in': nrm(ks[8], (L, D, IN_WIDTH), D ** -0.5),
        'w_out': nrm(ks[9], (L, MIX_WIDTH, D), MIX_WIDTH ** -0.5),
        'pool_w': nrm(ks[10], (L, POOL_GROUPS, POOL_GROUP_DIM, POOL_GROUP_DIM), POOL_GROUP_DIM ** -0.5),
        'pool_s': 1.0 + nrm(ks[11], (L, POOL_WIDTH), 0.1),
        'na_rpb': nrm(ks[12], (L, NA_HEADS, 2 * NA_WIN_ROWS - 1, 2 * NA_WIN_COLS - 1), 0.1),
        'sgu_norm_g': 1.0 + nrm(ks[13], (L, SGU_WIDTH), 0.02),
        'sgu_w': nrm(ks[14], (L, SGU_GROUPS, SGU_CHUNK, SGU_CHUNK), SGU_CHUNK ** -0.5),
        'sgu_b': 1.0 + nrm(ks[15], (L, SGU_GROUPS, SGU_CHUNK), 0.02),
        'mla_q_norm_g': 1.0 + nrm(ks[16], (L, MLA_Q_RANK), 0.02),
        'mla_w_uq': nrm(ks[17], (L, MLA_Q_RANK, MLA_HEADS * (MLA_NOPE_DIM + MLA_ROPE_DIM)), MLA_Q_RANK ** -0.5),
        'mla_kv_norm_g': 1.0 + nrm(ks[18], (L, MLA_KV_RANK), 0.02),
        'mla_w_ukv': nrm(ks[19], (L, MLA_KV_RANK, MLA_HEADS * (MLA_NOPE_DIM + MLA_V_DIM)), MLA_KV_RANK ** -0.5),
        'router_w': nrm(ks[20], (D, N_EXPERTS), D ** -0.5),
        'router_b': nrm(ks[21], (N_EXPERTS,), 0.01),
        'moe_w_gate': nrm(ks[22], (L, N_EXPERTS, D, D_EXPERT), D ** -0.5),
        'moe_w_up': nrm(ks[23], (L, N_EXPERTS, D, D_EXPERT), D ** -0.5),
        'moe_w_down': nrm(ks[24], (L, N_EXPERTS, D_EXPERT, D), D_EXPERT ** -0.5),
        'final_g': 1.0 + nrm(ks[25], (D,), 0.02),
    }


def reference(x, c, ctx, c_ctx, ada_w, ada_b, norm1_g, norm2_g, w_in, w_out, pool_w, pool_s, na_rpb,
              sgu_norm_g, sgu_w, sgu_b, mla_q_norm_g, mla_w_uq, mla_kv_norm_g, mla_w_ukv,
              router_w, router_b, moe_w_gate, moe_w_up, moe_w_down, final_g):
    B, S, _ = x.shape
    rows = S // GRID_W
    cos, sin = axial_rope_tables(S)
    xl, xc = x, ctx
    for l in range(DEPTH):
        ctx_out = l < DEPTH - 1
        mod_l = jnp.split((jax.nn.silu(c) @ ada_w[l] + ada_b[l])[:, None, :], N_MOD, axis=-1)
        mod_c = jnp.split(jax.nn.silu(c_ctx) @ ada_w[l] + ada_b[l], N_MOD, axis=-1)
        pl = modulate(rms_norm(xl, norm1_g[l]), mod_l[0], mod_l[1]) @ w_in[l]
        pc = modulate(rms_norm(xc, norm1_g[l]), mod_c[0], mod_c[1]) @ w_in[l]
        ml, mc = token_mixing(pl, pc, cos, sin, rows, pool_w[l], pool_s[l], na_rpb[l],
                              sgu_norm_g[l], sgu_w[l], sgu_b[l],
                              mla_q_norm_g[l], mla_w_uq[l], mla_kv_norm_g[l], mla_w_ukv[l], ctx_out)
        xl = xl + mod_l[2] * (ml @ w_out[l])
        hl = modulate(rms_norm(xl, norm2_g[l]), mod_l[3], mod_l[4])
        xl = xl + mod_l[5] * grouped_moe(hl, router_w, router_b, moe_w_gate[l], moe_w_up[l], moe_w_down[l])
        if ctx_out:
            xc = xc + mod_c[2] * (mc @ w_out[l])
            hc = modulate(rms_norm(xc, norm2_g[l]), mod_c[3], mod_c[4])
            xc = xc + mod_c[5] * grouped_moe(hc, router_w, router_b, moe_w_gate[l], moe_w_up[l], moe_w_down[l])
    return rms_norm(xl, final_g)
```

```cpp
#include <hip/hip_runtime.h>
#include <cstdio>
#include <cstdint>

#ifndef MK_ONE_LAUNCH
#define MK_ONE_LAUNCH 1
#endif

#define GAS __attribute__((address_space(1)))
#define LAS __attribute__((address_space(3)))
typedef unsigned short bf16;
typedef float f32x4 __attribute__((ext_vector_type(4)));
typedef unsigned u32x4 __attribute__((ext_vector_type(4)));
typedef unsigned u32x2 __attribute__((ext_vector_type(2)));
typedef int i32x4 __attribute__((ext_vector_type(4)));
typedef short bf16x8 __attribute__((ext_vector_type(8)));

constexpr int D = 1024, NB = 4, SEQ = 4096, DEPTH = 4, CTX = 256, GW = 64, GH = 64;
constexpr int TL = NB * SEQ, TC = NB * CTX, T = TL + TC;
constexpr int INW = 1952, INP = 2048;
constexpr int OFF_B = 256, OFF_C = 1024, OFF_D = 1536;
constexpr int NE = 16, DE = 256, CAP = T;
constexpr int RPAD = 2 * T + NE * 256;
constexpr int NMOD = 6;
constexpr float EPS = 1e-6f;
constexpr float LOG2E = 1.4426950408889634f;
constexpr float MLA_SCALE = 0.10206207261596575f;
constexpr int NWAVES = 8, NTHR = NWAVES * 64;

constexpr size_t MiB = 1u << 20;
constexpr size_t WS_CTL = 0, CTL_ZERO_BYTES = 1 * MiB;
constexpr size_t WS_MOD = 1 * MiB;
constexpr size_t WS_ROPE = 2 * MiB;
constexpr size_t WS_ROUTE = 3 * MiB;
constexpr size_t WS_TOK = 4 * MiB;
constexpr size_t WS_WL = 6 * MiB;
constexpr size_t WS_WUQ = 8 * MiB;
constexpr size_t WS_WUKV = 9 * MiB;
constexpr size_t WS_POOLW = 10 * MiB;
constexpr size_t WS_SGUW = 10 * MiB + 512 * 1024;
constexpr size_t WS_WIN = 12 * MiB;
constexpr size_t WS_WOUT = 28 * MiB;
constexpr size_t WS_W1 = 36 * MiB;
constexpr size_t WS_W2 = 100 * MiB;
constexpr size_t WS_XL = 132 * MiB;
constexpr size_t WS_HA = 200 * MiB;
constexpr size_t WS_PL = 234 * MiB;
constexpr size_t WS_Y = 234 * MiB;
constexpr size_t WS_QM = 302 * MiB;
constexpr size_t WS_KM = 315 * MiB;
constexpr size_t WS_VM = 328 * MiB;
constexpr size_t WS_ML = 337 * MiB;
constexpr size_t WS_HID = 371 * MiB;
constexpr size_t WS_END = 390 * MiB;
static_assert(WS_Y + (size_t)RPAD * D * 2 <= WS_KM && WS_HID + (size_t)RPAD * DE * 2 <= WS_END, "ws map");

constexpr int CW_TMO = 0;
constexpr int CW_BAR = 4096;
constexpr int CW_CNT = 8192;

constexpr int LDS_BYTES = 147456;
constexpr int MISC_OFF = 131072 + 320;

__device__ __forceinline__ float bf2f(bf16 v) { return __uint_as_float(((unsigned)v) << 16); }
__device__ __forceinline__ unsigned f2bf(float f) { unsigned u = __float_as_uint(f); return (u + 0x7fffu + ((u >> 16) & 1u)) >> 16; }
__device__ __forceinline__ unsigned pk2(float lo, float hi) { return f2bf(lo) | (f2bf(hi) << 16); }
__device__ __forceinline__ float wave_sum(float v) {
#pragma unroll
    for (int o = 1; o < 64; o <<= 1) v += __shfl_xor(v, o);
    return v;
}
__device__ __forceinline__ float wave_max(float v) {
#pragma unroll
    for (int o = 1; o < 64; o <<= 1) v = fmaxf(v, __shfl_xor(v, o));
    return v;
}
__device__ __forceinline__ float silu_f(float x) { return x / (1.f + __expf(-x)); }
__device__ __forceinline__ float gelu_tanh(float x) { const float u = 0.7978845608028654f * (x + 0.044715f * x * x * x); return 0.5f * x * (1.f + tanhf(u)); }
__device__ __forceinline__ float dot_bf16(const bf16* a, const bf16* b, int K) {
    float s = 0.f;
    for (int k = 0; k < K; k += 8) {
        const u32x4 av = *(const u32x4*)(a + k), bv = *(const u32x4*)(b + k);
#pragma unroll
        for (int j = 0; j < 4; ++j) {
            s += __uint_as_float(av[j] << 16) * __uint_as_float(bv[j] << 16);
            s += __uint_as_float(av[j] & 0xffff0000u) * __uint_as_float(bv[j] & 0xffff0000u);
        }
    }
    return s;
}
#define LDS_WAIT() asm volatile("s_waitcnt lgkmcnt(0)" ::: "memory")

#define XB_TMO      128
#define XB_XCNT(j)  (256  + 64 * (j))
#define XB_XSUB(j)  (1280 + 64 * (j))
#define XB_XGEN(j)  (2304 + 64 * (j))
#define XB_TOP      3328
#define XB_TOPGEN   3392
#define XCD_BAR_WORDS 3456
#define XB_SPIN_CAP (1u << 18)
__device__ __forceinline__ unsigned xb_ld(unsigned* p)              { return __hip_atomic_load(p, __ATOMIC_RELAXED, __HIP_MEMORY_SCOPE_AGENT); }
__device__ __forceinline__ unsigned xb_add(unsigned* p, unsigned v) { return __hip_atomic_fetch_add(p, v, __ATOMIC_RELAXED, __HIP_MEMORY_SCOPE_AGENT); }
__device__ __forceinline__ unsigned xb_xcc_id() { return (unsigned)__builtin_amdgcn_s_getreg((3 << 11) | 20) & 0xFu; }
#define XB_SPIN(cond, bar) do { unsigned _sp = 0; while (cond) { __builtin_amdgcn_s_sleep(1); \
    if ((++_sp & 255u) == 0u) { if (xb_ld(&(bar)[XB_TMO])) break; if (_sp > XB_SPIN_CAP) { atomicAdd(&(bar)[XB_TMO], 1u); break; } } } } while (0)
struct XcdBarrier { unsigned* bar; unsigned x; volatile LAS unsigned* st; };
__device__ __forceinline__ XcdBarrier xcd_barrier_post(unsigned* bar, volatile LAS unsigned* st) {
    XcdBarrier b; b.bar = bar; b.x = xb_xcc_id(); b.st = st;
    if (threadIdx.x == 0) (void)xb_add(&bar[XB_XCNT(b.x)], 1u);
    return b;
}
__device__ __forceinline__ void xcd_barrier_complete(unsigned* bar, unsigned x, unsigned& nloc, unsigned& nx) {
    const unsigned G = gridDim.x * gridDim.y * gridDim.z;
    unsigned sum, cnt, mine, sp = 0u;
    for (;;) {
        sum = 0u; cnt = 0u; mine = 0u;
#pragma unroll
        for (unsigned j = 0; j < 16; ++j) { const unsigned c = xb_ld(&bar[XB_XCNT(j)]); sum += c; cnt += (c > 0u) ? 1u : 0u; mine = (j == x) ? c : mine; }
        if (sum == G) break;
        __builtin_amdgcn_s_sleep(1);
        if ((++sp & 255u) == 0u) { if (xb_ld(&bar[XB_TMO])) break; if (sp > XB_SPIN_CAP) { atomicAdd(&bar[XB_TMO], 1u); break; } }
    }
    nloc = mine > 0u ? mine : 1u; nx = cnt > 0u ? cnt : 1u;
}
__device__ __forceinline__ void xcd_barrier(const XcdBarrier& b) {
    asm volatile("s_waitcnt vmcnt(0)" ::: "memory");
    __syncthreads();
    if (threadIdx.x == 0) {
        unsigned* bar = b.bar;
        __builtin_amdgcn_s_waitcnt(0);
        unsigned nloc = b.st[0], nx = b.st[1];
        if (nloc == 0u) { xcd_barrier_complete(bar, b.x, nloc, nx); b.st[0] = nloc; b.st[1] = nx; }
        const unsigned old = xb_add(&bar[XB_XSUB(b.x)], 1u);
        const unsigned gen = old / nloc;
        if (old + 1u == (gen + 1u) * nloc) {
            __builtin_amdgcn_fence(__ATOMIC_RELEASE, "agent");
            asm volatile("s_waitcnt vmcnt(0)" ::: "memory");
            const unsigned og = xb_add(&bar[XB_TOP], 1u);
            const unsigned tg = og / nx;
            if (og + 1u == (tg + 1u) * nx) xb_add(&bar[XB_TOPGEN], 1u);
            else XB_SPIN(xb_ld(&bar[XB_TOPGEN]) == tg, bar);
            __builtin_amdgcn_fence(__ATOMIC_ACQUIRE, "agent");
            xb_add(&bar[XB_XGEN(b.x)], 1u);
            asm volatile("s_waitcnt vmcnt(0)" ::: "memory");
        } else {
            XB_SPIN(xb_ld(&bar[XB_XGEN(b.x)]) == gen, bar);
            __builtin_amdgcn_fence(__ATOMIC_ACQUIRE, "agent");
            asm volatile("s_waitcnt vmcnt(0)" ::: "memory");
        }
    }
    __syncthreads();
}

struct Params {
    const float *x, *c, *ctx, *c_ctx, *ada_w, *ada_b, *norm1_g, *norm2_g, *w_in, *w_out, *pool_w, *pool_s, *na_rpb,
                *sgu_norm_g, *sgu_w, *sgu_b, *mla_q_norm_g, *mla_w_uq, *mla_kv_norm_g, *mla_w_ukv,
                *router_w, *router_b, *moe_w_gate, *moe_w_up, *moe_w_down, *final_g;
    float* out; unsigned char* ws; int ph_lo, ph_hi;
};
struct Frame {
    LAS unsigned char* lds;
    int tid, lane, wave, gw, ngw, gt, ngt;
    unsigned* ctl;
    float* mod; float* ropec; float* ropes; int* route; int* tok; float* wl;
    bf16 *wuq, *wukv, *poolw, *sguw, *win, *wout, *w1, *w2, *ha, *pl, *y, *qm, *km, *vm, *ml, *hid;
    float* xl;
};
__device__ __forceinline__ int row_batch(int r) { return r < TL ? (r >> 12) : ((r - TL) >> 8); }
__device__ __forceinline__ int row_mod(int r) { return r < TL ? (r >> 12) : 4; }
__device__ __forceinline__ const float* mod_vec(const Frame& F, int l, int mr, int k) { return F.mod + ((size_t)(l * 5 + mr) * NMOD + k) * D; }

__device__ __forceinline__ void transpose_item(const float* W, int K, int N, bf16* WT, int kb, int nb, int drow0, LAS float* scr, int lane) {
    const int k0 = 64 * kb, n0 = 32 * nb;
#pragma unroll 8
    for (int i = 0; i < 32; ++i) { const int kk = 2 * i + (lane >> 5); scr[kk * 33 + (lane & 31)] = W[(size_t)(k0 + kk) * N + n0 + (lane & 31)]; }
    LDS_WAIT(); asm volatile("" ::: "memory");
    const int c = lane & 7;
#pragma unroll
    for (int j = 0; j < 4; ++j) { const int n = (lane >> 3) + 8 * j; const LAS float* s = scr + (8 * c) * 33 + n;
        u32x4 o; o.x = pk2(s[0 * 33], s[1 * 33]); o.y = pk2(s[2 * 33], s[3 * 33]); o.z = pk2(s[4 * 33], s[5 * 33]); o.w = pk2(s[6 * 33], s[7 * 33]);
        *(u32x4*)(WT + (size_t)(drow0 + n) * K + k0 + 8 * c) = o; }
    LDS_WAIT(); asm volatile("" ::: "memory");
}
__device__ __forceinline__ void p0_prologue(const Params& p, Frame& F) {
    LAS float* scr = (LAS float*)(F.lds + F.wave * 16384);
    constexpr int I_IN = 16 * 61, I_OUT = 16 * 32, I_G = 128, I_L = I_IN + I_OUT + 3 * 16 * I_G + 48 + 32 + 8;
    for (int it = F.gw; it < DEPTH * I_L; it += F.ngw) {
        const int l = it / I_L; int r = it % I_L;
        if (r < I_IN) { transpose_item(p.w_in + (size_t)l * D * INW, D, INW, F.win + (size_t)l * INP * D, r / 61, r % 61, 32 * (r % 61), scr, F.lane); continue; } r -= I_IN;
        if (r < I_OUT) { transpose_item(p.w_out + (size_t)l * D * D, D, D, F.wout + (size_t)l * D * D, r / 32, r % 32, 32 * (r % 32), scr, F.lane); continue; } r -= I_OUT;
        if (r < 16 * I_G) { const int e = r / I_G, q = r % I_G, nb = q % 8, n0 = 32 * nb;
            transpose_item(p.moe_w_gate + (size_t)(l * NE + e) * D * DE, D, DE, F.w1 + (size_t)(l * NE + e) * 512 * D, q / 8, nb, (n0 / 128) * 256 + (n0 % 128), scr, F.lane); continue; } r -= 16 * I_G;
        if (r < 16 * I_G) { const int e = r / I_G, q = r % I_G, nb = q % 8, n0 = 32 * nb;
            transpose_item(p.moe_w_up + (size_t)(l * NE + e) * D * DE, D, DE, F.w1 + (size_t)(l * NE + e) * 512 * D, q / 8, nb, (n0 / 128) * 256 + 128 + (n0 % 128), scr, F.lane); continue; } r -= 16 * I_G;
        if (r < 16 * I_G) { const int e = r / I_G, q = r % I_G;
            transpose_item(p.moe_w_down + (size_t)(l * NE + e) * DE * D, DE, D, F.w2 + (size_t)(l * NE + e) * D * DE, q / 32, q % 32, 32 * (q % 32), scr, F.lane); continue; } r -= 16 * I_G;
        if (r < 48) { transpose_item(p.mla_w_uq + (size_t)l * 256 * 384, 256, 384, F.wuq + (size_t)l * 384 * 256, r / 12, r % 12, 32 * (r % 12), scr, F.lane); continue; } r -= 48;
        if (r < 32) { transpose_item(p.mla_w_ukv + (size_t)l * 128 * 512, 128, 512, F.wukv + (size_t)l * 512 * 128, r / 16, r % 16, 32 * (r % 16), scr, F.lane); continue; } r -= 32;
        { const int g = r / 2, nb = r % 2; transpose_item(p.pool_w + (size_t)(l * 4 + g) * 4096, 64, 64, F.poolw + (size_t)(l * 4 + g) * 4096, 0, nb, 32 * nb, scr, F.lane); }
    }
    for (int i = F.gt; i < DEPTH * 4 * 128 * 128; i += F.ngt) F.sguw[i] = (bf16)f2bf(p.sgu_w[i]);
    for (int i = F.gt; i < DEPTH * (INP - INW) * D; i += F.ngt) { const int l = i / ((INP - INW) * D), q = i % ((INP - INW) * D); F.win[(size_t)l * INP * D + (size_t)INW * D + q] = 0; }
    for (int i = F.gt; i < SEQ * 16; i += F.ngt) {
        const int t = i >> 4, k = i & 15; const float pos = (float)((k < 8) ? (t >> 6) : (t & 63));
        const float inv = __builtin_powf(10000.0f, -(float)(k & 7) / 8.0f);
        const float ang = pos * inv; F.ropec[i] = cosf(ang); F.ropes[i] = sinf(ang);
    }
    for (int i = F.gt; i < DEPTH * 5 * NMOD * D; i += F.ngt) {
        const int l = i / (5 * NMOD * D), r = (i / (NMOD * D)) % 5, n = i % (NMOD * D);
        const float* v = (r < 4) ? p.c + r * D : p.c_ctx; const float* w = p.ada_w + (size_t)l * D * NMOD * D + n;
        float acc = p.ada_b[l * NMOD * D + n];
#pragma unroll 8
        for (int k = 0; k < D; ++k) acc += silu_f(v[k]) * w[(size_t)k * NMOD * D];
        F.mod[i] = acc;
    }
}

__device__ __forceinline__ int ybase_of(const Frame& F, int l, int e) {
    int b = 0;
    for (int j = 0; j < e; ++j) b += ((int)F.ctl[CW_CNT + (l * NE + j) * 64] + 255) & ~255;
    return b;
}

__device__ __forceinline__ void p1_rows(const Params& p, Frame& F, int l) {
    for (int r = F.gw; r < T; r += F.ngw) {
        const int mr = row_mod(r);
        f32x4 v[4];
        if (l == 0) { const float* src = (r < TL) ? p.x + (size_t)r * D : p.ctx + (size_t)(r - TL) * D;
#pragma unroll
            for (int j = 0; j < 4; ++j) v[j] = *(const f32x4*)(src + 4 * F.lane + 256 * j);
        } else {
            const i32x4 rt = *(const i32x4*)(F.route + 4 * r);
            const bf16* y0 = F.y + (size_t)(ybase_of(F, l - 1, rt.x) + rt.y) * D; const bf16* y1 = F.y + (size_t)(ybase_of(F, l - 1, rt.z) + rt.w) * D;
            const float* g5 = mod_vec(F, l - 1, mr, 5);
#pragma unroll
            for (int j = 0; j < 4; ++j) { const int c = 4 * F.lane + 256 * j; v[j] = *(const f32x4*)(F.xl + (size_t)r * D + c);
                const u32x2 a = *(const u32x2*)(y0 + c), b = *(const u32x2*)(y1 + c); const f32x4 g = *(const f32x4*)(g5 + c);
                v[j].x += g.x * (__uint_as_float(a.x << 16) + __uint_as_float(b.x << 16)); v[j].y += g.y * (__uint_as_float(a.x & 0xffff0000u) + __uint_as_float(b.x & 0xffff0000u));
                v[j].z += g.z * (__uint_as_float(a.y << 16) + __uint_as_float(b.y << 16)); v[j].w += g.w * (__uint_as_float(a.y & 0xffff0000u) + __uint_as_float(b.y & 0xffff0000u)); }
        }
        float ss = 0.f;
#pragma unroll
        for (int j = 0; j < 4; ++j) { *(f32x4*)(F.xl + (size_t)r * D + 4 * F.lane + 256 * j) = v[j]; ss += v[j].x * v[j].x + v[j].y * v[j].y + v[j].z * v[j].z + v[j].w * v[j].w; }
        const float rstd = rsqrtf(wave_sum(ss) * (1.f / D) + EPS);
        const float* g1 = p.norm1_g + l * D; const float* sh = mod_vec(F, l, mr, 0); const float* sc = mod_vec(F, l, mr, 1);
#pragma unroll
        for (int j = 0; j < 4; ++j) { const int c = 4 * F.lane + 256 * j; const f32x4 g = *(const f32x4*)(g1 + c), s = *(const f32x4*)(sh + c), q = *(const f32x4*)(sc + c);
            const float h0 = v[j].x * rstd * g.x * (1.f + q.x) + s.x, h1 = v[j].y * rstd * g.y * (1.f + q.y) + s.y, h2 = v[j].z * rstd * g.z * (1.f + q.z) + s.z, h3 = v[j].w * rstd * g.w * (1.f + q.w) + s.w;
            u32x2 o; o.x = pk2(h0, h1); o.y = pk2(h2, h3); *(u32x2*)(F.ha + (size_t)r * D + c) = o; }
    }
}

__device__ __forceinline__ void p2_inproj_naive(Frame& F, int l) {
    const bf16* W = F.win + (size_t)l * INP * D;
    for (long i = F.gt; i < (long)T * INW; i += F.ngt) { const int r = (int)(i / INW), c = (int)(i % INW);
        F.pl[(size_t)r * INP + c] = (bf16)f2bf(dot_bf16(F.ha + (size_t)r * D, W + (size_t)c * D, D)); }
}

__device__ __forceinline__ void p3_mla_up_naive(const Params& p, Frame& F, int l) {
    for (int r = F.gw; r < T; r += F.ngw) {
        const bf16* pr = F.pl + (size_t)r * INP + OFF_D;
        float a[4]; { const u32x2 t = *(const u32x2*)(pr + 4 * F.lane); a[0] = __uint_as_float(t.x << 16); a[1] = __uint_as_float(t.x & 0xffff0000u); a[2] = __uint_as_float(t.y << 16); a[3] = __uint_as_float(t.y & 0xffff0000u); }
        const float rq = rsqrtf(wave_sum(a[0] * a[0] + a[1] * a[1] + a[2] * a[2] + a[3] * a[3]) * (1.f / 256.f) + EPS);
        float b2[2]; { const unsigned t = *(const unsigned*)(pr + 256 + 2 * F.lane); b2[0] = __uint_as_float(t << 16); b2[1] = __uint_as_float(t & 0xffff0000u); }
        const float rkv = rsqrtf(wave_sum(b2[0] * b2[0] + b2[1] * b2[1]) * (1.f / 128.f) + EPS);
        LAS float* sq = (LAS float*)(F.lds + F.wave * 4096);
        const float* gq = p.mla_q_norm_g + l * 256; const float* gk = p.mla_kv_norm_g + l * 128;
#pragma unroll
        for (int j = 0; j < 4; ++j) sq[4 * F.lane + j] = a[j] * rq * gq[4 * F.lane + j];
        sq[256 + 2 * F.lane] = b2[0] * rkv * gk[2 * F.lane]; sq[256 + 2 * F.lane + 1] = b2[1] * rkv * gk[2 * F.lane + 1];
        LDS_WAIT(); asm volatile("" ::: "memory");
        const bool lat = r < TL; const int t = r & (SEQ - 1);
        for (int f = F.lane; f < 384; f += 64) {
            const int h = f / 96, j = f % 96;
            float val;
            const bf16* wrow = F.wuq + (size_t)l * 384 * 256;
            auto qdot = [&](int ff) { float s = 0.f; const bf16* w = wrow + (size_t)ff * 256; for (int k = 0; k < 256; ++k) s += sq[k] * bf2f(w[k]); return s; };
            if (j < 64 || !lat) val = qdot(f);
            else { const int i = j - 64; const int base = h * 96 + 64;
                const int q8 = i & 7, half = (i >> 3) & 1, axis = i >> 4;
                const float cs = F.ropec[t * 16 + axis * 8 + q8], sn = F.ropes[t * 16 + axis * 8 + q8];
                const float x1 = qdot(base + axis * 16 + q8), x2 = qdot(base + axis * 16 + 8 + q8);
                val = half ? (x1 * sn + x2 * cs) : (x1 * cs - x2 * sn); }
            F.qm[(size_t)r * 384 + f] = (bf16)f2bf(val * (MLA_SCALE * LOG2E));
        }
        for (int f = F.lane; f < 512; f += 64) {
            const int h = f / 128, j = f % 128; float s = 0.f; const bf16* w = F.wukv + (size_t)l * 512 * 128 + (size_t)f * 128;
            for (int k = 0; k < 128; ++k) s += sq[256 + k] * bf2f(w[k]);
            if (j < 64) F.km[(size_t)r * 384 + h * 96 + j] = (bf16)f2bf(s); else F.vm[(size_t)r * 256 + h * 64 + (j - 64)] = (bf16)f2bf(s);
        }
        if (F.lane < 32) { const int i = F.lane, q8 = i & 7, half = (i >> 3) & 1, axis = i >> 4;
            const float x1 = bf2f(pr[384 + axis * 16 + q8]), x2 = bf2f(pr[384 + axis * 16 + 8 + q8]);
            float val;
            if (lat) { const float cs = F.ropec[t * 16 + axis * 8 + q8], sn = F.ropes[t * 16 + axis * 8 + q8]; val = half ? (x1 * sn + x2 * cs) : (x1 * cs - x2 * sn); }
            else val = bf2f(pr[384 + i]);
#pragma unroll
            for (int h = 0; h < 4; ++h) F.km[(size_t)r * 384 + h * 96 + 64 + i] = (bf16)f2bf(val); }
        LDS_WAIT(); asm volatile("" ::: "memory");
    }
}
__device__ __forceinline__ void p3_pool_naive(const Params& p, Frame& F, int l) {
    for (int i = F.gt; i < T * 256; i += F.ngt) {
        const int r = i >> 8, col = i & 255, g = col >> 6, d = col & 63;
        const int L = r < TL ? SEQ : CTX, t = r < TL ? (r & (SEQ - 1)) : ((r - TL) & (CTX - 1)), seg0 = r - t;
        const int win = 2 << g; int lo = t - win / 2, hi = t - win / 2 + win; lo = lo < 0 ? 0 : lo; hi = hi > L ? L : hi;
        const float inv = 1.f / (float)(hi - lo);
        const bf16* wt = F.poolw + (size_t)(l * 4 + g) * 4096 + d * 64;
        float acc = 0.f;
        for (int c = 0; c < 64; ++c) { float m = 0.f; for (int s = lo; s < hi; ++s) m += bf2f(F.pl[(size_t)(seg0 + s) * INP + g * 64 + c]);
            const float df = m * inv - bf2f(F.pl[(size_t)r * INP + g * 64 + c]); acc += df * bf2f(wt[c]); }
        F.ml[(size_t)r * D + col] = (bf16)f2bf(acc * p.pool_s[l * 256 + col]);
    }
}
__device__ __forceinline__ void p3_sgu1_naive(const Params& p, Frame& F, int l) {
    bf16* vg = F.hid;
    for (int r = F.gw; r < T; r += F.ngw) {
        const bf16* pv = F.pl + (size_t)r * INP + OFF_C + 256;
        float a[4]; { const u32x2 t = *(const u32x2*)(pv + 4 * F.lane); a[0] = gelu_tanh(__uint_as_float(t.x << 16)); a[1] = gelu_tanh(__uint_as_float(t.x & 0xffff0000u)); a[2] = gelu_tanh(__uint_as_float(t.y << 16)); a[3] = gelu_tanh(__uint_as_float(t.y & 0xffff0000u)); }
        float ss = a[0] * a[0] + a[1] * a[1] + a[2] * a[2] + a[3] * a[3];
#pragma unroll
        for (int o = 1; o < 16; o <<= 1) ss += __shfl_xor(ss, o);
        const float rs = rsqrtf(ss * (1.f / 64.f) + EPS); const float* gn = p.sgu_norm_g + l * 256 + 4 * F.lane;
        u32x2 o; o.x = pk2(a[0] * rs * gn[0], a[1] * rs * gn[1]); o.y = pk2(a[2] * rs * gn[2], a[3] * rs * gn[3]);
        *(u32x2*)(vg + (size_t)r * 256 + 4 * F.lane) = o;
    }
}
__device__ __forceinline__ void p3_sgu2_naive(const Params& p, Frame& F, int l) {
    const bf16* vg = F.hid;
    for (int i = F.gt; i < T * 256; i += F.ngt) {
        const int r = i >> 8, col = i & 255, g = col >> 6, pp = r & 127, r0 = r - pp;
        const bf16* w = F.sguw + ((size_t)(l * 4 + g) * 128 + pp) * 128;
        float acc = p.sgu_b[(l * 4 + g) * 128 + pp];
        for (int q = 0; q < 128; ++q) acc += bf2f(w[q]) * bf2f(vg[(size_t)(r0 + q) * 256 + col]);
        const float u = gelu_tanh(bf2f(F.pl[(size_t)r * INP + OFF_C + col]));
        F.ml[(size_t)r * D + 512 + col] = (bf16)f2bf(u * acc);
    }
}
__device__ __forceinline__ void p3_na_naive(const Params& p, Frame& F, int l) {
    LAS float* pw = (LAS float*)(F.lds + 65536 + F.wave * 2048);
    for (int it = F.gw; it < T * 4; it += F.ngw) {
        const int r = it >> 2, h = it & 3; const bool lat = r < TL; const int b = row_batch(r);
        float q[64];
        { const bf16* qp = F.pl + (size_t)r * INP + OFF_B + h * 64;
#pragma unroll
          for (int j = 0; j < 8; ++j) { const u32x4 t = *(const u32x4*)(qp + 8 * j);
#pragma unroll
              for (int k = 0; k < 4; ++k) { q[8 * j + 2 * k] = __uint_as_float(t[k] << 16); q[8 * j + 2 * k + 1] = __uint_as_float(t[k] & 0xffff0000u); } } }
        const int t = r & (SEQ - 1), gr = t >> 6, gc = t & 63, jb = gc >> 4;
        int rs = gr - 4; rs = rs < 0 ? 0 : (rs > GH - 8 ? GH - 8 : rs);
        int wsq = gc - 8; wsq = wsq < 0 ? 0 : (wsq > GW - 16 ? GW - 16 : wsq);
        int cs = 16 * jb - 8; cs = cs < 0 ? 0 : (cs > GW - 16 ? GW - 16 : cs); cs = cs > GW - 32 ? GW - 32 : cs;
        const float* rpb = p.na_rpb + (size_t)(l * 4 + h) * 15 * 31;
        float s[8];
#pragma unroll
        for (int i = 0; i < 8; ++i) {
            const int k = F.lane + 64 * (i & 3); const bool win = i < 4;
            int keyrow; float bias = 0.f; bool valid = true;
            if (win) { const int rr = k >> 5, cc = k & 31, kcol = cs + cc; keyrow = b * SEQ + (rs + rr) * 64 + kcol;
                valid = lat && (kcol >= wsq) && (kcol < wsq + 16);
                int dc = kcol - gc + 15; dc = dc < 0 ? 0 : (dc > 30 ? 30 : dc);
                bias = rpb[(rs + rr - gr + 7) * 31 + dc];
                if (!lat) keyrow = r; }
            else keyrow = TL + b * CTX + k;
            const bf16* kp = F.pl + (size_t)keyrow * INP + OFF_B + 256 + h * 64;
            float d = 0.f;
#pragma unroll
            for (int j = 0; j < 8; ++j) { const u32x4 tt = *(const u32x4*)(kp + 8 * j);
#pragma unroll
                for (int kk = 0; kk < 4; ++kk) d += q[8 * j + 2 * kk] * __uint_as_float(tt[kk] << 16) + q[8 * j + 2 * kk + 1] * __uint_as_float(tt[kk] & 0xffff0000u); }
            s[i] = valid ? (d * 0.125f + bias) : -1e30f;
        }
        float m = s[0];
#pragma unroll
        for (int i = 1; i < 8; ++i) m = fmaxf(m, s[i]);
        m = wave_max(m);
        float sum = 0.f;
#pragma unroll
        for (int i = 0; i < 8; ++i) { s[i] = __expf(s[i] - m); sum += s[i]; }
        sum = wave_sum(sum); const float inv = 1.f / sum;
#pragma unroll
        for (int i = 0; i < 8; ++i) pw[(i >> 2) * 256 + F.lane + 64 * (i & 3)] = s[i] * inv;
        LDS_WAIT(); asm volatile("" ::: "memory");
        float acc = 0.f;
        if (lat) for (int k = 0; k < 256; ++k) { const int rr = k >> 5, cc = k & 31; const int keyrow = b * SEQ + (rs + rr) * 64 + cs + cc;
            acc += pw[k] * bf2f(F.pl[(size_t)keyrow * INP + OFF_B + 512 + h * 64 + F.lane]); }
        for (int k = 0; k < 256; ++k) acc += pw[256 + k] * bf2f(F.pl[(size_t)(TL + b * CTX + k) * INP + OFF_B + 512 + h * 64 + F.lane]);
        F.ml[(size_t)r * D + 256 + h * 64 + F.lane] = (bf16)f2bf(acc);
        LDS_WAIT(); asm volatile("" ::: "memory");
    }
}
__device__ __forceinline__ void p4_mla_naive(Frame& F) {
    LAS float* pw = (LAS float*)(F.lds + 65536 + F.wave * 2048);
    for (int it = F.gw; it < T * 4; it += F.ngw) {
        const int r = it >> 2, h = it & 3; const bool lat = r < TL; const int b = row_batch(r);
        float q[96];
        { const bf16* qp = F.qm + (size_t)r * 384 + h * 96;
#pragma unroll
          for (int j = 0; j < 12; ++j) { const u32x4 t = *(const u32x4*)(qp + 8 * j);
#pragma unroll
              for (int k = 0; k < 4; ++k) { q[8 * j + 2 * k] = __uint_as_float(t[k] << 16); q[8 * j + 2 * k + 1] = __uint_as_float(t[k] & 0xffff0000u); } } }
        const int nk = lat ? (CTX + SEQ) : CTX;
        float m = -3.0e38f, lsum = 0.f, acc = 0.f;
        for (int k0 = 0; k0 < nk; k0 += 64) {
            const int k = k0 + F.lane; const int keyrow = (k < CTX) ? (TL + b * CTX + k) : (b * SEQ + k - CTX);
            const bf16* kp = F.km + (size_t)keyrow * 384 + h * 96;
            float d = 0.f;
#pragma unroll
            for (int j = 0; j < 12; ++j) { const u32x4 tt = *(const u32x4*)(kp + 8 * j);
#pragma unroll
                for (int kk = 0; kk < 4; ++kk) d += q[8 * j + 2 * kk] * __uint_as_float(tt[kk] << 16) + q[8 * j + 2 * kk + 1] * __uint_as_float(tt[kk] & 0xffff0000u); }
            const float mn = fmaxf(m, wave_max(d)); const float alpha = exp2f(m - mn); const float pe = exp2f(d - mn);
            lsum = lsum * alpha + wave_sum(pe); acc *= alpha; m = mn;
            pw[F.lane] = pe; LDS_WAIT(); asm volatile("" ::: "memory");
            for (int kk = 0; kk < 64; ++kk) { const int k2 = k0 + kk; const int kr2 = (k2 < CTX) ? (TL + b * CTX + k2) : (b * SEQ + k2 - CTX);
                acc += pw[kk] * bf2f(F.vm[(size_t)kr2 * 256 + h * 64 + F.lane]); }
            LDS_WAIT(); asm volatile("" ::: "memory");
        }
        F.ml[(size_t)r * D + 768 + h * 64 + F.lane] = (bf16)f2bf(acc / lsum);
    }
}

__device__ __forceinline__ void p5_outproj_naive(Frame& F, int l) {
    const bf16* W = F.wout + (size_t)l * D * D;
    for (long i = F.gt; i < (long)T * D; i += F.ngt) { const int r = (int)(i >> 10), c = (int)(i & 1023);
        const float g = mod_vec(F, l, row_mod(r), 2)[c];
        F.xl[(size_t)r * D + c] += g * dot_bf16(F.ml + (size_t)r * D, W + (size_t)c * D, D); }
}

__device__ __forceinline__ void p6_rows(const Params& p, Frame& F, int l) {
    for (int r = F.gw; r < T; r += F.ngw) {
        const int mr = row_mod(r);
        f32x4 v[4]; float ss = 0.f;
#pragma unroll
        for (int j = 0; j < 4; ++j) { v[j] = *(const f32x4*)(F.xl + (size_t)r * D + 4 * F.lane + 256 * j); ss += v[j].x * v[j].x + v[j].y * v[j].y + v[j].z * v[j].z + v[j].w * v[j].w; }
        const float rstd = rsqrtf(wave_sum(ss) * (1.f / D) + EPS);
        const float* g2 = p.norm2_g + l * D; const float* sh = mod_vec(F, l, mr, 3); const float* sc = mod_vec(F, l, mr, 4);
        float lg[16];
#pragma unroll
        for (int e = 0; e < 16; ++e) lg[e] = 0.f;
#pragma unroll
        for (int j = 0; j < 4; ++j) { const int c = 4 * F.lane + 256 * j; const f32x4 g = *(const f32x4*)(g2 + c), s = *(const f32x4*)(sh + c), q = *(const f32x4*)(sc + c);
            float hh[4]; hh[0] = v[j].x * rstd * g.x * (1.f + q.x) + s.x; hh[1] = v[j].y * rstd * g.y * (1.f + q.y) + s.y; hh[2] = v[j].z * rstd * g.z * (1.f + q.z) + s.z; hh[3] = v[j].w * rstd * g.w * (1.f + q.w) + s.w;
            u32x2 o; o.x = pk2(hh[0], hh[1]); o.y = pk2(hh[2], hh[3]); *(u32x2*)(F.ha + (size_t)r * D + c) = o;
#pragma unroll
            for (int i = 0; i < 4; ++i) { const float* rw = p.router_w + (size_t)(c + i) * NE;
#pragma unroll
                for (int e4 = 0; e4 < 4; ++e4) { const f32x4 w = *(const f32x4*)(rw + 4 * e4); lg[4 * e4] += hh[i] * w.x; lg[4 * e4 + 1] += hh[i] * w.y; lg[4 * e4 + 2] += hh[i] * w.z; lg[4 * e4 + 3] += hh[i] * w.w; } } }
        float sc16[16], bi[16];
#pragma unroll
        for (int e = 0; e < 16; ++e) { const float t = wave_sum(lg[e]); sc16[e] = 1.f / (1.f + __expf(-t)); bi[e] = sc16[e] + p.router_b[e]; }
        int sg = 0; float best = -3.0e38f;
#pragma unroll
        for (int g = 0; g < 4; ++g) { float m1 = -3.0e38f, m2 = -3.0e38f;
#pragma unroll
            for (int j = 0; j < 4; ++j) { const float x = bi[4 * g + j]; if (x > m1) { m2 = m1; m1 = x; } else if (x > m2) m2 = x; }
            const float gs = m1 + m2; if (gs > best) { best = gs; sg = g; } }
        int i0 = 0, i1 = 0; float b0 = -3.0e38f, b1 = -3.0e38f, s0 = 0.f, s1 = 0.f;
#pragma unroll
        for (int e = 0; e < 16; ++e) { if ((e >> 2) == sg) { const float x = bi[e]; if (x > b0) { b1 = b0; i1 = i0; s1 = s0; b0 = x; i0 = e; s0 = sc16[e]; } else if (x > b1) { b1 = x; i1 = e; s1 = sc16[e]; } } }
        const float ws = s0 + s1; const float w0 = s0 / ws, w1 = s1 / ws;
        if (F.lane == 0) {
            const int sl0 = (int)atomicAdd(&F.ctl[CW_CNT + (l * NE + i0) * 64], 1u); const int sl1 = (int)atomicAdd(&F.ctl[CW_CNT + (l * NE + i1) * 64], 1u);
            F.tok[i0 * CAP + sl0] = r; F.wl[i0 * CAP + sl0] = w0; F.tok[i1 * CAP + sl1] = r; F.wl[i1 * CAP + sl1] = w1;
            i32x4 rt; rt.x = i0; rt.y = sl0; rt.z = i1; rt.w = sl1; *(i32x4*)(F.route + 4 * r) = rt;
        }
    }
}

__device__ __forceinline__ void p7_moe1_naive(Frame& F, int l) {
    for (long i = F.gt; i < (long)T * 2 * DE; i += F.ngt) {
        const int a = (int)(i >> 8), f = (int)(i & 255), tokr = a >> 1, wh = a & 1;
        const int e = F.route[4 * tokr + 2 * wh], sl = F.route[4 * tokr + 2 * wh + 1];
        const bf16* W = F.w1 + (size_t)(l * NE + e) * 512 * D; const int grow = (f >> 7) * 256 + (f & 127);
        const float g = dot_bf16(F.ha + (size_t)tokr * D, W + (size_t)grow * D, D), u = dot_bf16(F.ha + (size_t)tokr * D, W + (size_t)(grow + 128) * D, D);
        F.hid[(size_t)(ybase_of(F, l, e) + sl) * DE + f] = (bf16)f2bf(F.wl[e * CAP + sl] * silu_f(g) * u);
    }
}
__device__ __forceinline__ void p8_moe2_naive(Frame& F, int l) {
    for (long i = F.gt; i < (long)T * 2 * D; i += F.ngt) {
        const int a = (int)(i >> 10), n = (int)(i & 1023), tokr = a >> 1, wh = a & 1;
        const int e = F.route[4 * tokr + 2 * wh], sl = F.route[4 * tokr + 2 * wh + 1]; const size_t pr = (size_t)(ybase_of(F, l, e) + sl);
        F.y[pr * D + n] = (bf16)f2bf(dot_bf16(F.hid + pr * DE, F.w2 + ((size_t)(l * NE + e) * D + n) * DE, DE));
    }
}

__device__ __forceinline__ void p9_final(const Params& p, Frame& F) {
    const int l = DEPTH - 1;
    for (int r = F.gw; r < TL; r += F.ngw) {
        const i32x4 rt = *(const i32x4*)(F.route + 4 * r);
        const bf16* y0 = F.y + (size_t)(ybase_of(F, l, rt.x) + rt.y) * D; const bf16* y1 = F.y + (size_t)(ybase_of(F, l, rt.z) + rt.w) * D;
        const float* g5 = mod_vec(F, l, row_mod(r), 5);
        f32x4 v[4]; float ss = 0.f;
#pragma unroll
        for (int j = 0; j < 4; ++j) { const int c = 4 * F.lane + 256 * j; v[j] = *(const f32x4*)(F.xl + (size_t)r * D + c);
            const u32x2 a = *(const u32x2*)(y0 + c), b = *(const u32x2*)(y1 + c); const f32x4 g = *(const f32x4*)(g5 + c);
            v[j].x += g.x * (__uint_as_float(a.x << 16) + __uint_as_float(b.x << 16)); v[j].y += g.y * (__uint_as_float(a.x & 0xffff0000u) + __uint_as_float(b.x & 0xffff0000u));
            v[j].z += g.z * (__uint_as_float(a.y << 16) + __uint_as_float(b.y << 16)); v[j].w += g.w * (__uint_as_float(a.y & 0xffff0000u) + __uint_as_float(b.y & 0xffff0000u));
            ss += v[j].x * v[j].x + v[j].y * v[j].y + v[j].z * v[j].z + v[j].w * v[j].w; }
        const float rstd = rsqrtf(wave_sum(ss) * (1.f / D) + EPS);
#pragma unroll
        for (int j = 0; j < 4; ++j) { const int c = 4 * F.lane + 256 * j; const f32x4 g = *(const f32x4*)(p.final_g + c);
            f32x4 o; o.x = v[j].x * rstd * g.x; o.y = v[j].y * rstd * g.y; o.z = v[j].z * rstd * g.z; o.w = v[j].w * rstd * g.w;
            *(f32x4*)(p.out + (size_t)r * D + c) = o; }
    }
}

constexpr int PH_FINAL = 1 + 10 * DEPTH, N_PHASES = PH_FINAL + 1;
__global__ void __launch_bounds__(NTHR, 2) fwd(Params p) {
    extern __shared__ __attribute__((aligned(16))) unsigned char lds_raw[];
    Frame F;
    F.lds = (LAS unsigned char*)lds_raw;
    F.tid = threadIdx.x; F.lane = F.tid & 63; F.wave = __builtin_amdgcn_readfirstlane(F.tid >> 6);
    F.gw = blockIdx.x * NWAVES + F.wave; F.ngw = gridDim.x * NWAVES; F.gt = blockIdx.x * NTHR + F.tid; F.ngt = gridDim.x * NTHR;
    unsigned char* ws = p.ws;
    F.ctl = (unsigned*)(ws + WS_CTL); F.mod = (float*)(ws + WS_MOD); F.ropec = (float*)(ws + WS_ROPE); F.ropes = F.ropec + SEQ * 16;
    F.route = (int*)(ws + WS_ROUTE); F.tok = (int*)(ws + WS_TOK); F.wl = (float*)(ws + WS_WL);
    F.wuq = (bf16*)(ws + WS_WUQ); F.wukv = (bf16*)(ws + WS_WUKV); F.poolw = (bf16*)(ws + WS_POOLW); F.sguw = (bf16*)(ws + WS_SGUW);
    F.win = (bf16*)(ws + WS_WIN); F.wout = (bf16*)(ws + WS_WOUT); F.w1 = (bf16*)(ws + WS_W1); F.w2 = (bf16*)(ws + WS_W2);
    F.xl = (float*)(ws + WS_XL); F.ha = (bf16*)(ws + WS_HA); F.pl = (bf16*)(ws + WS_PL); F.y = (bf16*)(ws + WS_Y);
    F.qm = (bf16*)(ws + WS_QM); F.km = (bf16*)(ws + WS_KM); F.vm = (bf16*)(ws + WS_VM); F.ml = (bf16*)(ws + WS_ML); F.hid = (bf16*)(ws + WS_HID);
    volatile LAS unsigned* MISC = (volatile LAS unsigned*)(F.lds + MISC_OFF);
    for (int u = F.tid; u < 32; u += NTHR) MISC[u] = 0u;
    __syncthreads();
#if MK_ONE_LAUNCH
    XcdBarrier bar = xcd_barrier_post(F.ctl + CW_BAR, MISC + 8);
#define GRID_BAR() xcd_barrier(bar)
#else
#define GRID_BAR() do {} while (0)
#endif
    const int lo = p.ph_lo, hi = p.ph_hi;
#define IN(k) (lo <= (k) && (k) < hi)
#define SEAM(k) do { if (IN((k) + 1)) GRID_BAR(); } while (0)
    if (IN(0)) { p0_prologue(p, F); SEAM(0); }
    for (int l = 0; l < DEPTH; ++l) {
        const int pb = 1 + 10 * l;
        if (IN(pb + 0)) { p1_rows(p, F, l); SEAM(pb + 0); }
        if (IN(pb + 1)) { p2_inproj_naive(F, l); SEAM(pb + 1); }
        if (IN(pb + 2)) { p3_mla_up_naive(p, F, l); p3_pool_naive(p, F, l); p3_sgu1_naive(p, F, l); p3_na_naive(p, F, l); SEAM(pb + 2); }
        if (IN(pb + 3)) { p3_sgu2_naive(p, F, l); SEAM(pb + 3); }
        if (IN(pb + 4)) { p4_mla_naive(F); SEAM(pb + 4); }
        if (IN(pb + 5)) { p5_outproj_naive(F, l); SEAM(pb + 5); }
        if (IN(pb + 6)) { p6_rows(p, F, l); SEAM(pb + 6); }
        if (IN(pb + 7)) { p7_moe1_naive(F, l); SEAM(pb + 7); }
        if (IN(pb + 8)) { p8_moe2_naive(F, l); if (l + 1 < DEPTH) { if (IN(pb + 10)) GRID_BAR(); } else SEAM(PH_FINAL - 1); }
    }
    if (IN(PH_FINAL)) p9_final(p, F);
}

extern "C" void kernel_launch(void* const* d_in, const int* in_sizes, int n_in, void* d_out, int out_size, void* d_ws, size_t ws_size, hipStream_t stream) {
    static int grid = 0;
    if (grid == 0) {
        if (n_in != 26 || out_size != TL * D || ws_size < WS_END) { fprintf(stderr, "kernel_launch: unexpected shapes: n_in %d out %d ws %zu (need %zu)\n", n_in, out_size, ws_size, (size_t)WS_END); grid = -1; return; }
        int dev = 0, cus = 0, per_cu = 0;
        if (hipGetDevice(&dev) != hipSuccess || hipDeviceGetAttribute(&cus, hipDeviceAttributeMultiprocessorCount, dev) != hipSuccess) { grid = -1; return; }
        if (hipFuncSetAttribute((const void*)fwd, hipFuncAttributeMaxDynamicSharedMemorySize, LDS_BYTES) != hipSuccess) { fprintf(stderr, "kernel_launch: hipFuncSetAttribute failed\n"); grid = -1; return; }
        if (hipOccupancyMaxActiveBlocksPerMultiprocessor(&per_cu, (const void*)fwd, NTHR, LDS_BYTES) != hipSuccess || per_cu < 1) fprintf(stderr, "kernel_launch: occupancy query says %d\n", per_cu);
        (void)hipGetLastError();
        grid = cus;
    }
    if (grid < 0) return;
    (void)hipMemsetAsync((char*)d_ws + WS_CTL, 0, CTL_ZERO_BYTES, stream);
    Params p{};
    const float** pp = (const float**)&p;
    for (int i = 0; i < 26; ++i) pp[i] = (const float*)d_in[i];
    p.out = (float*)d_out; p.ws = (unsigned char*)d_ws;
#if MK_ONE_LAUNCH
    p.ph_lo = 0; p.ph_hi = N_PHASES;
    hipLaunchKernelGGL(fwd, dim3(grid), dim3(NTHR), LDS_BYTES, stream, p);
#else
    for (int ph = 0; ph < N_PHASES; ++ph) {
        const int k = (ph - 1) % 10;
        if (ph > 0 && ph < PH_FINAL && k == 9) continue;
        p.ph_lo = ph; p.ph_hi = ph + 1;
        hipLaunchKernelGGL(fwd, dim3(grid), dim3(NTHR), LDS_BYTES, stream, p);
    }
#endif
}
```

```cpp
#include <hip/hip_runtime.h>
#include <cstdio>
#include <cstdint>

#ifndef MK_ONE_LAUNCH
#define MK_ONE_LAUNCH 1
#endif

#ifndef FAST_MLA
#define FAST_MLA 1
#endif
#ifndef FAST_GEMM
#define FAST_GEMM 0xF
#endif

#define GAS __attribute__((address_space(1)))
#define LAS __attribute__((address_space(3)))
typedef unsigned short bf16;
typedef float f32x4 __attribute__((ext_vector_type(4)));
typedef unsigned u32x4 __attribute__((ext_vector_type(4)));
typedef unsigned u32x2 __attribute__((ext_vector_type(2)));
typedef int i32x4 __attribute__((ext_vector_type(4)));
typedef short bf16x8 __attribute__((ext_vector_type(8)));

constexpr int D = 1024, NB = 4, SEQ = 4096, DEPTH = 4, CTX = 256, GW = 64, GH = 64;
constexpr int TL = NB * SEQ, TC = NB * CTX, T = TL + TC;
constexpr int INW = 1952, INP = 2048;
constexpr int OFF_B = 256, OFF_C = 1024, OFF_D = 1536;
constexpr int NE = 16, DE = 256, CAP = T;
constexpr int RPAD = 2 * T + NE * 256;
constexpr int NMOD = 6;
constexpr float EPS = 1e-6f;
constexpr float LOG2E = 1.4426950408889634f;
constexpr float MLA_SCALE = 0.10206207261596575f;
constexpr int NWAVES = 8, NTHR = NWAVES * 64;

constexpr size_t MiB = 1u << 20;
constexpr size_t WS_CTL = 0, CTL_ZERO_BYTES = 1 * MiB;
constexpr size_t WS_MOD = 1 * MiB;
constexpr size_t WS_ROPE = 2 * MiB;
constexpr size_t WS_ROUTE = 3 * MiB;
constexpr size_t WS_TOK = 4 * MiB;
constexpr size_t WS_WL = 6 * MiB;
constexpr size_t WS_WUQ = 8 * MiB;
constexpr size_t WS_WUKV = 9 * MiB;
constexpr size_t WS_POOLW = 10 * MiB;
constexpr size_t WS_SGUW = 10 * MiB + 512 * 1024;
constexpr size_t WS_WIN = 12 * MiB;
constexpr size_t WS_WOUT = 28 * MiB;
constexpr size_t WS_W1 = 36 * MiB;
constexpr size_t WS_W2 = 100 * MiB;
constexpr size_t WS_XL = 132 * MiB;
constexpr size_t WS_HA = 200 * MiB;
constexpr size_t WS_PL = 234 * MiB;
constexpr size_t WS_Y = 234 * MiB;
constexpr size_t WS_HS = WS_Y;
constexpr size_t WS_QM = 302 * MiB;
constexpr size_t WS_KM = 315 * MiB;
constexpr size_t WS_VM = 328 * MiB;
constexpr size_t WS_ML = 337 * MiB;
constexpr size_t WS_HID = 371 * MiB;
constexpr size_t WS_END = 390 * MiB;
static_assert(WS_Y + (size_t)RPAD * D * 2 <= WS_KM && WS_HID + (size_t)RPAD * DE * 2 <= WS_END, "ws map");

constexpr int CW_TMO = 0;
constexpr int CW_BAR = 4096;
constexpr int CW_CNT = 8192;

constexpr int LDS_BYTES = 147456;
constexpr int MISC_OFF = 131072 + 320;
constexpr int MOETAB_OFF = 131072 + 1024;

__device__ __forceinline__ float bf2f(bf16 v) { return __uint_as_float(((unsigned)v) << 16); }
__device__ __forceinline__ unsigned f2bf(float f) { unsigned u = __float_as_uint(f); return (u + 0x7fffu + ((u >> 16) & 1u)) >> 16; }
__device__ __forceinline__ unsigned pk2(float lo, float hi) { return f2bf(lo) | (f2bf(hi) << 16); }
__device__ __forceinline__ float wave_sum(float v) {
#pragma unroll
    for (int o = 1; o < 64; o <<= 1) v += __shfl_xor(v, o);
    return v;
}
__device__ __forceinline__ float wave_max(float v) {
#pragma unroll
    for (int o = 1; o < 64; o <<= 1) v = fmaxf(v, __shfl_xor(v, o));
    return v;
}
__device__ __forceinline__ float silu_f(float x) { return x / (1.f + __expf(-x)); }
__device__ __forceinline__ float gelu_tanh(float x) { const float u = 0.7978845608028654f * (x + 0.044715f * x * x * x); return 0.5f * x * (1.f + tanhf(u)); }
__device__ __forceinline__ float dot_bf16(const bf16* a, const bf16* b, int K) {
    float s = 0.f;
    for (int k = 0; k < K; k += 8) {
        const u32x4 av = *(const u32x4*)(a + k), bv = *(const u32x4*)(b + k);
#pragma unroll
        for (int j = 0; j < 4; ++j) {
            s += __uint_as_float(av[j] << 16) * __uint_as_float(bv[j] << 16);
            s += __uint_as_float(av[j] & 0xffff0000u) * __uint_as_float(bv[j] & 0xffff0000u);
        }
    }
    return s;
}
#define LDS_WAIT() asm volatile("s_waitcnt lgkmcnt(0)" ::: "memory")

#define XB_TMO      128
#define XB_XCNT(j)  (256  + 64 * (j))
#define XB_XSUB(j)  (1280 + 64 * (j))
#define XB_XGEN(j)  (2304 + 64 * (j))
#define XB_TOP      3328
#define XB_TOPGEN   3392
#define XCD_BAR_WORDS 3456
#define XB_SPIN_CAP (1u << 18)
__device__ __forceinline__ unsigned xb_ld(unsigned* p)              { return __hip_atomic_load(p, __ATOMIC_RELAXED, __HIP_MEMORY_SCOPE_AGENT); }
__device__ __forceinline__ unsigned xb_add(unsigned* p, unsigned v) { return __hip_atomic_fetch_add(p, v, __ATOMIC_RELAXED, __HIP_MEMORY_SCOPE_AGENT); }
__device__ __forceinline__ unsigned xb_xcc_id() { return (unsigned)__builtin_amdgcn_s_getreg((3 << 11) | 20) & 0xFu; }
#define XB_SPIN(cond, bar) do { unsigned _sp = 0; while (cond) { __builtin_amdgcn_s_sleep(1); \
    if ((++_sp & 255u) == 0u) { if (xb_ld(&(bar)[XB_TMO])) break; if (_sp > XB_SPIN_CAP) { atomicAdd(&(bar)[XB_TMO], 1u); break; } } } } while (0)
struct XcdBarrier { unsigned* bar; unsigned x; volatile LAS unsigned* st; };
__device__ __forceinline__ XcdBarrier xcd_barrier_post(unsigned* bar, volatile LAS unsigned* st) {
    XcdBarrier b; b.bar = bar; b.x = xb_xcc_id(); b.st = st;
    if (threadIdx.x == 0) (void)xb_add(&bar[XB_XCNT(b.x)], 1u);
    return b;
}
__device__ __forceinline__ void xcd_barrier_complete(unsigned* bar, unsigned x, unsigned& nloc, unsigned& nx) {
    const unsigned G = gridDim.x * gridDim.y * gridDim.z;
    unsigned sum, cnt, mine, sp = 0u;
    for (;;) {
        sum = 0u; cnt = 0u; mine = 0u;
#pragma unroll
        for (unsigned j = 0; j < 16; ++j) { const unsigned c = xb_ld(&bar[XB_XCNT(j)]); sum += c; cnt += (c > 0u) ? 1u : 0u; mine = (j == x) ? c : mine; }
        if (sum == G) break;
        __builtin_amdgcn_s_sleep(1);
        if ((++sp & 255u) == 0u) { if (xb_ld(&bar[XB_TMO])) break; if (sp > XB_SPIN_CAP) { atomicAdd(&bar[XB_TMO], 1u); break; } }
    }
    nloc = mine > 0u ? mine : 1u; nx = cnt > 0u ? cnt : 1u;
}
__device__ __forceinline__ void xcd_barrier(const XcdBarrier& b) {
    asm volatile("s_waitcnt vmcnt(0)" ::: "memory");
    __syncthreads();
    if (threadIdx.x == 0) {
        unsigned* bar = b.bar;
        __builtin_amdgcn_s_waitcnt(0);
        unsigned nloc = b.st[0], nx = b.st[1];
        if (nloc == 0u) { xcd_barrier_complete(bar, b.x, nloc, nx); b.st[0] = nloc; b.st[1] = nx; }
        const unsigned old = xb_add(&bar[XB_XSUB(b.x)], 1u);
        const unsigned gen = old / nloc;
        if (old + 1u == (gen + 1u) * nloc) {
            __builtin_amdgcn_fence(__ATOMIC_RELEASE, "agent");
            asm volatile("s_waitcnt vmcnt(0)" ::: "memory");
            const unsigned og = xb_add(&bar[XB_TOP], 1u);
            const unsigned tg = og / nx;
            if (og + 1u == (tg + 1u) * nx) xb_add(&bar[XB_TOPGEN], 1u);
            else XB_SPIN(xb_ld(&bar[XB_TOPGEN]) == tg, bar);
            __builtin_amdgcn_fence(__ATOMIC_ACQUIRE, "agent");
            xb_add(&bar[XB_XGEN(b.x)], 1u);
            asm volatile("s_waitcnt vmcnt(0)" ::: "memory");
        } else {
            XB_SPIN(xb_ld(&bar[XB_XGEN(b.x)]) == gen, bar);
            __builtin_amdgcn_fence(__ATOMIC_ACQUIRE, "agent");
            asm volatile("s_waitcnt vmcnt(0)" ::: "memory");
        }
    }
    __syncthreads();
}

struct Params {
    const float *x, *c, *ctx, *c_ctx, *ada_w, *ada_b, *norm1_g, *norm2_g, *w_in, *w_out, *pool_w, *pool_s, *na_rpb,
                *sgu_norm_g, *sgu_w, *sgu_b, *mla_q_norm_g, *mla_w_uq, *mla_kv_norm_g, *mla_w_ukv,
                *router_w, *router_b, *moe_w_gate, *moe_w_up, *moe_w_down, *final_g;
    float* out; unsigned char* ws; int ph_lo, ph_hi;
};
typedef const __attribute__((address_space(4))) Params& CPR;
struct Frame {
    LAS unsigned char* lds; unsigned char* ws;
    int tid, lane, wave, gw, ngw, gt, ngt;
    __device__ __forceinline__ unsigned* ctl() const { return (unsigned*)(ws + WS_CTL); }
    __device__ __forceinline__ float* mod() const { return (float*)(ws + WS_MOD); }
    __device__ __forceinline__ float* ropec() const { return (float*)(ws + WS_ROPE); }
    __device__ __forceinline__ float* ropes() const { return (float*)(ws + WS_ROPE) + SEQ * 16; }
    __device__ __forceinline__ int* route() const { return (int*)(ws + WS_ROUTE); }
    __device__ __forceinline__ int* tok() const { return (int*)(ws + WS_TOK); }
    __device__ __forceinline__ float* wl() const { return (float*)(ws + WS_WL); }
    __device__ __forceinline__ bf16* wuq() const { return (bf16*)(ws + WS_WUQ); }
    __device__ __forceinline__ bf16* wukv() const { return (bf16*)(ws + WS_WUKV); }
    __device__ __forceinline__ bf16* poolw() const { return (bf16*)(ws + WS_POOLW); }
    __device__ __forceinline__ bf16* sguw() const { return (bf16*)(ws + WS_SGUW); }
    __device__ __forceinline__ bf16* win() const { return (bf16*)(ws + WS_WIN); }
    __device__ __forceinline__ bf16* wout() const { return (bf16*)(ws + WS_WOUT); }
    __device__ __forceinline__ bf16* w1() const { return (bf16*)(ws + WS_W1); }
    __device__ __forceinline__ bf16* w2() const { return (bf16*)(ws + WS_W2); }
    __device__ __forceinline__ bf16* ha() const { return (bf16*)(ws + WS_HA); }
    __device__ __forceinline__ bf16* pl() const { return (bf16*)(ws + WS_PL); }
    __device__ __forceinline__ bf16* y() const { return (bf16*)(ws + WS_Y); }
    __device__ __forceinline__ bf16* hs() const { return (bf16*)(ws + WS_HS); }
    __device__ __forceinline__ bf16* qm() const { return (bf16*)(ws + WS_QM); }
    __device__ __forceinline__ bf16* km() const { return (bf16*)(ws + WS_KM); }
    __device__ __forceinline__ bf16* vm() const { return (bf16*)(ws + WS_VM); }
    __device__ __forceinline__ bf16* ml() const { return (bf16*)(ws + WS_ML); }
    __device__ __forceinline__ bf16* hid() const { return (bf16*)(ws + WS_HID); }
    __device__ __forceinline__ float* xl() const { return (float*)(ws + WS_XL); }
};
__device__ __forceinline__ int row_batch(int r) { return r < TL ? (r >> 12) : ((r - TL) >> 8); }
__device__ __forceinline__ int row_mod(int r) { return r < TL ? (r >> 12) : 4; }
__device__ __forceinline__ const float* mod_vec(const Frame& F, int l, int mr, int k) { return F.mod() + ((size_t)(l * 5 + mr) * NMOD + k) * D; }

namespace pg8 {
constexpr int BM = 256, BK = 64, HALF = 128, HTB = HALF * BK * 2, NXCD = 8, WGM = 8;
__host__ __device__ __forceinline__ int lds_byte(int r, int c) { const int st = (r >> 4) * 2 + (c >> 5), rr = r & 15, cc = c & 31, ob = rr * 64 + cc * 2; return st * 1024 + (ob ^ (((ob >> 9) & 1) << 5)); }
__host__ __device__ __forceinline__ void stage_rc(int b, int& R, int& C) { const int st = b / 1024, sb = b % 1024, swz = sb ^ (((sb >> 9) & 1) << 5); R = (st >> 1) * 16 + swz / 64; C = (st & 1) * 32 + (swz % 64) / 2; }
__host__ __device__ __forceinline__ int perm32(int rho) { const int n = rho >> 4, i = rho & 15; return 8 * (i >> 2) + 4 * n + (i & 3); }
struct Unit { int pm, pn, ex, slot0, cnt; };
struct StaticOrder {
    static constexpr bool GATHER = false;
    int nM, nN, nwg, G, c, K;
    __device__ __forceinline__ void init(int M, int N, int K_, int G_, int c_) { nM = M / BM; nN = N / BM; nwg = nM * nN; G = G_; c = c_; K = K_; }
    __device__ __forceinline__ bool next(int i, Unit& u) const {
        const long L = (long)i * G + c; if (L >= nwg) return false;
        int wgid = (int)L; { const int q = nwg / NXCD, r = nwg % NXCD, xcd = wgid % NXCD, off = wgid / NXCD; wgid = (xcd < r ? xcd * (q + 1) : r * (q + 1) + (xcd - r) * q) + off; }
        const int nig = WGM * nN, gid = wgid / nig, fm = gid * WGM, gsz = (nM - fm) < WGM ? (nM - fm) : WGM;
        u.pm = fm + ((wgid % nig) % gsz); u.pn = (wgid % nig) / gsz; u.ex = 0; u.slot0 = 0; u.cnt = 256; return true;
    }
    __device__ __forceinline__ size_t a_off(const Unit& u) const { return (size_t)u.pm * 256 * K * 2; }
    __device__ __forceinline__ size_t b_off(const Unit& u) const { return (size_t)u.pn * 256 * K * 2; }
    __device__ __forceinline__ unsigned row_off(const Unit&, int) const { return 0u; }
};
template <bool GATHER_, int NPN, int KK>
struct MoeOrder {
    static constexpr bool GATHER = GATHER_;
    const volatile LAS int* tab; const int* tok; int G, c; size_t bstride;
    __device__ __forceinline__ bool next(int i, Unit& u) const {
        const int L = i * G + c, nt = tab[16]; if (L >= nt * NPN) return false;
        const int ti = L / NPN; u.pm = ti; u.pn = L % NPN; int e = 0;
#pragma unroll
        for (int j = 1; j < 16; ++j) e += (tab[j] <= ti) ? 1 : 0;
        u.ex = e; u.slot0 = (ti - tab[e]) * 256; const int rem = tab[32 + e] - u.slot0; u.cnt = rem < 256 ? rem : 256; return true;
    }
    __device__ __forceinline__ size_t a_off(const Unit& u) const { return GATHER_ ? 0 : (size_t)u.pm * 256 * KK * 2; }
    __device__ __forceinline__ size_t b_off(const Unit& u) const { return (size_t)u.ex * bstride + (size_t)u.pn * 256 * KK * 2; }
    __device__ __forceinline__ unsigned row_off(const Unit& u, int R) const { const int rr = R < u.cnt ? R : u.cnt - 1; return (unsigned)tok[u.ex * CAP + u.slot0 + rr] * (unsigned)(KK * 2); }
};
__device__ __forceinline__ unsigned cvt_pk_bf16(float lo, float hi) { unsigned r; asm volatile("v_cvt_pk_bf16_f32 %0, %1, %2" : "=v"(r) : "v"(lo), "v"(hi)); return r; }
struct EpiBf16 {
    static constexpr bool PERM = true;
    bf16* O; int ldc;
    __device__ __forceinline__ void operator()(const f32x4 (&acc)[2][2][4][2], const Unit& u, int wr, int wc, int fr, int fq) const {
        asm volatile("" : "+v"(fr), "+v"(fq));
        const int row0 = u.pm * BM + wr * 64 + fr, col0 = u.pn * BM + wc * 32 + 8 * fq;
#pragma unroll
        for (int ai = 0; ai < 2; ++ai)
#pragma unroll
            for (int m = 0; m < 4; ++m) { bf16* rowp = O + (size_t)(row0 + ai * HALF + m * 16) * ldc + col0;
#pragma unroll
                for (int bj = 0; bj < 2; ++bj) { const f32x4 v0 = acc[ai][bj][m][0], v1 = acc[ai][bj][m][1];
                    u32x4 w; w.x = cvt_pk_bf16(v0[0], v0[1]); w.y = cvt_pk_bf16(v0[2], v0[3]); w.z = cvt_pk_bf16(v1[0], v1[1]); w.w = cvt_pk_bf16(v1[2], v1[3]);
                    *(u32x4*)(rowp + bj * HALF) = w; } }
    }
};
struct EpiResid {
    static constexpr bool PERM = false;
    float* X; int ldc; const float* modl;
    __device__ __forceinline__ void operator()(const f32x4 (&acc)[2][2][4][2], const Unit& u, int wr, int wc, int fr, int fq) const {
        asm volatile("" : "+v"(fr), "+v"(fq));
        const int row0 = u.pm * BM + wr * 64 + fr, col0 = u.pn * BM + wc * 32 + 4 * fq;
        const int mr = row_mod(u.pm * BM); const float* gp = modl + (size_t)(mr * NMOD + 2) * D + col0;
        f32x4 gv[2][2];
#pragma unroll
        for (int bj = 0; bj < 2; ++bj)
#pragma unroll
            for (int n = 0; n < 2; ++n) gv[bj][n] = *(const f32x4*)(gp + bj * HALF + n * 16);
#pragma unroll
        for (int ai = 0; ai < 2; ++ai)
#pragma unroll
            for (int m = 0; m < 4; ++m) { float* rowp = X + (size_t)(row0 + ai * HALF + m * 16) * ldc + col0;
#pragma unroll
                for (int bj = 0; bj < 2; ++bj)
#pragma unroll
                    for (int n = 0; n < 2; ++n) { f32x4* q = (f32x4*)(rowp + bj * HALF + n * 16); *q = *q + gv[bj][n] * acc[ai][bj][m][n]; } }
    }
};
struct EpiMoe1 {
    static constexpr bool PERM = true;
    bf16* H; const float* wl;
    __device__ __forceinline__ void operator()(const f32x4 (&acc)[2][2][4][2], const Unit& u, int wr, int wc, int fr, int fq) const {
        asm volatile("" : "+v"(fr), "+v"(fq));
        const int lrow0 = wr * 64 + fr, f0 = u.pn * HALF + wc * 32 + 8 * fq;
#pragma unroll
        for (int ai = 0; ai < 2; ++ai)
#pragma unroll
            for (int m = 0; m < 4; ++m) { const int lr = lrow0 + ai * HALF + m * 16;
                const float w = (lr < u.cnt) ? wl[(size_t)u.ex * CAP + u.slot0 + lr] : 0.f;
                float o[8];
#pragma unroll
                for (int n = 0; n < 2; ++n)
#pragma unroll
                    for (int i = 0; i < 4; ++i) { const float g = acc[ai][0][m][n][i], up = acc[ai][1][m][n][i]; o[4 * n + i] = (lr < u.cnt) ? w * (g / (1.f + __expf(-g))) * up : 0.f; }
                u32x4 pk; pk.x = cvt_pk_bf16(o[0], o[1]); pk.y = cvt_pk_bf16(o[2], o[3]); pk.z = cvt_pk_bf16(o[4], o[5]); pk.w = cvt_pk_bf16(o[6], o[7]);
                *(u32x4*)(H + (size_t)(u.pm * BM + lr) * DE + f0) = pk; }
    }
};

template <class Epi, class Sched, bool ALIGN_EPI>
__device__ __forceinline__ void gemm_phase(LAS unsigned char* lds, const int tid, const bf16* Abase, const bf16* Bbase, const int K, const Sched& S, const Epi& E) {
    constexpr bool GA = Sched::GATHER;
    const int wid = __builtin_amdgcn_readfirstlane(tid >> 6), lane = tid & 63, wr = wid >> 2, wc = wid & 3, fr = lane & 15, fq = lane >> 4;
    const int nt = K / BK;
    unsigned voffA[2], voffB[2]; int Rst, Cst;
#pragma unroll
    for (int i = 0; i < 2; ++i) { int R, C; stage_rc(tid * 16 + i * 8192, R, C); const int Rb = Epi::PERM ? ((R & ~31) + perm32(R & 31)) : R;
        voffA[i] = (unsigned)(R * K + C) * 2u; voffB[i] = (unsigned)(Rb * K + C) * 2u; if (i == 0) { Rst = R; Cst = C; } }
    const size_t kstep = (size_t)(BK * 2);
    const size_t hstep = (size_t)HALF * K * 2;
    const size_t hstepA = GA ? 0 : hstep;
    const unsigned ldsw = (unsigned)wid * 1024u;
    const int aoff = lds_byte(wr * 64 + fr, fq * 8), boff = lds_byte(wc * 32 + fr, fq * 8);
#define PG8_SA(b, h) (((b) * 2 + (h)) * HTB)
#define PG8_SB(b, h) ((4 + (b) * 2 + (h)) * HTB)
#define PG8_STAGE(bufoff, gbase, voff) do { _Pragma("unroll") for (int _i = 0; _i < 2; ++_i) \
        __builtin_amdgcn_global_load_lds((const unsigned*)((const char*)(gbase) + (voff)[_i]), (LAS unsigned*)(lds + (bufoff) + ldsw + _i * 8192), 16, 0, 0); } while (0)
#define PG8_LDA(dst, b, h) do { _Pragma("unroll") for (int m = 0; m < 4; ++m) _Pragma("unroll") for (int k = 0; k < 2; ++k) dst[m][k] = *(const LAS bf16x8*)(lds + PG8_SA(b, h) + aoff + m * 2048 + k * 1024); } while (0)
#define PG8_LDB(dst, b, h) do { _Pragma("unroll") for (int n = 0; n < 2; ++n) _Pragma("unroll") for (int k = 0; k < 2; ++k) dst[n][k] = *(const LAS bf16x8*)(lds + PG8_SB(b, h) + boff + n * 2048 + k * 1024); } while (0)
#define PG8_MMA(ai, bj, At, Bt) do { __builtin_amdgcn_s_setprio(1); _Pragma("unroll") for (int m = 0; m < 4; ++m) _Pragma("unroll") for (int n = 0; n < 2; ++n) _Pragma("unroll") for (int k = 0; k < 2; ++k) \
        acc[ai][bj][m][n] = __builtin_amdgcn_mfma_f32_16x16x32_bf16(Bt[n][k], At[m][k], acc[ai][bj][m][n], 0, 0, 0); __builtin_amdgcn_s_setprio(0); } while (0)
#define PG8_WAIT_V(n) asm volatile("s_waitcnt vmcnt(" #n ")" ::: "memory")
#define PG8_WAIT_L(n) asm volatile("s_waitcnt lgkmcnt(" #n ")" ::: "memory")
#define PG8_BAR __builtin_amdgcn_s_barrier()
#define PG8_SCHED __builtin_amdgcn_sched_barrier(0)
    Unit cur, nxt; int ui = 0;
    if (!S.next(0, cur)) return;
    f32x4 acc[2][2][4][2];
#pragma unroll
    for (int a = 0; a < 2; ++a)
#pragma unroll
        for (int b = 0; b < 2; ++b)
#pragma unroll
            for (int m = 0; m < 4; ++m)
#pragma unroll
                for (int n = 0; n < 2; ++n) acc[a][b][m][n] = (f32x4){0.f, 0.f, 0.f, 0.f};
    bf16x8 At[4][2], B0[2][2], B1[2][2];
    unsigned cv0[2], cv1[2];
#pragma unroll
    for (int i = 0; i < 2; ++i) { cv0[i] = GA ? S.row_off(cur, Rst + 64 * i) + (unsigned)Cst * 2u : voffA[i]; cv1[i] = GA ? S.row_off(cur, HALF + Rst + 64 * i) + (unsigned)Cst * 2u : voffA[i]; }
    const char* cA = (const char*)Abase + S.a_off(cur); const char* cB = (const char*)Bbase + S.b_off(cur);
    PG8_STAGE(PG8_SB(0, 0), cB, voffB); PG8_STAGE(PG8_SB(0, 1), cB + hstep, voffB); PG8_STAGE(PG8_SA(0, 0), cA, cv0); PG8_STAGE(PG8_SA(0, 1), cA + hstepA, cv1);
    if (wr == 1) PG8_BAR;
    PG8_WAIT_V(2); PG8_BAR;
    PG8_STAGE(PG8_SB(1, 0), cB + kstep, voffB); PG8_STAGE(PG8_SA(1, 0), cA + kstep, cv0); PG8_STAGE(PG8_SB(1, 1), cB + hstep + kstep, voffB);
    PG8_WAIT_V(6); PG8_BAR;
    for (;;) {
        const bool has_next = S.next(ui + 1, nxt);
        const char* nA = has_next ? (const char*)Abase + S.a_off(nxt) : cA; const char* nB = has_next ? (const char*)Bbase + S.b_off(nxt) : cB;
#pragma unroll 1
        for (int t = 0; t < nt; t += 2) {
            const bool last = (t == nt - 2);
            const char* a1 = cA + (size_t)(t + 1) * kstep;
            const char* a2 = last ? nA : cA + (size_t)(t + 2) * kstep; const char* b2 = last ? nB : cB + (size_t)(t + 2) * kstep;
            const char* a3 = a2 + kstep; const char* b3 = b2 + kstep;
            if constexpr (GA) { if (last && has_next) {
#pragma unroll
                for (int i = 0; i < 2; ++i) cv0[i] = S.row_off(nxt, Rst + 64 * i) + (unsigned)Cst * 2u; } }
            PG8_LDB(B0, 0, 0); PG8_LDB(B1, 0, 1); PG8_SCHED; PG8_LDA(At, 0, 0); PG8_STAGE(PG8_SA(1, 1), a1 + hstepA, cv1);
            if constexpr (GA) { if (last && has_next) {
#pragma unroll
                for (int i = 0; i < 2; ++i) cv1[i] = S.row_off(nxt, HALF + Rst + 64 * i) + (unsigned)Cst * 2u; } }
            PG8_WAIT_V(8); PG8_WAIT_L(0); PG8_BAR; PG8_MMA(0, 0, At, B0); PG8_MMA(0, 1, At, B1); PG8_BAR; PG8_SCHED;
            PG8_LDA(At, 0, 1); PG8_STAGE(PG8_SB(0, 0), b2, voffB); PG8_STAGE(PG8_SB(0, 1), b2 + hstep, voffB); PG8_STAGE(PG8_SA(0, 0), a2, cv0);
            PG8_WAIT_V(8); PG8_WAIT_L(0); PG8_BAR; PG8_MMA(1, 0, At, B0); PG8_MMA(1, 1, At, B1); PG8_BAR; PG8_SCHED;
            PG8_LDB(B0, 1, 0); PG8_LDB(B1, 1, 1); PG8_SCHED; PG8_LDA(At, 1, 0); PG8_STAGE(PG8_SA(0, 1), a2 + hstepA, cv1);
            PG8_WAIT_V(8); PG8_WAIT_L(0); PG8_BAR; PG8_MMA(0, 0, At, B0); PG8_MMA(0, 1, At, B1); PG8_BAR; PG8_SCHED;
            PG8_LDA(At, 1, 1); PG8_STAGE(PG8_SB(1, 0), b3, voffB); PG8_STAGE(PG8_SB(1, 1), b3 + hstep, voffB); PG8_STAGE(PG8_SA(1, 0), a3, cv0);
            PG8_WAIT_V(8); PG8_WAIT_L(0); PG8_BAR; PG8_MMA(1, 0, At, B0); PG8_MMA(1, 1, At, B1); PG8_BAR; PG8_SCHED;
        }
        if constexpr (ALIGN_EPI) { if (wr == 0) PG8_BAR; }
        E(acc, cur, wr, wc, fr, fq);
        if (!has_next) break;
#pragma unroll
        for (int a = 0; a < 2; ++a)
#pragma unroll
            for (int b = 0; b < 2; ++b)
#pragma unroll
                for (int m = 0; m < 4; ++m)
#pragma unroll
                    for (int n = 0; n < 2; ++n) acc[a][b][m][n] = (f32x4){0.f, 0.f, 0.f, 0.f};
        cur = nxt; cA = nA; cB = nB; ++ui;
        if constexpr (ALIGN_EPI) { if (wr == 1) PG8_BAR; }
    }
    PG8_WAIT_V(0);
    if constexpr (!ALIGN_EPI) { if (wr == 0) PG8_BAR; }
    PG8_BAR;
#undef PG8_SA
#undef PG8_SB
#undef PG8_STAGE
#undef PG8_LDA
#undef PG8_LDB
#undef PG8_MMA
#undef PG8_WAIT_V
#undef PG8_WAIT_L
#undef PG8_BAR
#undef PG8_SCHED
}
}

__device__ __forceinline__ void transpose_item(const float* W, int K, int N, bf16* WT, int kb, int nb, int drow0, LAS float* scr, int lane) {
    const int k0 = 64 * kb, n0 = 32 * nb;
#pragma unroll 8
    for (int i = 0; i < 32; ++i) { const int kk = 2 * i + (lane >> 5); scr[kk * 33 + (lane & 31)] = W[(size_t)(k0 + kk) * N + n0 + (lane & 31)]; }
    LDS_WAIT(); asm volatile("" ::: "memory");
    const int c = lane & 7;
#pragma unroll
    for (int j = 0; j < 4; ++j) { const int n = (lane >> 3) + 8 * j; const LAS float* s = scr + (8 * c) * 33 + n;
        u32x4 o; o.x = pk2(s[0 * 33], s[1 * 33]); o.y = pk2(s[2 * 33], s[3 * 33]); o.z = pk2(s[4 * 33], s[5 * 33]); o.w = pk2(s[6 * 33], s[7 * 33]);
        *(u32x4*)(WT + (size_t)(drow0 + n) * K + k0 + 8 * c) = o; }
    LDS_WAIT(); asm volatile("" ::: "memory");
}
__device__ __forceinline__ void p0_prologue(CPR p, Frame& F) {
    LAS float* scr = (LAS float*)(F.lds + F.wave * 16384);
    constexpr int I_IN = 16 * 61, I_OUT = 16 * 32, I_G = 128, I_L = I_IN + I_OUT + 3 * 16 * I_G + 48 + 32 + 8;
    for (int it = F.gw; it < DEPTH * I_L; it += F.ngw) {
        const int l = it / I_L; int r = it % I_L;
        if (r < I_IN) { transpose_item(p.w_in + (size_t)l * D * INW, D, INW, F.win() + (size_t)l * INP * D, r / 61, r % 61, 32 * (r % 61), scr, F.lane); continue; } r -= I_IN;
        if (r < I_OUT) { transpose_item(p.w_out + (size_t)l * D * D, D, D, F.wout() + (size_t)l * D * D, r / 32, r % 32, 32 * (r % 32), scr, F.lane); continue; } r -= I_OUT;
        if (r < 16 * I_G) { const int e = r / I_G, q = r % I_G, nb = q % 8, n0 = 32 * nb;
            transpose_item(p.moe_w_gate + (size_t)(l * NE + e) * D * DE, D, DE, F.w1() + (size_t)(l * NE + e) * 512 * D, q / 8, nb, (n0 / 128) * 256 + (n0 % 128), scr, F.lane); continue; } r -= 16 * I_G;
        if (r < 16 * I_G) { const int e = r / I_G, q = r % I_G, nb = q % 8, n0 = 32 * nb;
            transpose_item(p.moe_w_up + (size_t)(l * NE + e) * D * DE, D, DE, F.w1() + (size_t)(l * NE + e) * 512 * D, q / 8, nb, (n0 / 128) * 256 + 128 + (n0 % 128), scr, F.lane); continue; } r -= 16 * I_G;
        if (r < 16 * I_G) { const int e = r / I_G, q = r % I_G;
            transpose_item(p.moe_w_down + (size_t)(l * NE + e) * DE * D, DE, D, F.w2() + (size_t)(l * NE + e) * D * DE, q / 32, q % 32, 32 * (q % 32), scr, F.lane); continue; } r -= 16 * I_G;
        if (r < 48) { transpose_item(p.mla_w_uq + (size_t)l * 256 * 384, 256, 384, F.wuq() + (size_t)l * 384 * 256, r / 12, r % 12, 32 * (r % 12), scr, F.lane); continue; } r -= 48;
        if (r < 32) { transpose_item(p.mla_w_ukv + (size_t)l * 128 * 512, 128, 512, F.wukv() + (size_t)l * 512 * 128, r / 16, r % 16, 32 * (r % 16), scr, F.lane); continue; } r -= 32;
        { const int g = r / 2, nb = r % 2; transpose_item(p.pool_w + (size_t)(l * 4 + g) * 4096, 64, 64, F.poolw() + (size_t)(l * 4 + g) * 4096, 0, nb, 32 * nb, scr, F.lane); }
    }
    for (int i = F.gt; i < DEPTH * 4 * 128 * 128; i += F.ngt) F.sguw()[i] = (bf16)f2bf(p.sgu_w[i]);
    for (int i = F.gt; i < DEPTH * (INP - INW) * D; i += F.ngt) { const int l = i / ((INP - INW) * D), q = i % ((INP - INW) * D); F.win()[(size_t)l * INP * D + (size_t)INW * D + q] = 0; }
    for (int i = F.gt; i < SEQ * 16; i += F.ngt) {
        const int t = i >> 4, k = i & 15; const float pos = (float)((k < 8) ? (t >> 6) : (t & 63));
        const float inv = __builtin_powf(10000.0f, -(float)(k & 7) / 8.0f);
        const float ang = pos * inv; F.ropec()[i] = cosf(ang); F.ropes()[i] = sinf(ang);
    }
    for (int i = F.gt; i < DEPTH * 5 * NMOD * D; i += F.ngt) {
        const int l = i / (5 * NMOD * D), r = (i / (NMOD * D)) % 5, n = i % (NMOD * D);
        const float* v = (r < 4) ? p.c + r * D : p.c_ctx; const float* w = p.ada_w + (size_t)l * D * NMOD * D + n;
        float acc = p.ada_b[l * NMOD * D + n];
#pragma unroll 8
        for (int k = 0; k < D; ++k) acc += silu_f(v[k]) * w[(size_t)k * NMOD * D];
        F.mod()[i] = acc;
    }
}

__device__ __forceinline__ int ybase_of(const Frame& F, int l, int e) {
    int b = 0;
    for (int j = 0; j < e; ++j) b += ((int)F.ctl()[CW_CNT + (l * NE + j) * 64] + 255) & ~255;
    return b;
}

__device__ __forceinline__ void p1_rows(CPR p, Frame& F, int l) {
    for (int r = F.gw; r < T; r += F.ngw) {
        const int mr = row_mod(r);
        f32x4 v[4];
        if (l == 0) { const float* src = (r < TL) ? p.x + (size_t)r * D : p.ctx + (size_t)(r - TL) * D;
#pragma unroll
            for (int j = 0; j < 4; ++j) v[j] = *(const f32x4*)(src + 4 * F.lane + 256 * j);
        } else {
            const i32x4 rt = *(const i32x4*)(F.route() + 4 * r);
            const bf16* y0 = F.y() + (size_t)(ybase_of(F, l - 1, rt.x) + rt.y) * D; const bf16* y1 = F.y() + (size_t)(ybase_of(F, l - 1, rt.z) + rt.w) * D;
            const float* g5 = mod_vec(F, l - 1, mr, 5);
#pragma unroll
            for (int j = 0; j < 4; ++j) { const int c = 4 * F.lane + 256 * j; v[j] = *(const f32x4*)(F.xl() + (size_t)r * D + c);
                const u32x2 a = *(const u32x2*)(y0 + c), b = *(const u32x2*)(y1 + c); const f32x4 g = *(const f32x4*)(g5 + c);
                v[j].x += g.x * (__uint_as_float(a.x << 16) + __uint_as_float(b.x << 16)); v[j].y += g.y * (__uint_as_float(a.x & 0xffff0000u) + __uint_as_float(b.x & 0xffff0000u));
                v[j].z += g.z * (__uint_as_float(a.y << 16) + __uint_as_float(b.y << 16)); v[j].w += g.w * (__uint_as_float(a.y & 0xffff0000u) + __uint_as_float(b.y & 0xffff0000u)); }
        }
        float ss = 0.f;
#pragma unroll
        for (int j = 0; j < 4; ++j) { *(f32x4*)(F.xl() + (size_t)r * D + 4 * F.lane + 256 * j) = v[j]; ss += v[j].x * v[j].x + v[j].y * v[j].y + v[j].z * v[j].z + v[j].w * v[j].w; }
        const float rstd = rsqrtf(wave_sum(ss) * (1.f / D) + EPS);
        const float* g1 = p.norm1_g + l * D; const float* sh = mod_vec(F, l, mr, 0); const float* sc = mod_vec(F, l, mr, 1);
#pragma unroll
        for (int j = 0; j < 4; ++j) { const int c = 4 * F.lane + 256 * j; const f32x4 g = *(const f32x4*)(g1 + c), s = *(const f32x4*)(sh + c), q = *(const f32x4*)(sc + c);
            const float h0 = v[j].x * rstd * g.x * (1.f + q.x) + s.x, h1 = v[j].y * rstd * g.y * (1.f + q.y) + s.y, h2 = v[j].z * rstd * g.z * (1.f + q.z) + s.z, h3 = v[j].w * rstd * g.w * (1.f + q.w) + s.w;
            u32x2 o; o.x = pk2(h0, h1); o.y = pk2(h2, h3); *(u32x2*)(F.ha() + (size_t)r * D + c) = o; }
    }
}

__device__ __forceinline__ void p2_inproj_naive(Frame& F, int l) {
    const bf16* W = F.win() + (size_t)l * INP * D;
    for (long i = F.gt; i < (long)T * INW; i += F.ngt) { const int r = (int)(i / INW), c = (int)(i % INW);
        F.pl()[(size_t)r * INP + c] = (bf16)f2bf(dot_bf16(F.ha() + (size_t)r * D, W + (size_t)c * D, D)); }
}

__device__ __forceinline__ void p3_mla_up_naive(CPR p, Frame& F, int l) {
    for (int r = F.gw; r < T; r += F.ngw) {
        const bf16* pr = F.pl() + (size_t)r * INP + OFF_D;
        float a[4]; { const u32x2 t = *(const u32x2*)(pr + 4 * F.lane); a[0] = __uint_as_float(t.x << 16); a[1] = __uint_as_float(t.x & 0xffff0000u); a[2] = __uint_as_float(t.y << 16); a[3] = __uint_as_float(t.y & 0xffff0000u); }
        const float rq = rsqrtf(wave_sum(a[0] * a[0] + a[1] * a[1] + a[2] * a[2] + a[3] * a[3]) * (1.f / 256.f) + EPS);
        float b2[2]; { const unsigned t = *(const unsigned*)(pr + 256 + 2 * F.lane); b2[0] = __uint_as_float(t << 16); b2[1] = __uint_as_float(t & 0xffff0000u); }
        const float rkv = rsqrtf(wave_sum(b2[0] * b2[0] + b2[1] * b2[1]) * (1.f / 128.f) + EPS);
        LAS float* sq = (LAS float*)(F.lds + F.wave * 4096);
        const float* gq = p.mla_q_norm_g + l * 256; const float* gk = p.mla_kv_norm_g + l * 128;
#pragma unroll
        for (int j = 0; j < 4; ++j) sq[4 * F.lane + j] = a[j] * rq * gq[4 * F.lane + j];
        sq[256 + 2 * F.lane] = b2[0] * rkv * gk[2 * F.lane]; sq[256 + 2 * F.lane + 1] = b2[1] * rkv * gk[2 * F.lane + 1];
        LDS_WAIT(); asm volatile("" ::: "memory");
        const bool lat = r < TL; const int t = r & (SEQ - 1);
        for (int f = F.lane; f < 384; f += 64) {
            const int h = f / 96, j = f % 96;
            float val;
            const bf16* wrow = F.wuq() + (size_t)l * 384 * 256;
            auto qdot = [&](int ff) { float s = 0.f; const bf16* w = wrow + (size_t)ff * 256; for (int k = 0; k < 256; ++k) s += sq[k] * bf2f(w[k]); return s; };
            if (j < 64 || !lat) val = qdot(f);
            else { const int i = j - 64; const int base = h * 96 + 64;
                const int q8 = i & 7, half = (i >> 3) & 1, axis = i >> 4;
                const float cs = F.ropec()[t * 16 + axis * 8 + q8], sn = F.ropes()[t * 16 + axis * 8 + q8];
                const float x1 = qdot(base + axis * 16 + q8), x2 = qdot(base + axis * 16 + 8 + q8);
                val = half ? (x1 * sn + x2 * cs) : (x1 * cs - x2 * sn); }
            F.qm()[(size_t)r * 384 + f] = (bf16)f2bf(val * (MLA_SCALE * LOG2E));
        }
        for (int f = F.lane; f < 512; f += 64) {
            const int h = f / 128, j = f % 128; float s = 0.f; const bf16* w = F.wukv() + (size_t)l * 512 * 128 + (size_t)f * 128;
            for (int k = 0; k < 128; ++k) s += sq[256 + k] * bf2f(w[k]);
            if (j < 64) F.km()[(size_t)r * 384 + h * 96 + j] = (bf16)f2bf(s); else F.vm()[(size_t)r * 256 + h * 64 + (j - 64)] = (bf16)f2bf(s);
        }
        if (F.lane < 32) { const int i = F.lane, q8 = i & 7, half = (i >> 3) & 1, axis = i >> 4;
            const float x1 = bf2f(pr[384 + axis * 16 + q8]), x2 = bf2f(pr[384 + axis * 16 + 8 + q8]);
            float val;
            if (lat) { const float cs = F.ropec()[t * 16 + axis * 8 + q8], sn = F.ropes()[t * 16 + axis * 8 + q8]; val = half ? (x1 * sn + x2 * cs) : (x1 * cs - x2 * sn); }
            else val = bf2f(pr[384 + i]);
#pragma unroll
            for (int h = 0; h < 4; ++h) F.km()[(size_t)r * 384 + h * 96 + 64 + i] = (bf16)f2bf(val); }
        LDS_WAIT(); asm volatile("" ::: "memory");
    }
}
__device__ __forceinline__ void p3_pool_naive(CPR p, Frame& F, int l) {
    for (int i = F.gt; i < T * 256; i += F.ngt) {
        const int r = i >> 8, col = i & 255, g = col >> 6, d = col & 63;
        const int L = r < TL ? SEQ : CTX, t = r < TL ? (r & (SEQ - 1)) : ((r - TL) & (CTX - 1)), seg0 = r - t;
        const int win = 2 << g; int lo = t - win / 2, hi = t - win / 2 + win; lo = lo < 0 ? 0 : lo; hi = hi > L ? L : hi;
        const float inv = 1.f / (float)(hi - lo);
        const bf16* wt = F.poolw() + (size_t)(l * 4 + g) * 4096 + d * 64;
        float acc = 0.f;
        for (int c = 0; c < 64; ++c) { float m = 0.f; for (int s = lo; s < hi; ++s) m += bf2f(F.pl()[(size_t)(seg0 + s) * INP + g * 64 + c]);
            const float df = m * inv - bf2f(F.pl()[(size_t)r * INP + g * 64 + c]); acc += df * bf2f(wt[c]); }
        F.ml()[(size_t)r * D + col] = (bf16)f2bf(acc * p.pool_s[l * 256 + col]);
    }
}
__device__ __forceinline__ void p3_sgu1_naive(CPR p, Frame& F, int l) {
    bf16* vg = F.hid();
    for (int r = F.gw; r < T; r += F.ngw) {
        const bf16* pv = F.pl() + (size_t)r * INP + OFF_C + 256;
        float a[4]; { const u32x2 t = *(const u32x2*)(pv + 4 * F.lane); a[0] = gelu_tanh(__uint_as_float(t.x << 16)); a[1] = gelu_tanh(__uint_as_float(t.x & 0xffff0000u)); a[2] = gelu_tanh(__uint_as_float(t.y << 16)); a[3] = gelu_tanh(__uint_as_float(t.y & 0xffff0000u)); }
        float ss = a[0] * a[0] + a[1] * a[1] + a[2] * a[2] + a[3] * a[3];
#pragma unroll
        for (int o = 1; o < 16; o <<= 1) ss += __shfl_xor(ss, o);
        const float rs = rsqrtf(ss * (1.f / 64.f) + EPS); const float* gn = p.sgu_norm_g + l * 256 + 4 * F.lane;
        u32x2 o; o.x = pk2(a[0] * rs * gn[0], a[1] * rs * gn[1]); o.y = pk2(a[2] * rs * gn[2], a[3] * rs * gn[3]);
        *(u32x2*)(vg + (size_t)r * 256 + 4 * F.lane) = o;
    }
}
__device__ __forceinline__ void p3_sgu2_naive(CPR p, Frame& F, int l) {
    const bf16* vg = F.hid();
    for (int i = F.gt; i < T * 256; i += F.ngt) {
        const int r = i >> 8, col = i & 255, g = col >> 6, pp = r & 127, r0 = r - pp;
        const bf16* w = F.sguw() + ((size_t)(l * 4 + g) * 128 + pp) * 128;
        float acc = p.sgu_b[(l * 4 + g) * 128 + pp];
        for (int q = 0; q < 128; ++q) acc += bf2f(w[q]) * bf2f(vg[(size_t)(r0 + q) * 256 + col]);
        const float u = gelu_tanh(bf2f(F.pl()[(size_t)r * INP + OFF_C + col]));
        F.ml()[(size_t)r * D + 512 + col] = (bf16)f2bf(u * acc);
    }
}
__device__ __forceinline__ void p3_na_naive(CPR p, Frame& F, int l) {
    LAS float* pw = (LAS float*)(F.lds + 65536 + F.wave * 2048);
    for (int it = F.gw; it < T * 4; it += F.ngw) {
        const int r = it >> 2, h = it & 3; const bool lat = r < TL; const int b = row_batch(r);
        float q[64];
        { const bf16* qp = F.pl() + (size_t)r * INP + OFF_B + h * 64;
#pragma unroll
          for (int j = 0; j < 8; ++j) { const u32x4 t = *(const u32x4*)(qp + 8 * j);
#pragma unroll
              for (int k = 0; k < 4; ++k) { q[8 * j + 2 * k] = __uint_as_float(t[k] << 16); q[8 * j + 2 * k + 1] = __uint_as_float(t[k] & 0xffff0000u); } } }
        const int t = r & (SEQ - 1), gr = t >> 6, gc = t & 63, jb = gc >> 4;
        int rs = gr - 4; rs = rs < 0 ? 0 : (rs > GH - 8 ? GH - 8 : rs);
        int wsq = gc - 8; wsq = wsq < 0 ? 0 : (wsq > GW - 16 ? GW - 16 : wsq);
        int cs = 16 * jb - 8; cs = cs < 0 ? 0 : (cs > GW - 16 ? GW - 16 : cs); cs = cs > GW - 32 ? GW - 32 : cs;
        const float* rpb = p.na_rpb + (size_t)(l * 4 + h) * 15 * 31;
        float s[8];
#pragma unroll
        for (int i = 0; i < 8; ++i) {
            const int k = F.lane + 64 * (i & 3); const bool win = i < 4;
            int keyrow; float bias = 0.f; bool valid = true;
            if (win) { const int rr = k >> 5, cc = k & 31, kcol = cs + cc; keyrow = b * SEQ + (rs + rr) * 64 + kcol;
                valid = lat && (kcol >= wsq) && (kcol < wsq + 16);
                int dc = kcol - gc + 15; dc = dc < 0 ? 0 : (dc > 30 ? 30 : dc);
                bias = rpb[(rs + rr - gr + 7) * 31 + dc];
                if (!lat) keyrow = r; }
            else keyrow = TL + b * CTX + k;
            const bf16* kp = F.pl() + (size_t)keyrow * INP + OFF_B + 256 + h * 64;
            float d = 0.f;
#pragma unroll
            for (int j = 0; j < 8; ++j) { const u32x4 tt = *(const u32x4*)(kp + 8 * j);
#pragma unroll
                for (int kk = 0; kk < 4; ++kk) d += q[8 * j + 2 * kk] * __uint_as_float(tt[kk] << 16) + q[8 * j + 2 * kk + 1] * __uint_as_float(tt[kk] & 0xffff0000u); }
            s[i] = valid ? (d * 0.125f + bias) : -1e30f;
        }
        float m = s[0];
#pragma unroll
        for (int i = 1; i < 8; ++i) m = fmaxf(m, s[i]);
        m = wave_max(m);
        float sum = 0.f;
#pragma unroll
        for (int i = 0; i < 8; ++i) { s[i] = __expf(s[i] - m); sum += s[i]; }
        sum = wave_sum(sum); const float inv = 1.f / sum;
#pragma unroll
        for (int i = 0; i < 8; ++i) pw[(i >> 2) * 256 + F.lane + 64 * (i & 3)] = s[i] * inv;
        LDS_WAIT(); asm volatile("" ::: "memory");
        float acc = 0.f;
        if (lat) for (int k = 0; k < 256; ++k) { const int rr = k >> 5, cc = k & 31; const int keyrow = b * SEQ + (rs + rr) * 64 + cs + cc;
            acc += pw[k] * bf2f(F.pl()[(size_t)keyrow * INP + OFF_B + 512 + h * 64 + F.lane]); }
        for (int k = 0; k < 256; ++k) acc += pw[256 + k] * bf2f(F.pl()[(size_t)(TL + b * CTX + k) * INP + OFF_B + 512 + h * 64 + F.lane]);
        F.ml()[(size_t)r * D + 256 + h * 64 + F.lane] = (bf16)f2bf(acc);
        LDS_WAIT(); asm volatile("" ::: "memory");
    }
}
__device__ __forceinline__ void p4_mla_naive(Frame& F) {
    LAS float* pw = (LAS float*)(F.lds + 65536 + F.wave * 2048);
    for (int it = F.gw; it < T * 4; it += F.ngw) {
        const int r = it >> 2, h = it & 3; const bool lat = r < TL; const int b = row_batch(r);
        float q[96];
        { const bf16* qp = F.qm() + (size_t)r * 384 + h * 96;
#pragma unroll
          for (int j = 0; j < 12; ++j) { const u32x4 t = *(const u32x4*)(qp + 8 * j);
#pragma unroll
              for (int k = 0; k < 4; ++k) { q[8 * j + 2 * k] = __uint_as_float(t[k] << 16); q[8 * j + 2 * k + 1] = __uint_as_float(t[k] & 0xffff0000u); } } }
        const int nk = lat ? (CTX + SEQ) : CTX;
        float m = -3.0e38f, lsum = 0.f, acc = 0.f;
        for (int k0 = 0; k0 < nk; k0 += 64) {
            const int k = k0 + F.lane; const int keyrow = (k < CTX) ? (TL + b * CTX + k) : (b * SEQ + k - CTX);
            const bf16* kp = F.km() + (size_t)keyrow * 384 + h * 96;
            float d = 0.f;
#pragma unroll
            for (int j = 0; j < 12; ++j) { const u32x4 tt = *(const u32x4*)(kp + 8 * j);
#pragma unroll
                for (int kk = 0; kk < 4; ++kk) d += q[8 * j + 2 * kk] * __uint_as_float(tt[kk] << 16) + q[8 * j + 2 * kk + 1] * __uint_as_float(tt[kk] & 0xffff0000u); }
            const float mn = fmaxf(m, wave_max(d)); const float alpha = exp2f(m - mn); const float pe = exp2f(d - mn);
            lsum = lsum * alpha + wave_sum(pe); acc *= alpha; m = mn;
            pw[F.lane] = pe; LDS_WAIT(); asm volatile("" ::: "memory");
            for (int kk = 0; kk < 64; ++kk) { const int k2 = k0 + kk; const int kr2 = (k2 < CTX) ? (TL + b * CTX + k2) : (b * SEQ + k2 - CTX);
                acc += pw[kk] * bf2f(F.vm()[(size_t)kr2 * 256 + h * 64 + F.lane]); }
            LDS_WAIT(); asm volatile("" ::: "memory");
        }
        F.ml()[(size_t)r * D + 768 + h * 64 + F.lane] = (bf16)f2bf(acc / lsum);
    }
}

typedef float f32x16 __attribute__((ext_vector_type(16)));
typedef short s16x4 __attribute__((ext_vector_type(4)));
__device__ __forceinline__ s16x4 lds_tr16(const LAS unsigned char* p) { return __builtin_bit_cast(s16x4, __builtin_amdgcn_ds_read_tr16_b64_v4i16((LAS s16x4*)p)); }
__device__ __forceinline__ bf16x8 pack8(const f32x16& v, int o) {
    u32x4 w; w.x = pg8::cvt_pk_bf16(v[o + 0], v[o + 1]); w.y = pg8::cvt_pk_bf16(v[o + 2], v[o + 3]); w.z = pg8::cvt_pk_bf16(v[o + 4], v[o + 5]); w.w = pg8::cvt_pk_bf16(v[o + 6], v[o + 7]);
    return __builtin_bit_cast(bf16x8, w);
}
__device__ __forceinline__ void p4_mla_flash(Frame& F) {
    constexpr int KP = 208, VP = 144, KB = 64 * KP, VB = 64 * VP, BUF = KB + VB;
    const int tid = F.tid, lane = F.lane, w = F.wave, q = lane & 31, hh = lane >> 5;
    const bf16* qm = F.qm(); const bf16* km = F.km(); const bf16* vm = F.vm(); bf16* ml = F.ml();
    const int kc0 = tid, kc1 = 512 + (tid & 255);
    const int k0key = kc0 / 12, k0part = kc0 % 12, k1key = kc1 / 12, k1part = kc1 % 12, vkey = tid >> 3, vpart = tid & 7;
    const int trow = 4 * hh + ((lane & 15) >> 2), tcol = 16 * ((lane >> 4) & 1) + 4 * (lane & 3);
    for (int ui = blockIdx.x; ui < 272; ui += gridDim.x) {
        const int qt = ui < 256 ? (ui >> 2) : 64 + ((ui - 256) >> 2), h = ui & 3;
        const bool lat = qt < 64; const int b = lat ? (qt >> 4) : (qt - 64), ntile = lat ? 68 : 4;
        const int qrow = qt * 256 + w * 32 + q;
        bf16x8 qf[6];
#pragma unroll
        for (int ks = 0; ks < 6; ++ks) qf[ks] = *(const bf16x8*)(qm + (size_t)qrow * 384 + h * 96 + 16 * ks + 8 * hh);
        f32x16 ot0, ot1;
#pragma unroll
        for (int r = 0; r < 16; ++r) { ot0[r] = 0.f; ot1[r] = 0.f; }
        float m = -1.0e30f, l = 0.f;
        u32x4 kr0, kr1, vr;
#define MLA_LOAD(t) do { const int t_ = (t); const int kr_ = (lat && t_ >= 4) ? b * SEQ + 64 * (t_ - 4) : TL + b * CTX + 64 * t_; \
            kr0 = *(const u32x4*)(km + (size_t)(kr_ + k0key) * 384 + h * 96 + 8 * k0part); \
            if (tid < 256) kr1 = *(const u32x4*)(km + (size_t)(kr_ + k1key) * 384 + h * 96 + 8 * k1part); \
            vr = *(const u32x4*)(vm + (size_t)(kr_ + vkey) * 256 + h * 64 + 8 * vpart); } while (0)
#define MLA_STORE(bufi) do { LAS unsigned char* kb_ = F.lds + (bufi) * BUF; \
            *(LAS u32x4*)(kb_ + k0key * KP + k0part * 16) = kr0; if (tid < 256) *(LAS u32x4*)(kb_ + k1key * KP + k1part * 16) = kr1; \
            *(LAS u32x4*)(kb_ + KB + vkey * VP + vpart * 16) = vr; } while (0)
        MLA_LOAD(0); MLA_STORE(0);
        __syncthreads();
        for (int t = 0; t < ntile; ++t) {
            if (t + 1 < ntile) MLA_LOAD(t + 1);
            const LAS unsigned char* kb = F.lds + (t & 1) * BUF; const LAS unsigned char* vb = kb + KB;
            f32x16 s0, s1;
#pragma unroll
            for (int r = 0; r < 16; ++r) { s0[r] = 0.f; s1[r] = 0.f; }
#pragma unroll
            for (int ks = 0; ks < 6; ++ks) {
                const bf16x8 ka = *(const LAS bf16x8*)(kb + q * KP + (16 * ks + 8 * hh) * 2);
                const bf16x8 kb2 = *(const LAS bf16x8*)(kb + (32 + q) * KP + (16 * ks + 8 * hh) * 2);
                s0 = __builtin_amdgcn_mfma_f32_32x32x16_bf16(ka, qf[ks], s0, 0, 0, 0);
                s1 = __builtin_amdgcn_mfma_f32_32x32x16_bf16(kb2, qf[ks], s1, 0, 0, 0);
            }
            float mx = fmaxf(s0[0], s1[0]);
#pragma unroll
            for (int r = 1; r < 16; ++r) mx = fmaxf(mx, fmaxf(s0[r], s1[r]));
            mx = fmaxf(mx, __shfl_xor(mx, 32));
            const float mn = fmaxf(m, mx), alpha = __builtin_amdgcn_exp2f(m - mn); m = mn;
            float rs = 0.f;
#pragma unroll
            for (int r = 0; r < 16; ++r) { s0[r] = __builtin_amdgcn_exp2f(s0[r] - mn); s1[r] = __builtin_amdgcn_exp2f(s1[r] - mn); rs += s0[r] + s1[r]; }
            l = l * alpha + rs;
#pragma unroll
            for (int r = 0; r < 16; ++r) { ot0[r] *= alpha; ot1[r] *= alpha; }
            bf16x8 pb[4]; pb[0] = pack8(s0, 0); pb[1] = pack8(s0, 8); pb[2] = pack8(s1, 0); pb[3] = pack8(s1, 8);
#pragma unroll
            for (int kk = 0; kk < 4; ++kk) {
                const LAS unsigned char* a0 = vb + (16 * kk + trow) * VP + tcol * 2;
                const s16x4 lo0 = lds_tr16(a0), hi0 = lds_tr16(a0 + 8 * VP), lo1 = lds_tr16(a0 + 64), hi1 = lds_tr16(a0 + 8 * VP + 64);
                const bf16x8 v0 = (bf16x8){lo0[0], lo0[1], lo0[2], lo0[3], hi0[0], hi0[1], hi0[2], hi0[3]};
                const bf16x8 v1 = (bf16x8){lo1[0], lo1[1], lo1[2], lo1[3], hi1[0], hi1[1], hi1[2], hi1[3]};
                ot0 = __builtin_amdgcn_mfma_f32_32x32x16_bf16(v0, pb[kk], ot0, 0, 0, 0);
                ot1 = __builtin_amdgcn_mfma_f32_32x32x16_bf16(v1, pb[kk], ot1, 0, 0, 0);
            }
            if (t + 1 < ntile) MLA_STORE((t + 1) & 1);
            __syncthreads();
        }
#undef MLA_LOAD
#undef MLA_STORE
        l += __shfl_xor(l, 32);
        const float il = 1.f / l;
        bf16* orow = ml + (size_t)qrow * D + 768 + h * 64 + 4 * hh;
#pragma unroll
        for (int g = 0; g < 4; ++g) {
            u32x2 o0, o1;
            o0.x = pg8::cvt_pk_bf16(ot0[4 * g] * il, ot0[4 * g + 1] * il); o0.y = pg8::cvt_pk_bf16(ot0[4 * g + 2] * il, ot0[4 * g + 3] * il);
            o1.x = pg8::cvt_pk_bf16(ot1[4 * g] * il, ot1[4 * g + 1] * il); o1.y = pg8::cvt_pk_bf16(ot1[4 * g + 2] * il, ot1[4 * g + 3] * il);
            *(u32x2*)(orow + 8 * g) = o0; *(u32x2*)(orow + 32 + 8 * g) = o1;
        }
    }
}

__device__ __forceinline__ void p5_outproj_naive(Frame& F, int l) {
    const bf16* W = F.wout() + (size_t)l * D * D;
    for (long i = F.gt; i < (long)T * D; i += F.ngt) { const int r = (int)(i >> 10), c = (int)(i & 1023);
        const float g = mod_vec(F, l, row_mod(r), 2)[c];
        F.xl()[(size_t)r * D + c] += g * dot_bf16(F.ml() + (size_t)r * D, W + (size_t)c * D, D); }
}

__device__ __forceinline__ void p6_rows(CPR p, Frame& F, int l) {
    for (int r = F.gw; r < T; r += F.ngw) {
        const int mr = row_mod(r);
        f32x4 v[4]; float ss = 0.f;
#pragma unroll
        for (int j = 0; j < 4; ++j) { v[j] = *(const f32x4*)(F.xl() + (size_t)r * D + 4 * F.lane + 256 * j); ss += v[j].x * v[j].x + v[j].y * v[j].y + v[j].z * v[j].z + v[j].w * v[j].w; }
        const float rstd = rsqrtf(wave_sum(ss) * (1.f / D) + EPS);
        const float* g2 = p.norm2_g + l * D; const float* sh = mod_vec(F, l, mr, 3); const float* sc = mod_vec(F, l, mr, 4);
        float lg[16];
#pragma unroll
        for (int e = 0; e < 16; ++e) lg[e] = 0.f;
#pragma unroll
        for (int j = 0; j < 4; ++j) { const int c = 4 * F.lane + 256 * j; const f32x4 g = *(const f32x4*)(g2 + c), s = *(const f32x4*)(sh + c), q = *(const f32x4*)(sc + c);
            float hh[4]; hh[0] = v[j].x * rstd * g.x * (1.f + q.x) + s.x; hh[1] = v[j].y * rstd * g.y * (1.f + q.y) + s.y; hh[2] = v[j].z * rstd * g.z * (1.f + q.z) + s.z; hh[3] = v[j].w * rstd * g.w * (1.f + q.w) + s.w;
            u32x2 o; o.x = pk2(hh[0], hh[1]); o.y = pk2(hh[2], hh[3]); *(u32x2*)(F.ha() + (size_t)r * D + c) = o;
#pragma unroll
            for (int i = 0; i < 4; ++i) { const float* rw = p.router_w + (size_t)(c + i) * NE;
#pragma unroll
                for (int e4 = 0; e4 < 4; ++e4) { const f32x4 w = *(const f32x4*)(rw + 4 * e4); lg[4 * e4] += hh[i] * w.x; lg[4 * e4 + 1] += hh[i] * w.y; lg[4 * e4 + 2] += hh[i] * w.z; lg[4 * e4 + 3] += hh[i] * w.w; } } }
        float sc16[16], bi[16];
#pragma unroll
        for (int e = 0; e < 16; ++e) { const float t = wave_sum(lg[e]); sc16[e] = 1.f / (1.f + __expf(-t)); bi[e] = sc16[e] + p.router_b[e]; }
        int sg = 0; float best = -3.0e38f;
#pragma unroll
        for (int g = 0; g < 4; ++g) { float m1 = -3.0e38f, m2 = -3.0e38f;
#pragma unroll
            for (int j = 0; j < 4; ++j) { const float x = bi[4 * g + j]; if (x > m1) { m2 = m1; m1 = x; } else if (x > m2) m2 = x; }
            const float gs = m1 + m2; if (gs > best) { best = gs; sg = g; } }
        int i0 = 0, i1 = 0; float b0 = -3.0e38f, b1 = -3.0e38f, s0 = 0.f, s1 = 0.f;
#pragma unroll
        for (int e = 0; e < 16; ++e) { if ((e >> 2) == sg) { const float x = bi[e]; if (x > b0) { b1 = b0; i1 = i0; s1 = s0; b0 = x; i0 = e; s0 = sc16[e]; } else if (x > b1) { b1 = x; i1 = e; s1 = sc16[e]; } } }
        const float ws = s0 + s1; const float w0 = s0 / ws, w1 = s1 / ws;
        if (F.lane == 0) {
            const int sl0 = (int)atomicAdd(&F.ctl()[CW_CNT + (l * NE + i0) * 64], 1u); const int sl1 = (int)atomicAdd(&F.ctl()[CW_CNT + (l * NE + i1) * 64], 1u);
            F.tok()[i0 * CAP + sl0] = r; F.wl()[i0 * CAP + sl0] = w0; F.tok()[i1 * CAP + sl1] = r; F.wl()[i1 * CAP + sl1] = w1;
            i32x4 rt; rt.x = i0; rt.y = sl0; rt.z = i1; rt.w = sl1; *(i32x4*)(F.route() + 4 * r) = rt;
        }
    }
}

__device__ __forceinline__ void p6b_sort(Frame& F, int l) {
    for (int r = F.gw; r < T; r += F.ngw) {
        const i32x4 rt = *(const i32x4*)(F.route() + 4 * r);
        const u32x4* src = (const u32x4*)(F.ha() + (size_t)r * D) + F.lane;
        const u32x4 a = src[0], b = src[64];
        u32x4* d0 = (u32x4*)(F.hs() + (size_t)(ybase_of(F, l, rt.x) + rt.y) * D) + F.lane; u32x4* d1 = (u32x4*)(F.hs() + (size_t)(ybase_of(F, l, rt.z) + rt.w) * D) + F.lane;
        d0[0] = a; d0[64] = b; d1[0] = a; d1[64] = b;
    }
}

__device__ __forceinline__ void p7_moe1_naive(Frame& F, int l) {
    for (long i = F.gt; i < (long)T * 2 * DE; i += F.ngt) {
        const int a = (int)(i >> 8), f = (int)(i & 255), tokr = a >> 1, wh = a & 1;
        const int e = F.route()[4 * tokr + 2 * wh], sl = F.route()[4 * tokr + 2 * wh + 1];
        const bf16* W = F.w1() + (size_t)(l * NE + e) * 512 * D; const int grow = (f >> 7) * 256 + (f & 127);
        const float g = dot_bf16(F.ha() + (size_t)tokr * D, W + (size_t)grow * D, D), u = dot_bf16(F.ha() + (size_t)tokr * D, W + (size_t)(grow + 128) * D, D);
        F.hid()[(size_t)(ybase_of(F, l, e) + sl) * DE + f] = (bf16)f2bf(F.wl()[e * CAP + sl] * silu_f(g) * u);
    }
}
__device__ __forceinline__ void p8_moe2_naive(Frame& F, int l) {
    for (long i = F.gt; i < (long)T * 2 * D; i += F.ngt) {
        const int a = (int)(i >> 10), n = (int)(i & 1023), tokr = a >> 1, wh = a & 1;
        const int e = F.route()[4 * tokr + 2 * wh], sl = F.route()[4 * tokr + 2 * wh + 1]; const size_t pr = (size_t)(ybase_of(F, l, e) + sl);
        F.y()[pr * D + n] = (bf16)f2bf(dot_bf16(F.hid() + pr * DE, F.w2() + ((size_t)(l * NE + e) * D + n) * DE, DE));
    }
}

__device__ __forceinline__ void p9_final(CPR p, Frame& F) {
    const int l = DEPTH - 1;
    for (int r = F.gw; r < TL; r += F.ngw) {
        const i32x4 rt = *(const i32x4*)(F.route() + 4 * r);
        const bf16* y0 = F.y() + (size_t)(ybase_of(F, l, rt.x) + rt.y) * D; const bf16* y1 = F.y() + (size_t)(ybase_of(F, l, rt.z) + rt.w) * D;
        const float* g5 = mod_vec(F, l, row_mod(r), 5);
        f32x4 v[4]; float ss = 0.f;
#pragma unroll
        for (int j = 0; j < 4; ++j) { const int c = 4 * F.lane + 256 * j; v[j] = *(const f32x4*)(F.xl() + (size_t)r * D + c);
            const u32x2 a = *(const u32x2*)(y0 + c), b = *(const u32x2*)(y1 + c); const f32x4 g = *(const f32x4*)(g5 + c);
            v[j].x += g.x * (__uint_as_float(a.x << 16) + __uint_as_float(b.x << 16)); v[j].y += g.y * (__uint_as_float(a.x & 0xffff0000u) + __uint_as_float(b.x & 0xffff0000u));
            v[j].z += g.z * (__uint_as_float(a.y << 16) + __uint_as_float(b.y << 16)); v[j].w += g.w * (__uint_as_float(a.y & 0xffff0000u) + __uint_as_float(b.y & 0xffff0000u));
            ss += v[j].x * v[j].x + v[j].y * v[j].y + v[j].z * v[j].z + v[j].w * v[j].w; }
        const float rstd = rsqrtf(wave_sum(ss) * (1.f / D) + EPS);
#pragma unroll
        for (int j = 0; j < 4; ++j) { const int c = 4 * F.lane + 256 * j; const f32x4 g = *(const f32x4*)(p.final_g + c);
            f32x4 o; o.x = v[j].x * rstd * g.x; o.y = v[j].y * rstd * g.y; o.z = v[j].z * rstd * g.z; o.w = v[j].w * rstd * g.w;
            *(f32x4*)(p.out + (size_t)r * D + c) = o; }
    }
}

__device__ __forceinline__ void p2_inproj(Frame& F, int l) {
    pg8::StaticOrder S; S.init(T, INP, D, (int)gridDim.x, (int)blockIdx.x);
    pg8::EpiBf16 E{F.pl(), INP};
    pg8::gemm_phase<pg8::EpiBf16, pg8::StaticOrder, true>(F.lds, F.tid, F.ha(), F.win() + (size_t)l * INP * D, D, S, E);
}
__device__ __forceinline__ void p5_outproj(Frame& F, int l) {
    pg8::StaticOrder S; S.init(T, D, D, (int)gridDim.x, (int)blockIdx.x);
    pg8::EpiResid E{F.xl(), D, F.mod() + (size_t)l * 5 * NMOD * D};
    pg8::gemm_phase<pg8::EpiResid, pg8::StaticOrder, true>(F.lds, F.tid, F.ml(), F.wout() + (size_t)l * D * D, D, S, E);
}
__device__ __forceinline__ void moe_table(Frame& F, int l) {
    volatile LAS int* tab = (volatile LAS int*)(F.lds + MOETAB_OFF);
    __syncthreads();
    if (F.tid == 0) { int acc = 0;
        for (int e = 0; e < NE; ++e) { const int c = (int)F.ctl()[CW_CNT + (l * NE + e) * 64]; tab[e] = acc; tab[32 + e] = c; acc += (c + 255) >> 8; }
        tab[16] = acc; }
    __syncthreads();
}
__device__ __forceinline__ void p7_moe1(Frame& F, int l) {
    moe_table(F, l);
    pg8::MoeOrder<false, 2, D> S{(const volatile LAS int*)(F.lds + MOETAB_OFF), F.tok(), (int)gridDim.x, (int)blockIdx.x, (size_t)512 * D * 2};
    pg8::EpiMoe1 E{F.hid(), F.wl()};
    pg8::gemm_phase<pg8::EpiMoe1, pg8::MoeOrder<false, 2, D>, true>(F.lds, F.tid, F.hs(), F.w1() + (size_t)l * NE * 512 * D, D, S, E);
}
__device__ __forceinline__ void p8_moe2(Frame& F, int l) {
    moe_table(F, l);
    pg8::MoeOrder<false, 4, DE> S{(const volatile LAS int*)(F.lds + MOETAB_OFF), F.tok(), (int)gridDim.x, (int)blockIdx.x, (size_t)D * DE * 2};
    pg8::EpiBf16 E{F.y(), D};
    pg8::gemm_phase<pg8::EpiBf16, pg8::MoeOrder<false, 4, DE>, true>(F.lds, F.tid, F.hid(), F.w2() + (size_t)l * NE * D * DE, DE, S, E);
}

constexpr int PH_FINAL = 1 + 10 * DEPTH, N_PHASES = PH_FINAL + 1;
__global__ void __launch_bounds__(NTHR, 2) fwd(Params p) {
    extern __shared__ __attribute__((aligned(16))) unsigned char lds_raw[];
    Frame F;
    F.lds = (LAS unsigned char*)lds_raw;
    F.tid = threadIdx.x; F.lane = F.tid & 63; F.wave = __builtin_amdgcn_readfirstlane(F.tid >> 6);
    F.gw = blockIdx.x * NWAVES + F.wave; F.ngw = gridDim.x * NWAVES; F.gt = blockIdx.x * NTHR + F.tid; F.ngt = gridDim.x * NTHR;
    const __attribute__((address_space(4))) Params* KP = (const __attribute__((address_space(4))) Params*)__builtin_amdgcn_kernarg_segment_ptr();
    F.ws = KP->ws;
    volatile LAS unsigned* MISC = (volatile LAS unsigned*)(F.lds + MISC_OFF);
    for (int u = F.tid; u < 32; u += NTHR) MISC[u] = 0u;
    __syncthreads();
#if MK_ONE_LAUNCH
    (void)xcd_barrier_post(F.ctl() + CW_BAR, MISC + 8);
#define GRID_BAR() do { XcdBarrier b_; b_.bar = (unsigned*)(KP->ws + WS_CTL) + CW_BAR; b_.x = xb_xcc_id(); b_.st = (volatile LAS unsigned*)(F.lds + MISC_OFF) + 8; xcd_barrier(b_); } while (0)
#else
#define GRID_BAR() do {} while (0)
#endif
#define lo (KP->ph_lo)
#define hi (KP->ph_hi)
#define PB() do { asm volatile("" : "+s"(KP)); F.ws = KP->ws; int t_ = threadIdx.x; asm volatile("" : "+v"(t_)); F.tid = t_; F.lane = t_ & 63; F.wave = __builtin_amdgcn_readfirstlane(t_ >> 6); \
    F.gw = blockIdx.x * NWAVES + F.wave; F.gt = blockIdx.x * NTHR + t_; F.ngw = gridDim.x * NWAVES; F.ngt = gridDim.x * NTHR; } while (0)
#ifndef PH_MASK
#define PH_MASK 0xFFF
#endif
#define INK(k, kind) (((PH_MASK >> (kind)) & 1) && lo <= (k) && (k) < hi)
#define IN(k) (lo <= (k) && (k) < hi)
#define SEAM(k) do { if (IN((k) + 1)) GRID_BAR(); } while (0)
    if (INK(0, 9)) { PB(); p0_prologue(*KP, F); SEAM(0); }
    for (int l = 0; l < DEPTH; ++l) {
        const int pb = 1 + 10 * l;
        if (INK(pb + 0, 0)) { PB(); p1_rows(*KP, F, l); SEAM(pb + 0); }
        if (INK(pb + 1, 1)) { PB(); if (FAST_GEMM & 1) p2_inproj(F, l); else p2_inproj_naive(F, l); SEAM(pb + 1); }
        if (INK(pb + 2, 2)) { PB(); p3_mla_up_naive(*KP, F, l); p3_pool_naive(*KP, F, l); p3_sgu1_naive(*KP, F, l); p3_na_naive(*KP, F, l); SEAM(pb + 2); }
        if (INK(pb + 3, 3)) { PB(); p3_sgu2_naive(*KP, F, l); SEAM(pb + 3); }
        if (INK(pb + 4, 4)) { PB(); if (FAST_MLA) p4_mla_flash(F); else p4_mla_naive(F); SEAM(pb + 4); }
        if (INK(pb + 5, 5)) { PB(); if (FAST_GEMM & 2) p5_outproj(F, l); else p5_outproj_naive(F, l); SEAM(pb + 5); }
        if (INK(pb + 6, 6)) { PB(); p6_rows(*KP, F, l); SEAM(pb + 6); }
        if (INK(pb + 7, 11)) { PB(); if (FAST_GEMM & 4) p6b_sort(F, l); SEAM(pb + 7); }
        if (INK(pb + 8, 7)) { PB(); if (FAST_GEMM & 4) p7_moe1(F, l); else p7_moe1_naive(F, l); SEAM(pb + 8); }
        if (INK(pb + 9, 8)) { PB(); if (FAST_GEMM & 8) p8_moe2(F, l); else p8_moe2_naive(F, l); SEAM(pb + 9); }
    }
    if (INK(PH_FINAL, 10)) { PB(); p9_final(*KP, F); }
}

extern "C" void kernel_launch(void* const* d_in, const int* in_sizes, int n_in, void* d_out, int out_size, void* d_ws, size_t ws_size, hipStream_t stream) {
    static int grid = 0;
    if (grid == 0) {
        if (n_in != 26 || out_size != TL * D || ws_size < WS_END) { fprintf(stderr, "kernel_launch: unexpected shapes: n_in %d out %d ws %zu (need %zu)\n", n_in, out_size, ws_size, (size_t)WS_END); grid = -1; return; }
        int dev = 0, cus = 0, per_cu = 0;
        if (hipGetDevice(&dev) != hipSuccess || hipDeviceGetAttribute(&cus, hipDeviceAttributeMultiprocessorCount, dev) != hipSuccess) { grid = -1; return; }
        if (hipFuncSetAttribute((const void*)fwd, hipFuncAttributeMaxDynamicSharedMemorySize, LDS_BYTES) != hipSuccess) { fprintf(stderr, "kernel_launch: hipFuncSetAttribute failed\n"); grid = -1; return; }
        if (hipOccupancyMaxActiveBlocksPerMultiprocessor(&per_cu, (const void*)fwd, NTHR, LDS_BYTES) != hipSuccess || per_cu < 1) fprintf(stderr, "kernel_launch: occupancy query says %d\n", per_cu);
        (void)hipGetLastError();
        grid = cus;
    }
    if (grid < 0) return;
    (void)hipMemsetAsync((char*)d_ws + WS_CTL, 0, CTL_ZERO_BYTES, stream);
    Params p{};
    const float** pp = (const float**)&p;
    for (int i = 0; i < 26; ++i) pp[i] = (const float*)d_in[i];
    p.out = (float*)d_out; p.ws = (unsigned char*)d_ws;
#if MK_ONE_LAUNCH
    p.ph_lo = 0; p.ph_hi = N_PHASES;
    hipLaunchKernelGGL(fwd, dim3(grid), dim3(NTHR), LDS_BYTES, stream, p);
#else
    for (int ph = 0; ph < N_PHASES; ++ph) {
        p.ph_lo = ph; p.ph_hi = ph + 1;
        hipLaunchKernelGGL(fwd, dim3(grid), dim3(NTHR), LDS_BYTES, stream, p);
    }
#endif
}
```

```cpp
#include <hip/hip_runtime.h>
#include <cstdio>
#include <cstdint>

#ifndef MK_ONE_LAUNCH
#define MK_ONE_LAUNCH 1
#endif

#ifndef FAST_NA
#define FAST_NA 1
#endif
#ifndef FAST_UP
#define FAST_UP 1
#endif
#ifndef FAST_PS
#define FAST_PS 3
#endif
#ifndef FAST_MLA
#define FAST_MLA 1
#endif
#ifndef FAST_GEMM
#define FAST_GEMM 0xF
#endif

#define GAS __attribute__((address_space(1)))
#define LAS __attribute__((address_space(3)))
typedef unsigned short bf16;
typedef float f32x4 __attribute__((ext_vector_type(4)));
typedef unsigned u32x4 __attribute__((ext_vector_type(4)));
typedef unsigned u32x2 __attribute__((ext_vector_type(2)));
typedef int i32x4 __attribute__((ext_vector_type(4)));
typedef short bf16x8 __attribute__((ext_vector_type(8)));

constexpr int D = 1024, NB = 4, SEQ = 4096, DEPTH = 4, CTX = 256, GW = 64, GH = 64;
constexpr int TL = NB * SEQ, TC = NB * CTX, T = TL + TC;
constexpr int INW = 1952, INP = 2048;
constexpr int OFF_B = 256, OFF_C = 1024, OFF_D = 1536;
constexpr int NE = 16, DE = 256, CAP = T;
constexpr int RPAD = 2 * T + NE * 256;
constexpr int NMOD = 6;
constexpr float EPS = 1e-6f;
constexpr float LOG2E = 1.4426950408889634f;
constexpr float MLA_SCALE = 0.10206207261596575f;
constexpr int NWAVES = 8, NTHR = NWAVES * 64;

constexpr size_t MiB = 1u << 20;
constexpr size_t WS_CTL = 0, CTL_ZERO_BYTES = 1 * MiB;
constexpr size_t WS_MOD = 1 * MiB;
constexpr size_t WS_ROPE = 2 * MiB;
constexpr size_t WS_ROUTE = 3 * MiB;
constexpr size_t WS_TOK = 4 * MiB;
constexpr size_t WS_WL = 6 * MiB;
constexpr size_t WS_WUQ = 8 * MiB;
constexpr size_t WS_WUKV = 9 * MiB;
constexpr size_t WS_POOLW = 10 * MiB;
constexpr size_t WS_SGUW = 10 * MiB + 512 * 1024;
constexpr size_t WS_WIN = 12 * MiB;
constexpr size_t WS_WOUT = 28 * MiB;
constexpr size_t WS_W1 = 36 * MiB;
constexpr size_t WS_W2 = 100 * MiB;
constexpr size_t WS_XL = 132 * MiB;
constexpr size_t WS_HA = 200 * MiB;
constexpr size_t WS_PL = 234 * MiB;
constexpr size_t WS_Y = 234 * MiB;
constexpr size_t WS_HS = WS_Y;
constexpr size_t WS_QM = 302 * MiB;
constexpr size_t WS_KM = 315 * MiB;
constexpr size_t WS_VM = 328 * MiB;
constexpr size_t WS_ML = 337 * MiB;
constexpr size_t WS_HID = 371 * MiB;
constexpr size_t WS_END = 390 * MiB;
static_assert(WS_Y + (size_t)RPAD * D * 2 <= WS_KM && WS_HID + (size_t)RPAD * DE * 2 <= WS_END, "ws map");

constexpr int CW_TMO = 0;
constexpr int CW_BAR = 4096;
constexpr int CW_CNT = 8192;

constexpr int LDS_BYTES = 147456;
constexpr int MISC_OFF = 131072 + 320;
constexpr int MOETAB_OFF = 131072 + 1024;

__device__ __forceinline__ float bf2f(bf16 v) { return __uint_as_float(((unsigned)v) << 16); }
__device__ __forceinline__ unsigned f2bf(float f) { unsigned u = __float_as_uint(f); return (u + 0x7fffu + ((u >> 16) & 1u)) >> 16; }
__device__ __forceinline__ unsigned pk2(float lo, float hi) { return f2bf(lo) | (f2bf(hi) << 16); }
__device__ __forceinline__ float wave_sum(float v) {
#pragma unroll
    for (int o = 1; o < 64; o <<= 1) v += __shfl_xor(v, o);
    return v;
}
__device__ __forceinline__ float wave_max(float v) {
#pragma unroll
    for (int o = 1; o < 64; o <<= 1) v = fmaxf(v, __shfl_xor(v, o));
    return v;
}
__device__ __forceinline__ float silu_f(float x) { return x / (1.f + __expf(-x)); }
__device__ __forceinline__ float gelu_tanh(float x) { const float u = 1.5957691216057308f * (x + 0.044715f * x * x * x); return x / (1.f + __expf(-u)); }
__device__ __forceinline__ float dot_bf16(const bf16* a, const bf16* b, int K) {
    float s = 0.f;
    for (int k = 0; k < K; k += 8) {
        const u32x4 av = *(const u32x4*)(a + k), bv = *(const u32x4*)(b + k);
#pragma unroll
        for (int j = 0; j < 4; ++j) {
            s += __uint_as_float(av[j] << 16) * __uint_as_float(bv[j] << 16);
            s += __uint_as_float(av[j] & 0xffff0000u) * __uint_as_float(bv[j] & 0xffff0000u);
        }
    }
    return s;
}
#define LDS_WAIT() asm volatile("s_waitcnt lgkmcnt(0)" ::: "memory")

#define XB_TMO      128
#define XB_XCNT(j)  (256  + 64 * (j))
#define XB_XSUB(j)  (1280 + 64 * (j))
#define XB_XGEN(j)  (2304 + 64 * (j))
#define XB_TOP      3328
#define XB_TOPGEN   3392
#define XCD_BAR_WORDS 3456
#define XB_SPIN_CAP (1u << 18)
__device__ __forceinline__ unsigned xb_ld(unsigned* p)              { return __hip_atomic_load(p, __ATOMIC_RELAXED, __HIP_MEMORY_SCOPE_AGENT); }
__device__ __forceinline__ unsigned xb_add(unsigned* p, unsigned v) { return __hip_atomic_fetch_add(p, v, __ATOMIC_RELAXED, __HIP_MEMORY_SCOPE_AGENT); }
__device__ __forceinline__ unsigned xb_xcc_id() { return (unsigned)__builtin_amdgcn_s_getreg((3 << 11) | 20) & 0xFu; }
#define XB_SPIN(cond, bar) do { unsigned _sp = 0; while (cond) { __builtin_amdgcn_s_sleep(1); \
    if ((++_sp & 255u) == 0u) { if (xb_ld(&(bar)[XB_TMO])) break; if (_sp > XB_SPIN_CAP) { atomicAdd(&(bar)[XB_TMO], 1u); break; } } } } while (0)
struct XcdBarrier { unsigned* bar; unsigned x; volatile LAS unsigned* st; };
__device__ __forceinline__ XcdBarrier xcd_barrier_post(unsigned* bar, volatile LAS unsigned* st) {
    XcdBarrier b; b.bar = bar; b.x = xb_xcc_id(); b.st = st;
    if (threadIdx.x == 0) (void)xb_add(&bar[XB_XCNT(b.x)], 1u);
    return b;
}
__device__ __forceinline__ void xcd_barrier_complete(unsigned* bar, unsigned x, unsigned& nloc, unsigned& nx) {
    const unsigned G = gridDim.x * gridDim.y * gridDim.z;
    unsigned sum, cnt, mine, sp = 0u;
    for (;;) {
        sum = 0u; cnt = 0u; mine = 0u;
#pragma unroll
        for (unsigned j = 0; j < 16; ++j) { const unsigned c = xb_ld(&bar[XB_XCNT(j)]); sum += c; cnt += (c > 0u) ? 1u : 0u; mine = (j == x) ? c : mine; }
        if (sum == G) break;
        __builtin_amdgcn_s_sleep(1);
        if ((++sp & 255u) == 0u) { if (xb_ld(&bar[XB_TMO])) break; if (sp > XB_SPIN_CAP) { atomicAdd(&bar[XB_TMO], 1u); break; } }
    }
    nloc = mine > 0u ? mine : 1u; nx = cnt > 0u ? cnt : 1u;
}
__device__ __forceinline__ void xcd_barrier(const XcdBarrier& b) {
    asm volatile("s_waitcnt vmcnt(0)" ::: "memory");
    __syncthreads();
    if (threadIdx.x == 0) {
        unsigned* bar = b.bar;
        __builtin_amdgcn_s_waitcnt(0);
        unsigned nloc = b.st[0], nx = b.st[1];
        if (nloc == 0u) { xcd_barrier_complete(bar, b.x, nloc, nx); b.st[0] = nloc; b.st[1] = nx; }
        const unsigned old = xb_add(&bar[XB_XSUB(b.x)], 1u);
        const unsigned gen = old / nloc;
        if (old + 1u == (gen + 1u) * nloc) {
            __builtin_amdgcn_fence(__ATOMIC_RELEASE, "agent");
            asm volatile("s_waitcnt vmcnt(0)" ::: "memory");
            const unsigned og = xb_add(&bar[XB_TOP], 1u);
            const unsigned tg = og / nx;
            if (og + 1u == (tg + 1u) * nx) xb_add(&bar[XB_TOPGEN], 1u);
            else XB_SPIN(xb_ld(&bar[XB_TOPGEN]) == tg, bar);
            __builtin_amdgcn_fence(__ATOMIC_ACQUIRE, "agent");
            xb_add(&bar[XB_XGEN(b.x)], 1u);
            asm volatile("s_waitcnt vmcnt(0)" ::: "memory");
        } else {
            XB_SPIN(xb_ld(&bar[XB_XGEN(b.x)]) == gen, bar);
            __builtin_amdgcn_fence(__ATOMIC_ACQUIRE, "agent");
            asm volatile("s_waitcnt vmcnt(0)" ::: "memory");
        }
    }
    __syncthreads();
}

struct Params {
    const float *x, *c, *ctx, *c_ctx, *ada_w, *ada_b, *norm1_g, *norm2_g, *w_in, *w_out, *pool_w, *pool_s, *na_rpb,
                *sgu_norm_g, *sgu_w, *sgu_b, *mla_q_norm_g, *mla_w_uq, *mla_kv_norm_g, *mla_w_ukv,
                *router_w, *router_b, *moe_w_gate, *moe_w_up, *moe_w_down, *final_g;
    float* out; unsigned char* ws; int ph_lo, ph_hi;
};
typedef const __attribute__((address_space(4))) Params& CPR;
struct Frame {
    LAS unsigned char* lds; unsigned char* ws;
    int tid, lane, wave, gw, ngw, gt, ngt;
    __device__ __forceinline__ unsigned* ctl() const { return (unsigned*)(ws + WS_CTL); }
    __device__ __forceinline__ float* mod() const { return (float*)(ws + WS_MOD); }
    __device__ __forceinline__ float* ropec() const { return (float*)(ws + WS_ROPE); }
    __device__ __forceinline__ float* ropes() const { return (float*)(ws + WS_ROPE) + SEQ * 16; }
    __device__ __forceinline__ int* route() const { return (int*)(ws + WS_ROUTE); }
    __device__ __forceinline__ int* tok() const { return (int*)(ws + WS_TOK); }
    __device__ __forceinline__ float* wl() const { return (float*)(ws + WS_WL); }
    __device__ __forceinline__ bf16* wuq() const { return (bf16*)(ws + WS_WUQ); }
    __device__ __forceinline__ bf16* wukv() const { return (bf16*)(ws + WS_WUKV); }
    __device__ __forceinline__ bf16* poolw() const { return (bf16*)(ws + WS_POOLW); }
    __device__ __forceinline__ bf16* sguw() const { return (bf16*)(ws + WS_SGUW); }
    __device__ __forceinline__ bf16* win() const { return (bf16*)(ws + WS_WIN); }
    __device__ __forceinline__ bf16* wout() const { return (bf16*)(ws + WS_WOUT); }
    __device__ __forceinline__ bf16* w1() const { return (bf16*)(ws + WS_W1); }
    __device__ __forceinline__ bf16* w2() const { return (bf16*)(ws + WS_W2); }
    __device__ __forceinline__ bf16* ha() const { return (bf16*)(ws + WS_HA); }
    __device__ __forceinline__ bf16* pl() const { return (bf16*)(ws + WS_PL); }
    __device__ __forceinline__ bf16* y() const { return (bf16*)(ws + WS_Y); }
    __device__ __forceinline__ bf16* hs() const { return (bf16*)(ws + WS_HS); }
    __device__ __forceinline__ bf16* qm() const { return (bf16*)(ws + WS_QM); }
    __device__ __forceinline__ bf16* km() const { return (bf16*)(ws + WS_KM); }
    __device__ __forceinline__ bf16* vm() const { return (bf16*)(ws + WS_VM); }
    __device__ __forceinline__ bf16* ml() const { return (bf16*)(ws + WS_ML); }
    __device__ __forceinline__ bf16* hid() const { return (bf16*)(ws + WS_HID); }
    __device__ __forceinline__ float* xl() const { return (float*)(ws + WS_XL); }
};
__device__ __forceinline__ int row_batch(int r) { return r < TL ? (r >> 12) : ((r - TL) >> 8); }
__device__ __forceinline__ int row_mod(int r) { return r < TL ? (r >> 12) : 4; }
__device__ __forceinline__ const float* mod_vec(const Frame& F, int l, int mr, int k) { return F.mod() + ((size_t)(l * 5 + mr) * NMOD + k) * D; }

namespace pg8 {
constexpr int BM = 256, BK = 64, HALF = 128, HTB = HALF * BK * 2, NXCD = 8, WGM = 8;
__host__ __device__ __forceinline__ int lds_byte(int r, int c) { const int st = (r >> 4) * 2 + (c >> 5), rr = r & 15, cc = c & 31, ob = rr * 64 + cc * 2; return st * 1024 + (ob ^ (((ob >> 9) & 1) << 5)); }
__host__ __device__ __forceinline__ void stage_rc(int b, int& R, int& C) { const int st = b / 1024, sb = b % 1024, swz = sb ^ (((sb >> 9) & 1) << 5); R = (st >> 1) * 16 + swz / 64; C = (st & 1) * 32 + (swz % 64) / 2; }
__host__ __device__ __forceinline__ int perm32(int rho) { const int n = rho >> 4, i = rho & 15; return 8 * (i >> 2) + 4 * n + (i & 3); }
struct Unit { int pm, pn, ex, slot0, cnt; };
struct StaticOrder {
    static constexpr bool GATHER = false;
    int nM, nN, nwg, G, c, K;
    __device__ __forceinline__ void init(int M, int N, int K_, int G_, int c_) { nM = M / BM; nN = N / BM; nwg = nM * nN; G = G_; c = c_; K = K_; }
    __device__ __forceinline__ bool next(int i, Unit& u) const {
        const long L = (long)i * G + c; if (L >= nwg) return false;
        int wgid = (int)L; { const int q = nwg / NXCD, r = nwg % NXCD, xcd = wgid % NXCD, off = wgid / NXCD; wgid = (xcd < r ? xcd * (q + 1) : r * (q + 1) + (xcd - r) * q) + off; }
        const int nig = WGM * nN, gid = wgid / nig, fm = gid * WGM, gsz = (nM - fm) < WGM ? (nM - fm) : WGM;
        u.pm = fm + ((wgid % nig) % gsz); u.pn = (wgid % nig) / gsz; u.ex = 0; u.slot0 = 0; u.cnt = 256; return true;
    }
    __device__ __forceinline__ size_t a_off(const Unit& u) const { return (size_t)u.pm * 256 * K * 2; }
    __device__ __forceinline__ size_t b_off(const Unit& u) const { return (size_t)u.pn * 256 * K * 2; }
    __device__ __forceinline__ unsigned row_off(const Unit&, int) const { return 0u; }
};
template <bool GATHER_, int NPN, int KK>
struct MoeOrder {
    static constexpr bool GATHER = GATHER_;
    const volatile LAS int* tab; const int* tok; int G, c; size_t bstride;
    __device__ __forceinline__ bool next(int i, Unit& u) const {
        const int L = i * G + c, nt = tab[16]; if (L >= nt * NPN) return false;
        const int ti = L / NPN; u.pm = ti; u.pn = L % NPN; int e = 0;
#pragma unroll
        for (int j = 1; j < 16; ++j) e += (tab[j] <= ti) ? 1 : 0;
        u.ex = e; u.slot0 = (ti - tab[e]) * 256; const int rem = tab[32 + e] - u.slot0; u.cnt = rem < 256 ? rem : 256; return true;
    }
    __device__ __forceinline__ size_t a_off(const Unit& u) const { return GATHER_ ? 0 : (size_t)u.pm * 256 * KK * 2; }
    __device__ __forceinline__ size_t b_off(const Unit& u) const { return (size_t)u.ex * bstride + (size_t)u.pn * 256 * KK * 2; }
    __device__ __forceinline__ unsigned row_off(const Unit& u, int R) const { const int rr = R < u.cnt ? R : u.cnt - 1; return (unsigned)tok[u.ex * CAP + u.slot0 + rr] * (unsigned)(KK * 2); }
};
__device__ __forceinline__ unsigned cvt_pk_bf16(float lo, float hi) { unsigned r; asm volatile("v_cvt_pk_bf16_f32 %0, %1, %2" : "=v"(r) : "v"(lo), "v"(hi)); return r; }
struct EpiBf16 {
    static constexpr bool PERM = true;
    bf16* O; int ldc;
    __device__ __forceinline__ void operator()(const f32x4 (&acc)[2][2][4][2], const Unit& u, int wr, int wc, int fr, int fq) const {
        asm volatile("" : "+v"(fr), "+v"(fq));
        const int row0 = u.pm * BM + wr * 64 + fr, col0 = u.pn * BM + wc * 32 + 8 * fq;
#pragma unroll
        for (int ai = 0; ai < 2; ++ai)
#pragma unroll
            for (int m = 0; m < 4; ++m) { bf16* rowp = O + (size_t)(row0 + ai * HALF + m * 16) * ldc + col0;
#pragma unroll
                for (int bj = 0; bj < 2; ++bj) { const f32x4 v0 = acc[ai][bj][m][0], v1 = acc[ai][bj][m][1];
                    u32x4 w; w.x = cvt_pk_bf16(v0[0], v0[1]); w.y = cvt_pk_bf16(v0[2], v0[3]); w.z = cvt_pk_bf16(v1[0], v1[1]); w.w = cvt_pk_bf16(v1[2], v1[3]);
                    *(u32x4*)(rowp + bj * HALF) = w; } }
    }
};
struct EpiResid {
    static constexpr bool PERM = false;
    float* X; int ldc; const float* modl;
    __device__ __forceinline__ void operator()(const f32x4 (&acc)[2][2][4][2], const Unit& u, int wr, int wc, int fr, int fq) const {
        asm volatile("" : "+v"(fr), "+v"(fq));
        const int row0 = u.pm * BM + wr * 64 + fr, col0 = u.pn * BM + wc * 32 + 4 * fq;
        const int mr = row_mod(u.pm * BM); const float* gp = modl + (size_t)(mr * NMOD + 2) * D + col0;
        f32x4 gv[2][2];
#pragma unroll
        for (int bj = 0; bj < 2; ++bj)
#pragma unroll
            for (int n = 0; n < 2; ++n) gv[bj][n] = *(const f32x4*)(gp + bj * HALF + n * 16);
#pragma unroll
        for (int ai = 0; ai < 2; ++ai)
#pragma unroll
            for (int m = 0; m < 4; ++m) { float* rowp = X + (size_t)(row0 + ai * HALF + m * 16) * ldc + col0;
#pragma unroll
                for (int bj = 0; bj < 2; ++bj)
#pragma unroll
                    for (int n = 0; n < 2; ++n) { f32x4* q = (f32x4*)(rowp + bj * HALF + n * 16); *q = *q + gv[bj][n] * acc[ai][bj][m][n]; } }
    }
};
struct EpiMoe1 {
    static constexpr bool PERM = true;
    bf16* H; const float* wl;
    __device__ __forceinline__ void operator()(const f32x4 (&acc)[2][2][4][2], const Unit& u, int wr, int wc, int fr, int fq) const {
        asm volatile("" : "+v"(fr), "+v"(fq));
        const int lrow0 = wr * 64 + fr, f0 = u.pn * HALF + wc * 32 + 8 * fq;
#pragma unroll
        for (int ai = 0; ai < 2; ++ai)
#pragma unroll
            for (int m = 0; m < 4; ++m) { const int lr = lrow0 + ai * HALF + m * 16;
                const float w = (lr < u.cnt) ? wl[(size_t)u.ex * CAP + u.slot0 + lr] : 0.f;
                float o[8];
#pragma unroll
                for (int n = 0; n < 2; ++n)
#pragma unroll
                    for (int i = 0; i < 4; ++i) { const float g = acc[ai][0][m][n][i], up = acc[ai][1][m][n][i]; o[4 * n + i] = (lr < u.cnt) ? w * (g / (1.f + __expf(-g))) * up : 0.f; }
                u32x4 pk; pk.x = cvt_pk_bf16(o[0], o[1]); pk.y = cvt_pk_bf16(o[2], o[3]); pk.z = cvt_pk_bf16(o[4], o[5]); pk.w = cvt_pk_bf16(o[6], o[7]);
                *(u32x4*)(H + (size_t)(u.pm * BM + lr) * DE + f0) = pk; }
    }
};

template <class Epi, class Sched, bool ALIGN_EPI>
__device__ __forceinline__ void gemm_phase(LAS unsigned char* lds, const int tid, const bf16* Abase, const bf16* Bbase, const int K, const Sched& S, const Epi& E) {
    constexpr bool GA = Sched::GATHER;
    const int wid = __builtin_amdgcn_readfirstlane(tid >> 6), lane = tid & 63, wr = wid >> 2, wc = wid & 3, fr = lane & 15, fq = lane >> 4;
    const int nt = K / BK;
    unsigned voffA[2], voffB[2]; int Rst, Cst;
#pragma unroll
    for (int i = 0; i < 2; ++i) { int R, C; stage_rc(tid * 16 + i * 8192, R, C); const int Rb = Epi::PERM ? ((R & ~31) + perm32(R & 31)) : R;
        voffA[i] = (unsigned)(R * K + C) * 2u; voffB[i] = (unsigned)(Rb * K + C) * 2u; if (i == 0) { Rst = R; Cst = C; } }
    const size_t kstep = (size_t)(BK * 2);
    const size_t hstep = (size_t)HALF * K * 2;
    const size_t hstepA = GA ? 0 : hstep;
    const unsigned ldsw = (unsigned)wid * 1024u;
    const int aoff = lds_byte(wr * 64 + fr, fq * 8), boff = lds_byte(wc * 32 + fr, fq * 8);
#define PG8_SA(b, h) (((b) * 2 + (h)) * HTB)
#define PG8_SB(b, h) ((4 + (b) * 2 + (h)) * HTB)
#define PG8_STAGE(bufoff, gbase, voff) do { _Pragma("unroll") for (int _i = 0; _i < 2; ++_i) \
        __builtin_amdgcn_global_load_lds((const unsigned*)((const char*)(gbase) + (voff)[_i]), (LAS unsigned*)(lds + (bufoff) + ldsw + _i * 8192), 16, 0, 0); } while (0)
#define PG8_LDA(dst, b, h) do { _Pragma("unroll") for (int m = 0; m < 4; ++m) _Pragma("unroll") for (int k = 0; k < 2; ++k) dst[m][k] = *(const LAS bf16x8*)(lds + PG8_SA(b, h) + aoff + m * 2048 + k * 1024); } while (0)
#define PG8_LDB(dst, b, h) do { _Pragma("unroll") for (int n = 0; n < 2; ++n) _Pragma("unroll") for (int k = 0; k < 2; ++k) dst[n][k] = *(const LAS bf16x8*)(lds + PG8_SB(b, h) + boff + n * 2048 + k * 1024); } while (0)
#define PG8_MMA(ai, bj, At, Bt) do { __builtin_amdgcn_s_setprio(1); _Pragma("unroll") for (int m = 0; m < 4; ++m) _Pragma("unroll") for (int n = 0; n < 2; ++n) _Pragma("unroll") for (int k = 0; k < 2; ++k) \
        acc[ai][bj][m][n] = __builtin_amdgcn_mfma_f32_16x16x32_bf16(Bt[n][k], At[m][k], acc[ai][bj][m][n], 0, 0, 0); __builtin_amdgcn_s_setprio(0); } while (0)
#define PG8_WAIT_V(n) asm volatile("s_waitcnt vmcnt(" #n ")" ::: "memory")
#define PG8_WAIT_L(n) asm volatile("s_waitcnt lgkmcnt(" #n ")" ::: "memory")
#define PG8_BAR __builtin_amdgcn_s_barrier()
#define PG8_SCHED __builtin_amdgcn_sched_barrier(0)
    Unit cur, nxt; int ui = 0;
    if (!S.next(0, cur)) return;
    f32x4 acc[2][2][4][2];
#pragma unroll
    for (int a = 0; a < 2; ++a)
#pragma unroll
        for (int b = 0; b < 2; ++b)
#pragma unroll
            for (int m = 0; m < 4; ++m)
#pragma unroll
                for (int n = 0; n < 2; ++n) acc[a][b][m][n] = (f32x4){0.f, 0.f, 0.f, 0.f};
    bf16x8 At[4][2], B0[2][2], B1[2][2];
    unsigned cv0[2], cv1[2];
#pragma unroll
    for (int i = 0; i < 2; ++i) { cv0[i] = GA ? S.row_off(cur, Rst + 64 * i) + (unsigned)Cst * 2u : voffA[i]; cv1[i] = GA ? S.row_off(cur, HALF + Rst + 64 * i) + (unsigned)Cst * 2u : voffA[i]; }
    const char* cA = (const char*)Abase + S.a_off(cur); const char* cB = (const char*)Bbase + S.b_off(cur);
    PG8_STAGE(PG8_SB(0, 0), cB, voffB); PG8_STAGE(PG8_SB(0, 1), cB + hstep, voffB); PG8_STAGE(PG8_SA(0, 0), cA, cv0); PG8_STAGE(PG8_SA(0, 1), cA + hstepA, cv1);
    if (wr == 1) PG8_BAR;
    PG8_WAIT_V(2); PG8_BAR;
    PG8_STAGE(PG8_SB(1, 0), cB + kstep, voffB); PG8_STAGE(PG8_SA(1, 0), cA + kstep, cv0); PG8_STAGE(PG8_SB(1, 1), cB + hstep + kstep, voffB);
    PG8_WAIT_V(6); PG8_BAR;
    for (;;) {
        const bool has_next = S.next(ui + 1, nxt);
        const char* nA = has_next ? (const char*)Abase + S.a_off(nxt) : cA; const char* nB = has_next ? (const char*)Bbase + S.b_off(nxt) : cB;
#pragma unroll 1
        for (int t = 0; t < nt; t += 2) {
            const bool last = (t == nt - 2);
            const char* a1 = cA + (size_t)(t + 1) * kstep;
            const char* a2 = last ? nA : cA + (size_t)(t + 2) * kstep; const char* b2 = last ? nB : cB + (size_t)(t + 2) * kstep;
            const char* a3 = a2 + kstep; const char* b3 = b2 + kstep;
            if constexpr (GA) { if (last && has_next) {
#pragma unroll
                for (int i = 0; i < 2; ++i) cv0[i] = S.row_off(nxt, Rst + 64 * i) + (unsigned)Cst * 2u; } }
            PG8_LDB(B0, 0, 0); PG8_LDB(B1, 0, 1); PG8_SCHED; PG8_LDA(At, 0, 0); PG8_STAGE(PG8_SA(1, 1), a1 + hstepA, cv1);
            if constexpr (GA) { if (last && has_next) {
#pragma unroll
                for (int i = 0; i < 2; ++i) cv1[i] = S.row_off(nxt, HALF + Rst + 64 * i) + (unsigned)Cst * 2u; } }
            PG8_WAIT_V(8); PG8_WAIT_L(0); PG8_BAR; PG8_MMA(0, 0, At, B0); PG8_MMA(0, 1, At, B1); PG8_BAR; PG8_SCHED;
            PG8_LDA(At, 0, 1); PG8_STAGE(PG8_SB(0, 0), b2, voffB); PG8_STAGE(PG8_SB(0, 1), b2 + hstep, voffB); PG8_STAGE(PG8_SA(0, 0), a2, cv0);
            PG8_WAIT_V(8); PG8_WAIT_L(0); PG8_BAR; PG8_MMA(1, 0, At, B0); PG8_MMA(1, 1, At, B1); PG8_BAR; PG8_SCHED;
            PG8_LDB(B0, 1, 0); PG8_LDB(B1, 1, 1); PG8_SCHED; PG8_LDA(At, 1, 0); PG8_STAGE(PG8_SA(0, 1), a2 + hstepA, cv1);
            PG8_WAIT_V(8); PG8_WAIT_L(0); PG8_BAR; PG8_MMA(0, 0, At, B0); PG8_MMA(0, 1, At, B1); PG8_BAR; PG8_SCHED;
            PG8_LDA(At, 1, 1); PG8_STAGE(PG8_SB(1, 0), b3, voffB); PG8_STAGE(PG8_SB(1, 1), b3 + hstep, voffB); PG8_STAGE(PG8_SA(1, 0), a3, cv0);
            PG8_WAIT_V(8); PG8_WAIT_L(0); PG8_BAR; PG8_MMA(1, 0, At, B0); PG8_MMA(1, 1, At, B1); PG8_BAR; PG8_SCHED;
        }
        if constexpr (ALIGN_EPI) { if (wr == 0) PG8_BAR; }
        E(acc, cur, wr, wc, fr, fq);
        if (!has_next) break;
#pragma unroll
        for (int a = 0; a < 2; ++a)
#pragma unroll
            for (int b = 0; b < 2; ++b)
#pragma unroll
                for (int m = 0; m < 4; ++m)
#pragma unroll
                    for (int n = 0; n < 2; ++n) acc[a][b][m][n] = (f32x4){0.f, 0.f, 0.f, 0.f};
        cur = nxt; cA = nA; cB = nB; ++ui;
        if constexpr (ALIGN_EPI) { if (wr == 1) PG8_BAR; }
    }
    PG8_WAIT_V(0);
    if constexpr (!ALIGN_EPI) { if (wr == 0) PG8_BAR; }
    PG8_BAR;
#undef PG8_SA
#undef PG8_SB
#undef PG8_STAGE
#undef PG8_LDA
#undef PG8_LDB
#undef PG8_MMA
#undef PG8_WAIT_V
#undef PG8_WAIT_L
#undef PG8_BAR
#undef PG8_SCHED
}
}

__device__ __forceinline__ void transpose_item(const float* W, int K, int N, bf16* WT, int kb, int nb, int drow0, LAS float* scr, int lane, const float* kscale = nullptr) {
    const int k0 = 64 * kb, n0 = 32 * nb;
#pragma unroll 8
    for (int i = 0; i < 32; ++i) { const int kk = 2 * i + (lane >> 5); scr[kk * 33 + (lane & 31)] = W[(size_t)(k0 + kk) * N + n0 + (lane & 31)] * (kscale ? kscale[k0 + kk] : 1.f); }
    LDS_WAIT(); asm volatile("" ::: "memory");
    const int c = lane & 7;
#pragma unroll
    for (int j = 0; j < 4; ++j) { const int n = (lane >> 3) + 8 * j; const LAS float* s = scr + (8 * c) * 33 + n;
        u32x4 o; o.x = pk2(s[0 * 33], s[1 * 33]); o.y = pk2(s[2 * 33], s[3 * 33]); o.z = pk2(s[4 * 33], s[5 * 33]); o.w = pk2(s[6 * 33], s[7 * 33]);
        *(u32x4*)(WT + (size_t)(drow0 + n) * K + k0 + 8 * c) = o; }
    LDS_WAIT(); asm volatile("" ::: "memory");
}
__device__ __forceinline__ void p0_prologue(CPR p, Frame& F) {
    LAS float* scr = (LAS float*)(F.lds + F.wave * 16384);
    constexpr int I_IN = 16 * 61, I_OUT = 16 * 32, I_G = 128, I_L = I_IN + I_OUT + 3 * 16 * I_G + 48 + 32 + 8;
    for (int it = F.gw; it < DEPTH * I_L; it += F.ngw) {
        const int l = it / I_L; int r = it % I_L;
        if (r < I_IN) { transpose_item(p.w_in + (size_t)l * D * INW, D, INW, F.win() + (size_t)l * INP * D, r / 61, r % 61, 32 * (r % 61), scr, F.lane); continue; } r -= I_IN;
        if (r < I_OUT) { transpose_item(p.w_out + (size_t)l * D * D, D, D, F.wout() + (size_t)l * D * D, r / 32, r % 32, 32 * (r % 32), scr, F.lane); continue; } r -= I_OUT;
        if (r < 16 * I_G) { const int e = r / I_G, q = r % I_G, nb = q % 8, n0 = 32 * nb;
            transpose_item(p.moe_w_gate + (size_t)(l * NE + e) * D * DE, D, DE, F.w1() + (size_t)(l * NE + e) * 512 * D, q / 8, nb, (n0 / 128) * 256 + (n0 % 128), scr, F.lane); continue; } r -= 16 * I_G;
        if (r < 16 * I_G) { const int e = r / I_G, q = r % I_G, nb = q % 8, n0 = 32 * nb;
            transpose_item(p.moe_w_up + (size_t)(l * NE + e) * D * DE, D, DE, F.w1() + (size_t)(l * NE + e) * 512 * D, q / 8, nb, (n0 / 128) * 256 + 128 + (n0 % 128), scr, F.lane); continue; } r -= 16 * I_G;
        if (r < 16 * I_G) { const int e = r / I_G, q = r % I_G;
            transpose_item(p.moe_w_down + (size_t)(l * NE + e) * DE * D, DE, D, F.w2() + (size_t)(l * NE + e) * D * DE, q / 32, q % 32, 32 * (q % 32), scr, F.lane); continue; } r -= 16 * I_G;
        if (r < 48) { transpose_item(p.mla_w_uq + (size_t)l * 256 * 384, 256, 384, F.wuq() + (size_t)l * 384 * 256, r / 12, r % 12, 32 * (r % 12), scr, F.lane, p.mla_q_norm_g + l * 256); continue; } r -= 48;
        if (r < 32) { transpose_item(p.mla_w_ukv + (size_t)l * 128 * 512, 128, 512, F.wukv() + (size_t)l * 512 * 128, r / 16, r % 16, 32 * (r % 16), scr, F.lane, p.mla_kv_norm_g + l * 128); continue; } r -= 32;
        { const int g = r / 2, nb = r % 2; transpose_item(p.pool_w + (size_t)(l * 4 + g) * 4096, 64, 64, F.poolw() + (size_t)(l * 4 + g) * 4096, 0, nb, 32 * nb, scr, F.lane); }
    }
    for (int i = F.gt; i < DEPTH * 4 * 128 * 128; i += F.ngt) F.sguw()[i] = (bf16)f2bf(p.sgu_w[i]);
    for (int i = F.gt; i < DEPTH * (INP - INW) * D; i += F.ngt) { const int l = i / ((INP - INW) * D), q = i % ((INP - INW) * D); F.win()[(size_t)l * INP * D + (size_t)INW * D + q] = 0; }
    for (int i = F.gt; i < SEQ * 16; i += F.ngt) {
        const int t = i >> 4, k = i & 15; const float pos = (float)((k < 8) ? (t >> 6) : (t & 63));
        const float inv = __builtin_powf(10000.0f, -(float)(k & 7) / 8.0f);
        const float ang = pos * inv; F.ropec()[i] = cosf(ang); F.ropes()[i] = sinf(ang);
    }
    for (int i = F.gt; i < DEPTH * 5 * NMOD * D; i += F.ngt) {
        const int l = i / (5 * NMOD * D), r = (i / (NMOD * D)) % 5, n = i % (NMOD * D);
        const float* v = (r < 4) ? p.c + r * D : p.c_ctx; const float* w = p.ada_w + (size_t)l * D * NMOD * D + n;
        float acc = p.ada_b[l * NMOD * D + n];
#pragma unroll 8
        for (int k = 0; k < D; ++k) acc += silu_f(v[k]) * w[(size_t)k * NMOD * D];
        F.mod()[i] = acc;
    }
}

__device__ __forceinline__ int ybase_of(const Frame& F, int l, int e) {
    int b = 0;
    for (int j = 0; j < e; ++j) b += ((int)F.ctl()[CW_CNT + (l * NE + j) * 64] + 255) & ~255;
    return b;
}

__device__ __forceinline__ void p1_rows(CPR p, Frame& F, int l) {
    for (int r = F.gw; r < T; r += F.ngw) {
        const int mr = row_mod(r);
        f32x4 v[4];
        if (l == 0) { const float* src = (r < TL) ? p.x + (size_t)r * D : p.ctx + (size_t)(r - TL) * D;
#pragma unroll
            for (int j = 0; j < 4; ++j) v[j] = *(const f32x4*)(src + 4 * F.lane + 256 * j);
        } else {
            const i32x4 rt = *(const i32x4*)(F.route() + 4 * r);
            const bf16* y0 = F.y() + (size_t)(ybase_of(F, l - 1, rt.x) + rt.y) * D; const bf16* y1 = F.y() + (size_t)(ybase_of(F, l - 1, rt.z) + rt.w) * D;
            const float* g5 = mod_vec(F, l - 1, mr, 5);
#pragma unroll
            for (int j = 0; j < 4; ++j) { const int c = 4 * F.lane + 256 * j; v[j] = *(const f32x4*)(F.xl() + (size_t)r * D + c);
                const u32x2 a = *(const u32x2*)(y0 + c), b = *(const u32x2*)(y1 + c); const f32x4 g = *(const f32x4*)(g5 + c);
                v[j].x += g.x * (__uint_as_float(a.x << 16) + __uint_as_float(b.x << 16)); v[j].y += g.y * (__uint_as_float(a.x & 0xffff0000u) + __uint_as_float(b.x & 0xffff0000u));
                v[j].z += g.z * (__uint_as_float(a.y << 16) + __uint_as_float(b.y << 16)); v[j].w += g.w * (__uint_as_float(a.y & 0xffff0000u) + __uint_as_float(b.y & 0xffff0000u)); }
        }
        float ss = 0.f;
#pragma unroll
        for (int j = 0; j < 4; ++j) { *(f32x4*)(F.xl() + (size_t)r * D + 4 * F.lane + 256 * j) = v[j]; ss += v[j].x * v[j].x + v[j].y * v[j].y + v[j].z * v[j].z + v[j].w * v[j].w; }
        const float rstd = rsqrtf(wave_sum(ss) * (1.f / D) + EPS);
        const float* g1 = p.norm1_g + l * D; const float* sh = mod_vec(F, l, mr, 0); const float* sc = mod_vec(F, l, mr, 1);
#pragma unroll
        for (int j = 0; j < 4; ++j) { const int c = 4 * F.lane + 256 * j; const f32x4 g = *(const f32x4*)(g1 + c), s = *(const f32x4*)(sh + c), q = *(const f32x4*)(sc + c);
            const float h0 = v[j].x * rstd * g.x * (1.f + q.x) + s.x, h1 = v[j].y * rstd * g.y * (1.f + q.y) + s.y, h2 = v[j].z * rstd * g.z * (1.f + q.z) + s.z, h3 = v[j].w * rstd * g.w * (1.f + q.w) + s.w;
            u32x2 o; o.x = pk2(h0, h1); o.y = pk2(h2, h3); *(u32x2*)(F.ha() + (size_t)r * D + c) = o; }
    }
}

__device__ __forceinline__ void p2_inproj_naive(Frame& F, int l) {
    const bf16* W = F.win() + (size_t)l * INP * D;
    for (long i = F.gt; i < (long)T * INW; i += F.ngt) { const int r = (int)(i / INW), c = (int)(i % INW);
        F.pl()[(size_t)r * INP + c] = (bf16)f2bf(dot_bf16(F.ha() + (size_t)r * D, W + (size_t)c * D, D)); }
}

__device__ __forceinline__ void p3_mla_up_naive(CPR p, Frame& F, int l) {
    for (int r = F.gw; r < T; r += F.ngw) {
        const bf16* pr = F.pl() + (size_t)r * INP + OFF_D;
        float a[4]; { const u32x2 t = *(const u32x2*)(pr + 4 * F.lane); a[0] = __uint_as_float(t.x << 16); a[1] = __uint_as_float(t.x & 0xffff0000u); a[2] = __uint_as_float(t.y << 16); a[3] = __uint_as_float(t.y & 0xffff0000u); }
        const float rq = rsqrtf(wave_sum(a[0] * a[0] + a[1] * a[1] + a[2] * a[2] + a[3] * a[3]) * (1.f / 256.f) + EPS);
        float b2[2]; { const unsigned t = *(const unsigned*)(pr + 256 + 2 * F.lane); b2[0] = __uint_as_float(t << 16); b2[1] = __uint_as_float(t & 0xffff0000u); }
        const float rkv = rsqrtf(wave_sum(b2[0] * b2[0] + b2[1] * b2[1]) * (1.f / 128.f) + EPS);
        LAS float* sq = (LAS float*)(F.lds + F.wave * 4096);
#pragma unroll
        for (int j = 0; j < 4; ++j) sq[4 * F.lane + j] = a[j] * rq;
        sq[256 + 2 * F.lane] = b2[0] * rkv; sq[256 + 2 * F.lane + 1] = b2[1] * rkv;
        LDS_WAIT(); asm volatile("" ::: "memory");
        const bool lat = r < TL; const int t = r & (SEQ - 1);
        for (int f = F.lane; f < 384; f += 64) {
            const int h = f / 96, j = f % 96;
            float val;
            const bf16* wrow = F.wuq() + (size_t)l * 384 * 256;
            auto qdot = [&](int ff) { float s = 0.f; const bf16* w = wrow + (size_t)ff * 256; for (int k = 0; k < 256; ++k) s += sq[k] * bf2f(w[k]); return s; };
            if (j < 64 || !lat) val = qdot(f);
            else { const int i = j - 64; const int base = h * 96 + 64;
                const int q8 = i & 7, half = (i >> 3) & 1, axis = i >> 4;
                const float cs = F.ropec()[t * 16 + axis * 8 + q8], sn = F.ropes()[t * 16 + axis * 8 + q8];
                const float x1 = qdot(base + axis * 16 + q8), x2 = qdot(base + axis * 16 + 8 + q8);
                val = half ? (x1 * sn + x2 * cs) : (x1 * cs - x2 * sn); }
            F.qm()[(size_t)r * 384 + f] = (bf16)f2bf(val * (MLA_SCALE * LOG2E));
        }
        for (int f = F.lane; f < 512; f += 64) {
            const int h = f / 128, j = f % 128; float s = 0.f; const bf16* w = F.wukv() + (size_t)l * 512 * 128 + (size_t)f * 128;
            for (int k = 0; k < 128; ++k) s += sq[256 + k] * bf2f(w[k]);
            if (j < 64) F.km()[(size_t)r * 384 + h * 96 + j] = (bf16)f2bf(s); else F.vm()[(size_t)r * 256 + h * 64 + (j - 64)] = (bf16)f2bf(s);
        }
        if (F.lane < 32) { const int i = F.lane, q8 = i & 7, half = (i >> 3) & 1, axis = i >> 4;
            const float x1 = bf2f(pr[384 + axis * 16 + q8]), x2 = bf2f(pr[384 + axis * 16 + 8 + q8]);
            float val;
            if (lat) { const float cs = F.ropec()[t * 16 + axis * 8 + q8], sn = F.ropes()[t * 16 + axis * 8 + q8]; val = half ? (x1 * sn + x2 * cs) : (x1 * cs - x2 * sn); }
            else val = bf2f(pr[384 + i]);
#pragma unroll
            for (int h = 0; h < 4; ++h) F.km()[(size_t)r * 384 + h * 96 + 64 + i] = (bf16)f2bf(val); }
        LDS_WAIT(); asm volatile("" ::: "memory");
    }
}
__device__ __forceinline__ void p3_pool_naive(CPR p, Frame& F, int l) {
    for (int i = F.gt; i < T * 256; i += F.ngt) {
        const int r = i >> 8, col = i & 255, g = col >> 6, d = col & 63;
        const int L = r < TL ? SEQ : CTX, t = r < TL ? (r & (SEQ - 1)) : ((r - TL) & (CTX - 1)), seg0 = r - t;
        const int win = 2 << g; int lo = t - win / 2, hi = t - win / 2 + win; lo = lo < 0 ? 0 : lo; hi = hi > L ? L : hi;
        const float inv = 1.f / (float)(hi - lo);
        const bf16* wt = F.poolw() + (size_t)(l * 4 + g) * 4096 + d * 64;
        float acc = 0.f;
        for (int c = 0; c < 64; ++c) { float m = 0.f; for (int s = lo; s < hi; ++s) m += bf2f(F.pl()[(size_t)(seg0 + s) * INP + g * 64 + c]);
            const float df = m * inv - bf2f(F.pl()[(size_t)r * INP + g * 64 + c]); acc += df * bf2f(wt[c]); }
        F.ml()[(size_t)r * D + col] = (bf16)f2bf(acc * p.pool_s[l * 256 + col]);
    }
}
__device__ __forceinline__ void p3_sgu1_naive(CPR p, Frame& F, int l) {
    bf16* vg = F.hid();
    for (int r = F.gw; r < T; r += F.ngw) {
        const bf16* pv = F.pl() + (size_t)r * INP + OFF_C + 256;
        float a[4]; { const u32x2 t = *(const u32x2*)(pv + 4 * F.lane); a[0] = gelu_tanh(__uint_as_float(t.x << 16)); a[1] = gelu_tanh(__uint_as_float(t.x & 0xffff0000u)); a[2] = gelu_tanh(__uint_as_float(t.y << 16)); a[3] = gelu_tanh(__uint_as_float(t.y & 0xffff0000u)); }
        float ss = a[0] * a[0] + a[1] * a[1] + a[2] * a[2] + a[3] * a[3];
#pragma unroll
        for (int o = 1; o < 16; o <<= 1) ss += __shfl_xor(ss, o);
        const float rs = rsqrtf(ss * (1.f / 64.f) + EPS); const float* gn = p.sgu_norm_g + l * 256 + 4 * F.lane;
        u32x2 o; o.x = pk2(a[0] * rs * gn[0], a[1] * rs * gn[1]); o.y = pk2(a[2] * rs * gn[2], a[3] * rs * gn[3]);
        *(u32x2*)(vg + (size_t)r * 256 + 4 * F.lane) = o;
    }
}
__device__ __forceinline__ void p3_sgu2_naive(CPR p, Frame& F, int l) {
    const bf16* vg = F.hid();
    for (int i = F.gt; i < T * 256; i += F.ngt) {
        const int r = i >> 8, col = i & 255, g = col >> 6, pp = r & 127, r0 = r - pp;
        const bf16* w = F.sguw() + ((size_t)(l * 4 + g) * 128 + pp) * 128;
        float acc = p.sgu_b[(l * 4 + g) * 128 + pp];
        for (int q = 0; q < 128; ++q) acc += bf2f(w[q]) * bf2f(vg[(size_t)(r0 + q) * 256 + col]);
        const float u = gelu_tanh(bf2f(F.pl()[(size_t)r * INP + OFF_C + col]));
        F.ml()[(size_t)r * D + 512 + col] = (bf16)f2bf(u * acc);
    }
}
__device__ __forceinline__ void p3_na_naive(CPR p, Frame& F, int l) {
    LAS float* pw = (LAS float*)(F.lds + 65536 + F.wave * 2048);
    for (int it = F.gw; it < T * 4; it += F.ngw) {
        const int r = it >> 2, h = it & 3; const bool lat = r < TL; const int b = row_batch(r);
        float q[64];
        { const bf16* qp = F.pl() + (size_t)r * INP + OFF_B + h * 64;
#pragma unroll
          for (int j = 0; j < 8; ++j) { const u32x4 t = *(const u32x4*)(qp + 8 * j);
#pragma unroll
              for (int k = 0; k < 4; ++k) { q[8 * j + 2 * k] = __uint_as_float(t[k] << 16); q[8 * j + 2 * k + 1] = __uint_as_float(t[k] & 0xffff0000u); } } }
        const int t = r & (SEQ - 1), gr = t >> 6, gc = t & 63, jb = gc >> 4;
        int rs = gr - 4; rs = rs < 0 ? 0 : (rs > GH - 8 ? GH - 8 : rs);
        int wsq = gc - 8; wsq = wsq < 0 ? 0 : (wsq > GW - 16 ? GW - 16 : wsq);
        int cs = 16 * jb - 8; cs = cs < 0 ? 0 : (cs > GW - 16 ? GW - 16 : cs); cs = cs > GW - 32 ? GW - 32 : cs;
        const float* rpb = p.na_rpb + (size_t)(l * 4 + h) * 15 * 31;
        float s[8];
#pragma unroll
        for (int i = 0; i < 8; ++i) {
            const int k = F.lane + 64 * (i & 3); const bool win = i < 4;
            int keyrow; float bias = 0.f; bool valid = true;
            if (win) { const int rr = k >> 5, cc = k & 31, kcol = cs + cc; keyrow = b * SEQ + (rs + rr) * 64 + kcol;
                valid = lat && (kcol >= wsq) && (kcol < wsq + 16);
                int dc = kcol - gc + 15; dc = dc < 0 ? 0 : (dc > 30 ? 30 : dc);
                bias = rpb[(rs + rr - gr + 7) * 31 + dc];
                if (!lat) keyrow = r; }
            else keyrow = TL + b * CTX + k;
            const bf16* kp = F.pl() + (size_t)keyrow * INP + OFF_B + 256 + h * 64;
            float d = 0.f;
#pragma unroll
            for (int j = 0; j < 8; ++j) { const u32x4 tt = *(const u32x4*)(kp + 8 * j);
#pragma unroll
                for (int kk = 0; kk < 4; ++kk) d += q[8 * j + 2 * kk] * __uint_as_float(tt[kk] << 16) + q[8 * j + 2 * kk + 1] * __uint_as_float(tt[kk] & 0xffff0000u); }
            s[i] = valid ? (d * 0.125f + bias) : -1e30f;
        }
        float m = s[0];
#pragma unroll
        for (int i = 1; i < 8; ++i) m = fmaxf(m, s[i]);
        m = wave_max(m);
        float sum = 0.f;
#pragma unroll
        for (int i = 0; i < 8; ++i) { s[i] = __expf(s[i] - m); sum += s[i]; }
        sum = wave_sum(sum); const float inv = 1.f / sum;
#pragma unroll
        for (int i = 0; i < 8; ++i) pw[(i >> 2) * 256 + F.lane + 64 * (i & 3)] = s[i] * inv;
        LDS_WAIT(); asm volatile("" ::: "memory");
        float acc = 0.f;
        if (lat) for (int k = 0; k < 256; ++k) { const int rr = k >> 5, cc = k & 31; const int keyrow = b * SEQ + (rs + rr) * 64 + cs + cc;
            acc += pw[k] * bf2f(F.pl()[(size_t)keyrow * INP + OFF_B + 512 + h * 64 + F.lane]); }
        for (int k = 0; k < 256; ++k) acc += pw[256 + k] * bf2f(F.pl()[(size_t)(TL + b * CTX + k) * INP + OFF_B + 512 + h * 64 + F.lane]);
        F.ml()[(size_t)r * D + 256 + h * 64 + F.lane] = (bf16)f2bf(acc);
        LDS_WAIT(); asm volatile("" ::: "memory");
    }
}
__device__ __forceinline__ void p4_mla_naive(Frame& F) {
    LAS float* pw = (LAS float*)(F.lds + 65536 + F.wave * 2048);
    for (int it = F.gw; it < T * 4; it += F.ngw) {
        const int r = it >> 2, h = it & 3; const bool lat = r < TL; const int b = row_batch(r);
        float q[96];
        { const bf16* qp = F.qm() + (size_t)r * 384 + h * 96;
#pragma unroll
          for (int j = 0; j < 12; ++j) { const u32x4 t = *(const u32x4*)(qp + 8 * j);
#pragma unroll
              for (int k = 0; k < 4; ++k) { q[8 * j + 2 * k] = __uint_as_float(t[k] << 16); q[8 * j + 2 * k + 1] = __uint_as_float(t[k] & 0xffff0000u); } } }
        const int nk = lat ? (CTX + SEQ) : CTX;
        float m = -3.0e38f, lsum = 0.f, acc = 0.f;
        for (int k0 = 0; k0 < nk; k0 += 64) {
            const int k = k0 + F.lane; const int keyrow = (k < CTX) ? (TL + b * CTX + k) : (b * SEQ + k - CTX);
            const bf16* kp = F.km() + (size_t)keyrow * 384 + h * 96;
            float d = 0.f;
#pragma unroll
            for (int j = 0; j < 12; ++j) { const u32x4 tt = *(const u32x4*)(kp + 8 * j);
#pragma unroll
                for (int kk = 0; kk < 4; ++kk) d += q[8 * j + 2 * kk] * __uint_as_float(tt[kk] << 16) + q[8 * j + 2 * kk + 1] * __uint_as_float(tt[kk] & 0xffff0000u); }
            const float mn = fmaxf(m, wave_max(d)); const float alpha = exp2f(m - mn); const float pe = exp2f(d - mn);
            lsum = lsum * alpha + wave_sum(pe); acc *= alpha; m = mn;
            pw[F.lane] = pe; LDS_WAIT(); asm volatile("" ::: "memory");
            for (int kk = 0; kk < 64; ++kk) { const int k2 = k0 + kk; const int kr2 = (k2 < CTX) ? (TL + b * CTX + k2) : (b * SEQ + k2 - CTX);
                acc += pw[kk] * bf2f(F.vm()[(size_t)kr2 * 256 + h * 64 + F.lane]); }
            LDS_WAIT(); asm volatile("" ::: "memory");
        }
        F.ml()[(size_t)r * D + 768 + h * 64 + F.lane] = (bf16)f2bf(acc / lsum);
    }
}

typedef float f32x16 __attribute__((ext_vector_type(16)));
typedef short s16x4 __attribute__((ext_vector_type(4)));
__device__ __forceinline__ s16x4 lds_tr16(const LAS unsigned char* p) { return __builtin_bit_cast(s16x4, __builtin_amdgcn_ds_read_tr16_b64_v4i16((LAS s16x4*)p)); }
__device__ __forceinline__ bf16x8 pack8(const f32x16& v, int o) {
    u32x4 w; w.x = pg8::cvt_pk_bf16(v[o + 0], v[o + 1]); w.y = pg8::cvt_pk_bf16(v[o + 2], v[o + 3]); w.z = pg8::cvt_pk_bf16(v[o + 4], v[o + 5]); w.w = pg8::cvt_pk_bf16(v[o + 6], v[o + 7]);
    return __builtin_bit_cast(bf16x8, w);
}
__device__ __forceinline__ void p4_mla_flash(Frame& F) {
    constexpr int KP = 208, VP = 144, KB = 64 * KP, VB = 64 * VP, BUF = KB + VB;
    const int tid = F.tid, lane = F.lane, w = F.wave, q = lane & 31, hh = lane >> 5;
    const bf16* qm = F.qm(); const bf16* km = F.km(); const bf16* vm = F.vm(); bf16* ml = F.ml();
    const int kc0 = tid, kc1 = 512 + (tid & 255);
    const int k0key = kc0 / 12, k0part = kc0 % 12, k1key = kc1 / 12, k1part = kc1 % 12, vkey = tid >> 3, vpart = tid & 7;
    const int trow = 4 * hh + ((lane & 15) >> 2), tcol = 16 * ((lane >> 4) & 1) + 4 * (lane & 3);
    for (int ui = blockIdx.x; ui < 272; ui += gridDim.x) {
        const int qt = ui < 256 ? (ui >> 2) : 64 + ((ui - 256) >> 2), h = ui & 3;
        const bool lat = qt < 64; const int b = lat ? (qt >> 4) : (qt - 64), ntile = lat ? 68 : 4;
        const int qrow = qt * 256 + w * 32 + q;
        bf16x8 qf[6];
#pragma unroll
        for (int ks = 0; ks < 6; ++ks) qf[ks] = *(const bf16x8*)(qm + (size_t)qrow * 384 + h * 96 + 16 * ks + 8 * hh);
        f32x16 ot0, ot1;
#pragma unroll
        for (int r = 0; r < 16; ++r) { ot0[r] = 0.f; ot1[r] = 0.f; }
        float m = -1.0e30f, l = 0.f;
        u32x4 kr0, kr1, vr;
#define MLA_LOAD(t) do { const int t_ = (t); const int kr_ = (lat && t_ >= 4) ? b * SEQ + 64 * (t_ - 4) : TL + b * CTX + 64 * t_; \
            kr0 = *(const u32x4*)(km + (size_t)(kr_ + k0key) * 384 + h * 96 + 8 * k0part); \
            if (tid < 256) kr1 = *(const u32x4*)(km + (size_t)(kr_ + k1key) * 384 + h * 96 + 8 * k1part); \
            vr = *(const u32x4*)(vm + (size_t)(kr_ + vkey) * 256 + h * 64 + 8 * vpart); } while (0)
#define MLA_STORE(bufi) do { LAS unsigned char* kb_ = F.lds + (bufi) * BUF; \
            *(LAS u32x4*)(kb_ + k0key * KP + k0part * 16) = kr0; if (tid < 256) *(LAS u32x4*)(kb_ + k1key * KP + k1part * 16) = kr1; \
            *(LAS u32x4*)(kb_ + KB + vkey * VP + vpart * 16) = vr; } while (0)
        MLA_LOAD(0); MLA_STORE(0);
        __syncthreads();
        for (int t = 0; t < ntile; ++t) {
            if (t + 1 < ntile) MLA_LOAD(t + 1);
            const LAS unsigned char* kb = F.lds + (t & 1) * BUF; const LAS unsigned char* vb = kb + KB;
            f32x16 s0, s1;
#pragma unroll
            for (int r = 0; r < 16; ++r) { s0[r] = 0.f; s1[r] = 0.f; }
#pragma unroll
            for (int ks = 0; ks < 6; ++ks) {
                const bf16x8 ka = *(const LAS bf16x8*)(kb + q * KP + (16 * ks + 8 * hh) * 2);
                const bf16x8 kb2 = *(const LAS bf16x8*)(kb + (32 + q) * KP + (16 * ks + 8 * hh) * 2);
                s0 = __builtin_amdgcn_mfma_f32_32x32x16_bf16(ka, qf[ks], s0, 0, 0, 0);
                s1 = __builtin_amdgcn_mfma_f32_32x32x16_bf16(kb2, qf[ks], s1, 0, 0, 0);
            }
            float mx = fmaxf(s0[0], s1[0]);
#pragma unroll
            for (int r = 1; r < 16; ++r) mx = fmaxf(mx, fmaxf(s0[r], s1[r]));
            mx = fmaxf(mx, __shfl_xor(mx, 32));
            const float mn = fmaxf(m, mx), alpha = __builtin_amdgcn_exp2f(m - mn); m = mn;
            float rs = 0.f;
#pragma unroll
            for (int r = 0; r < 16; ++r) { s0[r] = __builtin_amdgcn_exp2f(s0[r] - mn); s1[r] = __builtin_amdgcn_exp2f(s1[r] - mn); rs += s0[r] + s1[r]; }
            l = l * alpha + rs;
#pragma unroll
            for (int r = 0; r < 16; ++r) { ot0[r] *= alpha; ot1[r] *= alpha; }
            bf16x8 pb[4]; pb[0] = pack8(s0, 0); pb[1] = pack8(s0, 8); pb[2] = pack8(s1, 0); pb[3] = pack8(s1, 8);
#pragma unroll
            for (int kk = 0; kk < 4; ++kk) {
                const LAS unsigned char* a0 = vb + (16 * kk + trow) * VP + tcol * 2;
                const s16x4 lo0 = lds_tr16(a0), hi0 = lds_tr16(a0 + 8 * VP), lo1 = lds_tr16(a0 + 64), hi1 = lds_tr16(a0 + 8 * VP + 64);
                const bf16x8 v0 = (bf16x8){lo0[0], lo0[1], lo0[2], lo0[3], hi0[0], hi0[1], hi0[2], hi0[3]};
                const bf16x8 v1 = (bf16x8){lo1[0], lo1[1], lo1[2], lo1[3], hi1[0], hi1[1], hi1[2], hi1[3]};
                ot0 = __builtin_amdgcn_mfma_f32_32x32x16_bf16(v0, pb[kk], ot0, 0, 0, 0);
                ot1 = __builtin_amdgcn_mfma_f32_32x32x16_bf16(v1, pb[kk], ot1, 0, 0, 0);
            }
            if (t + 1 < ntile) MLA_STORE((t + 1) & 1);
            __syncthreads();
        }
#undef MLA_LOAD
#undef MLA_STORE
        l += __shfl_xor(l, 32);
        const float il = 1.f / l;
        bf16* orow = ml + (size_t)qrow * D + 768 + h * 64 + 4 * hh;
#pragma unroll
        for (int g = 0; g < 4; ++g) {
            u32x2 o0, o1;
            o0.x = pg8::cvt_pk_bf16(ot0[4 * g] * il, ot0[4 * g + 1] * il); o0.y = pg8::cvt_pk_bf16(ot0[4 * g + 2] * il, ot0[4 * g + 3] * il);
            o1.x = pg8::cvt_pk_bf16(ot1[4 * g] * il, ot1[4 * g + 1] * il); o1.y = pg8::cvt_pk_bf16(ot1[4 * g + 2] * il, ot1[4 * g + 3] * il);
            *(u32x2*)(orow + 8 * g) = o0; *(u32x2*)(orow + 32 + 8 * g) = o1;
        }
    }
}

__device__ __forceinline__ void p3_na_mfma(CPR p, Frame& F, int l) {
    constexpr int TP = 144, KBs = 32 * TP, WB = 2 * KBs, BT_OFF = 8 * WB;
    const int tid = F.tid, lane = F.lane, q = lane & 31, hh = lane >> 5;
    LAS unsigned char* wk = F.lds + F.wave * WB; LAS unsigned char* wv = wk + KBs;
    LAS float* btab = (LAS float*)(F.lds + BT_OFF);
    __syncthreads();
    for (int i = tid; i < 4 * 465; i += NTHR) btab[i] = p.na_rpb[(size_t)l * 1860 + i] * LOG2E;
    __syncthreads();
    const bf16* pl = F.pl(); bf16* ml = F.ml();
    const int skey = lane >> 3, spart = lane & 7;
    const int trow = 4 * hh + ((lane & 15) >> 2), tcol = 16 * ((lane >> 4) & 1) + 4 * (lane & 3);
    constexpr float QS = 0.125f * LOG2E;
    for (int it = F.gw; it < 2176; it += F.ngw) {
        const bool lat = it < 2048; const int x = lat ? it : it - 2048;
        const int h = x & 3, b = lat ? (x >> 9) : (x >> 5), r = (x >> 3) & 63, jp = (x >> 2) & 1, g8 = (x >> 2) & 7;
        const int qrow = lat ? b * SEQ + r * 64 + 32 * jp + q : TL + b * CTX + 32 * g8 + q;
        const int ntile = lat ? 18 : 8;
        int rs = r - 4; rs = rs < 0 ? 0 : (rs > GH - 8 ? GH - 8 : rs);
        const int cb = jp ? 24 : 0, gc = 32 * jp + q; int wsq = gc - 8; wsq = wsq < 0 ? 0 : (wsq > GW - 16 ? GW - 16 : wsq);
        const int baddr = ((h * 15 + (rs - r + 7)) * 31 + cb - gc + 15 + 4 * hh) * 4;
        const int vk0 = cb + 4 * hh - wsq;
        bf16x8 qf[4];
#pragma unroll
        for (int ks = 0; ks < 4; ++ks) qf[ks] = *(const bf16x8*)(pl + (size_t)qrow * INP + OFF_B + 64 * h + 16 * ks + 8 * hh);
        f32x16 ot0, ot1;
#pragma unroll
        for (int i = 0; i < 16; ++i) { ot0[i] = 0.f; ot1[i] = 0.f; }
        float m = -1.0e30f, lsum = 0.f;
        u32x4 kr[4], vr[4];
#define NA_LOAD(t) do { const int t_ = (t); _Pragma("unroll") for (int j = 0; j < 4; ++j) { int row_; \
            if (t_ < 8) row_ = TL + b * CTX + 32 * t_ + 8 * j + skey; \
            else { const int x_ = 4 * (t_ - 8) + j, rr_ = (x_ * 205) >> 10, cg_ = x_ - 5 * rr_; row_ = b * SEQ + (rs + rr_) * 64 + cb + 8 * cg_ + skey; } \
            const bf16* src_ = pl + (size_t)row_ * INP + OFF_B + 256 + 64 * h + 8 * spart; kr[j] = *(const u32x4*)src_; vr[j] = *(const u32x4*)(src_ + 256); } } while (0)
#define NA_STORE() do { _Pragma("unroll") for (int j = 0; j < 4; ++j) { *(LAS u32x4*)(wk + (8 * j + skey) * TP + spart * 16) = kr[j]; *(LAS u32x4*)(wv + (8 * j + skey) * TP + spart * 16) = vr[j]; } } while (0)
        NA_LOAD(0); NA_STORE();
        for (int t = 0; t < ntile; ++t) {
            if (t + 1 < ntile) NA_LOAD(t + 1);
            f32x16 sc;
#pragma unroll
            for (int i = 0; i < 16; ++i) sc[i] = 0.f;
#pragma unroll
            for (int ks = 0; ks < 4; ++ks) {
                const bf16x8 ka = *(const LAS bf16x8*)(wk + q * TP + (16 * ks + 8 * hh) * 2);
                sc = __builtin_amdgcn_mfma_f32_32x32x16_bf16(ka, qf[ks], sc, 0, 0, 0);
            }
            if (t < 8) {
#pragma unroll
                for (int i = 0; i < 16; ++i) sc[i] *= QS;
            } else {
                const int wt = t - 8;
#pragma unroll
                for (int g = 0; g < 4; ++g) {
                    const int x_ = 4 * wt + g, rr_ = (x_ * 205) >> 10, cg_ = x_ - 5 * rr_;
                    const LAS float* bp = (const LAS float*)((const LAS unsigned char*)btab + baddr + (rr_ * 31 + 8 * cg_) * 4);
                    const int vk = vk0 + 8 * cg_;
#pragma unroll
                    for (int e = 0; e < 4; ++e) { const float bias = bp[e]; const bool ok = (unsigned)(vk + e) < 16u; sc[4 * g + e] = ok ? fmaf(sc[4 * g + e], QS, bias) : -1.0e30f; }
                }
            }
            float mx = sc[0];
#pragma unroll
            for (int i = 1; i < 16; ++i) mx = fmaxf(mx, sc[i]);
            mx = fmaxf(mx, __shfl_xor(mx, 32));
            const float mn = fmaxf(m, mx), alpha = __builtin_amdgcn_exp2f(m - mn); m = mn;
            float rsum = 0.f;
#pragma unroll
            for (int i = 0; i < 16; ++i) { sc[i] = __builtin_amdgcn_exp2f(sc[i] - mn); rsum += sc[i]; }
            lsum = lsum * alpha + rsum;
#pragma unroll
            for (int i = 0; i < 16; ++i) { ot0[i] *= alpha; ot1[i] *= alpha; }
            bf16x8 pb[2]; pb[0] = pack8(sc, 0); pb[1] = pack8(sc, 8);
#pragma unroll
            for (int kk = 0; kk < 2; ++kk) {
                const LAS unsigned char* a0 = wv + (16 * kk + trow) * TP + tcol * 2;
                const s16x4 lo0 = lds_tr16(a0), hi0 = lds_tr16(a0 + 8 * TP), lo1 = lds_tr16(a0 + 64), hi1 = lds_tr16(a0 + 8 * TP + 64);
                const bf16x8 v0 = (bf16x8){lo0[0], lo0[1], lo0[2], lo0[3], hi0[0], hi0[1], hi0[2], hi0[3]};
                const bf16x8 v1 = (bf16x8){lo1[0], lo1[1], lo1[2], lo1[3], hi1[0], hi1[1], hi1[2], hi1[3]};
                ot0 = __builtin_amdgcn_mfma_f32_32x32x16_bf16(v0, pb[kk], ot0, 0, 0, 0);
                ot1 = __builtin_amdgcn_mfma_f32_32x32x16_bf16(v1, pb[kk], ot1, 0, 0, 0);
            }
            if (t + 1 < ntile) NA_STORE();
        }
#undef NA_LOAD
#undef NA_STORE
        lsum += __shfl_xor(lsum, 32);
        const float il = 1.f / lsum;
        bf16* orow = ml + (size_t)qrow * D + 256 + h * 64 + 4 * hh;
#pragma unroll
        for (int g = 0; g < 4; ++g) {
            u32x2 o0, o1;
            o0.x = pg8::cvt_pk_bf16(ot0[4 * g] * il, ot0[4 * g + 1] * il); o0.y = pg8::cvt_pk_bf16(ot0[4 * g + 2] * il, ot0[4 * g + 3] * il);
            o1.x = pg8::cvt_pk_bf16(ot1[4 * g] * il, ot1[4 * g + 1] * il); o1.y = pg8::cvt_pk_bf16(ot1[4 * g + 2] * il, ot1[4 * g + 3] * il);
            *(u32x2*)(orow + 8 * g) = o0; *(u32x2*)(orow + 32 + 8 * g) = o1;
        }
    }
    __syncthreads();
}

__device__ __forceinline__ float sumsq8(const bf16x8& v) { const u32x4 u = __builtin_bit_cast(u32x4, v); float s = 0.f;
#pragma unroll
    for (int j = 0; j < 4; ++j) { const float a = __uint_as_float(u[j] << 16), b = __uint_as_float(u[j] & 0xffff0000u); s += a * a + b * b; }
    return s; }
__device__ __forceinline__ void p3_mla_up(Frame& F, int l) {
    const int lane = F.lane, tkn = lane & 31, hh = lane >> 5;
    const bf16* pl = F.pl(); const bf16* wq = F.wuq() + (size_t)l * 384 * 256; const bf16* wkv = F.wukv() + (size_t)l * 512 * 128;
    bf16* qm = F.qm(); bf16* km = F.km(); bf16* vm = F.vm();
    const int G = gridDim.x;
    for (int it = F.wave * G + blockIdx.x; it < T / 32; it += NWAVES * G) {
        const int row = it * 32 + tkn; const bool lat = row < TL; const int t = row & (SEQ - 1);
        const bf16* pr = pl + (size_t)row * INP + OFF_D;
        bf16x8 bq[16], bk[8]; float sq = 0.f, sk = 0.f;
#pragma unroll
        for (int ks = 0; ks < 16; ++ks) { bq[ks] = *(const bf16x8*)(pr + 16 * ks + 8 * hh); sq += sumsq8(bq[ks]); }
#pragma unroll
        for (int ks = 0; ks < 8; ++ks) { bk[ks] = *(const bf16x8*)(pr + 256 + 16 * ks + 8 * hh); sk += sumsq8(bk[ks]); }
        sq += __shfl_xor(sq, 32); sk += __shfl_xor(sk, 32);
        const float rq = rsqrtf(sq * (1.f / 256.f) + EPS) * (MLA_SCALE * LOG2E), rk = rsqrtf(sk * (1.f / 128.f) + EPS);
        f32x4 cr = {1.f, 1.f, 1.f, 1.f}, sr = {0.f, 0.f, 0.f, 0.f}, cc = cr, sc = sr;
        if (lat) { cr = *(const f32x4*)(F.ropec() + t * 16 + 4 * hh); sr = *(const f32x4*)(F.ropes() + t * 16 + 4 * hh); cc = *(const f32x4*)(F.ropec() + t * 16 + 8 + 4 * hh); sc = *(const f32x4*)(F.ropes() + t * 16 + 8 + 4 * hh); }
        for (int nt = 0; nt < 12; ++nt) {
            f32x16 acc;
#pragma unroll
            for (int i = 0; i < 16; ++i) acc[i] = 0.f;
            const bf16* wr = wq + (size_t)(32 * nt + tkn) * 256 + 8 * hh;
#pragma unroll
            for (int ks = 0; ks < 16; ++ks) acc = __builtin_amdgcn_mfma_f32_32x32x16_bf16(*(const bf16x8*)(wr + 16 * ks), bq[ks], acc, 0, 0, 0);
#pragma unroll
            for (int i = 0; i < 16; ++i) acc[i] *= rq;
            if (nt % 3 == 2) {
#pragma unroll
                for (int e = 0; e < 4; ++e) { const float x1 = acc[e], x2 = acc[4 + e], y1 = acc[8 + e], y2 = acc[12 + e];
                    acc[e] = x1 * cr[e] - x2 * sr[e]; acc[4 + e] = x1 * sr[e] + x2 * cr[e]; acc[8 + e] = y1 * cc[e] - y2 * sc[e]; acc[12 + e] = y1 * sc[e] + y2 * cc[e]; }
            }
            bf16* o = qm + (size_t)row * 384 + 32 * nt + 4 * hh;
#pragma unroll
            for (int g = 0; g < 4; ++g) { u32x2 w; w.x = pg8::cvt_pk_bf16(acc[4 * g], acc[4 * g + 1]); w.y = pg8::cvt_pk_bf16(acc[4 * g + 2], acc[4 * g + 3]); *(u32x2*)(o + 8 * g) = w; }
        }
        for (int nt = 0; nt < 16; ++nt) {
            f32x16 acc;
#pragma unroll
            for (int i = 0; i < 16; ++i) acc[i] = 0.f;
            const bf16* wr = wkv + (size_t)(32 * nt + tkn) * 128 + 8 * hh;
#pragma unroll
            for (int ks = 0; ks < 8; ++ks) acc = __builtin_amdgcn_mfma_f32_32x32x16_bf16(*(const bf16x8*)(wr + 16 * ks), bk[ks], acc, 0, 0, 0);
            const int h = nt >> 2, sub = nt & 3;
            bf16* o = (sub < 2) ? km + (size_t)row * 384 + 96 * h + 32 * sub + 4 * hh : vm + (size_t)row * 256 + 64 * h + 32 * (sub - 2) + 4 * hh;
#pragma unroll
            for (int g = 0; g < 4; ++g) { u32x2 w; w.x = pg8::cvt_pk_bf16(acc[4 * g] * rk, acc[4 * g + 1] * rk); w.y = pg8::cvt_pk_bf16(acc[4 * g + 2] * rk, acc[4 * g + 3] * rk); *(u32x2*)(o + 8 * g) = w; }
        }
        { const u32x4 a = *(const u32x4*)(pr + 384 + 16 * hh), bb = *(const u32x4*)(pr + 384 + 16 * hh + 8);
          float x1[8], x2[8];
#pragma unroll
          for (int j = 0; j < 4; ++j) { x1[2 * j] = __uint_as_float(a[j] << 16); x1[2 * j + 1] = __uint_as_float(a[j] & 0xffff0000u); x2[2 * j] = __uint_as_float(bb[j] << 16); x2[2 * j + 1] = __uint_as_float(bb[j] & 0xffff0000u); }
          float o1[8], o2[8];
#pragma unroll
          for (int j = 0; j < 8; ++j) { float c = 1.f, sn = 0.f; if (lat) { c = F.ropec()[t * 16 + 8 * hh + j]; sn = F.ropes()[t * 16 + 8 * hh + j]; } o1[j] = x1[j] * c - x2[j] * sn; o2[j] = x1[j] * sn + x2[j] * c; }
          u32x4 w1, w2;
#pragma unroll
          for (int j = 0; j < 4; ++j) { w1[j] = pg8::cvt_pk_bf16(o1[2 * j], o1[2 * j + 1]); w2[j] = pg8::cvt_pk_bf16(o2[2 * j], o2[2 * j + 1]); }
#pragma unroll
          for (int h = 0; h < 4; ++h) { bf16* o = km + (size_t)row * 384 + 96 * h + 64 + 16 * hh; *(u32x4*)o = w1; *(u32x4*)(o + 8) = w2; } }
    }
}

__device__ __forceinline__ void p3_pool_mfma(CPR p, Frame& F, int l) {
    const int lane = F.lane, tk = lane & 31, hh = lane >> 5;
    const bf16* pl = F.pl(); bf16* ml = F.ml();
    for (int it = F.gw; it < (T / 32) * 4; it += F.ngw) {
        const int g = it & 3, row = (it >> 2) * 32 + tk;
        const int L = row < TL ? SEQ : CTX, t = row < TL ? (row & (SEQ - 1)) : ((row - TL) & (CTX - 1)), seg0 = row - t;
        const int win = 2 << g; int lo = t - win / 2, hi = t - win / 2 + win; lo = lo < 0 ? 0 : lo; hi = hi > L ? L : hi;
        const float inv = 1.f / (float)(hi - lo);
        float sum[32];
#pragma unroll
        for (int i = 0; i < 32; ++i) sum[i] = 0.f;
        for (int sidx = lo; sidx < hi; ++sidx) {
            const bf16* src = pl + (size_t)(seg0 + sidx) * INP + 64 * g + 8 * hh;
#pragma unroll
            for (int ks = 0; ks < 4; ++ks) { const u32x4 v = *(const u32x4*)(src + 16 * ks);
#pragma unroll
                for (int j = 0; j < 4; ++j) { sum[8 * ks + 2 * j] += __uint_as_float(v[j] << 16); sum[8 * ks + 2 * j + 1] += __uint_as_float(v[j] & 0xffff0000u); } }
        }
        bf16x8 df[4];
        { const bf16* src = pl + (size_t)row * INP + 64 * g + 8 * hh;
#pragma unroll
          for (int ks = 0; ks < 4; ++ks) { const u32x4 v = *(const u32x4*)(src + 16 * ks); u32x4 w;
#pragma unroll
              for (int j = 0; j < 4; ++j) w[j] = pg8::cvt_pk_bf16(sum[8 * ks + 2 * j] * inv - __uint_as_float(v[j] << 16), sum[8 * ks + 2 * j + 1] * inv - __uint_as_float(v[j] & 0xffff0000u));
              df[ks] = __builtin_bit_cast(bf16x8, w); } }
        const bf16* wt = F.poolw() + (size_t)(l * 4 + g) * 4096;
#pragma unroll
        for (int dt = 0; dt < 2; ++dt) {
            f32x16 acc;
#pragma unroll
            for (int i = 0; i < 16; ++i) acc[i] = 0.f;
#pragma unroll
            for (int ks = 0; ks < 4; ++ks) acc = __builtin_amdgcn_mfma_f32_32x32x16_bf16(*(const bf16x8*)(wt + (size_t)(32 * dt + tk) * 64 + 16 * ks + 8 * hh), df[ks], acc, 0, 0, 0);
            const int col = 64 * g + 32 * dt + 4 * hh; const float* ps = p.pool_s + l * 256 + col; bf16* o = ml + (size_t)row * D + col;
#pragma unroll
            for (int gg = 0; gg < 4; ++gg) { const f32x4 sc = *(const f32x4*)(ps + 8 * gg); u32x2 w; w.x = pg8::cvt_pk_bf16(acc[4 * gg] * sc.x, acc[4 * gg + 1] * sc.y); w.y = pg8::cvt_pk_bf16(acc[4 * gg + 2] * sc.z, acc[4 * gg + 3] * sc.w); *(u32x2*)(o + 8 * gg) = w; }
        }
    }
}
__device__ __forceinline__ void p3_sgu_mfma(CPR p, Frame& F, int l) {
    constexpr int VP = 144;
    const int tid = F.tid, lane = F.lane, tk = lane & 31, hh = lane >> 5, pt = F.wave >> 1, ct = F.wave & 1;
    const bf16* pl = F.pl(); bf16* ml = F.ml();
    const int trow = 8 * hh + ((lane & 15) >> 2), tcol = 16 * ((lane >> 4) & 1) + 4 * (lane & 3);
    __syncthreads();
    for (int it = blockIdx.x; it < (T / 128) * 4; it += gridDim.x) {
        const int g = it & 3, r0 = (it >> 2) * 128;
        {
            const int qq = tid >> 2, c0 = 16 * (tid & 3);
            const bf16* src = pl + (size_t)(r0 + qq) * INP + OFF_C + 256 + 64 * g + c0;
            const u32x4 a = *(const u32x4*)src, b = *(const u32x4*)(src + 8);
            float v[16]; float ss = 0.f;
#pragma unroll
            for (int j = 0; j < 4; ++j) { v[2 * j] = gelu_tanh(__uint_as_float(a[j] << 16)); v[2 * j + 1] = gelu_tanh(__uint_as_float(a[j] & 0xffff0000u)); v[8 + 2 * j] = gelu_tanh(__uint_as_float(b[j] << 16)); v[8 + 2 * j + 1] = gelu_tanh(__uint_as_float(b[j] & 0xffff0000u)); }
#pragma unroll
            for (int j = 0; j < 16; ++j) ss += v[j] * v[j];
            ss += __shfl_xor(ss, 1); ss += __shfl_xor(ss, 2);
            const float rs = rsqrtf(ss * (1.f / 64.f) + EPS); const float* gn = p.sgu_norm_g + l * 256 + 64 * g + c0;
            u32x4 w0, w1;
#pragma unroll
            for (int j = 0; j < 4; ++j) { w0[j] = pg8::cvt_pk_bf16(v[2 * j] * rs * gn[2 * j], v[2 * j + 1] * rs * gn[2 * j + 1]); w1[j] = pg8::cvt_pk_bf16(v[8 + 2 * j] * rs * gn[8 + 2 * j], v[8 + 2 * j + 1] * rs * gn[8 + 2 * j + 1]); }
            LAS unsigned char* d = F.lds + qq * VP + c0 * 2; *(LAS u32x4*)d = w0; *(LAS u32x4*)(d + 16) = w1;
        }
        __syncthreads();
        f32x16 acc;
#pragma unroll
        for (int i = 0; i < 16; ++i) acc[i] = 0.f;
        const bf16* wrow = F.sguw() + ((size_t)(l * 4 + g) * 128 + 32 * pt + tk) * 128 + 8 * hh;
#pragma unroll
        for (int ks = 0; ks < 8; ++ks) {
            const LAS unsigned char* a0 = F.lds + (16 * ks + trow) * VP + (32 * ct + tcol) * 2;
            const s16x4 lo = lds_tr16(a0), hi4 = lds_tr16(a0 + 4 * VP);
            const bf16x8 va = (bf16x8){lo[0], lo[1], lo[2], lo[3], hi4[0], hi4[1], hi4[2], hi4[3]};
            acc = __builtin_amdgcn_mfma_f32_32x32x16_bf16(va, *(const bf16x8*)(wrow + 16 * ks), acc, 0, 0, 0);
        }
        const int row = r0 + 32 * pt + tk; const float bias = p.sgu_b[(l * 4 + g) * 128 + 32 * pt + tk];
        const int col = 64 * g + 32 * ct + 4 * hh;
#pragma unroll
        for (int gg = 0; gg < 4; ++gg) { const u32x2 uu = *(const u32x2*)(pl + (size_t)row * INP + OFF_C + col + 8 * gg);
            const float u0 = gelu_tanh(__uint_as_float(uu.x << 16)), u1 = gelu_tanh(__uint_as_float(uu.x & 0xffff0000u)), u2 = gelu_tanh(__uint_as_float(uu.y << 16)), u3 = gelu_tanh(__uint_as_float(uu.y & 0xffff0000u));
            u32x2 w; w.x = pg8::cvt_pk_bf16(u0 * (acc[4 * gg] + bias), u1 * (acc[4 * gg + 1] + bias)); w.y = pg8::cvt_pk_bf16(u2 * (acc[4 * gg + 2] + bias), u3 * (acc[4 * gg + 3] + bias));
            *(u32x2*)(ml + (size_t)row * D + 512 + col + 8 * gg) = w; }
        __syncthreads();
    }
}

__device__ __forceinline__ void p5_outproj_naive(Frame& F, int l) {
    const bf16* W = F.wout() + (size_t)l * D * D;
    for (long i = F.gt; i < (long)T * D; i += F.ngt) { const int r = (int)(i >> 10), c = (int)(i & 1023);
        const float g = mod_vec(F, l, row_mod(r), 2)[c];
        F.xl()[(size_t)r * D + c] += g * dot_bf16(F.ml() + (size_t)r * D, W + (size_t)c * D, D); }
}

__device__ __forceinline__ void p6_rows(CPR p, Frame& F, int l) {
    for (int r = F.gw; r < T; r += F.ngw) {
        const int mr = row_mod(r);
        f32x4 v[4]; float ss = 0.f;
#pragma unroll
        for (int j = 0; j < 4; ++j) { v[j] = *(const f32x4*)(F.xl() + (size_t)r * D + 4 * F.lane + 256 * j); ss += v[j].x * v[j].x + v[j].y * v[j].y + v[j].z * v[j].z + v[j].w * v[j].w; }
        const float rstd = rsqrtf(wave_sum(ss) * (1.f / D) + EPS);
        const float* g2 = p.norm2_g + l * D; const float* sh = mod_vec(F, l, mr, 3); const float* sc = mod_vec(F, l, mr, 4);
        float lg[16];
#pragma unroll
        for (int e = 0; e < 16; ++e) lg[e] = 0.f;
#pragma unroll
        for (int j = 0; j < 4; ++j) { const int c = 4 * F.lane + 256 * j; const f32x4 g = *(const f32x4*)(g2 + c), s = *(const f32x4*)(sh + c), q = *(const f32x4*)(sc + c);
            float hh[4]; hh[0] = v[j].x * rstd * g.x * (1.f + q.x) + s.x; hh[1] = v[j].y * rstd * g.y * (1.f + q.y) + s.y; hh[2] = v[j].z * rstd * g.z * (1.f + q.z) + s.z; hh[3] = v[j].w * rstd * g.w * (1.f + q.w) + s.w;
            u32x2 o; o.x = pk2(hh[0], hh[1]); o.y = pk2(hh[2], hh[3]); *(u32x2*)(F.ha() + (size_t)r * D + c) = o;
#pragma unroll
            for (int i = 0; i < 4; ++i) { const float* rw = p.router_w + (size_t)(c + i) * NE;
#pragma unroll
                for (int e4 = 0; e4 < 4; ++e4) { const f32x4 w = *(const f32x4*)(rw + 4 * e4); lg[4 * e4] += hh[i] * w.x; lg[4 * e4 + 1] += hh[i] * w.y; lg[4 * e4 + 2] += hh[i] * w.z; lg[4 * e4 + 3] += hh[i] * w.w; } } }
        float sc16[16], bi[16];
#pragma unroll
        for (int e = 0; e < 16; ++e) { const float t = wave_sum(lg[e]); sc16[e] = 1.f / (1.f + __expf(-t)); bi[e] = sc16[e] + p.router_b[e]; }
        int sg = 0; float best = -3.0e38f;
#pragma unroll
        for (int g = 0; g < 4; ++g) { float m1 = -3.0e38f, m2 = -3.0e38f;
#pragma unroll
            for (int j = 0; j < 4; ++j) { const float x = bi[4 * g + j]; if (x > m1) { m2 = m1; m1 = x; } else if (x > m2) m2 = x; }
            const float gs = m1 + m2; if (gs > best) { best = gs; sg = g; } }
        int i0 = 0, i1 = 0; float b0 = -3.0e38f, b1 = -3.0e38f, s0 = 0.f, s1 = 0.f;
#pragma unroll
        for (int e = 0; e < 16; ++e) { if ((e >> 2) == sg) { const float x = bi[e]; if (x > b0) { b1 = b0; i1 = i0; s1 = s0; b0 = x; i0 = e; s0 = sc16[e]; } else if (x > b1) { b1 = x; i1 = e; s1 = sc16[e]; } } }
        const float ws = s0 + s1; const float w0 = s0 / ws, w1 = s1 / ws;
        if (F.lane == 0) {
            const int sl0 = (int)atomicAdd(&F.ctl()[CW_CNT + (l * NE + i0) * 64], 1u); const int sl1 = (int)atomicAdd(&F.ctl()[CW_CNT + (l * NE + i1) * 64], 1u);
            F.tok()[i0 * CAP + sl0] = r; F.wl()[i0 * CAP + sl0] = w0; F.tok()[i1 * CAP + sl1] = r; F.wl()[i1 * CAP + sl1] = w1;
            i32x4 rt; rt.x = i0; rt.y = sl0; rt.z = i1; rt.w = sl1; *(i32x4*)(F.route() + 4 * r) = rt;
        }
    }
}

__device__ __forceinline__ void p6b_sort(Frame& F, int l) {
    for (int r = F.gw; r < T; r += F.ngw) {
        const i32x4 rt = *(const i32x4*)(F.route() + 4 * r);
        const u32x4* src = (const u32x4*)(F.ha() + (size_t)r * D) + F.lane;
        const u32x4 a = src[0], b = src[64];
        u32x4* d0 = (u32x4*)(F.hs() + (size_t)(ybase_of(F, l, rt.x) + rt.y) * D) + F.lane; u32x4* d1 = (u32x4*)(F.hs() + (size_t)(ybase_of(F, l, rt.z) + rt.w) * D) + F.lane;
        d0[0] = a; d0[64] = b; d1[0] = a; d1[64] = b;
    }
}

__device__ __forceinline__ void p7_moe1_naive(Frame& F, int l) {
    for (long i = F.gt; i < (long)T * 2 * DE; i += F.ngt) {
        const int a = (int)(i >> 8), f = (int)(i & 255), tokr = a >> 1, wh = a & 1;
        const int e = F.route()[4 * tokr + 2 * wh], sl = F.route()[4 * tokr + 2 * wh + 1];
        const bf16* W = F.w1() + (size_t)(l * NE + e) * 512 * D; const int grow = (f >> 7) * 256 + (f & 127);
        const float g = dot_bf16(F.ha() + (size_t)tokr * D, W + (size_t)grow * D, D), u = dot_bf16(F.ha() + (size_t)tokr * D, W + (size_t)(grow + 128) * D, D);
        F.hid()[(size_t)(ybase_of(F, l, e) + sl) * DE + f] = (bf16)f2bf(F.wl()[e * CAP + sl] * silu_f(g) * u);
    }
}
__device__ __forceinline__ void p8_moe2_naive(Frame& F, int l) {
    for (long i = F.gt; i < (long)T * 2 * D; i += F.ngt) {
        const int a = (int)(i >> 10), n = (int)(i & 1023), tokr = a >> 1, wh = a & 1;
        const int e = F.route()[4 * tokr + 2 * wh], sl = F.route()[4 * tokr + 2 * wh + 1]; const size_t pr = (size_t)(ybase_of(F, l, e) + sl);
        F.y()[pr * D + n] = (bf16)f2bf(dot_bf16(F.hid() + pr * DE, F.w2() + ((size_t)(l * NE + e) * D + n) * DE, DE));
    }
}

__device__ __forceinline__ void p9_final(CPR p, Frame& F) {
    const int l = DEPTH - 1;
    for (int r = F.gw; r < TL; r += F.ngw) {
        const i32x4 rt = *(const i32x4*)(F.route() + 4 * r);
        const bf16* y0 = F.y() + (size_t)(ybase_of(F, l, rt.x) + rt.y) * D; const bf16* y1 = F.y() + (size_t)(ybase_of(F, l, rt.z) + rt.w) * D;
        const float* g5 = mod_vec(F, l, row_mod(r), 5);
        f32x4 v[4]; float ss = 0.f;
#pragma unroll
        for (int j = 0; j < 4; ++j) { const int c = 4 * F.lane + 256 * j; v[j] = *(const f32x4*)(F.xl() + (size_t)r * D + c);
            const u32x2 a = *(const u32x2*)(y0 + c), b = *(const u32x2*)(y1 + c); const f32x4 g = *(const f32x4*)(g5 + c);
            v[j].x += g.x * (__uint_as_float(a.x << 16) + __uint_as_float(b.x << 16)); v[j].y += g.y * (__uint_as_float(a.x & 0xffff0000u) + __uint_as_float(b.x & 0xffff0000u));
            v[j].z += g.z * (__uint_as_float(a.y << 16) + __uint_as_float(b.y << 16)); v[j].w += g.w * (__uint_as_float(a.y & 0xffff0000u) + __uint_as_float(b.y & 0xffff0000u));
            ss += v[j].x * v[j].x + v[j].y * v[j].y + v[j].z * v[j].z + v[j].w * v[j].w; }
        const float rstd = rsqrtf(wave_sum(ss) * (1.f / D) + EPS);
#pragma unroll
        for (int j = 0; j < 4; ++j) { const int c = 4 * F.lane + 256 * j; const f32x4 g = *(const f32x4*)(p.final_g + c);
            f32x4 o; o.x = v[j].x * rstd * g.x; o.y = v[j].y * rstd * g.y; o.z = v[j].z * rstd * g.z; o.w = v[j].w * rstd * g.w;
            *(f32x4*)(p.out + (size_t)r * D + c) = o; }
    }
}

__device__ __forceinline__ void p2_inproj(Frame& F, int l) {
    pg8::StaticOrder S; S.init(T, INP, D, (int)gridDim.x, (int)blockIdx.x);
    pg8::EpiBf16 E{F.pl(), INP};
    pg8::gemm_phase<pg8::EpiBf16, pg8::StaticOrder, true>(F.lds, F.tid, F.ha(), F.win() + (size_t)l * INP * D, D, S, E);
}
__device__ __forceinline__ void p5_outproj(Frame& F, int l) {
    pg8::StaticOrder S; S.init(T, D, D, (int)gridDim.x, (int)blockIdx.x);
    pg8::EpiResid E{F.xl(), D, F.mod() + (size_t)l * 5 * NMOD * D};
    pg8::gemm_phase<pg8::EpiResid, pg8::StaticOrder, true>(F.lds, F.tid, F.ml(), F.wout() + (size_t)l * D * D, D, S, E);
}
__device__ __forceinline__ void moe_table(Frame& F, int l) {
    volatile LAS int* tab = (volatile LAS int*)(F.lds + MOETAB_OFF);
    __syncthreads();
    if (F.tid == 0) { int acc = 0;
        for (int e = 0; e < NE; ++e) { const int c = (int)F.ctl()[CW_CNT + (l * NE + e) * 64]; tab[e] = acc; tab[32 + e] = c; acc += (c + 255) >> 8; }
        tab[16] = acc; }
    __syncthreads();
}
__device__ __forceinline__ void p7_moe1(Frame& F, int l) {
    moe_table(F, l);
    pg8::MoeOrder<false, 2, D> S{(const volatile LAS int*)(F.lds + MOETAB_OFF), F.tok(), (int)gridDim.x, (int)blockIdx.x, (size_t)512 * D * 2};
    pg8::EpiMoe1 E{F.hid(), F.wl()};
    pg8::gemm_phase<pg8::EpiMoe1, pg8::MoeOrder<false, 2, D>, true>(F.lds, F.tid, F.hs(), F.w1() + (size_t)l * NE * 512 * D, D, S, E);
}
__device__ __forceinline__ void p8_moe2(Frame& F, int l) {
    moe_table(F, l);
    pg8::MoeOrder<false, 4, DE> S{(const volatile LAS int*)(F.lds + MOETAB_OFF), F.tok(), (int)gridDim.x, (int)blockIdx.x, (size_t)D * DE * 2};
    pg8::EpiBf16 E{F.y(), D};
    pg8::gemm_phase<pg8::EpiBf16, pg8::MoeOrder<false, 4, DE>, true>(F.lds, F.tid, F.hid(), F.w2() + (size_t)l * NE * D * DE, DE, S, E);
}

constexpr int PH_FINAL = 1 + 10 * DEPTH, N_PHASES = PH_FINAL + 1;
__global__ void __launch_bounds__(NTHR, 2) fwd(Params p) {
    extern __shared__ __attribute__((aligned(16))) unsigned char lds_raw[];
    Frame F;
    F.lds = (LAS unsigned char*)lds_raw;
    F.tid = threadIdx.x; F.lane = F.tid & 63; F.wave = __builtin_amdgcn_readfirstlane(F.tid >> 6);
    F.gw = blockIdx.x * NWAVES + F.wave; F.ngw = gridDim.x * NWAVES; F.gt = blockIdx.x * NTHR + F.tid; F.ngt = gridDim.x * NTHR;
    const __attribute__((address_space(4))) Params* KP = (const __attribute__((address_space(4))) Params*)__builtin_amdgcn_kernarg_segment_ptr();
    F.ws = KP->ws;
    volatile LAS unsigned* MISC = (volatile LAS unsigned*)(F.lds + MISC_OFF);
    for (int u = F.tid; u < 32; u += NTHR) MISC[u] = 0u;
    __syncthreads();
#if MK_ONE_LAUNCH
    (void)xcd_barrier_post(F.ctl() + CW_BAR, MISC + 8);
#define GRID_BAR() do { XcdBarrier b_; b_.bar = (unsigned*)(KP->ws + WS_CTL) + CW_BAR; b_.x = xb_xcc_id(); b_.st = (volatile LAS unsigned*)(F.lds + MISC_OFF) + 8; xcd_barrier(b_); } while (0)
#else
#define GRID_BAR() do {} while (0)
#endif
#define lo (KP->ph_lo)
#define hi (KP->ph_hi)
#define PB() do { asm volatile("" : "+s"(KP)); F.ws = KP->ws; int t_ = threadIdx.x; asm volatile("" : "+v"(t_)); F.tid = t_; F.lane = t_ & 63; F.wave = __builtin_amdgcn_readfirstlane(t_ >> 6); \
    F.gw = blockIdx.x * NWAVES + F.wave; F.gt = blockIdx.x * NTHR + t_; F.ngw = gridDim.x * NWAVES; F.ngt = gridDim.x * NTHR; } while (0)
#ifndef PH_MASK
#define PH_MASK 0xFFF
#endif
#define INK(k, kind) (((PH_MASK >> (kind)) & 1) && lo <= (k) && (k) < hi)
#define IN(k) (lo <= (k) && (k) < hi)
#define SEAM(k) do { if (IN((k) + 1)) GRID_BAR(); } while (0)
    if (INK(0, 9)) { PB(); p0_prologue(*KP, F); SEAM(0); }
    for (int l = 0; l < DEPTH; ++l) {
        const int pb = 1 + 10 * l;
        if (INK(pb + 0, 0)) { PB(); p1_rows(*KP, F, l); SEAM(pb + 0); }
        if (INK(pb + 1, 1)) { PB(); if (FAST_GEMM & 1) p2_inproj(F, l); else p2_inproj_naive(F, l); SEAM(pb + 1); }
        if (INK(pb + 2, 2)) { PB(); if (FAST_UP) p3_mla_up(F, l); else p3_mla_up_naive(*KP, F, l); if (FAST_PS & 1) p3_pool_mfma(*KP, F, l); else p3_pool_naive(*KP, F, l); if (FAST_PS & 2) p3_sgu_mfma(*KP, F, l); else p3_sgu1_naive(*KP, F, l); if (FAST_NA) p3_na_mfma(*KP, F, l); else p3_na_naive(*KP, F, l); SEAM(pb + 2); }
        if (INK(pb + 3, 3)) { PB(); if (!(FAST_PS & 2)) p3_sgu2_naive(*KP, F, l); SEAM(pb + 3); }
        if (INK(pb + 4, 4)) { PB(); if (FAST_MLA) p4_mla_flash(F); else p4_mla_naive(F); SEAM(pb + 4); }
        if (INK(pb + 5, 5)) { PB(); if (FAST_GEMM & 2) p5_outproj(F, l); else p5_outproj_naive(F, l); SEAM(pb + 5); }
        if (INK(pb + 6, 6)) { PB(); p6_rows(*KP, F, l); SEAM(pb + 6); }
        if (INK(pb + 7, 11)) { PB(); if (FAST_GEMM & 4) p6b_sort(F, l); SEAM(pb + 7); }
        if (INK(pb + 8, 7)) { PB(); if (FAST_GEMM & 4) p7_moe1(F, l); else p7_moe1_naive(F, l); SEAM(pb + 8); }
        if (INK(pb + 9, 8)) { PB(); if (FAST_GEMM & 8) p8_moe2(F, l); else p8_moe2_naive(F, l); SEAM(pb + 9); }
    }
    if (INK(PH_FINAL, 10)) { PB(); p9_final(*KP, F); }
}

extern "C" void kernel_launch(void* const* d_in, const int* in_sizes, int n_in, void* d_out, int out_size, void* d_ws, size_t ws_size, hipStream_t stream) {
    static int grid = 0;
    if (grid == 0) {
        if (n_in != 26 || out_size != TL * D || ws_size < WS_END) { fprintf(stderr, "kernel_launch: unexpected shapes: n_in %d out %d ws %zu (need %zu)\n", n_in, out_size, ws_size, (size_t)WS_END); grid = -1; return; }
        int dev = 0, cus = 0, per_cu = 0;
        if (hipGetDevice(&dev) != hipSuccess || hipDeviceGetAttribute(&cus, hipDeviceAttributeMultiprocessorCount, dev) != hipSuccess) { grid = -1; return; }
        if (hipFuncSetAttribute((const void*)fwd, hipFuncAttributeMaxDynamicSharedMemorySize, LDS_BYTES) != hipSuccess) { fprintf(stderr, "kernel_launch: hipFuncSetAttribute failed\n"); grid = -1; return; }
        if (hipOccupancyMaxActiveBlocksPerMultiprocessor(&per_cu, (const void*)fwd, NTHR, LDS_BYTES) != hipSuccess || per_cu < 1) fprintf(stderr, "kernel_launch: occupancy query says %d\n", per_cu);
        (void)hipGetLastError();
        grid = cus;
    }
    if (grid < 0) return;
    (void)hipMemsetAsync((char*)d_ws + WS_CTL, 0, CTL_ZERO_BYTES, stream);
    Params p{};
    const float** pp = (const float**)&p;
    for (int i = 0; i < 26; ++i) pp[i] = (const float*)d_in[i];
    p.out = (float*)d_out; p.ws = (unsigned char*)d_ws;
#if MK_ONE_LAUNCH
    p.ph_lo = 0; p.ph_hi = N_PHASES;
    hipLaunchKernelGGL(fwd, dim3(grid), dim3(NTHR), LDS_BYTES, stream, p);
#else
    for (int ph = 0; ph < N_PHASES; ++ph) {
        p.ph_lo = ph; p.ph_hi = ph + 1;
        hipLaunchKernelGGL(fwd, dim3(grid), dim3(NTHR), LDS_BYTES, stream, p);
    }
#endif
}
```

```cpp
#include <hip/hip_runtime.h>
#include <cstdio>
#include <cstdint>

#ifndef MK_ONE_LAUNCH
#define MK_ONE_LAUNCH 1
#endif

#ifndef FAST_NA
#define FAST_NA 1
#endif
#ifndef FAST_UP
#define FAST_UP 1
#endif
#ifndef FAST_PS
#define FAST_PS 3
#endif
#ifndef FAST_MLA
#define FAST_MLA 1
#endif
#ifndef FAST_GEMM
#define FAST_GEMM 0xF
#endif

#define GAS __attribute__((address_space(1)))
#define LAS __attribute__((address_space(3)))
typedef unsigned short bf16;
typedef float f32x4 __attribute__((ext_vector_type(4)));
typedef unsigned u32x4 __attribute__((ext_vector_type(4)));
typedef unsigned u32x2 __attribute__((ext_vector_type(2)));
typedef int i32x4 __attribute__((ext_vector_type(4)));
typedef short bf16x8 __attribute__((ext_vector_type(8)));

constexpr int D = 1024, NB = 4, SEQ = 4096, DEPTH = 4, CTX = 256, GW = 64, GH = 64;
constexpr int TL = NB * SEQ, TC = NB * CTX, T = TL + TC;
constexpr int INW = 1952, INP = 2048;
constexpr int OFF_B = 256, OFF_C = 1024, OFF_D = 1536;
constexpr int NE = 16, DE = 256, CAP = T;
constexpr int RPAD = 2 * T + NE * 256;
constexpr int NMOD = 6;
constexpr float EPS = 1e-6f;
constexpr float LOG2E = 1.4426950408889634f;
constexpr float MLA_SCALE = 0.10206207261596575f;
constexpr int NWAVES = 8, NTHR = NWAVES * 64;

constexpr size_t MiB = 1u << 20;
constexpr size_t WS_CTL = 0, CTL_ZERO_BYTES = 1 * MiB;
constexpr size_t WS_MOD = 1 * MiB;
constexpr size_t WS_ROPE = 2 * MiB;
constexpr size_t WS_ROUTE = 3 * MiB;
constexpr size_t WS_TOK = 4 * MiB;
constexpr size_t WS_WL = 6 * MiB;
constexpr size_t WS_WUQ = 8 * MiB;
constexpr size_t WS_WUKV = 9 * MiB;
constexpr size_t WS_POOLW = 10 * MiB;
constexpr size_t WS_SGUW = 10 * MiB + 512 * 1024;
constexpr size_t WS_WIN = 12 * MiB;
constexpr size_t WS_WOUT = 28 * MiB;
constexpr size_t WS_W1 = 36 * MiB;
constexpr size_t WS_W2 = 100 * MiB;
constexpr size_t WS_XL = 132 * MiB;
constexpr size_t WS_HA = 200 * MiB;
constexpr size_t WS_PL = 234 * MiB;
constexpr size_t WS_Y = 234 * MiB;
constexpr size_t WS_HS = WS_Y;
constexpr size_t WS_QM = 302 * MiB;
constexpr size_t WS_KM = 315 * MiB;
constexpr size_t WS_VM = 328 * MiB;
constexpr size_t WS_ML = 337 * MiB;
constexpr size_t WS_HID = 371 * MiB;
constexpr size_t WS_END = 390 * MiB;
static_assert(WS_Y + (size_t)RPAD * D * 2 <= WS_KM && WS_HID + (size_t)RPAD * DE * 2 <= WS_END, "ws map");

constexpr int CW_TMO = 0;
constexpr int CW_BAR = 4096;
constexpr int CW_CNT = 8192;

constexpr int LDS_BYTES = 147456;
constexpr int MISC_OFF = 131072 + 320;
constexpr int WTAB_OFF = 131072 + 512;
constexpr int MOETAB_OFF = 131072 + 1024;

__device__ __forceinline__ float bf2f(bf16 v) { return __uint_as_float(((unsigned)v) << 16); }
__device__ __forceinline__ unsigned f2bf(float f) { unsigned u = __float_as_uint(f); return (u + 0x7fffu + ((u >> 16) & 1u)) >> 16; }
__device__ __forceinline__ unsigned pk2(float lo, float hi) { return f2bf(lo) | (f2bf(hi) << 16); }
template <int X> __device__ __forceinline__ float lane_xor(float v) {
    static_assert(X >= 1 && X <= 16, "xor 32: xsum32 / xmax32 / other32");
    return __builtin_bit_cast(float, __builtin_amdgcn_ds_swizzle(__builtin_bit_cast(int, v), (X << 10) | 0x1F));
}
__device__ __forceinline__ float xsum32(float v) { const auto rr = __builtin_amdgcn_permlane32_swap(__float_as_uint(v), __float_as_uint(v), false, false); return __uint_as_float(rr[0]) + __uint_as_float(rr[1]); }
__device__ __forceinline__ float xmax32(float v) { const auto rr = __builtin_amdgcn_permlane32_swap(__float_as_uint(v), __float_as_uint(v), false, false); return fmaxf(__uint_as_float(rr[0]), __uint_as_float(rr[1])); }
__device__ __forceinline__ float other32(float v) { const auto rr = __builtin_amdgcn_permlane32_swap(__float_as_uint(v), __float_as_uint(v), false, false);
    const unsigned a = rr[0], b = rr[1]; return __uint_as_float((a ^ b) ^ __float_as_uint(v)); }
__device__ __forceinline__ float wave_sum(float v) { v += lane_xor<1>(v); v += lane_xor<2>(v); v += lane_xor<4>(v); v += lane_xor<8>(v); v += lane_xor<16>(v); return xsum32(v); }
__device__ __forceinline__ float wave_max(float v) { v = fmaxf(v, lane_xor<1>(v)); v = fmaxf(v, lane_xor<2>(v)); v = fmaxf(v, lane_xor<4>(v)); v = fmaxf(v, lane_xor<8>(v)); v = fmaxf(v, lane_xor<16>(v)); return xmax32(v); }
__device__ __forceinline__ float silu_f(float x) { return x / (1.f + __expf(-x)); }
__device__ __forceinline__ float gelu_tanh(float x) { const float u = 1.5957691216057308f * (x + 0.044715f * x * x * x); return x / (1.f + __expf(-u)); }
__device__ __forceinline__ float dot_bf16(const bf16* a, const bf16* b, int K) {
    float s = 0.f;
    for (int k = 0; k < K; k += 8) {
        const u32x4 av = *(const u32x4*)(a + k), bv = *(const u32x4*)(b + k);
#pragma unroll
        for (int j = 0; j < 4; ++j) {
            s += __uint_as_float(av[j] << 16) * __uint_as_float(bv[j] << 16);
            s += __uint_as_float(av[j] & 0xffff0000u) * __uint_as_float(bv[j] & 0xffff0000u);
        }
    }
    return s;
}
#define LDS_WAIT() asm volatile("s_waitcnt lgkmcnt(0)" ::: "memory")

#define XB_TMO      128
#define XB_XCNT(j)  (256  + 64 * (j))
#define XB_XSUB(j)  (1280 + 64 * (j))
#define XB_XGEN(j)  (2304 + 64 * (j))
#define XB_TOP      3328
#define XB_TOPGEN   3392
#define XCD_BAR_WORDS 3456
#define XB_SPIN_CAP (1u << 18)
__device__ __forceinline__ unsigned xb_ld(unsigned* p)              { return __hip_atomic_load(p, __ATOMIC_RELAXED, __HIP_MEMORY_SCOPE_AGENT); }
__device__ __forceinline__ unsigned xb_add(unsigned* p, unsigned v) { return __hip_atomic_fetch_add(p, v, __ATOMIC_RELAXED, __HIP_MEMORY_SCOPE_AGENT); }
__device__ __forceinline__ unsigned xb_xcc_id() { return (unsigned)__builtin_amdgcn_s_getreg((3 << 11) | 20) & 0xFu; }
#define XB_SPIN(cond, bar) do { unsigned _sp = 0; while (cond) { __builtin_amdgcn_s_sleep(1); \
    if ((++_sp & 255u) == 0u) { if (xb_ld(&(bar)[XB_TMO])) break; if (_sp > XB_SPIN_CAP) { atomicAdd(&(bar)[XB_TMO], 1u); break; } } } } while (0)
struct XcdBarrier { unsigned* bar; unsigned x; volatile LAS unsigned* st; };
__device__ __forceinline__ XcdBarrier xcd_barrier_post(unsigned* bar, volatile LAS unsigned* st) {
    XcdBarrier b; b.bar = bar; b.x = xb_xcc_id(); b.st = st;
    if (threadIdx.x == 0) (void)xb_add(&bar[XB_XCNT(b.x)], 1u);
    return b;
}
__device__ __forceinline__ void xcd_barrier_complete(unsigned* bar, unsigned x, unsigned& nloc, unsigned& nx) {
    const unsigned G = gridDim.x * gridDim.y * gridDim.z;
    unsigned sum, cnt, mine, sp = 0u;
    for (;;) {
        sum = 0u; cnt = 0u; mine = 0u;
#pragma unroll
        for (unsigned j = 0; j < 16; ++j) { const unsigned c = xb_ld(&bar[XB_XCNT(j)]); sum += c; cnt += (c > 0u) ? 1u : 0u; mine = (j == x) ? c : mine; }
        if (sum == G) break;
        __builtin_amdgcn_s_sleep(1);
        if ((++sp & 255u) == 0u) { if (xb_ld(&bar[XB_TMO])) break; if (sp > XB_SPIN_CAP) { atomicAdd(&bar[XB_TMO], 1u); break; } }
    }
    nloc = mine > 0u ? mine : 1u; nx = cnt > 0u ? cnt : 1u;
}
__device__ __forceinline__ void xcd_barrier(const XcdBarrier& b) {
    asm volatile("s_waitcnt vmcnt(0)" ::: "memory");
    __syncthreads();
    if (threadIdx.x == 0) {
        unsigned* bar = b.bar;
        __builtin_amdgcn_s_waitcnt(0);
        unsigned nloc = b.st[0], nx = b.st[1];
        if (nloc == 0u) { xcd_barrier_complete(bar, b.x, nloc, nx); b.st[0] = nloc; b.st[1] = nx; }
        const unsigned old = xb_add(&bar[XB_XSUB(b.x)], 1u);
        const unsigned gen = old / nloc;
        if (old + 1u == (gen + 1u) * nloc) {
            __builtin_amdgcn_fence(__ATOMIC_RELEASE, "agent");
            asm volatile("s_waitcnt vmcnt(0)" ::: "memory");
            const unsigned og = xb_add(&bar[XB_TOP], 1u);
            const unsigned tg = og / nx;
            if (og + 1u == (tg + 1u) * nx) xb_add(&bar[XB_TOPGEN], 1u);
            else XB_SPIN(xb_ld(&bar[XB_TOPGEN]) == tg, bar);
            __builtin_amdgcn_fence(__ATOMIC_ACQUIRE, "agent");
            xb_add(&bar[XB_XGEN(b.x)], 1u);
            asm volatile("s_waitcnt vmcnt(0)" ::: "memory");
        } else {
            XB_SPIN(xb_ld(&bar[XB_XGEN(b.x)]) == gen, bar);
            __builtin_amdgcn_fence(__ATOMIC_ACQUIRE, "agent");
            asm volatile("s_waitcnt vmcnt(0)" ::: "memory");
        }
    }
    __syncthreads();
}

struct Params {
    const float *x, *c, *ctx, *c_ctx, *ada_w, *ada_b, *norm1_g, *norm2_g, *w_in, *w_out, *pool_w, *pool_s, *na_rpb,
                *sgu_norm_g, *sgu_w, *sgu_b, *mla_q_norm_g, *mla_w_uq, *mla_kv_norm_g, *mla_w_ukv,
                *router_w, *router_b, *moe_w_gate, *moe_w_up, *moe_w_down, *final_g;
    float* out; unsigned char* ws; int ph_lo, ph_hi;
};
typedef const __attribute__((address_space(4))) Params& CPR;
struct Frame {
    LAS unsigned char* lds; unsigned char* ws;
    int tid, lane, wave, gw, ngw, gt, ngt;
    __device__ __forceinline__ unsigned* ctl() const { return (unsigned*)(ws + WS_CTL); }
    __device__ __forceinline__ float* mod() const { return (float*)(ws + WS_MOD); }
    __device__ __forceinline__ float* ropec() const { return (float*)(ws + WS_ROPE); }
    __device__ __forceinline__ float* ropes() const { return (float*)(ws + WS_ROPE) + SEQ * 16; }
    __device__ __forceinline__ int* route() const { return (int*)(ws + WS_ROUTE); }
    __device__ __forceinline__ int* tok() const { return (int*)(ws + WS_TOK); }
    __device__ __forceinline__ float* wl() const { return (float*)(ws + WS_WL); }
    __device__ __forceinline__ bf16* wuq() const { return (bf16*)(ws + WS_WUQ); }
    __device__ __forceinline__ bf16* wukv() const { return (bf16*)(ws + WS_WUKV); }
    __device__ __forceinline__ bf16* poolw() const { return (bf16*)(ws + WS_POOLW); }
    __device__ __forceinline__ bf16* sguw() const { return (bf16*)(ws + WS_SGUW); }
    __device__ __forceinline__ bf16* win() const { return (bf16*)(ws + WS_WIN); }
    __device__ __forceinline__ bf16* wout() const { return (bf16*)(ws + WS_WOUT); }
    __device__ __forceinline__ bf16* w1() const { return (bf16*)(ws + WS_W1); }
    __device__ __forceinline__ bf16* w2() const { return (bf16*)(ws + WS_W2); }
    __device__ __forceinline__ bf16* ha() const { return (bf16*)(ws + WS_HA); }
    __device__ __forceinline__ bf16* pl() const { return (bf16*)(ws + WS_PL); }
    __device__ __forceinline__ bf16* y() const { return (bf16*)(ws + WS_Y); }
    __device__ __forceinline__ bf16* hs() const { return (bf16*)(ws + WS_HS); }
    __device__ __forceinline__ bf16* qm() const { return (bf16*)(ws + WS_QM); }
    __device__ __forceinline__ bf16* km() const { return (bf16*)(ws + WS_KM); }
    __device__ __forceinline__ bf16* vm() const { return (bf16*)(ws + WS_VM); }
    __device__ __forceinline__ bf16* ml() const { return (bf16*)(ws + WS_ML); }
    __device__ __forceinline__ bf16* hid() const { return (bf16*)(ws + WS_HID); }
    __device__ __forceinline__ float* xl() const { return (float*)(ws + WS_XL); }
};
__device__ __forceinline__ int row_batch(int r) { return r < TL ? (r >> 12) : ((r - TL) >> 8); }
__device__ __forceinline__ int row_mod(int r) { return r < TL ? (r >> 12) : 4; }
__device__ __forceinline__ const float* mod_vec(const Frame& F, int l, int mr, int k) { return F.mod() + ((size_t)(l * 5 + mr) * NMOD + k) * D; }

namespace pg8 {
constexpr int BM = 256, BK = 64, HALF = 128, HTB = HALF * BK * 2, NXCD = 8, WGM = 8;
__host__ __device__ __forceinline__ int lds_byte(int r, int c) { const int st = (r >> 4) * 2 + (c >> 5), rr = r & 15, cc = c & 31, ob = rr * 64 + cc * 2; return st * 1024 + (ob ^ (((ob >> 9) & 1) << 5)); }
__host__ __device__ __forceinline__ void stage_rc(int b, int& R, int& C) { const int st = b / 1024, sb = b % 1024, swz = sb ^ (((sb >> 9) & 1) << 5); R = (st >> 1) * 16 + swz / 64; C = (st & 1) * 32 + (swz % 64) / 2; }
__host__ __device__ __forceinline__ int perm32(int rho) { const int n = rho >> 4, i = rho & 15; return 8 * (i >> 2) + 4 * n + (i & 3); }
struct Unit { int pm, pn, ex, slot0, cnt; };
struct StaticOrder {
    static constexpr bool GATHER = false;
    int nM, nN, nwg, G, c, K;
    __device__ __forceinline__ void init(int M, int N, int K_, int G_, int c_) { nM = M / BM; nN = N / BM; nwg = nM * nN; G = G_; c = c_; K = K_; }
    __device__ __forceinline__ bool next(int i, Unit& u) const {
        const long L = (long)i * G + c; if (L >= nwg) return false;
        int wgid = (int)L; { const int q = nwg / NXCD, r = nwg % NXCD, xcd = wgid % NXCD, off = wgid / NXCD; wgid = (xcd < r ? xcd * (q + 1) : r * (q + 1) + (xcd - r) * q) + off; }
        const int nig = WGM * nN, gid = wgid / nig, fm = gid * WGM, gsz = (nM - fm) < WGM ? (nM - fm) : WGM;
        u.pm = fm + ((wgid % nig) % gsz); u.pn = (wgid % nig) / gsz; u.ex = 0; u.slot0 = 0; u.cnt = 256; return true;
    }
    __device__ __forceinline__ size_t a_off(const Unit& u) const { return (size_t)u.pm * 256 * K * 2; }
    __device__ __forceinline__ size_t b_off(const Unit& u) const { return (size_t)u.pn * 256 * K * 2; }
    __device__ __forceinline__ unsigned row_off(const Unit&, int) const { return 0u; }
};
template <bool GATHER_, int NPN, int KK>
struct MoeOrder {
    static constexpr bool GATHER = GATHER_;
    const volatile LAS int* tab; const int* tok; int G, c; size_t bstride;
    __device__ __forceinline__ bool next(int i, Unit& u) const {
        const int L = i * G + c, nt = tab[16]; if (L >= nt * NPN) return false;
        const int ti = L / NPN; u.pm = ti; u.pn = L % NPN; const int e = tab[64 + ti];
        u.ex = e; u.slot0 = (ti - tab[e]) * 256; const int rem = tab[32 + e] - u.slot0; u.cnt = rem < 256 ? rem : 256; return true;
    }
    __device__ __forceinline__ size_t a_off(const Unit& u) const { return GATHER_ ? 0 : (size_t)u.pm * 256 * KK * 2; }
    __device__ __forceinline__ size_t b_off(const Unit& u) const { return (size_t)u.ex * bstride + (size_t)u.pn * 256 * KK * 2; }
    __device__ __forceinline__ unsigned row_off(const Unit& u, int R) const { const int rr = R < u.cnt ? R : u.cnt - 1; return (unsigned)tok[u.ex * CAP + u.slot0 + rr] * (unsigned)(KK * 2); }
};
__device__ __forceinline__ unsigned cvt_pk_bf16(float lo, float hi) { unsigned r; asm volatile("v_cvt_pk_bf16_f32 %0, %1, %2" : "=v"(r) : "v"(lo), "v"(hi)); return r; }
struct EpiBf16 {
    static constexpr bool PERM = true;
    bf16* O; int ldc;
    __device__ __forceinline__ void operator()(const f32x4 (&acc)[2][2][4][2], const Unit& u, int wr, int wc, int fr, int fq) const {
        asm volatile("" : "+v"(fr), "+v"(fq));
        const int row0 = u.pm * BM + wr * 64 + fr, col0 = u.pn * BM + wc * 32 + 8 * fq;
#pragma unroll
        for (int ai = 0; ai < 2; ++ai)
#pragma unroll
            for (int m = 0; m < 4; ++m) { bf16* rowp = O + (size_t)(row0 + ai * HALF + m * 16) * ldc + col0;
#pragma unroll
                for (int bj = 0; bj < 2; ++bj) { const f32x4 v0 = acc[ai][bj][m][0], v1 = acc[ai][bj][m][1];
                    u32x4 w; w.x = cvt_pk_bf16(v0[0], v0[1]); w.y = cvt_pk_bf16(v0[2], v0[3]); w.z = cvt_pk_bf16(v1[0], v1[1]); w.w = cvt_pk_bf16(v1[2], v1[3]);
                    *(u32x4*)(rowp + bj * HALF) = w; } }
    }
};
struct EpiResid {
    static constexpr bool PERM = false;
    float* X; int ldc; const float* modl; float gsc;
    __device__ __forceinline__ void operator()(const f32x4 (&acc)[2][2][4][2], const Unit& u, int wr, int wc, int fr, int fq) const {
        asm volatile("" : "+v"(fr), "+v"(fq));
        const int row0 = u.pm * BM + wr * 64 + fr, col0 = u.pn * BM + wc * 32 + 4 * fq;
        const int mr = row_mod(u.pm * BM); const float* gp = modl + (size_t)(mr * NMOD + 2) * D + col0;
        f32x4 gv[2][2];
#pragma unroll
        for (int bj = 0; bj < 2; ++bj)
#pragma unroll
            for (int n = 0; n < 2; ++n) gv[bj][n] = *(const f32x4*)(gp + bj * HALF + n * 16) * gsc;
#pragma unroll
        for (int ai = 0; ai < 2; ++ai)
#pragma unroll
            for (int m = 0; m < 4; ++m) { float* rowp = X + (size_t)(row0 + ai * HALF + m * 16) * ldc + col0;
#pragma unroll
                for (int bj = 0; bj < 2; ++bj)
#pragma unroll
                    for (int n = 0; n < 2; ++n) { f32x4* q = (f32x4*)(rowp + bj * HALF + n * 16); *q = *q + gv[bj][n] * acc[ai][bj][m][n]; } }
    }
};
struct EpiMoe1 {
    static constexpr bool PERM = true;
    bf16* H; const float* wl;
    __device__ __forceinline__ void operator()(const f32x4 (&acc)[2][2][4][2], const Unit& u, int wr, int wc, int fr, int fq) const {
        asm volatile("" : "+v"(fr), "+v"(fq));
        const int lrow0 = wr * 64 + fr, f0 = u.pn * HALF + wc * 32 + 8 * fq;
#pragma unroll
        for (int ai = 0; ai < 2; ++ai)
#pragma unroll
            for (int m = 0; m < 4; ++m) { const int lr = lrow0 + ai * HALF + m * 16;
                const float w = (lr < u.cnt) ? wl[(size_t)u.ex * CAP + u.slot0 + lr] : 0.f;
                float o[8];
#pragma unroll
                for (int n = 0; n < 2; ++n)
#pragma unroll
                    for (int i = 0; i < 4; ++i) { const float g = acc[ai][0][m][n][i], up = acc[ai][1][m][n][i]; o[4 * n + i] = (lr < u.cnt) ? w * (g / (1.f + __expf(-g))) * up : 0.f; }
                u32x4 pk; pk.x = cvt_pk_bf16(o[0], o[1]); pk.y = cvt_pk_bf16(o[2], o[3]); pk.z = cvt_pk_bf16(o[4], o[5]); pk.w = cvt_pk_bf16(o[6], o[7]);
                *(u32x4*)(H + (size_t)(u.pm * BM + lr) * DE + f0) = pk; }
    }
};

template <class Epi, class Sched, bool ALIGN_EPI>
__device__ __forceinline__ void gemm_phase(LAS unsigned char* lds, const int tid, const bf16* Abase, const bf16* Bbase, const int K, const Sched& S, const Epi& E) {
    constexpr bool GA = Sched::GATHER;
    const int wid = __builtin_amdgcn_readfirstlane(tid >> 6), lane = tid & 63, wr = wid >> 2, wc = wid & 3, fr = lane & 15, fq = lane >> 4;
    const int nt = K / BK;
    unsigned voffA[2], voffB[2]; int Rst, Cst;
#pragma unroll
    for (int i = 0; i < 2; ++i) { int R, C; stage_rc(tid * 16 + i * 8192, R, C); const int Rb = Epi::PERM ? ((R & ~31) + perm32(R & 31)) : R;
        voffA[i] = (unsigned)(R * K + C) * 2u; voffB[i] = (unsigned)(Rb * K + C) * 2u; if (i == 0) { Rst = R; Cst = C; } }
    const size_t kstep = (size_t)(BK * 2);
    const size_t hstep = (size_t)HALF * K * 2;
    const size_t hstepA = GA ? 0 : hstep;
    const unsigned ldsw = (unsigned)wid * 1024u;
    const int aoff = lds_byte(wr * 64 + fr, fq * 8), boff = lds_byte(wc * 32 + fr, fq * 8);
#define PG8_SA(b, h) (((b) * 2 + (h)) * HTB)
#define PG8_SB(b, h) ((4 + (b) * 2 + (h)) * HTB)
#define PG8_STAGE(bufoff, gbase, voff) do { _Pragma("unroll") for (int _i = 0; _i < 2; ++_i) \
        __builtin_amdgcn_global_load_lds((const unsigned*)((const char*)(gbase) + (voff)[_i]), (LAS unsigned*)(lds + (bufoff) + ldsw + _i * 8192), 16, 0, 0); } while (0)
#define PG8_LDA(dst, b, h) do { _Pragma("unroll") for (int m = 0; m < 4; ++m) _Pragma("unroll") for (int k = 0; k < 2; ++k) dst[m][k] = *(const LAS bf16x8*)(lds + PG8_SA(b, h) + aoff + m * 2048 + k * 1024); } while (0)
#define PG8_LDB(dst, b, h) do { _Pragma("unroll") for (int n = 0; n < 2; ++n) _Pragma("unroll") for (int k = 0; k < 2; ++k) dst[n][k] = *(const LAS bf16x8*)(lds + PG8_SB(b, h) + boff + n * 2048 + k * 1024); } while (0)
#define PG8_MMA(ai, bj, At, Bt) do { __builtin_amdgcn_s_setprio(1); _Pragma("unroll") for (int m = 0; m < 4; ++m) _Pragma("unroll") for (int n = 0; n < 2; ++n) _Pragma("unroll") for (int k = 0; k < 2; ++k) \
        acc[ai][bj][m][n] = __builtin_amdgcn_mfma_f32_16x16x32_bf16(Bt[n][k], At[m][k], acc[ai][bj][m][n], 0, 0, 0); __builtin_amdgcn_s_setprio(0); } while (0)
#define PG8_WAIT_V(n) asm volatile("s_waitcnt vmcnt(" #n ")" ::: "memory")
#define PG8_WAIT_L(n) asm volatile("s_waitcnt lgkmcnt(" #n ")" ::: "memory")
#define PG8_BAR __builtin_amdgcn_s_barrier()
#define PG8_SCHED __builtin_amdgcn_sched_barrier(0)
    Unit cur, nxt; int ui = 0;
    if (!S.next(0, cur)) return;
    f32x4 acc[2][2][4][2];
#pragma unroll
    for (int a = 0; a < 2; ++a)
#pragma unroll
        for (int b = 0; b < 2; ++b)
#pragma unroll
            for (int m = 0; m < 4; ++m)
#pragma unroll
                for (int n = 0; n < 2; ++n) acc[a][b][m][n] = (f32x4){0.f, 0.f, 0.f, 0.f};
    bf16x8 At[4][2], B0[2][2], B1[2][2];
    unsigned cv0[2], cv1[2];
#pragma unroll
    for (int i = 0; i < 2; ++i) { cv0[i] = GA ? S.row_off(cur, Rst + 64 * i) + (unsigned)Cst * 2u : voffA[i]; cv1[i] = GA ? S.row_off(cur, HALF + Rst + 64 * i) + (unsigned)Cst * 2u : voffA[i]; }
    const char* cA = (const char*)Abase + S.a_off(cur); const char* cB = (const char*)Bbase + S.b_off(cur);
    PG8_STAGE(PG8_SB(0, 0), cB, voffB); PG8_STAGE(PG8_SB(0, 1), cB + hstep, voffB); PG8_STAGE(PG8_SA(0, 0), cA, cv0); PG8_STAGE(PG8_SA(0, 1), cA + hstepA, cv1);
    if (wr == 1) PG8_BAR;
    PG8_WAIT_V(2); PG8_BAR;
    PG8_STAGE(PG8_SB(1, 0), cB + kstep, voffB); PG8_STAGE(PG8_SA(1, 0), cA + kstep, cv0); PG8_STAGE(PG8_SB(1, 1), cB + hstep + kstep, voffB);
    PG8_WAIT_V(6); PG8_BAR;
    for (;;) {
        const bool has_next = S.next(ui + 1, nxt);
        const char* nA = has_next ? (const char*)Abase + S.a_off(nxt) : cA; const char* nB = has_next ? (const char*)Bbase + S.b_off(nxt) : cB;
#pragma unroll 1
        for (int t = 0; t < nt; t += 2) {
            const bool last = (t == nt - 2);
            const char* a1 = cA + (size_t)(t + 1) * kstep;
            const char* a2 = last ? nA : cA + (size_t)(t + 2) * kstep; const char* b2 = last ? nB : cB + (size_t)(t + 2) * kstep;
            const char* a3 = a2 + kstep; const char* b3 = b2 + kstep;
            if constexpr (GA) { if (last && has_next) {
#pragma unroll
                for (int i = 0; i < 2; ++i) cv0[i] = S.row_off(nxt, Rst + 64 * i) + (unsigned)Cst * 2u; } }
            PG8_LDB(B0, 0, 0); PG8_LDB(B1, 0, 1); PG8_SCHED; PG8_LDA(At, 0, 0); PG8_STAGE(PG8_SA(1, 1), a1 + hstepA, cv1);
            if constexpr (GA) { if (last && has_next) {
#pragma unroll
                for (int i = 0; i < 2; ++i) cv1[i] = S.row_off(nxt, HALF + Rst + 64 * i) + (unsigned)Cst * 2u; } }
            PG8_WAIT_V(8); PG8_WAIT_L(0); PG8_BAR; PG8_MMA(0, 0, At, B0); PG8_MMA(0, 1, At, B1); PG8_BAR; PG8_SCHED;
            PG8_LDA(At, 0, 1); PG8_STAGE(PG8_SB(0, 0), b2, voffB); PG8_STAGE(PG8_SB(0, 1), b2 + hstep, voffB); PG8_STAGE(PG8_SA(0, 0), a2, cv0);
            PG8_WAIT_V(8); PG8_WAIT_L(0); PG8_BAR; PG8_MMA(1, 0, At, B0); PG8_MMA(1, 1, At, B1); PG8_BAR; PG8_SCHED;
            PG8_LDB(B0, 1, 0); PG8_LDB(B1, 1, 1); PG8_SCHED; PG8_LDA(At, 1, 0); PG8_STAGE(PG8_SA(0, 1), a2 + hstepA, cv1);
            PG8_WAIT_V(8); PG8_WAIT_L(0); PG8_BAR; PG8_MMA(0, 0, At, B0); PG8_MMA(0, 1, At, B1); PG8_BAR; PG8_SCHED;
            PG8_LDA(At, 1, 1); PG8_STAGE(PG8_SB(1, 0), b3, voffB); PG8_STAGE(PG8_SB(1, 1), b3 + hstep, voffB); PG8_STAGE(PG8_SA(1, 0), a3, cv0);
            PG8_WAIT_V(8); PG8_WAIT_L(0); PG8_BAR; PG8_MMA(1, 0, At, B0); PG8_MMA(1, 1, At, B1); PG8_BAR; PG8_SCHED;
        }
        if constexpr (ALIGN_EPI) { if (wr == 0) PG8_BAR; }
        E(acc, cur, wr, wc, fr, fq);
        if (!has_next) break;
#pragma unroll
        for (int a = 0; a < 2; ++a)
#pragma unroll
            for (int b = 0; b < 2; ++b)
#pragma unroll
                for (int m = 0; m < 4; ++m)
#pragma unroll
                    for (int n = 0; n < 2; ++n) acc[a][b][m][n] = (f32x4){0.f, 0.f, 0.f, 0.f};
        cur = nxt; cA = nA; cB = nB; ++ui;
        if constexpr (ALIGN_EPI) { if (wr == 1) PG8_BAR; }
    }
    PG8_WAIT_V(0);
    if constexpr (!ALIGN_EPI) { if (wr == 0) PG8_BAR; }
    PG8_BAR;
#undef PG8_SA
#undef PG8_SB
#undef PG8_STAGE
#undef PG8_LDA
#undef PG8_LDB
#undef PG8_MMA
#undef PG8_WAIT_V
#undef PG8_WAIT_L
#undef PG8_BAR
#undef PG8_SCHED
}
}

__device__ __forceinline__ void transpose_item(const float* W, int K, int N, bf16* WT, int kb, int nb, int drow0, LAS float* scr, int lane, const float* kscale = nullptr) {
    const int k0 = 64 * kb, n0 = 32 * nb;
#pragma unroll 8
    for (int i = 0; i < 32; ++i) { const int kk = 2 * i + (lane >> 5); scr[kk * 33 + (lane & 31)] = W[(size_t)(k0 + kk) * N + n0 + (lane & 31)] * (kscale ? kscale[k0 + kk] : 1.f); }
    LDS_WAIT(); asm volatile("" ::: "memory");
    const int c = lane & 7;
#pragma unroll
    for (int j = 0; j < 4; ++j) { const int n = (lane >> 3) + 8 * j; const LAS float* s = scr + (8 * c) * 33 + n;
        u32x4 o; o.x = pk2(s[0 * 33], s[1 * 33]); o.y = pk2(s[2 * 33], s[3 * 33]); o.z = pk2(s[4 * 33], s[5 * 33]); o.w = pk2(s[6 * 33], s[7 * 33]);
        *(u32x4*)(WT + (size_t)(drow0 + n) * K + k0 + 8 * c) = o; }
    LDS_WAIT(); asm volatile("" ::: "memory");
}
__device__ __forceinline__ void p0_prologue(CPR p, Frame& F) {
    LAS float* scr = (LAS float*)(F.lds + F.wave * 16384);
    constexpr int I_IN = 16 * 61, I_OUT = 16 * 32, I_G = 128, I_L = I_IN + I_OUT + 3 * 16 * I_G + 48 + 32 + 8;
    for (int it = F.gw; it < DEPTH * I_L; it += F.ngw) {
        const int l = it / I_L; int r = it % I_L;
        if (r < I_IN) { transpose_item(p.w_in + (size_t)l * D * INW, D, INW, F.win() + (size_t)l * INP * D, r / 61, r % 61, 32 * (r % 61), scr, F.lane); continue; } r -= I_IN;
        if (r < I_OUT) { transpose_item(p.w_out + (size_t)l * D * D, D, D, F.wout() + (size_t)l * D * D, r / 32, r % 32, 32 * (r % 32), scr, F.lane); continue; } r -= I_OUT;
        if (r < 16 * I_G) { const int e = r / I_G, q = r % I_G, nb = q % 8, n0 = 32 * nb;
            transpose_item(p.moe_w_gate + (size_t)(l * NE + e) * D * DE, D, DE, F.w1() + (size_t)(l * NE + e) * 512 * D, q / 8, nb, (n0 / 128) * 256 + (n0 % 128), scr, F.lane); continue; } r -= 16 * I_G;
        if (r < 16 * I_G) { const int e = r / I_G, q = r % I_G, nb = q % 8, n0 = 32 * nb;
            transpose_item(p.moe_w_up + (size_t)(l * NE + e) * D * DE, D, DE, F.w1() + (size_t)(l * NE + e) * 512 * D, q / 8, nb, (n0 / 128) * 256 + 128 + (n0 % 128), scr, F.lane); continue; } r -= 16 * I_G;
        if (r < 16 * I_G) { const int e = r / I_G, q = r % I_G;
            transpose_item(p.moe_w_down + (size_t)(l * NE + e) * DE * D, DE, D, F.w2() + (size_t)(l * NE + e) * D * DE, q / 32, q % 32, 32 * (q % 32), scr, F.lane); continue; } r -= 16 * I_G;
        if (r < 48) { transpose_item(p.mla_w_uq + (size_t)l * 256 * 384, 256, 384, F.wuq() + (size_t)l * 384 * 256, r / 12, r % 12, 32 * (r % 12), scr, F.lane, p.mla_q_norm_g + l * 256); continue; } r -= 48;
        if (r < 32) { transpose_item(p.mla_w_ukv + (size_t)l * 128 * 512, 128, 512, F.wukv() + (size_t)l * 512 * 128, r / 16, r % 16, 32 * (r % 16), scr, F.lane, p.mla_kv_norm_g + l * 128); continue; } r -= 32;
        { const int g = r / 2, nb = r % 2; transpose_item(p.pool_w + (size_t)(l * 4 + g) * 4096, 64, 64, F.poolw() + (size_t)(l * 4 + g) * 4096, 0, nb, 32 * nb, scr, F.lane); }
    }
    for (int i = F.gt; i < DEPTH * 4 * 128 * 128; i += F.ngt) F.sguw()[i] = (bf16)f2bf(p.sgu_w[i]);
    for (int i = F.gt; i < DEPTH * (INP - INW) * D; i += F.ngt) { const int l = i / ((INP - INW) * D), q = i % ((INP - INW) * D); F.win()[(size_t)l * INP * D + (size_t)INW * D + q] = 0; }
    for (int i = F.gt; i < SEQ * 16; i += F.ngt) {
        const int t = i >> 4, k = i & 15; const float pos = (float)((k < 8) ? (t >> 6) : (t & 63));
        const float inv = __builtin_powf(10000.0f, -(float)(k & 7) / 8.0f);
        const float ang = pos * inv; F.ropec()[i] = cosf(ang); F.ropes()[i] = sinf(ang);
    }
    for (int i = F.gt; i < DEPTH * 5 * NMOD * D; i += F.ngt) {
        const int l = i / (5 * NMOD * D), r = (i / (NMOD * D)) % 5, n = i % (NMOD * D);
        const float* v = (r < 4) ? p.c + r * D : p.c_ctx; const float* w = p.ada_w + (size_t)l * D * NMOD * D + n;
        float acc = p.ada_b[l * NMOD * D + n];
#pragma unroll 8
        for (int k = 0; k < D; ++k) acc += silu_f(v[k]) * w[(size_t)k * NMOD * D];
        F.mod()[i] = acc;
    }
}

__device__ __forceinline__ int ybase_of(const Frame& F, int l, int e) {
    int b = 0;
    for (int j = 0; j < e; ++j) b += ((int)F.ctl()[CW_CNT + (l * NE + j) * 64] + 255) & ~255;
    return b;
}
__device__ __forceinline__ void moe_table(Frame& F, int l) {
    volatile LAS int* tab = (volatile LAS int*)(F.lds + MOETAB_OFF);
    __syncthreads();
    if (F.tid == 0) { int acc = 0;
        for (int e = 0; e < NE; ++e) { const int c = (int)F.ctl()[CW_CNT + (l * NE + e) * 64]; tab[e] = acc; tab[32 + e] = c; acc += (c + 255) >> 8; }
        tab[16] = acc; }
    __syncthreads();
    if (F.tid < 192) { int e = 0;
        for (int j = 1; j < 16; ++j) e += (tab[j] <= F.tid) ? 1 : 0;
        tab[64 + F.tid] = e; }
    __syncthreads();
}
__device__ __forceinline__ void add_y4(f32x4& v, const f32x4& g, const u32x2& a, const u32x2& b) {
    v.x += g.x * (__uint_as_float(a.x << 16) + __uint_as_float(b.x << 16)); v.y += g.y * (__uint_as_float(a.x & 0xffff0000u) + __uint_as_float(b.x & 0xffff0000u));
    v.z += g.z * (__uint_as_float(a.y << 16) + __uint_as_float(b.y << 16)); v.w += g.w * (__uint_as_float(a.y & 0xffff0000u) + __uint_as_float(b.y & 0xffff0000u));
}
__device__ __forceinline__ float sumsq4(const f32x4& v) { return v.x * v.x + v.y * v.y + v.z * v.z + v.w * v.w; }

__device__ __forceinline__ void p1_rows(CPR p, Frame& F, int l, float ysc = 1.f) {
    const volatile LAS int* tab = (const volatile LAS int*)(F.lds + MOETAB_OFF);
    if (l > 0) moe_table(F, l - 1);
    for (int pi = F.gw; pi < T / 2; pi += F.ngw) {
        int c0 = 4 * F.lane; asm volatile("" : "+v"(c0));
        const int r0 = 2 * pi, mr = row_mod(r0);
        f32x4 v[2][4];
        if (l == 0) {
#pragma unroll
            for (int k = 0; k < 2; ++k) { const int r = r0 + k; const float* src = (r < TL) ? p.x + (size_t)r * D : p.ctx + (size_t)(r - TL) * D;
#pragma unroll
                for (int j = 0; j < 4; ++j) v[k][j] = *(const f32x4*)(src + c0 + 256 * j); }
        } else {
            const bf16* y0[2]; const bf16* y1[2];
#pragma unroll
            for (int k = 0; k < 2; ++k) { const i32x4 rt = *(const i32x4*)(F.route() + 4 * (r0 + k));
                y0[k] = F.y() + (size_t)(tab[rt.x] * 256 + rt.y) * D + c0; y1[k] = F.y() + (size_t)(tab[rt.z] * 256 + rt.w) * D + c0; }
            u32x2 a[2][4], b[2][4];
#pragma unroll
            for (int k = 0; k < 2; ++k)
#pragma unroll
                for (int j = 0; j < 4; ++j) { v[k][j] = *(const f32x4*)(F.xl() + (size_t)(r0 + k) * D + c0 + 256 * j); a[k][j] = *(const u32x2*)(y0[k] + 256 * j); b[k][j] = *(const u32x2*)(y1[k] + 256 * j); }
            const float* g5 = mod_vec(F, l - 1, mr, 5) + c0;
#pragma unroll
            for (int j = 0; j < 4; ++j) { const f32x4 g = *(const f32x4*)(g5 + 256 * j) * ysc; add_y4(v[0][j], g, a[0][j], b[0][j]); add_y4(v[1][j], g, a[1][j], b[1][j]); }
        }
        float ss0 = 0.f, ss1 = 0.f;
#pragma unroll
        for (int j = 0; j < 4; ++j) { *(f32x4*)(F.xl() + (size_t)r0 * D + c0 + 256 * j) = v[0][j]; *(f32x4*)(F.xl() + (size_t)(r0 + 1) * D + c0 + 256 * j) = v[1][j]; ss0 += sumsq4(v[0][j]); ss1 += sumsq4(v[1][j]); }
        ss0 = wave_sum(ss0); ss1 = wave_sum(ss1);
        const float rs0 = rsqrtf(ss0 * (1.f / D) + EPS), rs1 = rsqrtf(ss1 * (1.f / D) + EPS);
        const float* g1 = p.norm1_g + l * D + c0; const float* sh = mod_vec(F, l, mr, 0) + c0; const float* sc = mod_vec(F, l, mr, 1) + c0;
#pragma unroll
        for (int j = 0; j < 4; ++j) { const f32x4 g = *(const f32x4*)(g1 + 256 * j), s4 = *(const f32x4*)(sh + 256 * j), q4 = *(const f32x4*)(sc + 256 * j);
            const f32x4 mul = g * (q4 + 1.f);
            const f32x4 h0 = v[0][j] * rs0 * mul + s4, h1 = v[1][j] * rs1 * mul + s4;
            u32x2 o0, o1; o0.x = pk2(h0.x, h0.y); o0.y = pk2(h0.z, h0.w); o1.x = pk2(h1.x, h1.y); o1.y = pk2(h1.z, h1.w);
            *(u32x2*)(F.ha() + (size_t)r0 * D + c0 + 256 * j) = o0; *(u32x2*)(F.ha() + (size_t)(r0 + 1) * D + c0 + 256 * j) = o1; }
    }
}

__device__ __forceinline__ void p2_inproj_naive(Frame& F, int l) {
    const bf16* W = F.win() + (size_t)l * INP * D;
    for (long i = F.gt; i < (long)T * INW; i += F.ngt) { const int r = (int)(i / INW), c = (int)(i % INW);
        F.pl()[(size_t)r * INP + c] = (bf16)f2bf(dot_bf16(F.ha() + (size_t)r * D, W + (size_t)c * D, D)); }
}

__device__ __forceinline__ void p3_mla_up_naive(CPR p, Frame& F, int l) {
    for (int r = F.gw; r < T; r += F.ngw) {
        const bf16* pr = F.pl() + (size_t)r * INP + OFF_D;
        float a[4]; { const u32x2 t = *(const u32x2*)(pr + 4 * F.lane); a[0] = __uint_as_float(t.x << 16); a[1] = __uint_as_float(t.x & 0xffff0000u); a[2] = __uint_as_float(t.y << 16); a[3] = __uint_as_float(t.y & 0xffff0000u); }
        const float rq = rsqrtf(wave_sum(a[0] * a[0] + a[1] * a[1] + a[2] * a[2] + a[3] * a[3]) * (1.f / 256.f) + EPS);
        float b2[2]; { const unsigned t = *(const unsigned*)(pr + 256 + 2 * F.lane); b2[0] = __uint_as_float(t << 16); b2[1] = __uint_as_float(t & 0xffff0000u); }
        const float rkv = rsqrtf(wave_sum(b2[0] * b2[0] + b2[1] * b2[1]) * (1.f / 128.f) + EPS);
        LAS float* sq = (LAS float*)(F.lds + F.wave * 4096);
#pragma unroll
        for (int j = 0; j < 4; ++j) sq[4 * F.lane + j] = a[j] * rq;
        sq[256 + 2 * F.lane] = b2[0] * rkv; sq[256 + 2 * F.lane + 1] = b2[1] * rkv;
        LDS_WAIT(); asm volatile("" ::: "memory");
        const bool lat = r < TL; const int t = r & (SEQ - 1);
        for (int f = F.lane; f < 384; f += 64) {
            const int h = f / 96, j = f % 96;
            float val;
            const bf16* wrow = F.wuq() + (size_t)l * 384 * 256;
            auto qdot = [&](int ff) { float s = 0.f; const bf16* w = wrow + (size_t)ff * 256; for (int k = 0; k < 256; ++k) s += sq[k] * bf2f(w[k]); return s; };
            if (j < 64 || !lat) val = qdot(f);
            else { const int i = j - 64; const int base = h * 96 + 64;
                const int q8 = i & 7, half = (i >> 3) & 1, axis = i >> 4;
                const float cs = F.ropec()[t * 16 + axis * 8 + q8], sn = F.ropes()[t * 16 + axis * 8 + q8];
                const float x1 = qdot(base + axis * 16 + q8), x2 = qdot(base + axis * 16 + 8 + q8);
                val = half ? (x1 * sn + x2 * cs) : (x1 * cs - x2 * sn); }
            F.qm()[(size_t)r * 384 + f] = (bf16)f2bf(val * (MLA_SCALE * LOG2E));
        }
        for (int f = F.lane; f < 512; f += 64) {
            const int h = f / 128, j = f % 128; float s = 0.f; const bf16* w = F.wukv() + (size_t)l * 512 * 128 + (size_t)f * 128;
            for (int k = 0; k < 128; ++k) s += sq[256 + k] * bf2f(w[k]);
            if (j < 64) F.km()[(size_t)r * 384 + h * 96 + j] = (bf16)f2bf(s); else F.vm()[(size_t)r * 256 + h * 64 + (j - 64)] = (bf16)f2bf(s);
        }
        if (F.lane < 32) { const int i = F.lane, q8 = i & 7, half = (i >> 3) & 1, axis = i >> 4;
            const float x1 = bf2f(pr[384 + axis * 16 + q8]), x2 = bf2f(pr[384 + axis * 16 + 8 + q8]);
            float val;
            if (lat) { const float cs = F.ropec()[t * 16 + axis * 8 + q8], sn = F.ropes()[t * 16 + axis * 8 + q8]; val = half ? (x1 * sn + x2 * cs) : (x1 * cs - x2 * sn); }
            else val = bf2f(pr[384 + i]);
#pragma unroll
            for (int h = 0; h < 4; ++h) F.km()[(size_t)r * 384 + h * 96 + 64 + i] = (bf16)f2bf(val); }
        LDS_WAIT(); asm volatile("" ::: "memory");
    }
}
__device__ __forceinline__ void p3_pool_naive(CPR p, Frame& F, int l) {
    for (int i = F.gt; i < T * 256; i += F.ngt) {
        const int r = i >> 8, col = i & 255, g = col >> 6, d = col & 63;
        const int L = r < TL ? SEQ : CTX, t = r < TL ? (r & (SEQ - 1)) : ((r - TL) & (CTX - 1)), seg0 = r - t;
        const int win = 2 << g; int lo = t - win / 2, hi = t - win / 2 + win; lo = lo < 0 ? 0 : lo; hi = hi > L ? L : hi;
        const float inv = 1.f / (float)(hi - lo);
        const bf16* wt = F.poolw() + (size_t)(l * 4 + g) * 4096 + d * 64;
        float acc = 0.f;
        for (int c = 0; c < 64; ++c) { float m = 0.f; for (int s = lo; s < hi; ++s) m += bf2f(F.pl()[(size_t)(seg0 + s) * INP + g * 64 + c]);
            const float df = m * inv - bf2f(F.pl()[(size_t)r * INP + g * 64 + c]); acc += df * bf2f(wt[c]); }
        F.ml()[(size_t)r * D + col] = (bf16)f2bf(acc * p.pool_s[l * 256 + col]);
    }
}
__device__ __forceinline__ void p3_sgu1_naive(CPR p, Frame& F, int l) {
    bf16* vg = F.hid();
    for (int r = F.gw; r < T; r += F.ngw) {
        const bf16* pv = F.pl() + (size_t)r * INP + OFF_C + 256;
        float a[4]; { const u32x2 t = *(const u32x2*)(pv + 4 * F.lane); a[0] = gelu_tanh(__uint_as_float(t.x << 16)); a[1] = gelu_tanh(__uint_as_float(t.x & 0xffff0000u)); a[2] = gelu_tanh(__uint_as_float(t.y << 16)); a[3] = gelu_tanh(__uint_as_float(t.y & 0xffff0000u)); }
        float ss = a[0] * a[0] + a[1] * a[1] + a[2] * a[2] + a[3] * a[3];
        ss += lane_xor<1>(ss); ss += lane_xor<2>(ss); ss += lane_xor<4>(ss); ss += lane_xor<8>(ss);
        const float rs = rsqrtf(ss * (1.f / 64.f) + EPS); const float* gn = p.sgu_norm_g + l * 256 + 4 * F.lane;
        u32x2 o; o.x = pk2(a[0] * rs * gn[0], a[1] * rs * gn[1]); o.y = pk2(a[2] * rs * gn[2], a[3] * rs * gn[3]);
        *(u32x2*)(vg + (size_t)r * 256 + 4 * F.lane) = o;
    }
}
__device__ __forceinline__ void p3_sgu2_naive(CPR p, Frame& F, int l) {
    const bf16* vg = F.hid();
    for (int i = F.gt; i < T * 256; i += F.ngt) {
        const int r = i >> 8, col = i & 255, g = col >> 6, pp = r & 127, r0 = r - pp;
        const bf16* w = F.sguw() + ((size_t)(l * 4 + g) * 128 + pp) * 128;
        float acc = p.sgu_b[(l * 4 + g) * 128 + pp];
        for (int q = 0; q < 128; ++q) acc += bf2f(w[q]) * bf2f(vg[(size_t)(r0 + q) * 256 + col]);
        const float u = gelu_tanh(bf2f(F.pl()[(size_t)r * INP + OFF_C + col]));
        F.ml()[(size_t)r * D + 512 + col] = (bf16)f2bf(u * acc);
    }
}
__device__ __forceinline__ void p3_na_naive(CPR p, Frame& F, int l) {
    LAS float* pw = (LAS float*)(F.lds + 65536 + F.wave * 2048);
    for (int it = F.gw; it < T * 4; it += F.ngw) {
        const int r = it >> 2, h = it & 3; const bool lat = r < TL; const int b = row_batch(r);
        float q[64];
        { const bf16* qp = F.pl() + (size_t)r * INP + OFF_B + h * 64;
#pragma unroll
          for (int j = 0; j < 8; ++j) { const u32x4 t = *(const u32x4*)(qp + 8 * j);
#pragma unroll
              for (int k = 0; k < 4; ++k) { q[8 * j + 2 * k] = __uint_as_float(t[k] << 16); q[8 * j + 2 * k + 1] = __uint_as_float(t[k] & 0xffff0000u); } } }
        const int t = r & (SEQ - 1), gr = t >> 6, gc = t & 63, jb = gc >> 4;
        int rs = gr - 4; rs = rs < 0 ? 0 : (rs > GH - 8 ? GH - 8 : rs);
        int wsq = gc - 8; wsq = wsq < 0 ? 0 : (wsq > GW - 16 ? GW - 16 : wsq);
        int cs = 16 * jb - 8; cs = cs < 0 ? 0 : (cs > GW - 16 ? GW - 16 : cs); cs = cs > GW - 32 ? GW - 32 : cs;
        const float* rpb = p.na_rpb + (size_t)(l * 4 + h) * 15 * 31;
        float s[8];
#pragma unroll
        for (int i = 0; i < 8; ++i) {
            const int k = F.lane + 64 * (i & 3); const bool win = i < 4;
            int keyrow; float bias = 0.f; bool valid = true;
            if (win) { const int rr = k >> 5, cc = k & 31, kcol = cs + cc; keyrow = b * SEQ + (rs + rr) * 64 + kcol;
                valid = lat && (kcol >= wsq) && (kcol < wsq + 16);
                int dc = kcol - gc + 15; dc = dc < 0 ? 0 : (dc > 30 ? 30 : dc);
                bias = rpb[(rs + rr - gr + 7) * 31 + dc];
                if (!lat) keyrow = r; }
            else keyrow = TL + b * CTX + k;
            const bf16* kp = F.pl() + (size_t)keyrow * INP + OFF_B + 256 + h * 64;
            float d = 0.f;
#pragma unroll
            for (int j = 0; j < 8; ++j) { const u32x4 tt = *(const u32x4*)(kp + 8 * j);
#pragma unroll
                for (int kk = 0; kk < 4; ++kk) d += q[8 * j + 2 * kk] * __uint_as_float(tt[kk] << 16) + q[8 * j + 2 * kk + 1] * __uint_as_float(tt[kk] & 0xffff0000u); }
            s[i] = valid ? (d * 0.125f + bias) : -1e30f;
        }
        float m = s[0];
#pragma unroll
        for (int i = 1; i < 8; ++i) m = fmaxf(m, s[i]);
        m = wave_max(m);
        float sum = 0.f;
#pragma unroll
        for (int i = 0; i < 8; ++i) { s[i] = __expf(s[i] - m); sum += s[i]; }
        sum = wave_sum(sum); const float inv = 1.f / sum;
#pragma unroll
        for (int i = 0; i < 8; ++i) pw[(i >> 2) * 256 + F.lane + 64 * (i & 3)] = s[i] * inv;
        LDS_WAIT(); asm volatile("" ::: "memory");
        float acc = 0.f;
        if (lat) for (int k = 0; k < 256; ++k) { const int rr = k >> 5, cc = k & 31; const int keyrow = b * SEQ + (rs + rr) * 64 + cs + cc;
            acc += pw[k] * bf2f(F.pl()[(size_t)keyrow * INP + OFF_B + 512 + h * 64 + F.lane]); }
        for (int k = 0; k < 256; ++k) acc += pw[256 + k] * bf2f(F.pl()[(size_t)(TL + b * CTX + k) * INP + OFF_B + 512 + h * 64 + F.lane]);
        F.ml()[(size_t)r * D + 256 + h * 64 + F.lane] = (bf16)f2bf(acc);
        LDS_WAIT(); asm volatile("" ::: "memory");
    }
}
__device__ __forceinline__ void p4_mla_naive(Frame& F) {
    LAS float* pw = (LAS float*)(F.lds + 65536 + F.wave * 2048);
    for (int it = F.gw; it < T * 4; it += F.ngw) {
        const int r = it >> 2, h = it & 3; const bool lat = r < TL; const int b = row_batch(r);
        float q[96];
        { const bf16* qp = F.qm() + (size_t)r * 384 + h * 96;
#pragma unroll
          for (int j = 0; j < 12; ++j) { const u32x4 t = *(const u32x4*)(qp + 8 * j);
#pragma unroll
              for (int k = 0; k < 4; ++k) { q[8 * j + 2 * k] = __uint_as_float(t[k] << 16); q[8 * j + 2 * k + 1] = __uint_as_float(t[k] & 0xffff0000u); } } }
        const int nk = lat ? (CTX + SEQ) : CTX;
        float m = -3.0e38f, lsum = 0.f, acc = 0.f;
        for (int k0 = 0; k0 < nk; k0 += 64) {
            const int k = k0 + F.lane; const int keyrow = (k < CTX) ? (TL + b * CTX + k) : (b * SEQ + k - CTX);
            const bf16* kp = F.km() + (size_t)keyrow * 384 + h * 96;
            float d = 0.f;
#pragma unroll
            for (int j = 0; j < 12; ++j) { const u32x4 tt = *(const u32x4*)(kp + 8 * j);
#pragma unroll
                for (int kk = 0; kk < 4; ++kk) d += q[8 * j + 2 * kk] * __uint_as_float(tt[kk] << 16) + q[8 * j + 2 * kk + 1] * __uint_as_float(tt[kk] & 0xffff0000u); }
            const float mn = fmaxf(m, wave_max(d)); const float alpha = exp2f(m - mn); const float pe = exp2f(d - mn);
            lsum = lsum * alpha + wave_sum(pe); acc *= alpha; m = mn;
            pw[F.lane] = pe; LDS_WAIT(); asm volatile("" ::: "memory");
            for (int kk = 0; kk < 64; ++kk) { const int k2 = k0 + kk; const int kr2 = (k2 < CTX) ? (TL + b * CTX + k2) : (b * SEQ + k2 - CTX);
                acc += pw[kk] * bf2f(F.vm()[(size_t)kr2 * 256 + h * 64 + F.lane]); }
            LDS_WAIT(); asm volatile("" ::: "memory");
        }
        F.ml()[(size_t)r * D + 768 + h * 64 + F.lane] = (bf16)f2bf(acc / lsum);
    }
}

typedef float f32x16 __attribute__((ext_vector_type(16)));
typedef short s16x4 __attribute__((ext_vector_type(4)));
__device__ __forceinline__ s16x4 lds_tr16(const LAS unsigned char* p) { return __builtin_bit_cast(s16x4, __builtin_amdgcn_ds_read_tr16_b64_v4i16((LAS s16x4*)p)); }
__device__ __forceinline__ bf16x8 pack8(const f32x16& v, int o) {
    u32x4 w; w.x = pg8::cvt_pk_bf16(v[o + 0], v[o + 1]); w.y = pg8::cvt_pk_bf16(v[o + 2], v[o + 3]); w.z = pg8::cvt_pk_bf16(v[o + 4], v[o + 5]); w.w = pg8::cvt_pk_bf16(v[o + 6], v[o + 7]);
    return __builtin_bit_cast(bf16x8, w);
}
__device__ __forceinline__ void p4_mla_flash(Frame& F) {
    constexpr int KP = 208, VP = 144, KB = 64 * KP, VB = 64 * VP, BUF = KB + VB;
    const int tid = F.tid, lane = F.lane, w = F.wave, q = lane & 31, hh = lane >> 5;
    const bf16* qm = F.qm(); const bf16* km = F.km(); const bf16* vm = F.vm(); bf16* ml = F.ml();
    const int kc0 = tid, kc1 = 512 + (tid & 255);
    const int k0key = kc0 / 12, k0part = kc0 % 12, k1key = kc1 / 12, k1part = kc1 % 12, vkey = tid >> 3, vpart = tid & 7;
    const int trow = 4 * hh + ((lane & 15) >> 2), tcol = 16 * ((lane >> 4) & 1) + 4 * (lane & 3);
    for (int ui = blockIdx.x; ui < 272; ui += gridDim.x) {
        const int qt = ui < 256 ? (ui >> 2) : 64 + ((ui - 256) >> 2), h = ui & 3;
        const bool lat = qt < 64; const int b = lat ? (qt >> 4) : (qt - 64), ntile = lat ? 68 : 4;
        const int qrow = qt * 256 + w * 32 + q;
        bf16x8 qf[6];
#pragma unroll
        for (int ks = 0; ks < 6; ++ks) qf[ks] = *(const bf16x8*)(qm + (size_t)qrow * 384 + h * 96 + 16 * ks + 8 * hh);
        f32x16 ot0, ot1;
#pragma unroll
        for (int r = 0; r < 16; ++r) { ot0[r] = 0.f; ot1[r] = 0.f; }
        float m = -1.0e30f, l = 0.f;
        u32x4 kr0, kr1, vr;
#define MLA_LOAD(t) do { const int t_ = (t); const int kr_ = (lat && t_ >= 4) ? b * SEQ + 64 * (t_ - 4) : TL + b * CTX + 64 * t_; \
            kr0 = *(const u32x4*)(km + (size_t)(kr_ + k0key) * 384 + h * 96 + 8 * k0part); \
            if (tid < 256) kr1 = *(const u32x4*)(km + (size_t)(kr_ + k1key) * 384 + h * 96 + 8 * k1part); \
            vr = *(const u32x4*)(vm + (size_t)(kr_ + vkey) * 256 + h * 64 + 8 * vpart); } while (0)
#define MLA_STORE(bufi) do { LAS unsigned char* kb_ = F.lds + (bufi) * BUF; \
            *(LAS u32x4*)(kb_ + k0key * KP + k0part * 16) = kr0; if (tid < 256) *(LAS u32x4*)(kb_ + k1key * KP + k1part * 16) = kr1; \
            *(LAS u32x4*)(kb_ + KB + vkey * VP + vpart * 16) = vr; } while (0)
        MLA_LOAD(0); MLA_STORE(0);
        __syncthreads();
        for (int t = 0; t < ntile; ++t) {
            if (t + 1 < ntile) MLA_LOAD(t + 1);
            const LAS unsigned char* kb = F.lds + (t & 1) * BUF; const LAS unsigned char* vb = kb + KB;
            f32x16 s0, s1;
#pragma unroll
            for (int r = 0; r < 16; ++r) { s0[r] = 0.f; s1[r] = 0.f; }
#pragma unroll
            for (int ks = 0; ks < 6; ++ks) {
                const bf16x8 ka = *(const LAS bf16x8*)(kb + q * KP + (16 * ks + 8 * hh) * 2);
                const bf16x8 kb2 = *(const LAS bf16x8*)(kb + (32 + q) * KP + (16 * ks + 8 * hh) * 2);
                s0 = __builtin_amdgcn_mfma_f32_32x32x16_bf16(ka, qf[ks], s0, 0, 0, 0);
                s1 = __builtin_amdgcn_mfma_f32_32x32x16_bf16(kb2, qf[ks], s1, 0, 0, 0);
            }
            float mx = fmaxf(s0[0], s1[0]);
#pragma unroll
            for (int r = 1; r < 16; ++r) mx = fmaxf(mx, fmaxf(s0[r], s1[r]));
            mx = xmax32(mx);
            const float mn = fmaxf(m, mx), alpha = __builtin_amdgcn_exp2f(m - mn); m = mn;
            float rs = 0.f;
#pragma unroll
            for (int r = 0; r < 16; ++r) { s0[r] = __builtin_amdgcn_exp2f(s0[r] - mn); s1[r] = __builtin_amdgcn_exp2f(s1[r] - mn); rs += s0[r] + s1[r]; }
            l = l * alpha + rs;
#pragma unroll
            for (int r = 0; r < 16; ++r) { ot0[r] *= alpha; ot1[r] *= alpha; }
            bf16x8 pb[4]; pb[0] = pack8(s0, 0); pb[1] = pack8(s0, 8); pb[2] = pack8(s1, 0); pb[3] = pack8(s1, 8);
#pragma unroll
            for (int kk = 0; kk < 4; ++kk) {
                const LAS unsigned char* a0 = vb + (16 * kk + trow) * VP + tcol * 2;
                const s16x4 lo0 = lds_tr16(a0), hi0 = lds_tr16(a0 + 8 * VP), lo1 = lds_tr16(a0 + 64), hi1 = lds_tr16(a0 + 8 * VP + 64);
                const bf16x8 v0 = (bf16x8){lo0[0], lo0[1], lo0[2], lo0[3], hi0[0], hi0[1], hi0[2], hi0[3]};
                const bf16x8 v1 = (bf16x8){lo1[0], lo1[1], lo1[2], lo1[3], hi1[0], hi1[1], hi1[2], hi1[3]};
                ot0 = __builtin_amdgcn_mfma_f32_32x32x16_bf16(v0, pb[kk], ot0, 0, 0, 0);
                ot1 = __builtin_amdgcn_mfma_f32_32x32x16_bf16(v1, pb[kk], ot1, 0, 0, 0);
            }
            if (t + 1 < ntile) MLA_STORE((t + 1) & 1);
            __syncthreads();
        }
#undef MLA_LOAD
#undef MLA_STORE
        l = xsum32(l);
        const float il = 1.f / l;
        bf16* orow = ml + (size_t)qrow * D + 768 + h * 64 + 4 * hh;
#pragma unroll
        for (int g = 0; g < 4; ++g) {
            u32x2 o0, o1;
            o0.x = pg8::cvt_pk_bf16(ot0[4 * g] * il, ot0[4 * g + 1] * il); o0.y = pg8::cvt_pk_bf16(ot0[4 * g + 2] * il, ot0[4 * g + 3] * il);
            o1.x = pg8::cvt_pk_bf16(ot1[4 * g] * il, ot1[4 * g + 1] * il); o1.y = pg8::cvt_pk_bf16(ot1[4 * g + 2] * il, ot1[4 * g + 3] * il);
            *(u32x2*)(orow + 8 * g) = o0; *(u32x2*)(orow + 32 + 8 * g) = o1;
        }
    }
}

__device__ __forceinline__ void p3_na_mfma(CPR p, Frame& F, int l) {
    constexpr int TP = 144, KBs = 32 * TP, WB = 2 * KBs, BT_OFF = 8 * WB;
    const int tid = F.tid, lane = F.lane, q = lane & 31, hh = lane >> 5;
    LAS unsigned char* wk = F.lds + F.wave * WB; LAS unsigned char* wv = wk + KBs;
    LAS float* btab = (LAS float*)(F.lds + BT_OFF);
    __syncthreads();
    for (int i = tid; i < 4 * 465; i += NTHR) btab[i] = p.na_rpb[(size_t)l * 1860 + i] * LOG2E;
    __syncthreads();
    const bf16* pl = F.pl(); bf16* ml = F.ml();
    const int skey = lane >> 3, spart = lane & 7;
    const int trow = 4 * hh + ((lane & 15) >> 2), tcol = 16 * ((lane >> 4) & 1) + 4 * (lane & 3);
    constexpr float QS = 0.125f * LOG2E;
    for (int it = F.gw; it < 2176; it += F.ngw) {
        const bool lat = it < 2048; const int x = lat ? it : it - 2048;
        const int h = x & 3, b = lat ? (x >> 9) : (x >> 5), r = (x >> 3) & 63, jp = (x >> 2) & 1, g8 = (x >> 2) & 7;
        const int qrow = lat ? b * SEQ + r * 64 + 32 * jp + q : TL + b * CTX + 32 * g8 + q;
        const int ntile = lat ? 18 : 8;
        int rs = r - 4; rs = rs < 0 ? 0 : (rs > GH - 8 ? GH - 8 : rs);
        const int cb = jp ? 24 : 0, gc = 32 * jp + q; int wsq = gc - 8; wsq = wsq < 0 ? 0 : (wsq > GW - 16 ? GW - 16 : wsq);
        const int baddr = ((h * 15 + (rs - r + 7)) * 31 + cb - gc + 15 + 4 * hh) * 4;
        const int vk0 = cb + 4 * hh - wsq;
        bf16x8 qf[4];
#pragma unroll
        for (int ks = 0; ks < 4; ++ks) qf[ks] = *(const bf16x8*)(pl + (size_t)qrow * INP + OFF_B + 64 * h + 16 * ks + 8 * hh);
        f32x16 ot0, ot1;
#pragma unroll
        for (int i = 0; i < 16; ++i) { ot0[i] = 0.f; ot1[i] = 0.f; }
        float m = -1.0e30f, lsum = 0.f;
        u32x4 kr[4], vr[4];
#define NA_LOAD(t) do { const int t_ = (t); _Pragma("unroll") for (int j = 0; j < 4; ++j) { int row_; \
            if (t_ < 8) row_ = TL + b * CTX + 32 * t_ + 8 * j + skey; \
            else { const int x_ = 4 * (t_ - 8) + j, rr_ = (x_ * 205) >> 10, cg_ = x_ - 5 * rr_; row_ = b * SEQ + (rs + rr_) * 64 + cb + 8 * cg_ + skey; } \
            const bf16* src_ = pl + (size_t)row_ * INP + OFF_B + 256 + 64 * h + 8 * spart; kr[j] = *(const u32x4*)src_; vr[j] = *(const u32x4*)(src_ + 256); } } while (0)
#define NA_STORE() do { _Pragma("unroll") for (int j = 0; j < 4; ++j) { *(LAS u32x4*)(wk + (8 * j + skey) * TP + spart * 16) = kr[j]; *(LAS u32x4*)(wv + (8 * j + skey) * TP + spart * 16) = vr[j]; } } while (0)
        NA_LOAD(0); NA_STORE();
        for (int t = 0; t < ntile; ++t) {
            if (t + 1 < ntile) NA_LOAD(t + 1);
            f32x16 sc;
#pragma unroll
            for (int i = 0; i < 16; ++i) sc[i] = 0.f;
#pragma unroll
            for (int ks = 0; ks < 4; ++ks) {
                const bf16x8 ka = *(const LAS bf16x8*)(wk + q * TP + (16 * ks + 8 * hh) * 2);
                sc = __builtin_amdgcn_mfma_f32_32x32x16_bf16(ka, qf[ks], sc, 0, 0, 0);
            }
            if (t < 8) {
#pragma unroll
                for (int i = 0; i < 16; ++i) sc[i] *= QS;
            } else {
                const int wt = t - 8;
#pragma unroll
                for (int g = 0; g < 4; ++g) {
                    const int x_ = 4 * wt + g, rr_ = (x_ * 205) >> 10, cg_ = x_ - 5 * rr_;
                    const LAS float* bp = (const LAS float*)((const LAS unsigned char*)btab + baddr + (rr_ * 31 + 8 * cg_) * 4);
                    const int vk = vk0 + 8 * cg_;
#pragma unroll
                    for (int e = 0; e < 4; ++e) { const float bias = bp[e]; const bool ok = (unsigned)(vk + e) < 16u; sc[4 * g + e] = ok ? fmaf(sc[4 * g + e], QS, bias) : -1.0e30f; }
                }
            }
            float mx = sc[0];
#pragma unroll
            for (int i = 1; i < 16; ++i) mx = fmaxf(mx, sc[i]);
            mx = xmax32(mx);
            const float mn = fmaxf(m, mx), alpha = __builtin_amdgcn_exp2f(m - mn); m = mn;
            float rsum = 0.f;
#pragma unroll
            for (int i = 0; i < 16; ++i) { sc[i] = __builtin_amdgcn_exp2f(sc[i] - mn); rsum += sc[i]; }
            lsum = lsum * alpha + rsum;
#pragma unroll
            for (int i = 0; i < 16; ++i) { ot0[i] *= alpha; ot1[i] *= alpha; }
            bf16x8 pb[2]; pb[0] = pack8(sc, 0); pb[1] = pack8(sc, 8);
#pragma unroll
            for (int kk = 0; kk < 2; ++kk) {
                const LAS unsigned char* a0 = wv + (16 * kk + trow) * TP + tcol * 2;
                const s16x4 lo0 = lds_tr16(a0), hi0 = lds_tr16(a0 + 8 * TP), lo1 = lds_tr16(a0 + 64), hi1 = lds_tr16(a0 + 8 * TP + 64);
                const bf16x8 v0 = (bf16x8){lo0[0], lo0[1], lo0[2], lo0[3], hi0[0], hi0[1], hi0[2], hi0[3]};
                const bf16x8 v1 = (bf16x8){lo1[0], lo1[1], lo1[2], lo1[3], hi1[0], hi1[1], hi1[2], hi1[3]};
                ot0 = __builtin_amdgcn_mfma_f32_32x32x16_bf16(v0, pb[kk], ot0, 0, 0, 0);
                ot1 = __builtin_amdgcn_mfma_f32_32x32x16_bf16(v1, pb[kk], ot1, 0, 0, 0);
            }
            if (t + 1 < ntile) NA_STORE();
        }
#undef NA_LOAD
#undef NA_STORE
        lsum = xsum32(lsum);
        const float il = 1.f / lsum;
        bf16* orow = ml + (size_t)qrow * D + 256 + h * 64 + 4 * hh;
#pragma unroll
        for (int g = 0; g < 4; ++g) {
            u32x2 o0, o1;
            o0.x = pg8::cvt_pk_bf16(ot0[4 * g] * il, ot0[4 * g + 1] * il); o0.y = pg8::cvt_pk_bf16(ot0[4 * g + 2] * il, ot0[4 * g + 3] * il);
            o1.x = pg8::cvt_pk_bf16(ot1[4 * g] * il, ot1[4 * g + 1] * il); o1.y = pg8::cvt_pk_bf16(ot1[4 * g + 2] * il, ot1[4 * g + 3] * il);
            *(u32x2*)(orow + 8 * g) = o0; *(u32x2*)(orow + 32 + 8 * g) = o1;
        }
    }
    __syncthreads();
}

__device__ __forceinline__ float sumsq8(const bf16x8& v) { const u32x4 u = __builtin_bit_cast(u32x4, v); float s = 0.f;
#pragma unroll
    for (int j = 0; j < 4; ++j) { const float a = __uint_as_float(u[j] << 16), b = __uint_as_float(u[j] & 0xffff0000u); s += a * a + b * b; }
    return s; }
__device__ __forceinline__ void p3_mla_up(Frame& F, int l) {
    const int lane = F.lane, tkn = lane & 31, hh = lane >> 5;
    const bf16* pl = F.pl(); const bf16* wq = F.wuq() + (size_t)l * 384 * 256; const bf16* wkv = F.wukv() + (size_t)l * 512 * 128;
    bf16* qm = F.qm(); bf16* km = F.km(); bf16* vm = F.vm();
    for (int it = F.gw; it < (T / 32) * 4; it += F.ngw) {
        const int h = it & 3, row = (it >> 2) * 32 + tkn; const bool lat = row < TL; const int t = row & (SEQ - 1);
        const bf16* pr = pl + (size_t)row * INP + OFF_D;
        bf16x8 bq[16], bk[8]; float sq = 0.f, sk = 0.f;
#pragma unroll
        for (int ks = 0; ks < 16; ++ks) { bq[ks] = *(const bf16x8*)(pr + 16 * ks + 8 * hh); sq += sumsq8(bq[ks]); }
#pragma unroll
        for (int ks = 0; ks < 8; ++ks) { bk[ks] = *(const bf16x8*)(pr + 256 + 16 * ks + 8 * hh); sk += sumsq8(bk[ks]); }
        sq = xsum32(sq); sk = xsum32(sk);
        const float rq = rsqrtf(sq * (1.f / 256.f) + EPS) * (MLA_SCALE * LOG2E), rk = rsqrtf(sk * (1.f / 128.f) + EPS);
        f32x4 cr = {1.f, 1.f, 1.f, 1.f}, sr = {0.f, 0.f, 0.f, 0.f}, cc = cr, sc = sr;
        if (lat) { cr = *(const f32x4*)(F.ropec() + t * 16 + 4 * hh); sr = *(const f32x4*)(F.ropes() + t * 16 + 4 * hh); cc = *(const f32x4*)(F.ropec() + t * 16 + 8 + 4 * hh); sc = *(const f32x4*)(F.ropes() + t * 16 + 8 + 4 * hh); }
#pragma unroll
        for (int q3 = 0; q3 < 3; ++q3) {
            const int nt = 3 * h + q3;
            f32x16 acc;
#pragma unroll
            for (int i = 0; i < 16; ++i) acc[i] = 0.f;
            const bf16* wr = wq + (size_t)(32 * nt + tkn) * 256 + 8 * hh;
#pragma unroll
            for (int ks = 0; ks < 16; ++ks) acc = __builtin_amdgcn_mfma_f32_32x32x16_bf16(*(const bf16x8*)(wr + 16 * ks), bq[ks], acc, 0, 0, 0);
#pragma unroll
            for (int i = 0; i < 16; ++i) acc[i] *= rq;
            if (q3 == 2) {
#pragma unroll
                for (int e = 0; e < 4; ++e) { const float x1 = acc[e], x2 = acc[4 + e], y1 = acc[8 + e], y2 = acc[12 + e];
                    acc[e] = x1 * cr[e] - x2 * sr[e]; acc[4 + e] = x1 * sr[e] + x2 * cr[e]; acc[8 + e] = y1 * cc[e] - y2 * sc[e]; acc[12 + e] = y1 * sc[e] + y2 * cc[e]; }
            }
            bf16* o = qm + (size_t)row * 384 + 32 * nt + 4 * hh;
#pragma unroll
            for (int g = 0; g < 4; ++g) { u32x2 w; w.x = pg8::cvt_pk_bf16(acc[4 * g], acc[4 * g + 1]); w.y = pg8::cvt_pk_bf16(acc[4 * g + 2], acc[4 * g + 3]); *(u32x2*)(o + 8 * g) = w; }
        }
#pragma unroll
        for (int sub = 0; sub < 4; ++sub) {
            const int nt = 4 * h + sub;
            f32x16 acc;
#pragma unroll
            for (int i = 0; i < 16; ++i) acc[i] = 0.f;
            const bf16* wr = wkv + (size_t)(32 * nt + tkn) * 128 + 8 * hh;
#pragma unroll
            for (int ks = 0; ks < 8; ++ks) acc = __builtin_amdgcn_mfma_f32_32x32x16_bf16(*(const bf16x8*)(wr + 16 * ks), bk[ks], acc, 0, 0, 0);
            bf16* o = (sub < 2) ? km + (size_t)row * 384 + 96 * h + 32 * sub + 4 * hh : vm + (size_t)row * 256 + 64 * h + 32 * (sub - 2) + 4 * hh;
#pragma unroll
            for (int g = 0; g < 4; ++g) { u32x2 w; w.x = pg8::cvt_pk_bf16(acc[4 * g] * rk, acc[4 * g + 1] * rk); w.y = pg8::cvt_pk_bf16(acc[4 * g + 2] * rk, acc[4 * g + 3] * rk); *(u32x2*)(o + 8 * g) = w; }
        }
        { const u32x4 a = *(const u32x4*)(pr + 384 + 16 * hh), bb = *(const u32x4*)(pr + 384 + 16 * hh + 8);
          float x1[8], x2[8];
#pragma unroll
          for (int j = 0; j < 4; ++j) { x1[2 * j] = __uint_as_float(a[j] << 16); x1[2 * j + 1] = __uint_as_float(a[j] & 0xffff0000u); x2[2 * j] = __uint_as_float(bb[j] << 16); x2[2 * j + 1] = __uint_as_float(bb[j] & 0xffff0000u); }
          float o1[8], o2[8];
#pragma unroll
          for (int j = 0; j < 8; ++j) { float c = 1.f, sn = 0.f; if (lat) { c = F.ropec()[t * 16 + 8 * hh + j]; sn = F.ropes()[t * 16 + 8 * hh + j]; } o1[j] = x1[j] * c - x2[j] * sn; o2[j] = x1[j] * sn + x2[j] * c; }
          u32x4 w1, w2;
#pragma unroll
          for (int j = 0; j < 4; ++j) { w1[j] = pg8::cvt_pk_bf16(o1[2 * j], o1[2 * j + 1]); w2[j] = pg8::cvt_pk_bf16(o2[2 * j], o2[2 * j + 1]); }
          bf16* o = km + (size_t)row * 384 + 96 * h + 64 + 16 * hh; *(u32x4*)o = w1; *(u32x4*)(o + 8) = w2; }
    }
}

__device__ __forceinline__ void p3_pool_mfma(CPR p, Frame& F, int l) {
    const int lane = F.lane, tk = lane & 31, hh = lane >> 5;
    const bf16* pl = F.pl(); bf16* ml = F.ml();
    for (int it = F.gw; it < (T / 32) * 4; it += F.ngw) {
        const int g = it & 3, row = (it >> 2) * 32 + tk;
        const int L = row < TL ? SEQ : CTX, t = row < TL ? (row & (SEQ - 1)) : ((row - TL) & (CTX - 1)), seg0 = row - t;
        const int win = 2 << g; int lo = t - win / 2, hi = t - win / 2 + win; lo = lo < 0 ? 0 : lo; hi = hi > L ? L : hi;
        const float inv = 1.f / (float)(hi - lo);
        float sum[32];
#pragma unroll
        for (int i = 0; i < 32; ++i) sum[i] = 0.f;
        for (int sidx = lo; sidx < hi; ++sidx) {
            const bf16* src = pl + (size_t)(seg0 + sidx) * INP + 64 * g + 8 * hh;
#pragma unroll
            for (int ks = 0; ks < 4; ++ks) { const u32x4 v = *(const u32x4*)(src + 16 * ks);
#pragma unroll
                for (int j = 0; j < 4; ++j) { sum[8 * ks + 2 * j] += __uint_as_float(v[j] << 16); sum[8 * ks + 2 * j + 1] += __uint_as_float(v[j] & 0xffff0000u); } }
        }
        bf16x8 df[4];
        { const bf16* src = pl + (size_t)row * INP + 64 * g + 8 * hh;
#pragma unroll
          for (int ks = 0; ks < 4; ++ks) { const u32x4 v = *(const u32x4*)(src + 16 * ks); u32x4 w;
#pragma unroll
              for (int j = 0; j < 4; ++j) w[j] = pg8::cvt_pk_bf16(sum[8 * ks + 2 * j] * inv - __uint_as_float(v[j] << 16), sum[8 * ks + 2 * j + 1] * inv - __uint_as_float(v[j] & 0xffff0000u));
              df[ks] = __builtin_bit_cast(bf16x8, w); } }
        const bf16* wt = F.poolw() + (size_t)(l * 4 + g) * 4096;
#pragma unroll
        for (int dt = 0; dt < 2; ++dt) {
            f32x16 acc;
#pragma unroll
            for (int i = 0; i < 16; ++i) acc[i] = 0.f;
#pragma unroll
            for (int ks = 0; ks < 4; ++ks) acc = __builtin_amdgcn_mfma_f32_32x32x16_bf16(*(const bf16x8*)(wt + (size_t)(32 * dt + tk) * 64 + 16 * ks + 8 * hh), df[ks], acc, 0, 0, 0);
            const int col = 64 * g + 32 * dt + 4 * hh; const float* ps = p.pool_s + l * 256 + col; bf16* o = ml + (size_t)row * D + col;
#pragma unroll
            for (int gg = 0; gg < 4; ++gg) { const f32x4 sc = *(const f32x4*)(ps + 8 * gg); u32x2 w; w.x = pg8::cvt_pk_bf16(acc[4 * gg] * sc.x, acc[4 * gg + 1] * sc.y); w.y = pg8::cvt_pk_bf16(acc[4 * gg + 2] * sc.z, acc[4 * gg + 3] * sc.w); *(u32x2*)(o + 8 * gg) = w; }
        }
    }
}
__device__ __forceinline__ void p3_sgu_mfma(CPR p, Frame& F, int l) {
    constexpr int VP = 144;
    const int tid = F.tid, lane = F.lane, tk = lane & 31, hh = lane >> 5, pt = F.wave >> 1, ct = F.wave & 1;
    const bf16* pl = F.pl(); bf16* ml = F.ml();
    const int trow = 8 * hh + ((lane & 15) >> 2), tcol = 16 * ((lane >> 4) & 1) + 4 * (lane & 3);
    __syncthreads();
    for (int it = blockIdx.x; it < (T / 128) * 4; it += gridDim.x) {
        const int g = it & 3, r0 = (it >> 2) * 128;
        {
            const int qq = tid >> 2, c0 = 16 * (tid & 3);
            const bf16* src = pl + (size_t)(r0 + qq) * INP + OFF_C + 256 + 64 * g + c0;
            const u32x4 a = *(const u32x4*)src, b = *(const u32x4*)(src + 8);
            float v[16]; float ss = 0.f;
#pragma unroll
            for (int j = 0; j < 4; ++j) { v[2 * j] = gelu_tanh(__uint_as_float(a[j] << 16)); v[2 * j + 1] = gelu_tanh(__uint_as_float(a[j] & 0xffff0000u)); v[8 + 2 * j] = gelu_tanh(__uint_as_float(b[j] << 16)); v[8 + 2 * j + 1] = gelu_tanh(__uint_as_float(b[j] & 0xffff0000u)); }
#pragma unroll
            for (int j = 0; j < 16; ++j) ss += v[j] * v[j];
            ss += lane_xor<1>(ss); ss += lane_xor<2>(ss);
            const float rs = rsqrtf(ss * (1.f / 64.f) + EPS); const float* gn = p.sgu_norm_g + l * 256 + 64 * g + c0;
            u32x4 w0, w1;
#pragma unroll
            for (int j = 0; j < 4; ++j) { w0[j] = pg8::cvt_pk_bf16(v[2 * j] * rs * gn[2 * j], v[2 * j + 1] * rs * gn[2 * j + 1]); w1[j] = pg8::cvt_pk_bf16(v[8 + 2 * j] * rs * gn[8 + 2 * j], v[8 + 2 * j + 1] * rs * gn[8 + 2 * j + 1]); }
            LAS unsigned char* d = F.lds + qq * VP + c0 * 2; *(LAS u32x4*)d = w0; *(LAS u32x4*)(d + 16) = w1;
        }
        __syncthreads();
        f32x16 acc;
#pragma unroll
        for (int i = 0; i < 16; ++i) acc[i] = 0.f;
        const bf16* wrow = F.sguw() + ((size_t)(l * 4 + g) * 128 + 32 * pt + tk) * 128 + 8 * hh;
#pragma unroll
        for (int ks = 0; ks < 8; ++ks) {
            const LAS unsigned char* a0 = F.lds + (16 * ks + trow) * VP + (32 * ct + tcol) * 2;
            const s16x4 lo = lds_tr16(a0), hi4 = lds_tr16(a0 + 4 * VP);
            const bf16x8 va = (bf16x8){lo[0], lo[1], lo[2], lo[3], hi4[0], hi4[1], hi4[2], hi4[3]};
            acc = __builtin_amdgcn_mfma_f32_32x32x16_bf16(va, *(const bf16x8*)(wrow + 16 * ks), acc, 0, 0, 0);
        }
        const int row = r0 + 32 * pt + tk; const float bias = p.sgu_b[(l * 4 + g) * 128 + 32 * pt + tk];
        const int col = 64 * g + 32 * ct + 4 * hh;
#pragma unroll
        for (int gg = 0; gg < 4; ++gg) { const u32x2 uu = *(const u32x2*)(pl + (size_t)row * INP + OFF_C + col + 8 * gg);
            const float u0 = gelu_tanh(__uint_as_float(uu.x << 16)), u1 = gelu_tanh(__uint_as_float(uu.x & 0xffff0000u)), u2 = gelu_tanh(__uint_as_float(uu.y << 16)), u3 = gelu_tanh(__uint_as_float(uu.y & 0xffff0000u));
            u32x2 w; w.x = pg8::cvt_pk_bf16(u0 * (acc[4 * gg] + bias), u1 * (acc[4 * gg + 1] + bias)); w.y = pg8::cvt_pk_bf16(u2 * (acc[4 * gg + 2] + bias), u3 * (acc[4 * gg + 3] + bias));
            *(u32x2*)(ml + (size_t)row * D + 512 + col + 8 * gg) = w; }
        __syncthreads();
    }
}

__device__ __forceinline__ void p5_outproj_naive(Frame& F, int l) {
    const bf16* W = F.wout() + (size_t)l * D * D;
    for (long i = F.gt; i < (long)T * D; i += F.ngt) { const int r = (int)(i >> 10), c = (int)(i & 1023);
        const float g = mod_vec(F, l, row_mod(r), 2)[c];
        F.xl()[(size_t)r * D + c] += g * dot_bf16(F.ml() + (size_t)r * D, W + (size_t)c * D, D); }
}

template <int OFF> __device__ __forceinline__ void rs_step(float (&x)[16], int n, bool up) {
#pragma unroll
    for (int k = 0; k < 8; ++k) if (k < n) { const float send = up ? x[k] : x[k + n]; const float keep = up ? x[k + n] : x[k];
        if constexpr (OFF == 32) x[k] = keep + other32(send); else x[k] = keep + lane_xor<OFF>(send); }
}
__device__ __forceinline__ void route_row(CPR p, Frame& F, int l, int r, float (&lg)[16], bool commit) {
    const int lane = F.lane;
    rs_step<32>(lg, 8, (lane & 32) != 0); rs_step<16>(lg, 4, (lane & 16) != 0); rs_step<8>(lg, 2, (lane & 8) != 0); rs_step<4>(lg, 1, (lane & 4) != 0);
    float tsum = lg[0]; tsum += lane_xor<2>(tsum); tsum += lane_xor<1>(tsum);
    float sc16[16], bi[16];
#pragma unroll
    for (int e = 0; e < 16; ++e) { const float t = __builtin_bit_cast(float, __builtin_amdgcn_readlane(__builtin_bit_cast(int, tsum), 4 * e)); sc16[e] = 1.f / (1.f + __expf(-t)); bi[e] = sc16[e] + p.router_b[e]; }
    int sg = 0; float best = -3.0e38f;
#pragma unroll
    for (int g = 0; g < 4; ++g) { float m1 = -3.0e38f, m2 = -3.0e38f;
#pragma unroll
        for (int j = 0; j < 4; ++j) { const float x = bi[4 * g + j]; if (x > m1) { m2 = m1; m1 = x; } else if (x > m2) m2 = x; }
        const float gs = m1 + m2; if (gs > best) { best = gs; sg = g; } }
    int i0 = 0, i1 = 0; float b0 = -3.0e38f, b1 = -3.0e38f, s0 = 0.f, s1 = 0.f;
#pragma unroll
    for (int e = 0; e < 16; ++e) { if ((e >> 2) == sg) { const float x = bi[e]; if (x > b0) { b1 = b0; i1 = i0; s1 = s0; b0 = x; i0 = e; s0 = sc16[e]; } else if (x > b1) { b1 = x; i1 = e; s1 = sc16[e]; } } }
    const float ws = s0 + s1; const float w0 = s0 / ws, w1 = s1 / ws;
    if (lane == 0 && commit) {
        const int sl0 = (int)atomicAdd(&F.ctl()[CW_CNT + (l * NE + i0) * 64], 1u); const int sl1 = (int)atomicAdd(&F.ctl()[CW_CNT + (l * NE + i1) * 64], 1u);
        F.tok()[i0 * CAP + sl0] = r; F.wl()[i0 * CAP + sl0] = w0; F.tok()[i1 * CAP + sl1] = r; F.wl()[i1 * CAP + sl1] = w1;
        i32x4 rt; rt.x = i0; rt.y = sl0; rt.z = i1; rt.w = sl1; *(i32x4*)(F.route() + 4 * r) = rt;
    }
}
__device__ __forceinline__ float fma_s(float a, float b, float c) { float r; asm("v_fma_f32 %0, %1, %2, %3" : "=v"(r) : "v"(a), "v"(b), "v"(c)); return r; }
__device__ __forceinline__ void p6_rows(CPR p, Frame& F, int l, bool commit = true) {
    LAS float* rwt = (LAS float*)F.lds;
    __syncthreads();
    for (int i = F.tid; i < NE * D; i += NTHR) { const int e = i >> 10, c = i & 1023; rwt[i] = p.router_w[c * NE + e]; }
    __syncthreads();
    for (int pi = F.gw; pi < T / 2; pi += F.ngw) {
        int c0 = 4 * F.lane; asm volatile("" : "+v"(c0));
        const int r0 = 2 * pi, mr = row_mod(r0);
        f32x4 v[2][4]; float ss0 = 0.f, ss1 = 0.f;
#pragma unroll
        for (int j = 0; j < 4; ++j) { v[0][j] = *(const f32x4*)(F.xl() + (size_t)r0 * D + c0 + 256 * j); v[1][j] = *(const f32x4*)(F.xl() + (size_t)(r0 + 1) * D + c0 + 256 * j); }
#pragma unroll
        for (int j = 0; j < 4; ++j) { ss0 += sumsq4(v[0][j]); ss1 += sumsq4(v[1][j]); }
        ss0 = wave_sum(ss0); ss1 = wave_sum(ss1);
        const float rs0 = rsqrtf(ss0 * (1.f / D) + EPS), rs1 = rsqrtf(ss1 * (1.f / D) + EPS);
        const float* g2 = p.norm2_g + l * D + c0; const float* sh = mod_vec(F, l, mr, 3) + c0; const float* sc = mod_vec(F, l, mr, 4) + c0;
#pragma unroll
        for (int j = 0; j < 4; ++j) { const f32x4 g = *(const f32x4*)(g2 + 256 * j), s4 = *(const f32x4*)(sh + 256 * j), q4 = *(const f32x4*)(sc + 256 * j);
            const f32x4 mul = g * (q4 + 1.f);
            v[0][j] = v[0][j] * rs0 * mul + s4; v[1][j] = v[1][j] * rs1 * mul + s4;
            u32x2 o0, o1; o0.x = pk2(v[0][j].x, v[0][j].y); o0.y = pk2(v[0][j].z, v[0][j].w); o1.x = pk2(v[1][j].x, v[1][j].y); o1.y = pk2(v[1][j].z, v[1][j].w);
            *(u32x2*)(F.ha() + (size_t)r0 * D + c0 + 256 * j) = o0; *(u32x2*)(F.ha() + (size_t)(r0 + 1) * D + c0 + 256 * j) = o1; }
        float lg0[16], lg1[16];
#pragma unroll
        for (int e = 0; e < 16; ++e) { lg0[e] = 0.f; lg1[e] = 0.f; }
#pragma unroll
        for (int j = 0; j < 4; ++j) {
#pragma unroll
            for (int e = 0; e < 16; ++e) { const f32x4 w = *(const LAS f32x4*)(rwt + e * D + c0 + 256 * j);
                lg0[e] = fma_s(v[0][j].x, w.x, fma_s(v[0][j].y, w.y, fma_s(v[0][j].z, w.z, fma_s(v[0][j].w, w.w, lg0[e]))));
                lg1[e] = fma_s(v[1][j].x, w.x, fma_s(v[1][j].y, w.y, fma_s(v[1][j].z, w.z, fma_s(v[1][j].w, w.w, lg1[e])))); }
            asm volatile("" ::: "memory");
        }
        route_row(p, F, l, r0, lg0, commit); route_row(p, F, l, r0 + 1, lg1, commit);
    }
    __syncthreads();
}

__device__ __forceinline__ void p6b_sort(Frame& F, int l) {
    const volatile LAS int* tab = (const volatile LAS int*)(F.lds + MOETAB_OFF);
    moe_table(F, l);
    for (int pi = F.gw; pi < T / 2; pi += F.ngw) {
        const int r = 2 * pi;
        const i32x4 rt0 = *(const i32x4*)(F.route() + 4 * r), rt1 = *(const i32x4*)(F.route() + 4 * r + 4);
        const u32x4* src = (const u32x4*)(F.ha() + (size_t)r * D) + F.lane;
        const u32x4 a0 = src[0], b0 = src[64], a1 = src[128], b1 = src[192];
        u32x4* d00 = (u32x4*)(F.hs() + (size_t)(tab[rt0.x] * 256 + rt0.y) * D) + F.lane; u32x4* d01 = (u32x4*)(F.hs() + (size_t)(tab[rt0.z] * 256 + rt0.w) * D) + F.lane;
        u32x4* d10 = (u32x4*)(F.hs() + (size_t)(tab[rt1.x] * 256 + rt1.y) * D) + F.lane; u32x4* d11 = (u32x4*)(F.hs() + (size_t)(tab[rt1.z] * 256 + rt1.w) * D) + F.lane;
        d00[0] = a0; d00[64] = b0; d01[0] = a0; d01[64] = b0; d10[0] = a1; d10[64] = b1; d11[0] = a1; d11[64] = b1;
    }
}

__device__ __forceinline__ void p7_moe1_naive(Frame& F, int l) {
    for (long i = F.gt; i < (long)T * 2 * DE; i += F.ngt) {
        const int a = (int)(i >> 8), f = (int)(i & 255), tokr = a >> 1, wh = a & 1;
        const int e = F.route()[4 * tokr + 2 * wh], sl = F.route()[4 * tokr + 2 * wh + 1];
        const bf16* W = F.w1() + (size_t)(l * NE + e) * 512 * D; const int grow = (f >> 7) * 256 + (f & 127);
        const float g = dot_bf16(F.ha() + (size_t)tokr * D, W + (size_t)grow * D, D), u = dot_bf16(F.ha() + (size_t)tokr * D, W + (size_t)(grow + 128) * D, D);
        F.hid()[(size_t)(ybase_of(F, l, e) + sl) * DE + f] = (bf16)f2bf(F.wl()[e * CAP + sl] * silu_f(g) * u);
    }
}
__device__ __forceinline__ void p8_moe2_naive(Frame& F, int l) {
    for (long i = F.gt; i < (long)T * 2 * D; i += F.ngt) {
        const int a = (int)(i >> 10), n = (int)(i & 1023), tokr = a >> 1, wh = a & 1;
        const int e = F.route()[4 * tokr + 2 * wh], sl = F.route()[4 * tokr + 2 * wh + 1]; const size_t pr = (size_t)(ybase_of(F, l, e) + sl);
        F.y()[pr * D + n] = (bf16)f2bf(dot_bf16(F.hid() + pr * DE, F.w2() + ((size_t)(l * NE + e) * D + n) * DE, DE));
    }
}

__device__ __forceinline__ void p9_final(CPR p, Frame& F) {
    const int l = DEPTH - 1;
    const volatile LAS int* tab = (const volatile LAS int*)(F.lds + MOETAB_OFF);
    moe_table(F, l);
    for (int pi = F.gw; pi < TL / 2; pi += F.ngw) {
        int c0 = 4 * F.lane; asm volatile("" : "+v"(c0));
        const int r0 = 2 * pi;
        const bf16* y0[2]; const bf16* y1[2];
#pragma unroll
        for (int k = 0; k < 2; ++k) { const i32x4 rt = *(const i32x4*)(F.route() + 4 * (r0 + k));
            y0[k] = F.y() + (size_t)(tab[rt.x] * 256 + rt.y) * D + c0; y1[k] = F.y() + (size_t)(tab[rt.z] * 256 + rt.w) * D + c0; }
        f32x4 v[2][4]; u32x2 a[2][4], b[2][4];
#pragma unroll
        for (int k = 0; k < 2; ++k)
#pragma unroll
            for (int j = 0; j < 4; ++j) { v[k][j] = *(const f32x4*)(F.xl() + (size_t)(r0 + k) * D + c0 + 256 * j); a[k][j] = *(const u32x2*)(y0[k] + 256 * j); b[k][j] = *(const u32x2*)(y1[k] + 256 * j); }
        const float* g5 = mod_vec(F, l, row_mod(r0), 5) + c0;
        float ss0 = 0.f, ss1 = 0.f;
#pragma unroll
        for (int j = 0; j < 4; ++j) { const f32x4 g = *(const f32x4*)(g5 + 256 * j); add_y4(v[0][j], g, a[0][j], b[0][j]); add_y4(v[1][j], g, a[1][j], b[1][j]); ss0 += sumsq4(v[0][j]); ss1 += sumsq4(v[1][j]); }
        ss0 = wave_sum(ss0); ss1 = wave_sum(ss1);
        const float rs0 = rsqrtf(ss0 * (1.f / D) + EPS), rs1 = rsqrtf(ss1 * (1.f / D) + EPS);
#pragma unroll
        for (int j = 0; j < 4; ++j) { const f32x4 g = *(const f32x4*)(p.final_g + c0 + 256 * j);
            *(f32x4*)(p.out + (size_t)r0 * D + c0 + 256 * j) = v[0][j] * rs0 * g; *(f32x4*)(p.out + (size_t)(r0 + 1) * D + c0 + 256 * j) = v[1][j] * rs1 * g; }
    }
}

__device__ __forceinline__ void p2_inproj(Frame& F, int l) {
    pg8::StaticOrder S; S.init(T, INP, D, (int)gridDim.x, (int)blockIdx.x);
    pg8::EpiBf16 E{F.pl(), INP};
    pg8::gemm_phase<pg8::EpiBf16, pg8::StaticOrder, true>(F.lds, F.tid, F.ha(), F.win() + (size_t)l * INP * D, D, S, E);
}
__device__ __forceinline__ void p5_outproj(Frame& F, int l, float gsc = 1.f) {
    pg8::StaticOrder S; S.init(T, D, D, (int)gridDim.x, (int)blockIdx.x);
    pg8::EpiResid E{F.xl(), D, F.mod() + (size_t)l * 5 * NMOD * D, gsc};
    pg8::gemm_phase<pg8::EpiResid, pg8::StaticOrder, true>(F.lds, F.tid, F.ml(), F.wout() + (size_t)l * D * D, D, S, E);
}
__device__ __forceinline__ void p7_moe1(Frame& F, int l) {
    moe_table(F, l);
    pg8::MoeOrder<false, 2, D> S{(const volatile LAS int*)(F.lds + MOETAB_OFF), F.tok(), (int)gridDim.x, (int)blockIdx.x, (size_t)512 * D * 2};
    pg8::EpiMoe1 E{F.hid(), F.wl()};
    pg8::gemm_phase<pg8::EpiMoe1, pg8::MoeOrder<false, 2, D>, true>(F.lds, F.tid, F.hs(), F.w1() + (size_t)l * NE * 512 * D, D, S, E);
}
__device__ __forceinline__ void p8_moe2(Frame& F, int l) {
    moe_table(F, l);
    pg8::MoeOrder<false, 4, DE> S{(const volatile LAS int*)(F.lds + MOETAB_OFF), F.tok(), (int)gridDim.x, (int)blockIdx.x, (size_t)D * DE * 2};
    pg8::EpiBf16 E{F.y(), D};
    pg8::gemm_phase<pg8::EpiBf16, pg8::MoeOrder<false, 4, DE>, true>(F.lds, F.tid, F.hid(), F.w2() + (size_t)l * NE * D * DE, DE, S, E);
}

constexpr int PH_FINAL = 1 + 10 * DEPTH, N_PHASES = PH_FINAL + 1;
__global__ void __launch_bounds__(NTHR, 2) fwd(Params p) {
    extern __shared__ __attribute__((aligned(16))) unsigned char lds_raw[];
    Frame F;
    F.lds = (LAS unsigned char*)lds_raw;
    F.tid = threadIdx.x; F.lane = F.tid & 63; F.wave = __builtin_amdgcn_readfirstlane(F.tid >> 6);
    F.gw = blockIdx.x * NWAVES + F.wave; F.ngw = gridDim.x * NWAVES; F.gt = blockIdx.x * NTHR + F.tid; F.ngt = gridDim.x * NTHR;
    const __attribute__((address_space(4))) Params* KP = (const __attribute__((address_space(4))) Params*)__builtin_amdgcn_kernarg_segment_ptr();
    F.ws = KP->ws;
    volatile LAS unsigned* MISC = (volatile LAS unsigned*)(F.lds + MISC_OFF);
    for (int u = F.tid; u < 32; u += NTHR) MISC[u] = 0u;
    if (F.lane == 0) ((volatile LAS int*)(F.lds + WTAB_OFF))[__builtin_amdgcn_s_getreg((5 << 11) | 4) & 63] = F.wave;
    __syncthreads();
#if MK_ONE_LAUNCH
    (void)xcd_barrier_post(F.ctl() + CW_BAR, MISC + 8);
#define GRID_BAR() do { XcdBarrier b_; b_.bar = (unsigned*)(KP->ws + WS_CTL) + CW_BAR; b_.x = xb_xcc_id(); b_.st = (volatile LAS unsigned*)(F.lds + MISC_OFF) + 8; xcd_barrier(b_); } while (0)
#else
#define GRID_BAR() do {} while (0)
#endif
#define lo (KP->ph_lo)
#define hi (KP->ph_hi)
#define PB() do { asm volatile("" : "+s"(KP)); F.ws = KP->ws; int ln_; asm volatile("v_mbcnt_lo_u32_b32 %0, -1, 0\n\tv_mbcnt_hi_u32_b32 %0, -1, %0" : "=v"(ln_)); \
    F.wave = __builtin_amdgcn_readfirstlane(((volatile LAS int*)(F.lds + WTAB_OFF))[__builtin_amdgcn_s_getreg((5 << 11) | 4) & 63]); F.lane = ln_; const int t_ = F.wave * 64 + ln_; F.tid = t_; \
    F.gw = blockIdx.x * NWAVES + F.wave; F.gt = blockIdx.x * NTHR + t_; F.ngw = gridDim.x * NWAVES; F.ngt = gridDim.x * NTHR; } while (0)
#ifndef PH_MASK
#define PH_MASK 0xFFF
#endif
#define INK(k, kind) (((PH_MASK >> (kind)) & 1) && lo <= (k) && (k) < hi)
#define IN(k) (lo <= (k) && (k) < hi)
#define SEAM(k) do { if (IN((k) + 1)) { GRID_BAR(); if (PROBE_REP & 0x10000) { GRID_BAR(); GRID_BAR(); } } } while (0)
#ifndef PROBE_REP
#define PROBE_REP 0
#endif
#define RUNK(kind, body) do { PB(); body; if ((PROBE_REP >> (kind)) & 1) { PB(); body; } } while (0)
    if (INK(0, 9)) { RUNK(9, p0_prologue(*KP, F)); SEAM(0); }
    for (int l = 0; l < DEPTH; ++l) {
        const int pb = 1 + 10 * l;
        if (INK(pb + 0, 0)) { PB(); p1_rows(*KP, F, l); if (PROBE_REP & 1) { GRID_BAR(); PB(); p1_rows(*KP, F, l, 0.f); } SEAM(pb + 0); }
        if (INK(pb + 1, 1)) { RUNK(1, { if (FAST_GEMM & 1) p2_inproj(F, l); else p2_inproj_naive(F, l); }); SEAM(pb + 1); }
        if (INK(pb + 2, 2)) { RUNK(12, { if (FAST_UP) p3_mla_up(F, l); else p3_mla_up_naive(*KP, F, l); }); RUNK(13, { if (FAST_PS & 1) p3_pool_mfma(*KP, F, l); else p3_pool_naive(*KP, F, l); });
                              RUNK(14, { if (FAST_PS & 2) p3_sgu_mfma(*KP, F, l); else p3_sgu1_naive(*KP, F, l); }); RUNK(15, { if (FAST_NA) p3_na_mfma(*KP, F, l); else p3_na_naive(*KP, F, l); });
                              if (!(FAST_PS & 2)) { GRID_BAR(); PB(); p3_sgu2_naive(*KP, F, l); } SEAM(pb + 3); }
        if (INK(pb + 4, 4)) { RUNK(4, { if (FAST_MLA) p4_mla_flash(F); else p4_mla_naive(F); }); SEAM(pb + 4); }
        if (INK(pb + 5, 5)) { PB(); if (FAST_GEMM & 2) p5_outproj(F, l); else p5_outproj_naive(F, l); if (PROBE_REP & 32) { GRID_BAR(); PB(); p5_outproj(F, l, 0.f); } SEAM(pb + 5); }
        if (INK(pb + 6, 6)) { PB(); p6_rows(*KP, F, l); if (PROBE_REP & 64) { PB(); p6_rows(*KP, F, l, false); } SEAM(pb + 6); }
        if (INK(pb + 7, 11)) { RUNK(11, { if (FAST_GEMM & 4) p6b_sort(F, l); }); SEAM(pb + 7); }
        if (INK(pb + 8, 7)) { RUNK(7, { if (FAST_GEMM & 4) p7_moe1(F, l); else p7_moe1_naive(F, l); }); SEAM(pb + 8); }
        if (INK(pb + 9, 8)) { RUNK(8, { if (FAST_GEMM & 8) p8_moe2(F, l); else p8_moe2_naive(F, l); }); SEAM(pb + 9); }
    }
    if (INK(PH_FINAL, 10)) { PB(); p9_final(*KP, F); }
}

extern "C" void kernel_launch(void* const* d_in, const int* in_sizes, int n_in, void* d_out, int out_size, void* d_ws, size_t ws_size, hipStream_t stream) {
    static int grid = 0;
    if (grid == 0) {
        if (n_in != 26 || out_size != TL * D || ws_size < WS_END) { fprintf(stderr, "kernel_launch: unexpected shapes: n_in %d out %d ws %zu (need %zu)\n", n_in, out_size, ws_size, (size_t)WS_END); grid = -1; return; }
        int dev = 0, cus = 0, per_cu = 0;
        if (hipGetDevice(&dev) != hipSuccess || hipDeviceGetAttribute(&cus, hipDeviceAttributeMultiprocessorCount, dev) != hipSuccess) { grid = -1; return; }
        if (hipFuncSetAttribute((const void*)fwd, hipFuncAttributeMaxDynamicSharedMemorySize, LDS_BYTES) != hipSuccess) { fprintf(stderr, "kernel_launch: hipFuncSetAttribute failed\n"); grid = -1; return; }
        if (hipOccupancyMaxActiveBlocksPerMultiprocessor(&per_cu, (const void*)fwd, NTHR, LDS_BYTES) != hipSuccess || per_cu < 1) fprintf(stderr, "kernel_launch: occupancy query says %d\n", per_cu);
        (void)hipGetLastError();
        grid = cus;
    }
    if (grid < 0) return;
    (void)hipMemsetAsync((char*)d_ws + WS_CTL, 0, CTL_ZERO_BYTES, stream);
    Params p{};
    const float** pp = (const float**)&p;
    for (int i = 0; i < 26; ++i) pp[i] = (const float*)d_in[i];
    p.out = (float*)d_out; p.ws = (unsigned char*)d_ws;
#if MK_ONE_LAUNCH
    p.ph_lo = 0; p.ph_hi = N_PHASES;
    hipLaunchKernelGGL(fwd, dim3(grid), dim3(NTHR), LDS_BYTES, stream, p);
#else
    for (int ph = 0; ph < N_PHASES; ++ph) {
        p.ph_lo = ph; p.ph_hi = ph + 1;
        hipLaunchKernelGGL(fwd, dim3(grid), dim3(NTHR), LDS_BYTES, stream, p);
    }
#endif
}
```

```cpp
#include <hip/hip_runtime.h>
#include <cstdio>
#include <cstdint>

#ifndef MK_ONE_LAUNCH
#define MK_ONE_LAUNCH 1
#endif

#ifndef FAST_NA
#define FAST_NA 1
#endif
#ifndef FAST_UP
#define FAST_UP 1
#endif
#ifndef FAST_PS
#define FAST_PS 3
#endif
#ifndef FAST_MLA
#define FAST_MLA 1
#endif
#ifndef FAST_GEMM
#define FAST_GEMM 0xF
#endif

#define GAS __attribute__((address_space(1)))
#define LAS __attribute__((address_space(3)))
typedef unsigned short bf16;
typedef float f32x4 __attribute__((ext_vector_type(4)));
typedef unsigned u32x4 __attribute__((ext_vector_type(4)));
typedef unsigned u32x2 __attribute__((ext_vector_type(2)));
typedef int i32x4 __attribute__((ext_vector_type(4)));
typedef int i32x2 __attribute__((ext_vector_type(2)));
typedef short bf16x8 __attribute__((ext_vector_type(8)));

constexpr int D = 1024, NB = 4, SEQ = 4096, DEPTH = 4, CTX = 256, GW = 64, GH = 64;
constexpr int TL = NB * SEQ, TC = NB * CTX, T = TL + TC;
constexpr int INW = 1952, INP = 2048;
constexpr int OFF_B = 256, OFF_C = 1024, OFF_D = 1536;
constexpr int NE = 16, DE = 256, CAP = T;
constexpr int RPAD = 2 * T + NE * 256;
constexpr int NMOD = 6;
constexpr float EPS = 1e-6f;
constexpr float LOG2E = 1.4426950408889634f;
constexpr float MLA_SCALE = 0.10206207261596575f;
constexpr int NWAVES = 8, NTHR = NWAVES * 64;

constexpr size_t MiB = 1u << 20;
constexpr size_t WS_CTL = 0, CTL_ZERO_BYTES = 1 * MiB;
constexpr size_t WS_MOD = 1 * MiB;
constexpr size_t WS_ROPE = 2 * MiB;
constexpr size_t WS_RWT = 2 * MiB + 768 * 1024;
constexpr size_t WS_ROUTE = 3 * MiB;
constexpr size_t WS_TOK = 4 * MiB;
constexpr size_t WS_WL = 6 * MiB;
constexpr size_t WS_WUQ = 8 * MiB;
constexpr size_t WS_WUKV = 9 * MiB;
constexpr size_t WS_POOLW = 10 * MiB;
constexpr size_t WS_SGUW = 10 * MiB + 512 * 1024;
constexpr size_t WS_WIN = 12 * MiB;
constexpr size_t WS_WOUT = 28 * MiB;
constexpr size_t WS_W1 = 36 * MiB;
constexpr size_t WS_W2 = 100 * MiB;
constexpr size_t WS_XL = 132 * MiB;
constexpr size_t WS_HA = 200 * MiB;
constexpr size_t WS_PL = 234 * MiB;
constexpr size_t WS_Y = 234 * MiB;
constexpr size_t WS_HS = WS_Y;
constexpr size_t WS_QM = 302 * MiB;
constexpr size_t WS_KM = 315 * MiB;
constexpr size_t WS_VM = 328 * MiB;
constexpr size_t WS_ML = 337 * MiB;
constexpr size_t WS_HID = 371 * MiB;
constexpr size_t WS_WOUTF = 390 * MiB;
constexpr size_t WS_END = 398 * MiB;
static_assert(WS_Y + (size_t)RPAD * D * 2 <= WS_KM && WS_HID + (size_t)RPAD * DE * 2 <= WS_END, "ws map");

constexpr int CW_TMO = 0;
constexpr int CW_BAR = 4096;
constexpr int CW_HEAD = 12288;
constexpr int CW_RDY = 131072;
constexpr int CW_HEAD2 = 13312;
constexpr int CW_RDY2 = 32768;
constexpr int CW_CNT = 8192;

constexpr int LDS_BYTES = 147456;
constexpr int MISC_OFF = 131072 + 320;
constexpr int WTAB_OFF = 131072 + 512;
constexpr int DYNQ_OFF = 131072 + 4096;
constexpr int ROWTAB_OFF = 131072 + 2048;
constexpr int MOETAB_OFF = 131072 + 1024;

__device__ __forceinline__ float bf2f(bf16 v) { return __uint_as_float(((unsigned)v) << 16); }
__device__ __forceinline__ unsigned f2bf(float f) { unsigned u = __float_as_uint(f); return (u + 0x7fffu + ((u >> 16) & 1u)) >> 16; }
typedef __bf16 hwbf2 __attribute__((ext_vector_type(2)));
typedef float hwf2 __attribute__((ext_vector_type(2)));
__device__ __forceinline__ unsigned pk2(float lo, float hi) { hwf2 v; v.x = lo; v.y = hi; return __builtin_bit_cast(unsigned, __builtin_convertvector(v, hwbf2)); }
template <int X> __device__ __forceinline__ float lane_xor(float v) {
    static_assert(X >= 1 && X <= 16, "xor 32: xsum32 / xmax32 / other32");
    return __builtin_bit_cast(float, __builtin_amdgcn_ds_swizzle(__builtin_bit_cast(int, v), (X << 10) | 0x1F));
}
__device__ __forceinline__ float xsum32(float v) { const auto rr = __builtin_amdgcn_permlane32_swap(__float_as_uint(v), __float_as_uint(v), false, false); return __uint_as_float(rr[0]) + __uint_as_float(rr[1]); }
__device__ __forceinline__ float xmax32(float v) { const auto rr = __builtin_amdgcn_permlane32_swap(__float_as_uint(v), __float_as_uint(v), false, false); return fmaxf(__uint_as_float(rr[0]), __uint_as_float(rr[1])); }
__device__ __forceinline__ float other32(float v) { const auto rr = __builtin_amdgcn_permlane32_swap(__float_as_uint(v), __float_as_uint(v), false, false);
    const unsigned a = rr[0], b = rr[1]; return __uint_as_float((a ^ b) ^ __float_as_uint(v)); }
__device__ __forceinline__ float wave_sum(float v) { v += lane_xor<1>(v); v += lane_xor<2>(v); v += lane_xor<4>(v); v += lane_xor<8>(v); v += lane_xor<16>(v); return xsum32(v); }
__device__ __forceinline__ float wave_max(float v) { v = fmaxf(v, lane_xor<1>(v)); v = fmaxf(v, lane_xor<2>(v)); v = fmaxf(v, lane_xor<4>(v)); v = fmaxf(v, lane_xor<8>(v)); v = fmaxf(v, lane_xor<16>(v)); return xmax32(v); }
__device__ __forceinline__ float silu_f(float x) { return x / (1.f + __expf(-x)); }
__device__ __forceinline__ float gelu_tanh(float x) { const float u = 1.5957691216057308f * (x + 0.044715f * x * x * x); return x / (1.f + __expf(-u)); }
__device__ __forceinline__ float dot_bf16(const bf16* a, const bf16* b, int K) {
    float s = 0.f;
    for (int k = 0; k < K; k += 8) {
        const u32x4 av = *(const u32x4*)(a + k), bv = *(const u32x4*)(b + k);
#pragma unroll
        for (int j = 0; j < 4; ++j) {
            s += __uint_as_float(av[j] << 16) * __uint_as_float(bv[j] << 16);
            s += __uint_as_float(av[j] & 0xffff0000u) * __uint_as_float(bv[j] & 0xffff0000u);
        }
    }
    return s;
}
#define LDS_WAIT() asm volatile("s_waitcnt lgkmcnt(0)" ::: "memory")

#define XB_TMO      128
#define XB_XCNT(j)  (256  + 64 * (j))
#define XB_XSUB(j)  (1280 + 64 * (j))
#define XB_XGEN(j)  (2304 + 64 * (j))
#define XB_TOP      3328
#define XB_TOPGEN   3392
#define XCD_BAR_WORDS 3456
#define XB_SPIN_CAP (1u << 18)
__device__ __forceinline__ unsigned xb_ld(unsigned* p)              { return __hip_atomic_load(p, __ATOMIC_RELAXED, __HIP_MEMORY_SCOPE_AGENT); }
__device__ __forceinline__ unsigned xb_add(unsigned* p, unsigned v) { return __hip_atomic_fetch_add(p, v, __ATOMIC_RELAXED, __HIP_MEMORY_SCOPE_AGENT); }
__device__ __forceinline__ unsigned xb_xcc_id() { return (unsigned)__builtin_amdgcn_s_getreg((3 << 11) | 20) & 0xFu; }
#define XB_SPIN(cond, bar) do { unsigned _sp = 0; while (cond) { __builtin_amdgcn_s_sleep(1); \
    if ((++_sp & 255u) == 0u) { if (xb_ld(&(bar)[XB_TMO])) break; if (_sp > XB_SPIN_CAP) { atomicAdd(&(bar)[XB_TMO], 1u); break; } } } } while (0)
struct XcdBarrier { unsigned* bar; unsigned x; volatile LAS unsigned* st; };
__device__ __forceinline__ XcdBarrier xcd_barrier_post(unsigned* bar, volatile LAS unsigned* st) {
    XcdBarrier b; b.bar = bar; b.x = xb_xcc_id(); b.st = st;
    if (threadIdx.x == 0) (void)xb_add(&bar[XB_XCNT(b.x)], 1u);
    return b;
}
__device__ __forceinline__ void xcd_barrier_complete(unsigned* bar, unsigned x, unsigned& nloc, unsigned& nx) {
    const unsigned G = gridDim.x * gridDim.y * gridDim.z;
    unsigned sum, cnt, mine, sp = 0u;
    for (;;) {
        sum = 0u; cnt = 0u; mine = 0u;
#pragma unroll
        for (unsigned j = 0; j < 16; ++j) { const unsigned c = xb_ld(&bar[XB_XCNT(j)]); sum += c; cnt += (c > 0u) ? 1u : 0u; mine = (j == x) ? c : mine; }
        if (sum == G) break;
        __builtin_amdgcn_s_sleep(1);
        if ((++sp & 255u) == 0u) { if (xb_ld(&bar[XB_TMO])) break; if (sp > XB_SPIN_CAP) { atomicAdd(&bar[XB_TMO], 1u); break; } }
    }
    nloc = mine > 0u ? mine : 1u; nx = cnt > 0u ? cnt : 1u;
}
__device__ __forceinline__ void xcd_barrier(const XcdBarrier& b) {
    asm volatile("s_waitcnt vmcnt(0)" ::: "memory");
    __syncthreads();
    if (threadIdx.x == 0) {
        unsigned* bar = b.bar;
        __builtin_amdgcn_s_waitcnt(0);
        unsigned nloc = b.st[0], nx = b.st[1];
        if (nloc == 0u) { xcd_barrier_complete(bar, b.x, nloc, nx); b.st[0] = nloc; b.st[1] = nx; }
        const unsigned old = xb_add(&bar[XB_XSUB(b.x)], 1u);
        const unsigned gen = old / nloc;
        if (old + 1u == (gen + 1u) * nloc) {
            __builtin_amdgcn_fence(__ATOMIC_RELEASE, "agent");
            asm volatile("s_waitcnt vmcnt(0)" ::: "memory");
            const unsigned og = xb_add(&bar[XB_TOP], 1u);
            const unsigned tg = og / nx;
            if (og + 1u == (tg + 1u) * nx) xb_add(&bar[XB_TOPGEN], 1u);
            else XB_SPIN(xb_ld(&bar[XB_TOPGEN]) == tg, bar);
            __builtin_amdgcn_fence(__ATOMIC_ACQUIRE, "agent");
            xb_add(&bar[XB_XGEN(b.x)], 1u);
            asm volatile("s_waitcnt vmcnt(0)" ::: "memory");
        } else {
            XB_SPIN(xb_ld(&bar[XB_XGEN(b.x)]) == gen, bar);
            __builtin_amdgcn_fence(__ATOMIC_ACQUIRE, "agent");
            asm volatile("s_waitcnt vmcnt(0)" ::: "memory");
        }
    }
    __syncthreads();
}

struct Params {
    const float *x, *c, *ctx, *c_ctx, *ada_w, *ada_b, *norm1_g, *norm2_g, *w_in, *w_out, *pool_w, *pool_s, *na_rpb,
                *sgu_norm_g, *sgu_w, *sgu_b, *mla_q_norm_g, *mla_w_uq, *mla_kv_norm_g, *mla_w_ukv,
                *router_w, *router_b, *moe_w_gate, *moe_w_up, *moe_w_down, *final_g;
    float* out; unsigned char* ws; int ph_lo, ph_hi;
};
typedef const __attribute__((address_space(4))) Params& CPR;
struct Frame {
    LAS unsigned char* lds; unsigned char* ws;
    int tid, lane, wave, gw, ngw, gt, ngt;
    __device__ __forceinline__ unsigned* ctl() const { return (unsigned*)(ws + WS_CTL); }
    __device__ __forceinline__ float* mod() const { return (float*)(ws + WS_MOD); }
    __device__ __forceinline__ float* ropec() const { return (float*)(ws + WS_ROPE); }
    __device__ __forceinline__ float* ropes() const { return (float*)(ws + WS_ROPE) + SEQ * 16; }
    __device__ __forceinline__ bf16* rwf() const { return (bf16*)(ws + WS_RWT); }
    __device__ __forceinline__ int* route() const { return (int*)(ws + WS_ROUTE); }
    __device__ __forceinline__ int* tok() const { return (int*)(ws + WS_TOK); }
    __device__ __forceinline__ float* wl() const { return (float*)(ws + WS_WL); }
    __device__ __forceinline__ bf16* wuq() const { return (bf16*)(ws + WS_WUQ); }
    __device__ __forceinline__ bf16* wukv() const { return (bf16*)(ws + WS_WUKV); }
    __device__ __forceinline__ bf16* poolw() const { return (bf16*)(ws + WS_POOLW); }
    __device__ __forceinline__ bf16* sguw() const { return (bf16*)(ws + WS_SGUW); }
    __device__ __forceinline__ bf16* win() const { return (bf16*)(ws + WS_WIN); }
    __device__ __forceinline__ bf16* wout() const { return (bf16*)(ws + WS_WOUT); }
    __device__ __forceinline__ bf16* woutf() const { return (bf16*)(ws + WS_WOUTF); }
    __device__ __forceinline__ bf16* w1() const { return (bf16*)(ws + WS_W1); }
    __device__ __forceinline__ bf16* w2() const { return (bf16*)(ws + WS_W2); }
    __device__ __forceinline__ bf16* ha() const { return (bf16*)(ws + WS_HA); }
    __device__ __forceinline__ bf16* pl() const { return (bf16*)(ws + WS_PL); }
    __device__ __forceinline__ bf16* y() const { return (bf16*)(ws + WS_Y); }
    __device__ __forceinline__ bf16* hs() const { return (bf16*)(ws + WS_HS); }
    __device__ __forceinline__ bf16* qm() const { return (bf16*)(ws + WS_QM); }
    __device__ __forceinline__ bf16* km() const { return (bf16*)(ws + WS_KM); }
    __device__ __forceinline__ bf16* vm() const { return (bf16*)(ws + WS_VM); }
    __device__ __forceinline__ bf16* ml() const { return (bf16*)(ws + WS_ML); }
    __device__ __forceinline__ bf16* hid() const { return (bf16*)(ws + WS_HID); }
    __device__ __forceinline__ bf16* xl() const { return (bf16*)(ws + WS_XL); }
};
#ifndef PROBE_T
#define PROBE_T (-1)
#endif
#ifndef PROBE_TMUL
#define PROBE_TMUL 8
#endif
#ifndef PROBE_BLK
#define PROBE_BLK 0
#endif
#define TMARK(kind) do { if (PROBE_T >= 0 && blockIdx.x == PROBE_BLK && threadIdx.x == 0) { volatile LAS unsigned* M_ = (volatile LAS unsigned*)(F.lds + MISC_OFF) + 16; const unsigned now_ = (unsigned)wall_clock64(); \
    if ((kind) == PROBE_T) M_[1] += now_ - M_[0]; M_[0] = now_; } } while (0)
__device__ __forceinline__ int row_batch(int r) { return r < TL ? (r >> 12) : ((r - TL) >> 8); }
__device__ __forceinline__ int row_mod(int r) { return r < TL ? (r >> 12) : 4; }
__device__ __forceinline__ const float* mod_vec(const Frame& F, int l, int mr, int k) { return F.mod() + ((size_t)(l * 5 + mr) * NMOD + k) * D; }

namespace pg8 {
constexpr int BM = 256, BK = 64, HALF = 128, HTB = HALF * BK * 2, NXCD = 8, WGM = 8;
__host__ __device__ __forceinline__ int lds_byte(int r, int c) { const int st = (r >> 4) * 2 + (c >> 5), rr = r & 15, cc = c & 31, ob = rr * 64 + cc * 2; return st * 1024 + (ob ^ (((ob >> 9) & 1) << 5)); }
__host__ __device__ __forceinline__ void stage_rc(int b, int& R, int& C) { const int st = b / 1024, sb = b % 1024, swz = sb ^ (((sb >> 9) & 1) << 5); R = (st >> 1) * 16 + swz / 64; C = (st & 1) * 32 + (swz % 64) / 2; }
__host__ __device__ __forceinline__ int perm32(int rho) { const int n = rho >> 4, i = rho & 15; return 8 * (i >> 2) + 4 * n + (i & 3); }
struct Unit { int pm, pn, ex, slot0, cnt; };
struct StaticOrder {
    static constexpr bool GATHER = false;
    int nM, nN, nwg, G, c, K;
    unsigned* rdy = nullptr; int pub_from = 0;
    int pn_rot = 0;
    __device__ __forceinline__ void init(int M, int N, int K_, int G_, int c_) { nM = M / BM; nN = N / BM; nwg = nM * nN; G = G_; c = c_; K = K_; }
    __device__ __forceinline__ bool next(int i, Unit& u) const {
        const long L = (long)i * G + c; if (L >= nwg) return false;
        int wgid = (int)L; { const int q = nwg / NXCD, r = nwg % NXCD, xcd = wgid % NXCD, off = wgid / NXCD; wgid = (xcd < r ? xcd * (q + 1) : r * (q + 1) + (xcd - r) * q) + off; }
        const int nig = WGM * nN, gid = wgid / nig, fm = gid * WGM, gsz = (nM - fm) < WGM ? (nM - fm) : WGM;
        u.pm = fm + ((wgid % nig) % gsz); u.pn = (wgid % nig) / gsz + pn_rot; if (u.pn >= nN) u.pn -= nN; u.ex = 0; u.slot0 = 0; u.cnt = 256; return true;
    }
    __device__ __forceinline__ size_t a_off(const Unit& u) const { return (size_t)u.pm * 256 * K * 2; }
    __device__ __forceinline__ size_t b_off(const Unit& u) const { return (size_t)u.pn * 256 * K * 2; }
    __device__ __forceinline__ unsigned row_off(const Unit&, int, int) const { return 0u; }
    __device__ __forceinline__ void fill(const Unit&, int, int) const {}
    __device__ __forceinline__ void begin(int) const {}
    __device__ __forceinline__ void a_ready(const Unit&, int) const {}
    __device__ __forceinline__ void done(const Unit& u, int lane) const {
        if (rdy && u.pn >= pub_from) { asm volatile("s_waitcnt vmcnt(0)" ::: "memory"); if (lane == 0) (void)__hip_atomic_fetch_add(rdy + 64 * u.pm, 1u, __ATOMIC_RELAXED, __HIP_MEMORY_SCOPE_AGENT); } }
};
template <bool GATHER_, int NPN, int KK, bool DYN_ = false, bool PUB_ = false>
struct MoeOrder {
    static constexpr bool GATHER = GATHER_;
    const volatile LAS int* tab; const int* tok; int G, c; size_t bstride;
    volatile LAS unsigned* rtab;
    unsigned* head; unsigned* rdy; unsigned* tmo; volatile LAS int* dq;
    __device__ __forceinline__ void begin(int tid) const {
        if constexpr (DYN_) { if (tid == 0) { dq[0] = (int)__hip_atomic_fetch_add(head, 1u, __ATOMIC_RELAXED, __HIP_MEMORY_SCOPE_AGENT); dq[1] = (int)__hip_atomic_fetch_add(head, 1u, __ATOMIC_RELAXED, __HIP_MEMORY_SCOPE_AGENT); }
            __syncthreads(); } }
    __device__ __forceinline__ void a_ready(const Unit& u, int tid) const {
        if constexpr (DYN_) {
            if (tid < 64) { unsigned spins = 0;
                while ((unsigned)__builtin_amdgcn_readfirstlane(__hip_atomic_load(rdy + 64 * u.pm, __ATOMIC_RELAXED, __HIP_MEMORY_SCOPE_AGENT)) < 16u) {
                    __builtin_amdgcn_s_sleep(2);
                    if (++spins > (1u << 20)) { if (tid == 0) __hip_atomic_store(tmo, 1u, __ATOMIC_RELAXED, __HIP_MEMORY_SCOPE_AGENT); break; } }
                __builtin_amdgcn_fence(__ATOMIC_ACQUIRE, "agent");
                asm volatile("s_waitcnt vmcnt(0)" ::: "memory"); }
            asm volatile("" ::: "memory"); __builtin_amdgcn_s_barrier(); asm volatile("" ::: "memory"); } }
    __device__ __forceinline__ void done(const Unit& u, int lane) const {
        if constexpr (PUB_) { asm volatile("s_waitcnt vmcnt(0)" ::: "memory"); if (lane == 0) (void)__hip_atomic_fetch_add(rdy + 64 * u.pm, 1u, __ATOMIC_RELAXED, __HIP_MEMORY_SCOPE_AGENT); } }
    __device__ __forceinline__ bool next(int i, Unit& u) const {
        int L;
        if constexpr (DYN_) { L = dq[i & 1]; if (i >= 1 && threadIdx.x == 0) dq[(i + 1) & 1] = (int)__hip_atomic_fetch_add(head, 1u, __ATOMIC_RELAXED, __HIP_MEMORY_SCOPE_AGENT); }
        else L = i * G + c;
        const int nt = tab[16]; if (L >= nt * NPN) return false;
        const int ti = L / NPN; u.pm = ti; u.pn = L % NPN; const int e = tab[64 + ti];
        u.ex = e; u.slot0 = (ti - tab[e]) * 256; const int rem = tab[32 + e] - u.slot0; u.cnt = rem < 256 ? rem : 256; return true;
    }
    __device__ __forceinline__ size_t a_off(const Unit& u) const { return GATHER_ ? 0 : (size_t)u.pm * 256 * KK * 2; }
    __device__ __forceinline__ size_t b_off(const Unit& u) const { return (size_t)u.ex * bstride + (size_t)u.pn * 256 * KK * 2; }
    __device__ __forceinline__ unsigned row_off(const Unit&, int ui, int R) const { return rtab[(ui & 1) * 256 + R]; }
    __device__ __forceinline__ void fill(const Unit& u, int ui, int tid) const {
        if (GATHER_ && tid < 256) { const int rr = tid < u.cnt ? tid : u.cnt - 1; rtab[(ui & 1) * 256 + tid] = (unsigned)tok[u.ex * CAP + u.slot0 + rr] * (unsigned)(KK * 2); } }
};
__device__ __forceinline__ unsigned cvt_pk_bf16(float lo, float hi) { unsigned r; asm volatile("v_cvt_pk_bf16_f32 %0, %1, %2" : "=v"(r) : "v"(lo), "v"(hi)); return r; }
struct EpiBf16 {
    static constexpr bool PERM = true;
    bf16* O; int ldc; bool wt = false; int nbytes = 0;
    __device__ __forceinline__ void operator()(const f32x4 (&acc)[2][2][4][2], const Unit& u, int wr, int wc, int fr, int fq) const {
        asm volatile("" : "+v"(fr), "+v"(fq));
        const int row0 = u.pm * BM + wr * 64 + fr, col0 = u.pn * BM + wc * 32 + 8 * fq;
        const __amdgpu_buffer_rsrc_t rs = __builtin_amdgcn_make_buffer_rsrc((void*)O, 0, nbytes, 0x00020000);
#pragma unroll
        for (int ai = 0; ai < 2; ++ai)
#pragma unroll
            for (int m = 0; m < 4; ++m) { const size_t eo = (size_t)(row0 + ai * HALF + m * 16) * ldc + col0; bf16* rowp = O + eo;
#pragma unroll
                for (int bj = 0; bj < 2; ++bj) { const f32x4 v0 = acc[ai][bj][m][0], v1 = acc[ai][bj][m][1];
                    u32x4 w; w.x = cvt_pk_bf16(v0[0], v0[1]); w.y = cvt_pk_bf16(v0[2], v0[3]); w.z = cvt_pk_bf16(v1[0], v1[1]); w.w = cvt_pk_bf16(v1[2], v1[3]);
                    if (wt) __builtin_amdgcn_raw_buffer_store_b128(w, rs, (int)((eo + bj * HALF) * 2), 0, 16); else *(u32x4*)(rowp + bj * HALF) = w; } }
    }
};
struct EpiResid {
    static constexpr bool PERM = true;
    bf16* X; int ldc; const float* modl; float gsc;
    __device__ __forceinline__ void operator()(const f32x4 (&acc)[2][2][4][2], const Unit& u, int wr, int wc, int fr, int fq) const {
        asm volatile("" : "+v"(fr), "+v"(fq));
        const int row0 = u.pm * BM + wr * 64 + fr, col0 = u.pn * BM + wc * 32 + 8 * fq;
        const int mr = row_mod(u.pm * BM); const float* gp = modl + (size_t)(mr * NMOD + 2) * D + col0;
        f32x4 gv[2][2];
#pragma unroll
        for (int bj = 0; bj < 2; ++bj)
#pragma unroll
            for (int n = 0; n < 2; ++n) gv[bj][n] = *(const f32x4*)(gp + bj * HALF + n * 4) * gsc;
#pragma unroll
        for (int ai = 0; ai < 2; ++ai)
#pragma unroll
            for (int m = 0; m < 4; ++m) { bf16* rowp = X + (size_t)(row0 + ai * HALF + m * 16) * ldc + col0;
                u32x4 xv[2];
#pragma unroll
                for (int bj = 0; bj < 2; ++bj) xv[bj] = *(const u32x4*)(rowp + bj * HALF);
#pragma unroll
                for (int bj = 0; bj < 2; ++bj) { const f32x4 a0 = acc[ai][bj][m][0], a1 = acc[ai][bj][m][1]; u32x4 w;
                    w.x = cvt_pk_bf16(__uint_as_float(xv[bj].x << 16) + gv[bj][0].x * a0[0], __uint_as_float(xv[bj].x & 0xffff0000u) + gv[bj][0].y * a0[1]);
                    w.y = cvt_pk_bf16(__uint_as_float(xv[bj].y << 16) + gv[bj][0].z * a0[2], __uint_as_float(xv[bj].y & 0xffff0000u) + gv[bj][0].w * a0[3]);
                    w.z = cvt_pk_bf16(__uint_as_float(xv[bj].z << 16) + gv[bj][1].x * a1[0], __uint_as_float(xv[bj].z & 0xffff0000u) + gv[bj][1].y * a1[1]);
                    w.w = cvt_pk_bf16(__uint_as_float(xv[bj].w << 16) + gv[bj][1].z * a1[2], __uint_as_float(xv[bj].w & 0xffff0000u) + gv[bj][1].w * a1[3]);
                    *(u32x4*)(rowp + bj * HALF) = w; } }
    }
};
struct EpiMoe1 {
    static constexpr bool PERM = true;
    bf16* H; const float* wl;
    __device__ __forceinline__ void operator()(const f32x4 (&acc)[2][2][4][2], const Unit& u, int wr, int wc, int fr, int fq) const {
        asm volatile("" : "+v"(fr), "+v"(fq));
        const int lrow0 = wr * 64 + fr, f0 = u.pn * HALF + wc * 32 + 8 * fq;
        const __amdgpu_buffer_rsrc_t rs = __builtin_amdgcn_make_buffer_rsrc((void*)H, 0, RPAD * DE * 2, 0x00020000);
        float wv[2][4];
#pragma unroll
        for (int ai = 0; ai < 2; ++ai)
#pragma unroll
            for (int m = 0; m < 4; ++m) { const int lr = lrow0 + ai * HALF + m * 16; wv[ai][m] = (lr < u.cnt) ? wl[(size_t)u.ex * CAP + u.slot0 + lr] : 0.f; }
        __builtin_amdgcn_sched_barrier(0);
#pragma unroll
        for (int ai = 0; ai < 2; ++ai)
#pragma unroll
            for (int m = 0; m < 4; ++m) { const int lr = lrow0 + ai * HALF + m * 16;
                const float w = wv[ai][m];
                float o[8];
#pragma unroll
                for (int n = 0; n < 2; ++n)
#pragma unroll
                    for (int i = 0; i < 4; ++i) { const float g = acc[ai][0][m][n][i], up = acc[ai][1][m][n][i]; o[4 * n + i] = (lr < u.cnt) ? w * (g / (1.f + __expf(-g))) * up : 0.f; }
                u32x4 pk; pk.x = cvt_pk_bf16(o[0], o[1]); pk.y = cvt_pk_bf16(o[2], o[3]); pk.z = cvt_pk_bf16(o[4], o[5]); pk.w = cvt_pk_bf16(o[6], o[7]);
                __builtin_amdgcn_raw_buffer_store_b128(pk, rs, (int)(((u.pm * BM + lr) * DE + f0) * 2), 0, 16); }
    }
};

template <class Epi, class Sched, bool ALIGN_EPI>
__device__ __forceinline__ void gemm_phase(LAS unsigned char* lds, const int tid, const bf16* Abase, const bf16* Bbase, const int K, const Sched& S, const Epi& E) {
    constexpr bool GA = Sched::GATHER;
    const int wid = __builtin_amdgcn_readfirstlane(tid >> 6), lane = tid & 63, wr = wid >> 2, wc = wid & 3, fr = lane & 15, fq = lane >> 4;
    const int nt = K / BK;
    unsigned voffA[2], voffB[2]; int Rst, Cst;
#pragma unroll
    for (int i = 0; i < 2; ++i) { int R, C; stage_rc(tid * 16 + i * 8192, R, C); const int Rb = Epi::PERM ? ((R & ~31) + perm32(R & 31)) : R;
        voffA[i] = (unsigned)(R * K + C) * 2u; voffB[i] = (unsigned)(Rb * K + C) * 2u; if (i == 0) { Rst = R; Cst = C; } }
    const size_t kstep = (size_t)(BK * 2);
    const size_t hstep = (size_t)HALF * K * 2;
    const size_t hstepA = GA ? 0 : hstep;
    const unsigned ldsw = (unsigned)wid * 1024u;
    const int aoff = lds_byte(wr * 64 + fr, fq * 8), boff = lds_byte(wc * 32 + fr, fq * 8);
#define PG8_SA(b, h) (((b) * 2 + (h)) * HTB)
#define PG8_SB(b, h) ((4 + (b) * 2 + (h)) * HTB)
#define PG8_STAGE(bufoff, gbase, voff) do { _Pragma("unroll") for (int _i = 0; _i < 2; ++_i) \
        __builtin_amdgcn_global_load_lds((const unsigned*)((const char*)(gbase) + (voff)[_i]), (LAS unsigned*)(lds + (bufoff) + ldsw + _i * 8192), 16, 0, 0); } while (0)
#define PG8_LDA(dst, b, h) do { _Pragma("unroll") for (int m = 0; m < 4; ++m) _Pragma("unroll") for (int k = 0; k < 2; ++k) dst[m][k] = *(const LAS bf16x8*)(lds + PG8_SA(b, h) + aoff + m * 2048 + k * 1024); } while (0)
#define PG8_LDB(dst, b, h) do { _Pragma("unroll") for (int n = 0; n < 2; ++n) _Pragma("unroll") for (int k = 0; k < 2; ++k) dst[n][k] = *(const LAS bf16x8*)(lds + PG8_SB(b, h) + boff + n * 2048 + k * 1024); } while (0)
#define PG8_MMA(ai, bj, At, Bt) do { __builtin_amdgcn_s_setprio(1); _Pragma("unroll") for (int m = 0; m < 4; ++m) _Pragma("unroll") for (int n = 0; n < 2; ++n) _Pragma("unroll") for (int k = 0; k < 2; ++k) \
        acc[ai][bj][m][n] = __builtin_amdgcn_mfma_f32_16x16x32_bf16(Bt[n][k], At[m][k], acc[ai][bj][m][n], 0, 0, 0); __builtin_amdgcn_s_setprio(0); } while (0)
#define PG8_WAIT_V(n) asm volatile("s_waitcnt vmcnt(" #n ")" ::: "memory")
#define PG8_WAIT_L(n) asm volatile("s_waitcnt lgkmcnt(" #n ")" ::: "memory")
#define PG8_BAR __builtin_amdgcn_s_barrier()
#define PG8_SCHED __builtin_amdgcn_sched_barrier(0)
    Unit cur, nxt; int ui = 0;
    S.begin(tid);
    if (!S.next(0, cur)) return;
    S.a_ready(cur, tid);
    f32x4 acc[2][2][4][2];
#pragma unroll
    for (int a = 0; a < 2; ++a)
#pragma unroll
        for (int b = 0; b < 2; ++b)
#pragma unroll
            for (int m = 0; m < 4; ++m)
#pragma unroll
                for (int n = 0; n < 2; ++n) acc[a][b][m][n] = (f32x4){0.f, 0.f, 0.f, 0.f};
    bf16x8 At[4][2], B0[2][2], B1[2][2];
    unsigned cv0[2], cv1[2];
    if constexpr (GA) { S.fill(cur, 0, tid); __syncthreads(); }
#pragma unroll
    for (int i = 0; i < 2; ++i) { cv0[i] = GA ? S.row_off(cur, 0, Rst + 64 * i) + (unsigned)Cst * 2u : voffA[i]; cv1[i] = GA ? S.row_off(cur, 0, HALF + Rst + 64 * i) + (unsigned)Cst * 2u : voffA[i]; }
    const char* cA = (const char*)Abase + S.a_off(cur); const char* cB = (const char*)Bbase + S.b_off(cur);
    PG8_STAGE(PG8_SB(0, 0), cB, voffB); PG8_STAGE(PG8_SB(0, 1), cB + hstep, voffB); PG8_STAGE(PG8_SA(0, 0), cA, cv0); PG8_STAGE(PG8_SA(0, 1), cA + hstepA, cv1);
    if (wr == 1) PG8_BAR;
    PG8_WAIT_V(2); PG8_BAR;
    PG8_STAGE(PG8_SB(1, 0), cB + kstep, voffB); PG8_STAGE(PG8_SA(1, 0), cA + kstep, cv0); PG8_STAGE(PG8_SB(1, 1), cB + hstep + kstep, voffB);
    PG8_WAIT_V(6); PG8_BAR;
    for (;;) {
        const bool has_next = S.next(ui + 1, nxt);
        const char* nA = has_next ? (const char*)Abase + S.a_off(nxt) : cA; const char* nB = has_next ? (const char*)Bbase + S.b_off(nxt) : cB;
        if constexpr (GA) { if (has_next) S.fill(nxt, ui + 1, tid); }
#pragma unroll 1
        for (int t = 0; t < nt; t += 2) {
            const bool last = (t == nt - 2);
            if (last && has_next) S.a_ready(nxt, tid);
            const char* a1 = cA + (size_t)(t + 1) * kstep;
            const char* a2 = last ? nA : cA + (size_t)(t + 2) * kstep; const char* b2 = last ? nB : cB + (size_t)(t + 2) * kstep;
            const char* a3 = a2 + kstep; const char* b3 = b2 + kstep;
            if constexpr (GA) { if (last && has_next) {
#pragma unroll
                for (int i = 0; i < 2; ++i) cv0[i] = S.row_off(nxt, ui + 1, Rst + 64 * i) + (unsigned)Cst * 2u; } }
            PG8_LDB(B0, 0, 0); PG8_LDB(B1, 0, 1); PG8_SCHED; PG8_LDA(At, 0, 0); PG8_STAGE(PG8_SA(1, 1), a1 + hstepA, cv1);
            if constexpr (GA) { if (last && has_next) {
#pragma unroll
                for (int i = 0; i < 2; ++i) cv1[i] = S.row_off(nxt, ui + 1, HALF + Rst + 64 * i) + (unsigned)Cst * 2u; } }
            PG8_WAIT_V(8); PG8_WAIT_L(0); PG8_BAR; PG8_MMA(0, 0, At, B0); PG8_MMA(0, 1, At, B1); PG8_BAR; PG8_SCHED;
            PG8_LDA(At, 0, 1); PG8_STAGE(PG8_SB(0, 0), b2, voffB); PG8_STAGE(PG8_SB(0, 1), b2 + hstep, voffB); PG8_STAGE(PG8_SA(0, 0), a2, cv0);
            PG8_WAIT_V(8); PG8_WAIT_L(0); PG8_BAR; PG8_MMA(1, 0, At, B0); PG8_MMA(1, 1, At, B1); PG8_BAR; PG8_SCHED;
            PG8_LDB(B0, 1, 0); PG8_LDB(B1, 1, 1); PG8_SCHED; PG8_LDA(At, 1, 0); PG8_STAGE(PG8_SA(0, 1), a2 + hstepA, cv1);
            PG8_WAIT_V(8); PG8_WAIT_L(0); PG8_BAR; PG8_MMA(0, 0, At, B0); PG8_MMA(0, 1, At, B1); PG8_BAR; PG8_SCHED;
            PG8_LDA(At, 1, 1); PG8_STAGE(PG8_SB(1, 0), b3, voffB); PG8_STAGE(PG8_SB(1, 1), b3 + hstep, voffB); PG8_STAGE(PG8_SA(1, 0), a3, cv0);
            PG8_WAIT_V(8); PG8_WAIT_L(0); PG8_BAR; PG8_MMA(1, 0, At, B0); PG8_MMA(1, 1, At, B1); PG8_BAR; PG8_SCHED;
        }
        if constexpr (ALIGN_EPI) { if (wr == 0) PG8_BAR; }
        E(acc, cur, wr, wc, fr, fq);
        S.done(cur, lane);
        if (!has_next) break;
#pragma unroll
        for (int a = 0; a < 2; ++a)
#pragma unroll
            for (int b = 0; b < 2; ++b)
#pragma unroll
                for (int m = 0; m < 4; ++m)
#pragma unroll
                    for (int n = 0; n < 2; ++n) acc[a][b][m][n] = (f32x4){0.f, 0.f, 0.f, 0.f};
        cur = nxt; cA = nA; cB = nB; ++ui;
        if constexpr (ALIGN_EPI) { if (wr == 1) PG8_BAR; }
    }
    PG8_WAIT_V(0);
    if constexpr (!ALIGN_EPI) { if (wr == 0) PG8_BAR; }
    PG8_BAR;
#undef PG8_SA
#undef PG8_SB
#undef PG8_STAGE
#undef PG8_LDA
#undef PG8_LDB
#undef PG8_MMA
#undef PG8_WAIT_V
#undef PG8_WAIT_L
#undef PG8_BAR
#undef PG8_SCHED
}
}

__device__ __forceinline__ void transpose_item(const float* W, int K, int N, bf16* WT, int kb, int nb, int drow0, LAS float* scr, int lane, const float* kscale = nullptr) {
    const int k0 = 64 * kb, n0 = 32 * nb;
#pragma unroll 8
    for (int i = 0; i < 32; ++i) { const int kk = 2 * i + (lane >> 5); scr[kk * 33 + (lane & 31)] = W[(size_t)(k0 + kk) * N + n0 + (lane & 31)] * (kscale ? kscale[k0 + kk] : 1.f); }
    LDS_WAIT(); asm volatile("" ::: "memory");
    const int c = lane & 7;
#pragma unroll
    for (int j = 0; j < 4; ++j) { const int n = (lane >> 3) + 8 * j; const LAS float* s = scr + (8 * c) * 33 + n;
        u32x4 o; o.x = pk2(s[0 * 33], s[1 * 33]); o.y = pk2(s[2 * 33], s[3 * 33]); o.z = pk2(s[4 * 33], s[5 * 33]); o.w = pk2(s[6 * 33], s[7 * 33]);
        *(u32x4*)(WT + (size_t)(drow0 + n) * K + k0 + 8 * c) = o; }
    LDS_WAIT(); asm volatile("" ::: "memory");
}
__device__ __forceinline__ void transpose_item_fm(const float* W, int K, int N, bf16* FM, int kb, int nb, LAS float* scr, int lane, const float* kscale = nullptr) {
    const int k0 = 64 * kb, n0 = 32 * nb, KS = K / 16;
#pragma unroll 8
    for (int i = 0; i < 32; ++i) { const int kk = 2 * i + (lane >> 5); scr[kk * 33 + (lane & 31)] = W[(size_t)(k0 + kk) * N + n0 + (lane & 31)] * (kscale ? kscale[k0 + kk] : 1.f); }
    LDS_WAIT(); asm volatile("" ::: "memory");
#pragma unroll
    for (int q = 0; q < 4; ++q) { const LAS float* sp = scr + (16 * q + 8 * (lane >> 5)) * 33 + (lane & 31);
        u32x4 o; o.x = pk2(sp[0 * 33], sp[1 * 33]); o.y = pk2(sp[2 * 33], sp[3 * 33]); o.z = pk2(sp[4 * 33], sp[5 * 33]); o.w = pk2(sp[6 * 33], sp[7 * 33]);
        *(u32x4*)(FM + ((size_t)(nb * KS + 4 * kb + q) * 64 + lane) * 8) = o; }
    LDS_WAIT(); asm volatile("" ::: "memory");
}
__device__ __forceinline__ void convert_layer(CPR p, Frame& F, int l, int rank, int nranks) {
    asm volatile("" : "+s"(nranks));
    LAS float* scr = (LAS float*)(F.lds + F.wave * 16384);
    constexpr int I_IN = 16 * 61, I_OUT = 16 * 32, I_G = 128, I_L = I_IN + 2 * I_OUT + 3 * 16 * I_G + 48 + 32 + 8;
    for (int it = rank; it < I_L; it += nranks) {
        int r = it;
        if (r < I_OUT) { transpose_item_fm(p.w_out + (size_t)l * D * D, D, D, F.woutf() + (size_t)l * D * D, r / 32, r % 32, scr, F.lane); continue; } r -= I_OUT;
        if (r < I_IN) { transpose_item(p.w_in + (size_t)l * D * INW, D, INW, F.win() + (size_t)l * INP * D, r / 61, r % 61, 32 * (r % 61), scr, F.lane); continue; } r -= I_IN;
        if (r < I_OUT) { transpose_item(p.w_out + (size_t)l * D * D, D, D, F.wout() + (size_t)l * D * D, r / 32, r % 32, 32 * (r % 32), scr, F.lane); continue; } r -= I_OUT;
        if (r < 16 * I_G) { const int e = r / I_G, q = r % I_G, nb = q % 8, n0 = 32 * nb;
            transpose_item(p.moe_w_gate + (size_t)(l * NE + e) * D * DE, D, DE, F.w1() + (size_t)(l * NE + e) * 512 * D, q / 8, nb, (n0 / 128) * 256 + (n0 % 128), scr, F.lane); continue; } r -= 16 * I_G;
        if (r < 16 * I_G) { const int e = r / I_G, q = r % I_G, nb = q % 8, n0 = 32 * nb;
            transpose_item(p.moe_w_up + (size_t)(l * NE + e) * D * DE, D, DE, F.w1() + (size_t)(l * NE + e) * 512 * D, q / 8, nb, (n0 / 128) * 256 + 128 + (n0 % 128), scr, F.lane); continue; } r -= 16 * I_G;
        if (r < 16 * I_G) { const int e = r / I_G, q = r % I_G;
            transpose_item(p.moe_w_down + (size_t)(l * NE + e) * DE * D, DE, D, F.w2() + (size_t)(l * NE + e) * D * DE, q / 32, q % 32, 32 * (q % 32), scr, F.lane); continue; } r -= 16 * I_G;
        if (r < 48) { transpose_item_fm(p.mla_w_uq + (size_t)l * 256 * 384, 256, 384, F.wuq() + (size_t)l * 384 * 256, r / 12, r % 12, scr, F.lane, p.mla_q_norm_g + l * 256); continue; } r -= 48;
        if (r < 32) { transpose_item_fm(p.mla_w_ukv + (size_t)l * 128 * 512, 128, 512, F.wukv() + (size_t)l * 512 * 128, r / 16, r % 16, scr, F.lane, p.mla_kv_norm_g + l * 128); continue; } r -= 32;
        { const int g = r / 2, nb = r % 2; transpose_item(p.pool_w + (size_t)(l * 4 + g) * 4096, 64, 64, F.poolw() + (size_t)(l * 4 + g) * 4096, 0, nb, 32 * nb, scr, F.lane); }
    }
    for (int i = rank * 64 + F.lane; i < 4 * 128 * 128; i += nranks * 64) F.sguw()[l * 4 * 128 * 128 + i] = (bf16)f2bf(p.sgu_w[l * 4 * 128 * 128 + i]);
    for (int i = rank * 64 + F.lane; i < (INP - INW) * D; i += nranks * 64) F.win()[(size_t)l * INP * D + (size_t)INW * D + i] = 0;
}
__device__ __forceinline__ void p0_prologue(CPR p, Frame& F) {
    convert_layer(p, F, 0, F.gw, F.ngw);
    for (int i = F.gt; i < SEQ * 16; i += F.ngt) {
        const int t = i >> 4, k = i & 15; const float pos = (float)((k < 8) ? (t >> 6) : (t & 63));
        const float inv = __builtin_powf(10000.0f, -(float)(k & 7) / 8.0f);
        const float ang = pos * inv; F.ropec()[i] = cosf(ang); F.ropes()[i] = sinf(ang);
    }
    for (int i = F.gt; i < NE * D; i += F.ngt) { const int sx = i >> 9, ln = (i >> 3) & 63, j = i & 7;
        const float v = p.router_w[(32 * sx + 8 * (ln >> 4) + j) * NE + (ln & 15)]; const unsigned hi = f2bf(v);
        F.rwf()[i] = (bf16)hi; F.rwf()[NE * D + i] = (bf16)f2bf(v - __uint_as_float(hi << 16)); }
    {
        LAS float* sv = (LAS float*)F.lds;
        LAS float* red = sv + 5 * D;
        __syncthreads();
        for (int i = F.tid; i < 5 * D; i += NTHR) { const int r = i >> 10, k = i & 1023; sv[i] = silu_f(r < 4 ? p.c[r * D + k] : p.c_ctx[k]); }
        __syncthreads();
        const int hw = F.tid >> 5, cl = F.tid & 31;
        for (int it = blockIdx.x; it < DEPTH * (NMOD * D / 32); it += gridDim.x) {
            const int l = it / (NMOD * D / 32), n = (it % (NMOD * D / 32)) * 32 + cl;
            const float* w = p.ada_w + (size_t)l * D * NMOD * D + (size_t)(64 * hw) * NMOD * D + n;
            float a0 = 0.f, a1 = 0.f, a2 = 0.f, a3 = 0.f, a4 = 0.f;
#pragma unroll 16
            for (int k = 0; k < 64; ++k) { const float x = w[(size_t)k * NMOD * D]; const int kk = 64 * hw + k;
                a0 += sv[kk] * x; a1 += sv[D + kk] * x; a2 += sv[2 * D + kk] * x; a3 += sv[3 * D + kk] * x; a4 += sv[4 * D + kk] * x; }
            red[(hw * 5 + 0) * 32 + cl] = a0; red[(hw * 5 + 1) * 32 + cl] = a1; red[(hw * 5 + 2) * 32 + cl] = a2; red[(hw * 5 + 3) * 32 + cl] = a3; red[(hw * 5 + 4) * 32 + cl] = a4;
            __syncthreads();
            if (F.tid < 160) { const int r = F.tid >> 5; float acc = p.ada_b[l * NMOD * D + (it % (NMOD * D / 32)) * 32 + cl];
#pragma unroll
                for (int h2 = 0; h2 < 16; ++h2) acc += red[(h2 * 5 + r) * 32 + cl];
                F.mod()[((size_t)(l * 5 + r) * NMOD * D) + (it % (NMOD * D / 32)) * 32 + cl] = acc; }
            __syncthreads();
        }
    }
}

__device__ __forceinline__ int ybase_of(const Frame& F, int l, int e) {
    int b = 0;
    for (int j = 0; j < e; ++j) b += ((int)F.ctl()[CW_CNT + (l * NE + j) * 64] + 255) & ~255;
    return b;
}
__device__ __forceinline__ void moe_table(Frame& F, int l) {
    volatile LAS int* tab = (volatile LAS int*)(F.lds + MOETAB_OFF);
    __syncthreads();
    if (F.tid < NE) tab[32 + F.tid] = (int)F.ctl()[CW_CNT + (l * NE + F.tid) * 64];
    __syncthreads();
    if (F.tid == 0) { int acc = 0;
        for (int e = 0; e < NE; ++e) { tab[e] = acc; acc += (tab[32 + e] + 255) >> 8; }
        tab[16] = acc; }
    __syncthreads();
    if (F.tid < 192) { int e = 0;
        for (int j = 1; j < 16; ++j) e += (tab[j] <= F.tid) ? 1 : 0;
        tab[64 + F.tid] = e; }
    __syncthreads();
}
__device__ __forceinline__ void add_y4(f32x4& v, const f32x4& g, const u32x2& a, const u32x2& b) {
    v.x += g.x * (__uint_as_float(a.x << 16) + __uint_as_float(b.x << 16)); v.y += g.y * (__uint_as_float(a.x & 0xffff0000u) + __uint_as_float(b.x & 0xffff0000u));
    v.z += g.z * (__uint_as_float(a.y << 16) + __uint_as_float(b.y << 16)); v.w += g.w * (__uint_as_float(a.y & 0xffff0000u) + __uint_as_float(b.y & 0xffff0000u));
}
__device__ __forceinline__ f32x4 ld_bf4(const bf16* p) { const u32x2 u = *(const u32x2*)p; f32x4 v; v.x = __uint_as_float(u.x << 16); v.y = __uint_as_float(u.x & 0xffff0000u); v.z = __uint_as_float(u.y << 16); v.w = __uint_as_float(u.y & 0xffff0000u); return v; }
__device__ __forceinline__ void st_bf4(bf16* p, const f32x4& v) { u32x2 u; u.x = pk2(v.x, v.y); u.y = pk2(v.z, v.w); *(u32x2*)p = u; }
__device__ __forceinline__ float sumsq4(const f32x4& v) { return v.x * v.x + v.y * v.y + v.z * v.z + v.w * v.w; }

__device__ __forceinline__ void p1_rows(CPR p, Frame& F, int l, float ysc = 1.f) {
    const volatile LAS int* tab = (const volatile LAS int*)(F.lds + MOETAB_OFF);
    if (l > 0) moe_table(F, l - 1);
    for (int pi = F.gw; pi < T / 2; pi += F.ngw) {
        int c0 = 4 * F.lane; asm volatile("" : "+v"(c0));
        const int r0 = 2 * pi, mr = row_mod(r0);
        f32x4 v[2][4];
        if (l == 0) {
#pragma unroll
            for (int k = 0; k < 2; ++k) { const int r = r0 + k; const float* src = (r < TL) ? p.x + (size_t)r * D : p.ctx + (size_t)(r - TL) * D;
#pragma unroll
                for (int j = 0; j < 4; ++j) v[k][j] = *(const f32x4*)(src + c0 + 256 * j); }
        } else {
            const bf16* y0[2]; const bf16* y1[2];
#pragma unroll
            for (int k = 0; k < 2; ++k) { const i32x4 rt = *(const i32x4*)(F.route() + 4 * (r0 + k));
                y0[k] = F.y() + (size_t)(tab[rt.x] * 256 + rt.y) * D + c0; y1[k] = F.y() + (size_t)(tab[rt.z] * 256 + rt.w) * D + c0; }
            u32x2 a[2][4], b[2][4];
#pragma unroll
            for (int k = 0; k < 2; ++k)
#pragma unroll
                for (int j = 0; j < 4; ++j) { v[k][j] = ld_bf4(F.xl() + (size_t)(r0 + k) * D + c0 + 256 * j); a[k][j] = *(const u32x2*)(y0[k] + 256 * j); b[k][j] = *(const u32x2*)(y1[k] + 256 * j); }
            const float* g5 = mod_vec(F, l - 1, mr, 5) + c0;
#pragma unroll
            for (int j = 0; j < 4; ++j) { const f32x4 g = *(const f32x4*)(g5 + 256 * j) * ysc; add_y4(v[0][j], g, a[0][j], b[0][j]); add_y4(v[1][j], g, a[1][j], b[1][j]); }
        }
        const float* g1 = p.norm1_g + l * D + c0; const float* sh = mod_vec(F, l, mr, 0) + c0; const float* sc = mod_vec(F, l, mr, 1) + c0;
        f32x4 gq[4], sq4[4], qq[4];
#pragma unroll
        for (int j = 0; j < 4; ++j) { gq[j] = *(const f32x4*)(g1 + 256 * j); sq4[j] = *(const f32x4*)(sh + 256 * j); qq[j] = *(const f32x4*)(sc + 256 * j); }
        __builtin_amdgcn_sched_barrier(0);
        float ss0 = 0.f, ss1 = 0.f;
#pragma unroll
        for (int j = 0; j < 4; ++j) { st_bf4(F.xl() + (size_t)r0 * D + c0 + 256 * j, v[0][j]); st_bf4(F.xl() + (size_t)(r0 + 1) * D + c0 + 256 * j, v[1][j]); ss0 += sumsq4(v[0][j]); ss1 += sumsq4(v[1][j]); }
        ss0 = wave_sum(ss0); ss1 = wave_sum(ss1);
        const float rs0 = rsqrtf(ss0 * (1.f / D) + EPS), rs1 = rsqrtf(ss1 * (1.f / D) + EPS);
#pragma unroll
        for (int j = 0; j < 4; ++j) { const f32x4 g = gq[j], s4 = sq4[j], q4 = qq[j];
            const f32x4 mul = g * (q4 + 1.f);
            const f32x4 h0 = v[0][j] * rs0 * mul + s4, h1 = v[1][j] * rs1 * mul + s4;
            u32x2 o0, o1; o0.x = pk2(h0.x, h0.y); o0.y = pk2(h0.z, h0.w); o1.x = pk2(h1.x, h1.y); o1.y = pk2(h1.z, h1.w);
            *(u32x2*)(F.ha() + (size_t)r0 * D + c0 + 256 * j) = o0; *(u32x2*)(F.ha() + (size_t)(r0 + 1) * D + c0 + 256 * j) = o1; }
    }
}

__device__ __forceinline__ void p2_inproj_naive(Frame& F, int l) {
    const bf16* W = F.win() + (size_t)l * INP * D;
    for (long i = F.gt; i < (long)T * INW; i += F.ngt) { const int r = (int)(i / INW), c = (int)(i % INW);
        F.pl()[(size_t)r * INP + c] = (bf16)f2bf(dot_bf16(F.ha() + (size_t)r * D, W + (size_t)c * D, D)); }
}

__device__ __forceinline__ void p3_mla_up_naive(CPR p, Frame& F, int l) {
    for (int r = F.gw; r < T; r += F.ngw) {
        const bf16* pr = F.pl() + (size_t)r * INP + OFF_D;
        float a[4]; { const u32x2 t = *(const u32x2*)(pr + 4 * F.lane); a[0] = __uint_as_float(t.x << 16); a[1] = __uint_as_float(t.x & 0xffff0000u); a[2] = __uint_as_float(t.y << 16); a[3] = __uint_as_float(t.y & 0xffff0000u); }
        const float rq = rsqrtf(wave_sum(a[0] * a[0] + a[1] * a[1] + a[2] * a[2] + a[3] * a[3]) * (1.f / 256.f) + EPS);
        float b2[2]; { const unsigned t = *(const unsigned*)(pr + 256 + 2 * F.lane); b2[0] = __uint_as_float(t << 16); b2[1] = __uint_as_float(t & 0xffff0000u); }
        const float rkv = rsqrtf(wave_sum(b2[0] * b2[0] + b2[1] * b2[1]) * (1.f / 128.f) + EPS);
        LAS float* sq = (LAS float*)(F.lds + F.wave * 4096);
#pragma unroll
        for (int j = 0; j < 4; ++j) sq[4 * F.lane + j] = a[j] * rq;
        sq[256 + 2 * F.lane] = b2[0] * rkv; sq[256 + 2 * F.lane + 1] = b2[1] * rkv;
        LDS_WAIT(); asm volatile("" ::: "memory");
        const bool lat = r < TL; const int t = r & (SEQ - 1);
        for (int f = F.lane; f < 384; f += 64) {
            const int h = f / 96, j = f % 96;
            float val;
            const bf16* wrow = F.wuq() + (size_t)l * 384 * 256;
            auto qdot = [&](int ff) { float s = 0.f; const bf16* w = wrow + (size_t)ff * 256; for (int k = 0; k < 256; ++k) s += sq[k] * bf2f(w[k]); return s; };
            if (j < 64 || !lat) val = qdot(f);
            else { const int i = j - 64; const int base = h * 96 + 64;
                const int q8 = i & 7, half = (i >> 3) & 1, axis = i >> 4;
                const float cs = F.ropec()[t * 16 + axis * 8 + q8], sn = F.ropes()[t * 16 + axis * 8 + q8];
                const float x1 = qdot(base + axis * 16 + q8), x2 = qdot(base + axis * 16 + 8 + q8);
                val = half ? (x1 * sn + x2 * cs) : (x1 * cs - x2 * sn); }
            F.qm()[(size_t)r * 384 + f] = (bf16)f2bf(val * (MLA_SCALE * LOG2E));
        }
        for (int f = F.lane; f < 512; f += 64) {
            const int h = f / 128, j = f % 128; float s = 0.f; const bf16* w = F.wukv() + (size_t)l * 512 * 128 + (size_t)f * 128;
            for (int k = 0; k < 128; ++k) s += sq[256 + k] * bf2f(w[k]);
            if (j < 64) F.km()[(size_t)r * 384 + h * 96 + j] = (bf16)f2bf(s); else F.vm()[(size_t)r * 256 + h * 64 + (j - 64)] = (bf16)f2bf(s);
        }
        if (F.lane < 32) { const int i = F.lane, q8 = i & 7, half = (i >> 3) & 1, axis = i >> 4;
            const float x1 = bf2f(pr[384 + axis * 16 + q8]), x2 = bf2f(pr[384 + axis * 16 + 8 + q8]);
            float val;
            if (lat) { const float cs = F.ropec()[t * 16 + axis * 8 + q8], sn = F.ropes()[t * 16 + axis * 8 + q8]; val = half ? (x1 * sn + x2 * cs) : (x1 * cs - x2 * sn); }
            else val = bf2f(pr[384 + i]);
#pragma unroll
            for (int h = 0; h < 4; ++h) F.km()[(size_t)r * 384 + h * 96 + 64 + i] = (bf16)f2bf(val); }
        LDS_WAIT(); asm volatile("" ::: "memory");
    }
}
__device__ __forceinline__ void p3_pool_naive(CPR p, Frame& F, int l) {
    for (int i = F.gt; i < T * 256; i += F.ngt) {
        const int r = i >> 8, col = i & 255, g = col >> 6, d = col & 63;
        const int L = r < TL ? SEQ : CTX, t = r < TL ? (r & (SEQ - 1)) : ((r - TL) & (CTX - 1)), seg0 = r - t;
        const int win = 2 << g; int lo = t - win / 2, hi = t - win / 2 + win; lo = lo < 0 ? 0 : lo; hi = hi > L ? L : hi;
        const float inv = 1.f / (float)(hi - lo);
        const bf16* wt = F.poolw() + (size_t)(l * 4 + g) * 4096 + d * 64;
        float acc = 0.f;
        for (int c = 0; c < 64; ++c) { float m = 0.f; for (int s = lo; s < hi; ++s) m += bf2f(F.pl()[(size_t)(seg0 + s) * INP + g * 64 + c]);
            const float df = m * inv - bf2f(F.pl()[(size_t)r * INP + g * 64 + c]); acc += df * bf2f(wt[c]); }
        F.ml()[(size_t)r * D + col] = (bf16)f2bf(acc * p.pool_s[l * 256 + col]);
    }
}
__device__ __forceinline__ void p3_sgu1_naive(CPR p, Frame& F, int l) {
    bf16* vg = F.hid();
    for (int r = F.gw; r < T; r += F.ngw) {
        const bf16* pv = F.pl() + (size_t)r * INP + OFF_C + 256;
        float a[4]; { const u32x2 t = *(const u32x2*)(pv + 4 * F.lane); a[0] = gelu_tanh(__uint_as_float(t.x << 16)); a[1] = gelu_tanh(__uint_as_float(t.x & 0xffff0000u)); a[2] = gelu_tanh(__uint_as_float(t.y << 16)); a[3] = gelu_tanh(__uint_as_float(t.y & 0xffff0000u)); }
        float ss = a[0] * a[0] + a[1] * a[1] + a[2] * a[2] + a[3] * a[3];
        ss += lane_xor<1>(ss); ss += lane_xor<2>(ss); ss += lane_xor<4>(ss); ss += lane_xor<8>(ss);
        const float rs = rsqrtf(ss * (1.f / 64.f) + EPS); const float* gn = p.sgu_norm_g + l * 256 + 4 * F.lane;
        u32x2 o; o.x = pk2(a[0] * rs * gn[0], a[1] * rs * gn[1]); o.y = pk2(a[2] * rs * gn[2], a[3] * rs * gn[3]);
        *(u32x2*)(vg + (size_t)r * 256 + 4 * F.lane) = o;
    }
}
__device__ __forceinline__ void p3_sgu2_naive(CPR p, Frame& F, int l) {
    const bf16* vg = F.hid();
    for (int i = F.gt; i < T * 256; i += F.ngt) {
        const int r = i >> 8, col = i & 255, g = col >> 6, pp = r & 127, r0 = r - pp;
        const bf16* w = F.sguw() + ((size_t)(l * 4 + g) * 128 + pp) * 128;
        float acc = p.sgu_b[(l * 4 + g) * 128 + pp];
        for (int q = 0; q < 128; ++q) acc += bf2f(w[q]) * bf2f(vg[(size_t)(r0 + q) * 256 + col]);
        const float u = gelu_tanh(bf2f(F.pl()[(size_t)r * INP + OFF_C + col]));
        F.ml()[(size_t)r * D + 512 + col] = (bf16)f2bf(u * acc);
    }
}
__device__ __forceinline__ void p3_na_naive(CPR p, Frame& F, int l) {
    LAS float* pw = (LAS float*)(F.lds + 65536 + F.wave * 2048);
    for (int it = F.gw; it < T * 4; it += F.ngw) {
        const int r = it >> 2, h = it & 3; const bool lat = r < TL; const int b = row_batch(r);
        float q[64];
        { const bf16* qp = F.pl() + (size_t)r * INP + OFF_B + h * 64;
#pragma unroll
          for (int j = 0; j < 8; ++j) { const u32x4 t = *(const u32x4*)(qp + 8 * j);
#pragma unroll
              for (int k = 0; k < 4; ++k) { q[8 * j + 2 * k] = __uint_as_float(t[k] << 16); q[8 * j + 2 * k + 1] = __uint_as_float(t[k] & 0xffff0000u); } } }
        const int t = r & (SEQ - 1), gr = t >> 6, gc = t & 63, jb = gc >> 4;
        int rs = gr - 4; rs = rs < 0 ? 0 : (rs > GH - 8 ? GH - 8 : rs);
        int wsq = gc - 8; wsq = wsq < 0 ? 0 : (wsq > GW - 16 ? GW - 16 : wsq);
        int cs = 16 * jb - 8; cs = cs < 0 ? 0 : (cs > GW - 16 ? GW - 16 : cs); cs = cs > GW - 32 ? GW - 32 : cs;
        const float* rpb = p.na_rpb + (size_t)(l * 4 + h) * 15 * 31;
        float s[8];
#pragma unroll
        for (int i = 0; i < 8; ++i) {
            const int k = F.lane + 64 * (i & 3); const bool win = i < 4;
            int keyrow; float bias = 0.f; bool valid = true;
            if (win) { const int rr = k >> 5, cc = k & 31, kcol = cs + cc; keyrow = b * SEQ + (rs + rr) * 64 + kcol;
                valid = lat && (kcol >= wsq) && (kcol < wsq + 16);
                int dc = kcol - gc + 15; dc = dc < 0 ? 0 : (dc > 30 ? 30 : dc);
                bias = rpb[(rs + rr - gr + 7) * 31 + dc];
                if (!lat) keyrow = r; }
            else keyrow = TL + b * CTX + k;
            const bf16* kp = F.pl() + (size_t)keyrow * INP + OFF_B + 256 + h * 64;
            float d = 0.f;
#pragma unroll
            for (int j = 0; j < 8; ++j) { const u32x4 tt = *(const u32x4*)(kp + 8 * j);
#pragma unroll
                for (int kk = 0; kk < 4; ++kk) d += q[8 * j + 2 * kk] * __uint_as_float(tt[kk] << 16) + q[8 * j + 2 * kk + 1] * __uint_as_float(tt[kk] & 0xffff0000u); }
            s[i] = valid ? (d * 0.125f + bias) : -1e30f;
        }
        float m = s[0];
#pragma unroll
        for (int i = 1; i < 8; ++i) m = fmaxf(m, s[i]);
        m = wave_max(m);
        float sum = 0.f;
#pragma unroll
        for (int i = 0; i < 8; ++i) { s[i] = __expf(s[i] - m); sum += s[i]; }
        sum = wave_sum(sum); const float inv = 1.f / sum;
#pragma unroll
        for (int i = 0; i < 8; ++i) pw[(i >> 2) * 256 + F.lane + 64 * (i & 3)] = s[i] * inv;
        LDS_WAIT(); asm volatile("" ::: "memory");
        float acc = 0.f;
        if (lat) for (int k = 0; k < 256; ++k) { const int rr = k >> 5, cc = k & 31; const int keyrow = b * SEQ + (rs + rr) * 64 + cs + cc;
            acc += pw[k] * bf2f(F.pl()[(size_t)keyrow * INP + OFF_B + 512 + h * 64 + F.lane]); }
        for (int k = 0; k < 256; ++k) acc += pw[256 + k] * bf2f(F.pl()[(size_t)(TL + b * CTX + k) * INP + OFF_B + 512 + h * 64 + F.lane]);
        F.ml()[(size_t)r * D + 256 + h * 64 + F.lane] = (bf16)f2bf(acc);
        LDS_WAIT(); asm volatile("" ::: "memory");
    }
}
__device__ __forceinline__ void p4_mla_naive(Frame& F) {
    LAS float* pw = (LAS float*)(F.lds + 65536 + F.wave * 2048);
    for (int it = F.gw; it < T * 4; it += F.ngw) {
        const int r = it >> 2, h = it & 3; const bool lat = r < TL; const int b = row_batch(r);
        float q[96];
        { const bf16* qp = F.qm() + (size_t)r * 384 + h * 96;
#pragma unroll
          for (int j = 0; j < 12; ++j) { const u32x4 t = *(const u32x4*)(qp + 8 * j);
#pragma unroll
              for (int k = 0; k < 4; ++k) { q[8 * j + 2 * k] = __uint_as_float(t[k] << 16); q[8 * j + 2 * k + 1] = __uint_as_float(t[k] & 0xffff0000u); } } }
        const int nk = lat ? (CTX + SEQ) : CTX;
        float m = -3.0e38f, lsum = 0.f, acc = 0.f;
        for (int k0 = 0; k0 < nk; k0 += 64) {
            const int k = k0 + F.lane; const int keyrow = (k < CTX) ? (TL + b * CTX + k) : (b * SEQ + k - CTX);
            const bf16* kp = F.km() + (size_t)keyrow * 384 + h * 96;
            float d = 0.f;
#pragma unroll
            for (int j = 0; j < 12; ++j) { const u32x4 tt = *(const u32x4*)(kp + 8 * j);
#pragma unroll
                for (int kk = 0; kk < 4; ++kk) d += q[8 * j + 2 * kk] * __uint_as_float(tt[kk] << 16) + q[8 * j + 2 * kk + 1] * __uint_as_float(tt[kk] & 0xffff0000u); }
            const float mn = fmaxf(m, wave_max(d)); const float alpha = exp2f(m - mn); const float pe = exp2f(d - mn);
            lsum = lsum * alpha + wave_sum(pe); acc *= alpha; m = mn;
            pw[F.lane] = pe; LDS_WAIT(); asm volatile("" ::: "memory");
            for (int kk = 0; kk < 64; ++kk) { const int k2 = k0 + kk; const int kr2 = (k2 < CTX) ? (TL + b * CTX + k2) : (b * SEQ + k2 - CTX);
                acc += pw[kk] * bf2f(F.vm()[(size_t)kr2 * 256 + h * 64 + F.lane]); }
            LDS_WAIT(); asm volatile("" ::: "memory");
        }
        F.ml()[(size_t)r * D + 768 + h * 64 + F.lane] = (bf16)f2bf(acc / lsum);
    }
}

typedef float f32x16 __attribute__((ext_vector_type(16)));
typedef short s16x4 __attribute__((ext_vector_type(4)));
__device__ __forceinline__ s16x4 lds_tr16(const LAS unsigned char* p) { return __builtin_bit_cast(s16x4, __builtin_amdgcn_ds_read_tr16_b64_v4i16((LAS s16x4*)p)); }
__device__ __forceinline__ bf16x8 pack8(const f32x16& v, int o) {
    u32x4 w; w.x = pg8::cvt_pk_bf16(v[o + 0], v[o + 1]); w.y = pg8::cvt_pk_bf16(v[o + 2], v[o + 3]); w.z = pg8::cvt_pk_bf16(v[o + 4], v[o + 5]); w.w = pg8::cvt_pk_bf16(v[o + 6], v[o + 7]);
    return __builtin_bit_cast(bf16x8, w);
}
template <int MODE> __device__ __forceinline__ void p4_mla_flash(Frame& F) {
    constexpr int KP = 208, VP = 144, KB = 64 * KP, VB = 64 * VP, BUF = KB + VB;
    const int tid = F.tid, lane = F.lane, w = F.wave, q = lane & 31, hh = lane >> 5;
    const bf16* qm = F.qm(); const bf16* km = F.km(); const bf16* vm = F.vm(); bf16* ml = (MODE == 0) ? F.ml() : F.hid() - 768;
    const int kc0 = tid, kc1 = 512 + (tid & 255);
    const int k0key = kc0 / 12, k0part = kc0 % 12, k1key = kc1 / 12, k1part = kc1 % 12, vkey = tid >> 3, vpart = tid & 7;
    const int trow = 4 * hh + ((lane & 15) >> 2), tcol = 16 * ((lane >> 4) & 1) + 4 * (lane & 3);
    for (int ui = blockIdx.x; ui < 272; ui += gridDim.x) {
        const int qt = ui < 256 ? (ui >> 2) : 64 + ((ui - 256) >> 2), h = ui & 3;
        const bool lat = qt < 64; const int b = lat ? (qt >> 4) : (qt - 64), ntile = lat ? 68 : 4;
        const int qrow = qt * 256 + w * 32 + q;
        bf16x8 qf[6];
#pragma unroll
        for (int ks = 0; ks < 6; ++ks) qf[ks] = *(const bf16x8*)(qm + (size_t)qrow * 384 + h * 96 + 16 * ks + 8 * hh);
        f32x16 ot0, ot1;
#pragma unroll
        for (int r = 0; r < 16; ++r) { ot0[r] = 0.f; ot1[r] = 0.f; }
        constexpr float THR = 8.f;
        float mref = 0.f, l = 0.f; f32x16 negm;
#pragma unroll
        for (int r = 0; r < 16; ++r) negm[r] = 0.f;
        u32x4 ka0, ka1, va, kb0, kb1, vbr;
#define MLA_LOAD(t, K0, K1, V) do { const int t_ = (t); const int kr_ = (lat && t_ >= 4) ? b * SEQ + 64 * (t_ - 4) : TL + b * CTX + 64 * t_; \
            K0 = *(const u32x4*)(km + (size_t)(kr_ + k0key) * 384 + h * 96 + 8 * k0part); \
            K1 = *(const u32x4*)(km + (size_t)(kr_ + k1key) * 384 + h * 96 + 8 * k1part);     \
            V = *(const u32x4*)(vm + (size_t)(kr_ + vkey) * 256 + h * 64 + 8 * vpart); } while (0)
#define MLA_STORE(bufi, K0, K1, V) do { LAS unsigned char* kb_ = F.lds + (bufi) * BUF; \
            *(LAS u32x4*)(kb_ + k0key * KP + k0part * 16) = K0; *(LAS u32x4*)(kb_ + k1key * KP + k1part * 16) = K1; \
            *(LAS u32x4*)(kb_ + KB + vkey * VP + vpart * 16) = V; } while (0)
#define MLA_TILE(t, bufi) do { \
            const LAS unsigned char* kb = F.lds + (bufi) * BUF; const LAS unsigned char* vb = kb + KB; \
            bf16x8 kf[12]; \
            if (MODE != 4) { _Pragma("unroll") for (int ks = 0; ks < 6; ++ks) { kf[2 * ks] = *(const LAS bf16x8*)(kb + q * KP + (16 * ks + 8 * hh) * 2); kf[2 * ks + 1] = *(const LAS bf16x8*)(kb + (32 + q) * KP + (16 * ks + 8 * hh) * 2); } } \
            __builtin_amdgcn_sched_barrier(0);                            \
            f32x16 s0 = negm, s1 = negm; \
            __builtin_amdgcn_s_setprio(1); \
            if (MODE != 4) { _Pragma("unroll") for (int ks = 0; ks < 6; ++ks) { \
                s0 = __builtin_amdgcn_mfma_f32_32x32x16_bf16(kf[2 * ks], qf[ks], s0, 0, 0, 0); \
                s1 = __builtin_amdgcn_mfma_f32_32x32x16_bf16(kf[2 * ks + 1], qf[ks], s1, 0, 0, 0); } } \
            __builtin_amdgcn_s_setprio(0); \
            __builtin_amdgcn_sched_barrier(0); \
            s16x4 vl[8], vh[8];                                            \
            if (MODE != 5) { _Pragma("unroll") for (int kk = 0; kk < 4; ++kk) { const LAS unsigned char* a0 = vb + (16 * kk + trow) * VP + tcol * 2; \
                vl[2 * kk] = lds_tr16(a0); vh[2 * kk] = lds_tr16(a0 + 8 * VP); vl[2 * kk + 1] = lds_tr16(a0 + 64); vh[2 * kk + 1] = lds_tr16(a0 + 8 * VP + 64); } } \
            __builtin_amdgcn_sched_barrier(0); \
            float mx = __builtin_fmaxf(s0[0], s1[0]); \
            if (MODE != 2) { _Pragma("unroll") for (int r = 1; r < 16; ++r) mx = __builtin_fmaxf(__builtin_fmaxf(mx, s0[r]), s1[r]); \
            mx = xmax32(mx); } \
            if (MODE != 2 && ((t) == 0 || __any(mx > THR))) { \
                const float dl = ((t) == 0) ? mx : __builtin_fmaxf(mx, 0.f), alpha = __builtin_amdgcn_exp2f(-dl); \
                mref += dl; l *= alpha; \
                _Pragma("unroll") for (int r = 0; r < 16; ++r) { ot0[r] *= alpha; ot1[r] *= alpha; s0[r] -= dl; s1[r] -= dl; negm[r] = -mref; } } \
            float rs = 0.f; \
            if (MODE != 2) { _Pragma("unroll") for (int r = 0; r < 16; ++r) { s0[r] = __builtin_amdgcn_exp2f(s0[r]); s1[r] = __builtin_amdgcn_exp2f(s1[r]); rs += s0[r] + s1[r]; } } \
            l += rs + ((MODE == 2) ? mx : 0.f); \
            bf16x8 pb[4]; pb[0] = pack8(s0, 0); pb[1] = pack8(s0, 8); pb[2] = pack8(s1, 0); pb[3] = pack8(s1, 8); \
            _Pragma("unroll") for (int kk = 0; kk < 4; ++kk) { \
                const bf16x8 v0 = (bf16x8){vl[2 * kk][0], vl[2 * kk][1], vl[2 * kk][2], vl[2 * kk][3], vh[2 * kk][0], vh[2 * kk][1], vh[2 * kk][2], vh[2 * kk][3]}; \
                const bf16x8 v1 = (bf16x8){vl[2 * kk + 1][0], vl[2 * kk + 1][1], vl[2 * kk + 1][2], vl[2 * kk + 1][3], vh[2 * kk + 1][0], vh[2 * kk + 1][1], vh[2 * kk + 1][2], vh[2 * kk + 1][3]}; \
                if (MODE != 5) { ot0 = __builtin_amdgcn_mfma_f32_32x32x16_bf16(v0, pb[kk], ot0, 0, 0, 0); \
                ot1 = __builtin_amdgcn_mfma_f32_32x32x16_bf16(v1, pb[kk], ot1, 0, 0, 0); } else { ot0[kk] += __builtin_bit_cast(float, pb[kk][0] | (pb[kk][7] << 16)); } } } while (0)
        MLA_LOAD(0, ka0, ka1, va); MLA_LOAD(1, kb0, kb1, vbr);
        MLA_STORE(0, ka0, ka1, va);
        __syncthreads();
        for (int t = 0; t < ntile; t += 2) {
            if (MODE != 3 && t + 2 < ntile) MLA_LOAD(t + 2, ka0, ka1, va);
            MLA_TILE(t, 0);
            if (MODE != 3) MLA_STORE(1, kb0, kb1, vbr);
            if (MODE != 6) __syncthreads();
            if (MODE != 3 && t + 3 < ntile) MLA_LOAD(t + 3, kb0, kb1, vbr);
            MLA_TILE(t + 1, 1);
            if (MODE != 3 && t + 2 < ntile) MLA_STORE(0, ka0, ka1, va);
            if (MODE != 6) __syncthreads();
        }
        if (MODE == 6) __syncthreads();
#undef MLA_TILE
#undef MLA_LOAD
#undef MLA_STORE
        l = xsum32(l);
        const float il = 1.f / l;
        bf16* orow = ml + (size_t)qrow * D + 768 + h * 64 + 4 * hh;
#pragma unroll
        for (int g = 0; g < 4; ++g) {
            u32x2 o0, o1;
            o0.x = pg8::cvt_pk_bf16(ot0[4 * g] * il, ot0[4 * g + 1] * il); o0.y = pg8::cvt_pk_bf16(ot0[4 * g + 2] * il, ot0[4 * g + 3] * il);
            o1.x = pg8::cvt_pk_bf16(ot1[4 * g] * il, ot1[4 * g + 1] * il); o1.y = pg8::cvt_pk_bf16(ot1[4 * g + 2] * il, ot1[4 * g + 3] * il);
            *(u32x2*)(orow + 8 * g) = o0; *(u32x2*)(orow + 32 + 8 * g) = o1;
        }
    }
}

__device__ __forceinline__ void p3_na_mfma(CPR p, Frame& F, int l) {
    constexpr int TP = 144, KBs = 32 * TP, WB = 2 * KBs, BT_OFF = 8 * WB;
    const int tid = F.tid, lane = F.lane, q = lane & 31, hh = lane >> 5;
    LAS unsigned char* wk = F.lds + F.wave * WB; LAS unsigned char* wv = wk + KBs;
    LAS float* btab = (LAS float*)(F.lds + BT_OFF);
    __syncthreads();
    for (int i = tid; i < 4 * 465; i += NTHR) btab[i] = p.na_rpb[(size_t)l * 1860 + i] * LOG2E;
    __syncthreads();
    const bf16* pl = F.pl(); bf16* ml = F.ml();
    const int skey = lane >> 3, spart = lane & 7;
    const int trow = 4 * hh + ((lane & 15) >> 2), tcol = 16 * ((lane >> 4) & 1) + 4 * (lane & 3);
    constexpr float QS = 0.125f * LOG2E;
    for (int pass = 0, it = F.gw; it < 2176; ++pass, it = F.ngw * pass + (F.ngw - 1 - F.gw)) {
        const bool lat = it < 2048; const int x = lat ? it : it - 2048;
        const int h = x & 3, b = lat ? (x >> 9) : (x >> 5), r = (x >> 3) & 63, jp = (x >> 2) & 1, g8 = (x >> 2) & 7;
        const int qrow = lat ? b * SEQ + r * 64 + 32 * jp + q : TL + b * CTX + 32 * g8 + q;
        const int ntile = lat ? 18 : 8;
        int rs = r - 4; rs = rs < 0 ? 0 : (rs > GH - 8 ? GH - 8 : rs);
        const int cb = jp ? 24 : 0, gc = 32 * jp + q; int wsq = gc - 8; wsq = wsq < 0 ? 0 : (wsq > GW - 16 ? GW - 16 : wsq);
        const int baddr = ((h * 15 + (rs - r + 7)) * 31 + cb - gc + 15 + 4 * hh) * 4;
        const int vk0 = cb + 4 * hh - wsq;
        bf16x8 qf[4];
#pragma unroll
        for (int ks = 0; ks < 4; ++ks) qf[ks] = *(const bf16x8*)(pl + (size_t)qrow * INP + OFF_B + 64 * h + 16 * ks + 8 * hh);
        f32x16 ot0, ot1;
#pragma unroll
        for (int i = 0; i < 16; ++i) { ot0[i] = 0.f; ot1[i] = 0.f; }
        constexpr float THR = 8.f;
        float mref = 0.f, lsum = 0.f;
        u32x4 krA[4], vrA[4], krB[4], vrB[4];
#define NA_LOAD(t, KR, VR) do { const int t_ = (t); _Pragma("unroll") for (int j = 0; j < 4; ++j) { int row_; \
            if (t_ < 8) row_ = TL + b * CTX + 32 * t_ + 8 * j + skey; \
            else { const int x_ = 4 * (t_ - 8) + j, rr_ = (x_ * 205) >> 10, cg_ = x_ - 5 * rr_; row_ = b * SEQ + (rs + rr_) * 64 + cb + 8 * cg_ + skey; } \
            const bf16* src_ = pl + (size_t)row_ * INP + OFF_B + 256 + 64 * h + 8 * spart; KR[j] = *(const u32x4*)src_; VR[j] = *(const u32x4*)(src_ + 256); } } while (0)
#define NA_STORE(KR, VR) do { _Pragma("unroll") for (int j = 0; j < 4; ++j) { *(LAS u32x4*)(wk + (8 * j + skey) * TP + spart * 16) = KR[j]; *(LAS u32x4*)(wv + (8 * j + skey) * TP + spart * 16) = VR[j]; } } while (0)
#define NA_TILE(t) do { \
            bf16x8 kf[4]; \
            _Pragma("unroll") \
            for (int ks = 0; ks < 4; ++ks) kf[ks] = *(const LAS bf16x8*)(wk + q * TP + (16 * ks + 8 * hh) * 2); \
            __builtin_amdgcn_sched_barrier(0); \
            f32x16 sc; \
            _Pragma("unroll") \
            for (int i = 0; i < 16; ++i) sc[i] = 0.f; \
            _Pragma("unroll") \
            for (int ks = 0; ks < 4; ++ks) sc = __builtin_amdgcn_mfma_f32_32x32x16_bf16(kf[ks], qf[ks], sc, 0, 0, 0); \
            __builtin_amdgcn_sched_barrier(0); \
            s16x4 vl[4], vh[4]; \
            _Pragma("unroll") \
            for (int kk = 0; kk < 2; ++kk) { const LAS unsigned char* a0 = wv + (16 * kk + trow) * TP + tcol * 2; \
                vl[2 * kk] = lds_tr16(a0); vh[2 * kk] = lds_tr16(a0 + 8 * TP); vl[2 * kk + 1] = lds_tr16(a0 + 64); vh[2 * kk + 1] = lds_tr16(a0 + 8 * TP + 64); } \
            __builtin_amdgcn_sched_barrier(0); \
            const float nm = -mref; \
            if (t < 8) { \
            _Pragma("unroll") \
                for (int i = 0; i < 16; ++i) sc[i] = fmaf(sc[i], QS, nm); \
            } else { \
                const int wt = t - 8; \
            _Pragma("unroll") \
                for (int g = 0; g < 4; ++g) { \
                    const int x_ = 4 * wt + g, rr_ = (x_ * 205) >> 10, cg_ = x_ - 5 * rr_; \
                    const LAS float* bp = (const LAS float*)((const LAS unsigned char*)btab + baddr + (rr_ * 31 + 8 * cg_) * 4); \
                    const int vk = vk0 + 8 * cg_; \
            _Pragma("unroll") \
                    for (int e = 0; e < 4; ++e) { float bias = bp[e]; asm volatile("" : "+v"(bias));     \
                        const bool ok = (unsigned)(vk + e) < 16u; sc[4 * g + e] = ok ? fmaf(sc[4 * g + e], QS, bias + nm) : -1.0e30f; } \
                } \
            } \
            float mx = sc[0]; \
            _Pragma("unroll") \
            for (int i = 1; i < 16; i += 2) mx = __builtin_fmaxf(__builtin_fmaxf(mx, sc[i]), sc[i + 1 < 16 ? i + 1 : i]); \
            mx = xmax32(mx); \
            if (t == 0 || __any(mx > THR)) { \
                const float dl = (t == 0) ? mx : __builtin_fmaxf(mx, 0.f), alpha = __builtin_amdgcn_exp2f(-dl); \
                mref += dl; lsum *= alpha; \
            _Pragma("unroll") \
                for (int i = 0; i < 16; ++i) { ot0[i] *= alpha; ot1[i] *= alpha; sc[i] -= dl; } \
            } \
            float rsum = 0.f; \
            _Pragma("unroll") \
            for (int i = 0; i < 16; ++i) { sc[i] = __builtin_amdgcn_exp2f(sc[i]); rsum += sc[i]; } \
            lsum += rsum; \
            bf16x8 pb[2]; pb[0] = pack8(sc, 0); pb[1] = pack8(sc, 8); \
            _Pragma("unroll") \
            for (int kk = 0; kk < 2; ++kk) { \
                const bf16x8 v0 = (bf16x8){vl[2 * kk][0], vl[2 * kk][1], vl[2 * kk][2], vl[2 * kk][3], vh[2 * kk][0], vh[2 * kk][1], vh[2 * kk][2], vh[2 * kk][3]}; \
                const bf16x8 v1 = (bf16x8){vl[2 * kk + 1][0], vl[2 * kk + 1][1], vl[2 * kk + 1][2], vl[2 * kk + 1][3], vh[2 * kk + 1][0], vh[2 * kk + 1][1], vh[2 * kk + 1][2], vh[2 * kk + 1][3]}; \
                ot0 = __builtin_amdgcn_mfma_f32_32x32x16_bf16(v0, pb[kk], ot0, 0, 0, 0); \
                ot1 = __builtin_amdgcn_mfma_f32_32x32x16_bf16(v1, pb[kk], ot1, 0, 0, 0); \
            } \
        } while (0)
        NA_LOAD(0, krA, vrA); NA_LOAD(1, krB, vrB); NA_STORE(krA, vrA);
        if (2 < ntile) NA_LOAD(2, krA, vrA);
        for (int t = 0; t < ntile; t += 2) {
            NA_TILE(t);
            NA_STORE(krB, vrB); if (t + 3 < ntile) NA_LOAD(t + 3, krB, vrB);
            NA_TILE(t + 1);
            if (t + 2 < ntile) { NA_STORE(krA, vrA); if (t + 4 < ntile) NA_LOAD(t + 4, krA, vrA); }
        }
#undef NA_TILE
#undef NA_LOAD
#undef NA_STORE
        lsum = xsum32(lsum);
        const float il = 1.f / lsum;
        bf16* orow = ml + (size_t)qrow * D + 256 + h * 64 + 4 * hh;
#pragma unroll
        for (int g = 0; g < 4; ++g) {
            u32x2 o0, o1;
            o0.x = pg8::cvt_pk_bf16(ot0[4 * g] * il, ot0[4 * g + 1] * il); o0.y = pg8::cvt_pk_bf16(ot0[4 * g + 2] * il, ot0[4 * g + 3] * il);
            o1.x = pg8::cvt_pk_bf16(ot1[4 * g] * il, ot1[4 * g + 1] * il); o1.y = pg8::cvt_pk_bf16(ot1[4 * g + 2] * il, ot1[4 * g + 3] * il);
            *(u32x2*)(orow + 8 * g) = o0; *(u32x2*)(orow + 32 + 8 * g) = o1;
        }
    }
    __syncthreads();
}

__device__ __forceinline__ float sumsq8(const bf16x8& v) { const u32x4 u = __builtin_bit_cast(u32x4, v); float s = 0.f;
#pragma unroll
    for (int j = 0; j < 4; ++j) { const float a = __uint_as_float(u[j] << 16), b = __uint_as_float(u[j] & 0xffff0000u); s += a * a + b * b; }
    return s; }
template <int PART> __device__ __forceinline__ void mla_up_item(Frame& F, int l, int it) {
    const int lane = F.lane, tkn = lane & 31, hh = lane >> 5;
    const bf16* pl = F.pl(); const bf16* wq = F.wuq() + (size_t)l * 384 * 256; const bf16* wkv = F.wukv() + (size_t)l * 512 * 128;
    bf16* qm = F.qm(); bf16* km = F.km(); bf16* vm = F.vm();
    {
        const int h = it & 3, row = (it >> 2) * 32 + tkn; const bool lat = row < TL; const int t = row & (SEQ - 1);
        int lnw = lane; asm volatile("" : "+v"(lnw));
        const bf16* pr = pl + (size_t)row * INP + OFF_D;
        bf16x8 bq[16], bk[8]; float sq = 0.f, sk = 0.f;
        if (PART != 1) {
#pragma unroll
            for (int ks = 0; ks < 16; ++ks) { bq[ks] = *(const bf16x8*)(pr + 16 * ks + 8 * hh); sq += sumsq8(bq[ks]); } }
        if (PART != 0) {
#pragma unroll
            for (int ks = 0; ks < 8; ++ks) { bk[ks] = *(const bf16x8*)(pr + 256 + 16 * ks + 8 * hh); sk += sumsq8(bk[ks]); } }
        sq = xsum32(sq); sk = xsum32(sk);
        const float rq = rsqrtf(sq * (1.f / 256.f) + EPS) * (MLA_SCALE * LOG2E), rk = rsqrtf(sk * (1.f / 128.f) + EPS);
        if (PART != 1) {
            bf16x8 wfa[16], wfb[16];
#define UPQ_LOAD(W, q3_) do { const bf16* wr_ = wq + ((size_t)(3 * h + (q3_)) * 16 * 64 + lnw) * 8; _Pragma("unroll") for (int ks = 0; ks < 16; ++ks) W[ks] = *(const bf16x8*)(wr_ + 512 * ks); } while (0)
#define UPQ_TILE(W, q3_) do { const int nt = 3 * h + (q3_); f32x16 acc; _Pragma("unroll") for (int i = 0; i < 16; ++i) acc[i] = 0.f; \
            f32x4 cr = {1.f, 1.f, 1.f, 1.f}, sr = {0.f, 0.f, 0.f, 0.f}, cc = cr, sc = sr;       \
            if ((q3_) == 2 && lat) { cr = *(const f32x4*)(F.ropec() + t * 16 + 4 * hh); sr = *(const f32x4*)(F.ropes() + t * 16 + 4 * hh); cc = *(const f32x4*)(F.ropec() + t * 16 + 8 + 4 * hh); sc = *(const f32x4*)(F.ropes() + t * 16 + 8 + 4 * hh); } \
            __builtin_amdgcn_sched_barrier(0); \
            _Pragma("unroll") for (int ks = 0; ks < 16; ++ks) acc = __builtin_amdgcn_mfma_f32_32x32x16_bf16(W[ks], bq[ks], acc, 0, 0, 0); \
            __builtin_amdgcn_sched_barrier(0); \
            _Pragma("unroll") for (int i = 0; i < 16; ++i) acc[i] *= rq; \
            if ((q3_) == 2) { _Pragma("unroll") for (int e = 0; e < 4; ++e) { const float x1 = acc[e], x2 = acc[4 + e], y1 = acc[8 + e], y2 = acc[12 + e]; \
                    acc[e] = x1 * cr[e] - x2 * sr[e]; acc[4 + e] = x1 * sr[e] + x2 * cr[e]; acc[8 + e] = y1 * cc[e] - y2 * sc[e]; acc[12 + e] = y1 * sc[e] + y2 * cc[e]; } } \
            bf16* o = qm + (size_t)row * 384 + 32 * nt + 4 * hh; \
            _Pragma("unroll") for (int g = 0; g < 4; ++g) { u32x2 w; w.x = pg8::cvt_pk_bf16(acc[4 * g], acc[4 * g + 1]); w.y = pg8::cvt_pk_bf16(acc[4 * g + 2], acc[4 * g + 3]); *(u32x2*)(o + 8 * g) = w; } } while (0)
            UPQ_LOAD(wfa, 0); UPQ_LOAD(wfb, 1); UPQ_TILE(wfa, 0); UPQ_LOAD(wfa, 2); UPQ_TILE(wfb, 1); UPQ_TILE(wfa, 2);
#undef UPQ_LOAD
#undef UPQ_TILE
        }
        if (PART != 0) {
            bf16x8 wka[8], wkb[8];
#define UPK_LOAD(W, sub_) do { const bf16* wr_ = wkv + ((size_t)(4 * h + (sub_)) * 8 * 64 + lnw) * 8; _Pragma("unroll") for (int ks = 0; ks < 8; ++ks) W[ks] = *(const bf16x8*)(wr_ + 512 * ks); } while (0)
#define UPK_TILE(W, sub_) do { f32x16 acc; _Pragma("unroll") for (int i = 0; i < 16; ++i) acc[i] = 0.f; \
            __builtin_amdgcn_sched_barrier(0); \
            _Pragma("unroll") for (int ks = 0; ks < 8; ++ks) acc = __builtin_amdgcn_mfma_f32_32x32x16_bf16(W[ks], bk[ks], acc, 0, 0, 0); \
            __builtin_amdgcn_sched_barrier(0); \
            bf16* o = ((sub_) < 2) ? km + (size_t)row * 384 + 96 * h + 32 * (sub_) + 4 * hh : vm + (size_t)row * 256 + 64 * h + 32 * ((sub_) - 2) + 4 * hh; \
            _Pragma("unroll") for (int g = 0; g < 4; ++g) { u32x2 w; w.x = pg8::cvt_pk_bf16(acc[4 * g] * rk, acc[4 * g + 1] * rk); w.y = pg8::cvt_pk_bf16(acc[4 * g + 2] * rk, acc[4 * g + 3] * rk); *(u32x2*)(o + 8 * g) = w; } } while (0)
            UPK_LOAD(wka, 0); UPK_LOAD(wkb, 1); UPK_TILE(wka, 0); UPK_LOAD(wka, 2); UPK_TILE(wkb, 1); UPK_LOAD(wkb, 3); UPK_TILE(wka, 2); UPK_TILE(wkb, 3);
#undef UPK_LOAD
#undef UPK_TILE
        }
        if (PART != 1) { const u32x4 a = *(const u32x4*)(pr + 384 + 16 * hh), bb = *(const u32x4*)(pr + 384 + 16 * hh + 8);
          float x1[8], x2[8];
#pragma unroll
          for (int j = 0; j < 4; ++j) { x1[2 * j] = __uint_as_float(a[j] << 16); x1[2 * j + 1] = __uint_as_float(a[j] & 0xffff0000u); x2[2 * j] = __uint_as_float(bb[j] << 16); x2[2 * j + 1] = __uint_as_float(bb[j] & 0xffff0000u); }
          float o1[8], o2[8];
#pragma unroll
          for (int j = 0; j < 8; ++j) { float c = 1.f, sn = 0.f; if (lat) { c = F.ropec()[t * 16 + 8 * hh + j]; sn = F.ropes()[t * 16 + 8 * hh + j]; } o1[j] = x1[j] * c - x2[j] * sn; o2[j] = x1[j] * sn + x2[j] * c; }
          u32x4 w1, w2;
#pragma unroll
          for (int j = 0; j < 4; ++j) { w1[j] = pg8::cvt_pk_bf16(o1[2 * j], o1[2 * j + 1]); w2[j] = pg8::cvt_pk_bf16(o2[2 * j], o2[2 * j + 1]); }
          bf16* o = km + (size_t)row * 384 + 96 * h + 64 + 16 * hh; *(u32x4*)o = w1; *(u32x4*)(o + 8) = w2; }
    }
}

__device__ __forceinline__ void p3_mla_up(Frame& F, int l) {
    for (int it = F.gw; it < (T / 32) * 4; it += F.ngw) mla_up_item<2>(F, l, it);
}
__device__ __forceinline__ void p3_mla_up_queued(Frame& F, int l, int lc) {
    volatile LAS int* dq = (volatile LAS int*)(F.lds + DYNQ_OFF);
    unsigned* head = F.ctl() + CW_HEAD2 + lc * 64; unsigned* rdy = F.ctl() + CW_RDY2 + lc * 128 * 64;
    constexpr int NID = (T / 32) * 4 * 2;
    for (;;) {
        __syncthreads();
        if (F.tid == 0) dq[0] = (int)__hip_atomic_fetch_add(head, 16u, __ATOMIC_RELAXED, __HIP_MEMORY_SCOPE_AGENT);
        __syncthreads();
        const int base = dq[0];
        if (base >= NID) break;
        if (F.wave == 0) {
            const int t0 = base >> 6, t1 = (base + 15) >> 6; unsigned spins = 0;
            while ((unsigned)__builtin_amdgcn_readfirstlane(__hip_atomic_load(rdy + 64 * t0, __ATOMIC_RELAXED, __HIP_MEMORY_SCOPE_AGENT)) < 16u ||
                   (unsigned)__builtin_amdgcn_readfirstlane(__hip_atomic_load(rdy + 64 * t1, __ATOMIC_RELAXED, __HIP_MEMORY_SCOPE_AGENT)) < 16u) {
                __builtin_amdgcn_s_sleep(2);
                if (++spins > (1u << 20)) { if (F.lane == 0) __hip_atomic_store(F.ctl() + CW_TMO, 1u, __ATOMIC_RELAXED, __HIP_MEMORY_SCOPE_AGENT); break; } }
            __builtin_amdgcn_fence(__ATOMIC_ACQUIRE, "agent"); asm volatile("s_waitcnt vmcnt(0)" ::: "memory"); }
        __syncthreads();
        { const int id = base + F.wave, it = id >> 1; if (id & 1) mla_up_item<1>(F, l, it); else mla_up_item<0>(F, l, it); }
        { const int id = base + 8 + (F.wave ^ 1), it = id >> 1; if (id & 1) mla_up_item<1>(F, l, it); else mla_up_item<0>(F, l, it); }
    }
}
__device__ __forceinline__ void p3_pool_mfma(CPR p, Frame& F, int l) {
    const int lane = F.lane, tk = lane & 31, hh = lane >> 5;
    const bf16* pl = F.pl(); bf16* ml = F.ml();
    for (int pass = 0, it = F.gw; it < (T / 32) * 4; ++pass, it = F.ngw * pass + ((F.gw + 256) % F.ngw)) {
        const int g = it & 3, row = (it >> 2) * 32 + tk;
        const int L = row < TL ? SEQ : CTX, t = row < TL ? (row & (SEQ - 1)) : ((row - TL) & (CTX - 1)), seg0 = row - t;
        const int win = 2 << g; int lo = t - win / 2, hi = t - win / 2 + win; lo = lo < 0 ? 0 : lo; hi = hi > L ? L : hi;
        const float inv = 1.f / (float)(hi - lo);
        const bf16* wt = F.poolw() + (size_t)(l * 4 + g) * 4096;
        bf16x8 wf[8]; f32x4 psv[2][4];
#pragma unroll
        for (int i = 0; i < 8; ++i) wf[i] = *(const bf16x8*)(wt + (size_t)(32 * (i >> 2) + tk) * 64 + 16 * (i & 3) + 8 * hh);
#pragma unroll
        for (int i = 0; i < 8; ++i) psv[i >> 2][i & 3] = *(const f32x4*)(p.pool_s + l * 256 + 64 * g + 32 * (i >> 2) + 4 * hh + 8 * (i & 3));
        float sum[32];
#pragma unroll
        for (int i = 0; i < 32; ++i) sum[i] = 0.f;
        for (int w0 = 0; w0 < win; w0 += 4) {
            u32x4 wv[4][4]; bool okv[4];
#pragma unroll
            for (int d = 0; d < 4; ++d) { const int sidx = t - win / 2 + w0 + d; okv[d] = (w0 + d < win) && sidx >= 0 && sidx < L; const int sc2 = okv[d] ? sidx : t;
                const bf16* src = pl + (size_t)(seg0 + sc2) * INP + 64 * g + 8 * hh;
#pragma unroll
                for (int ks = 0; ks < 4; ++ks) wv[d][ks] = *(const u32x4*)(src + 16 * ks); }
            __builtin_amdgcn_sched_barrier(0);
#pragma unroll
            for (int d = 0; d < 4; ++d)
#pragma unroll
                for (int ks = 0; ks < 4; ++ks)
#pragma unroll
                    for (int j = 0; j < 4; ++j) { sum[8 * ks + 2 * j] += okv[d] ? __uint_as_float(wv[d][ks][j] << 16) : 0.f; sum[8 * ks + 2 * j + 1] += okv[d] ? __uint_as_float(wv[d][ks][j] & 0xffff0000u) : 0.f; }
            __builtin_amdgcn_sched_barrier(0);
        }
        bf16x8 df[4];
        { const bf16* src = pl + (size_t)row * INP + 64 * g + 8 * hh;
#pragma unroll
          for (int ks = 0; ks < 4; ++ks) { const u32x4 v = *(const u32x4*)(src + 16 * ks); u32x4 w;
#pragma unroll
              for (int j = 0; j < 4; ++j) w[j] = pg8::cvt_pk_bf16(sum[8 * ks + 2 * j] * inv - __uint_as_float(v[j] << 16), sum[8 * ks + 2 * j + 1] * inv - __uint_as_float(v[j] & 0xffff0000u));
              df[ks] = __builtin_bit_cast(bf16x8, w); } }
#pragma unroll
        for (int dt = 0; dt < 2; ++dt) {
            f32x16 acc;
#pragma unroll
            for (int i = 0; i < 16; ++i) acc[i] = 0.f;
#pragma unroll
            for (int ks = 0; ks < 4; ++ks) acc = __builtin_amdgcn_mfma_f32_32x32x16_bf16(wf[4 * dt + ks], df[ks], acc, 0, 0, 0);
            const int col = 64 * g + 32 * dt + 4 * hh; bf16* o = ml + (size_t)row * D + col;
#pragma unroll
            for (int gg = 0; gg < 4; ++gg) { const f32x4 sc = psv[dt][gg]; u32x2 w; w.x = pg8::cvt_pk_bf16(acc[4 * gg] * sc.x, acc[4 * gg + 1] * sc.y); w.y = pg8::cvt_pk_bf16(acc[4 * gg + 2] * sc.z, acc[4 * gg + 3] * sc.w); *(u32x2*)(o + 8 * gg) = w; }
        }
    }
}
__device__ __forceinline__ void p3_sgu_mfma(CPR p, Frame& F, int l) {
    constexpr int VP = 144;
    const int tid = F.tid, lane = F.lane, tk = lane & 31, hh = lane >> 5, pt = F.wave >> 1, ct = F.wave & 1;
    const bf16* pl = F.pl(); bf16* ml = F.ml();
    const int trow = 8 * hh + ((lane & 15) >> 2), tcol = 16 * ((lane >> 4) & 1) + 4 * (lane & 3);
    __syncthreads();
    for (int pass = 0, it = blockIdx.x; it < (T / 128) * 4; ++pass, it = (int)gridDim.x * pass + ((pass == 2) ? (((int)blockIdx.x + 64) % (int)gridDim.x) : (int)blockIdx.x)) {
        const int g = it & 3, r0 = (it >> 2) * 128;
        bf16x8 wf[8]; u32x2 uv[4];
        const int orow = r0 + 32 * pt + tk, ocol = 64 * g + 32 * ct + 4 * hh;
        const float obias = p.sgu_b[(l * 4 + g) * 128 + 32 * pt + tk];
        { const bf16* wrow = F.sguw() + ((size_t)(l * 4 + g) * 128 + 32 * pt + tk) * 128 + 8 * hh;
#pragma unroll
          for (int ks = 0; ks < 8; ++ks) wf[ks] = *(const bf16x8*)(wrow + 16 * ks);
#pragma unroll
          for (int gg = 0; gg < 4; ++gg) uv[gg] = *(const u32x2*)(pl + (size_t)orow * INP + OFF_C + ocol + 8 * gg); }
        {
            const int qq = tid >> 2, c0 = 16 * (tid & 3);
            const bf16* src = pl + (size_t)(r0 + qq) * INP + OFF_C + 256 + 64 * g + c0;
            const u32x4 a = *(const u32x4*)src, b = *(const u32x4*)(src + 8);
            const float* gnp = p.sgu_norm_g + l * 256 + 64 * g + c0;
            const f32x4 gn0 = *(const f32x4*)gnp, gn1 = *(const f32x4*)(gnp + 4), gn2 = *(const f32x4*)(gnp + 8), gn3 = *(const f32x4*)(gnp + 12);
            const float gn[16] = {gn0.x, gn0.y, gn0.z, gn0.w, gn1.x, gn1.y, gn1.z, gn1.w, gn2.x, gn2.y, gn2.z, gn2.w, gn3.x, gn3.y, gn3.z, gn3.w};
            float v[16]; float ss = 0.f;
#pragma unroll
            for (int j = 0; j < 4; ++j) { v[2 * j] = gelu_tanh(__uint_as_float(a[j] << 16)); v[2 * j + 1] = gelu_tanh(__uint_as_float(a[j] & 0xffff0000u)); v[8 + 2 * j] = gelu_tanh(__uint_as_float(b[j] << 16)); v[8 + 2 * j + 1] = gelu_tanh(__uint_as_float(b[j] & 0xffff0000u)); }
#pragma unroll
            for (int j = 0; j < 16; ++j) ss += v[j] * v[j];
            ss += lane_xor<1>(ss); ss += lane_xor<2>(ss);
            const float rs = rsqrtf(ss * (1.f / 64.f) + EPS);
            u32x4 w0, w1;
#pragma unroll
            for (int j = 0; j < 4; ++j) { w0[j] = pg8::cvt_pk_bf16(v[2 * j] * rs * gn[2 * j], v[2 * j + 1] * rs * gn[2 * j + 1]); w1[j] = pg8::cvt_pk_bf16(v[8 + 2 * j] * rs * gn[8 + 2 * j], v[8 + 2 * j + 1] * rs * gn[8 + 2 * j + 1]); }
            LAS unsigned char* d = F.lds + qq * VP + c0 * 2; *(LAS u32x4*)d = w0; *(LAS u32x4*)(d + 16) = w1;
        }
        __syncthreads();
        f32x16 acc;
#pragma unroll
        for (int i = 0; i < 16; ++i) acc[i] = 0.f;
        s16x4 vlo[8], vhi[8];
#pragma unroll
        for (int ks = 0; ks < 8; ++ks) { const LAS unsigned char* a0 = F.lds + (16 * ks + trow) * VP + (32 * ct + tcol) * 2; vlo[ks] = lds_tr16(a0); vhi[ks] = lds_tr16(a0 + 4 * VP); }
        __builtin_amdgcn_sched_barrier(0);
#pragma unroll
        for (int ks = 0; ks < 8; ++ks) {
            const bf16x8 va = (bf16x8){vlo[ks][0], vlo[ks][1], vlo[ks][2], vlo[ks][3], vhi[ks][0], vhi[ks][1], vhi[ks][2], vhi[ks][3]};
            acc = __builtin_amdgcn_mfma_f32_32x32x16_bf16(va, wf[ks], acc, 0, 0, 0);
        }
        const int row = orow, col = ocol; const float bias = obias;
#pragma unroll
        for (int gg = 0; gg < 4; ++gg) { const u32x2 uu = uv[gg];
            const float u0 = gelu_tanh(__uint_as_float(uu.x << 16)), u1 = gelu_tanh(__uint_as_float(uu.x & 0xffff0000u)), u2 = gelu_tanh(__uint_as_float(uu.y << 16)), u3 = gelu_tanh(__uint_as_float(uu.y & 0xffff0000u));
            u32x2 w; w.x = pg8::cvt_pk_bf16(u0 * (acc[4 * gg] + bias), u1 * (acc[4 * gg + 1] + bias)); w.y = pg8::cvt_pk_bf16(u2 * (acc[4 * gg + 2] + bias), u3 * (acc[4 * gg + 3] + bias));
            *(u32x2*)(ml + (size_t)row * D + 512 + col + 8 * gg) = w; }
        __syncthreads();
    }
}

__device__ __forceinline__ void p5_outproj_naive(Frame& F, int l) {
    const bf16* W = F.wout() + (size_t)l * D * D;
    for (long i = F.gt; i < (long)T * D; i += F.ngt) { const int r = (int)(i >> 10), c = (int)(i & 1023);
        const float g = mod_vec(F, l, row_mod(r), 2)[c];
        F.xl()[(size_t)r * D + c] = (bf16)f2bf(bf2f(F.xl()[(size_t)r * D + c]) + g * dot_bf16(F.ml() + (size_t)r * D, W + (size_t)c * D, D)); }
}

constexpr int P6_MAXPASS = 2, P6_MAXDEC = P6_MAXPASS * NWAVES * 16;
constexpr int P6_DEC_OFF = 65536, P6_CNT_OFF = P6_DEC_OFF + P6_MAXDEC * 16, P6_MOD_OFF = P6_CNT_OFF + 256;
static_assert(2 * P6_MAXDEC == NTHR && P6_MOD_OFF + 5 * 2 * 1024 * 4 <= 131072, "P6 LDS layout");
__device__ __forceinline__ void route_commit_wg(Frame& F, int l) {
    LAS int* lcnt = (LAS int*)(F.lds + P6_CNT_OFF);
    __syncthreads();
    int e = 0, pos = 0, row = -1; float w = 0.f; const int which = F.tid & 1;
    { const i32x4 d = ((const LAS i32x4*)(F.lds + P6_DEC_OFF))[F.tid >> 1]; row = d.w;
      if (row >= 0) { e = which ? (d.x >> 8) : (d.x & 255); w = __builtin_bit_cast(float, which ? d.z : d.y); pos = __hip_atomic_fetch_add(lcnt + e, 1, __ATOMIC_RELAXED, __HIP_MEMORY_SCOPE_WORKGROUP); } }
    __syncthreads();
    if (F.tid < NE) { const int n = lcnt[F.tid]; lcnt[16 + F.tid] = n ? (int)atomicAdd(F.ctl() + CW_CNT + l * NE * 64 + F.tid * 64, (unsigned)n) : 0; }
    __syncthreads();
    if (row >= 0) { const int slot = lcnt[16 + e] + pos; F.tok()[e * CAP + slot] = row; F.wl()[e * CAP + slot] = w; i32x2 rt; rt.x = e; rt.y = slot; *(i32x2*)(F.route() + 4 * row + 2 * which) = rt; }
}
__device__ __forceinline__ void p6_rows(CPR p, Frame& F, int l, bool commit = true) {
    LAS float* mdl = (LAS float*)(F.lds + P6_MOD_OFF);
    __syncthreads();
    { u32x4 t[8];
#pragma unroll
      for (int k = 0; k < 8; ++k) t[k] = ((const u32x4*)F.rwf())[F.tid + NTHR * k];
#pragma unroll
      for (int k = 0; k < 8; ++k) ((LAS u32x4*)F.lds)[F.tid + NTHR * k] = t[k]; }
    for (int i = F.tid; i < 5 * 256; i += NTHR) { const int mr = i >> 8, c = (i & 255) * 4;
        const f32x4 g = *(const f32x4*)(p.norm2_g + l * D + c), s4 = *(const f32x4*)(mod_vec(F, l, mr, 3) + c), q4 = *(const f32x4*)(mod_vec(F, l, mr, 4) + c);
        *(LAS f32x4*)(mdl + mr * 2048 + c) = g * (q4 + 1.f); *(LAS f32x4*)(mdl + mr * 2048 + 1024 + c) = s4; }
    if (F.tid < P6_MAXDEC) { i32x4 z; z.x = 0; z.y = 0; z.z = 0; z.w = -1; ((LAS i32x4*)(F.lds + P6_DEC_OFF))[F.tid] = z; }
    if (F.tid < 32) ((LAS int*)(F.lds + P6_CNT_OFF))[F.tid] = 0;
    __syncthreads();
    TMARK(60);
    const int nitems = ((l + 1 < DEPTH) ? T : TL) / 16;
    const int q = F.lane >> 4, n = F.lane & 15;
    const f32x4 rb = *(const f32x4*)(p.router_b + 4 * q);
    int kpass = 0;
    for (int it = F.wave * (int)gridDim.x + (int)blockIdx.x; it < nitems && kpass < P6_MAXPASS; it += NWAVES * (int)gridDim.x, ++kpass) {
        const int row = it * 16 + n, mr = row_mod(it * 16);
        const bf16* xr = F.xl() + (size_t)row * D + 8 * q;
        u32x4 raw[32];
#pragma unroll
        for (int sx = 0; sx < 32; ++sx) raw[sx] = *(const u32x4*)(xr + 32 * sx);
        float ss = 0.f;
#pragma unroll
        for (int sx = 0; sx < 32; ++sx)
#pragma unroll
            for (int d = 0; d < 4; ++d) { const float a = __uint_as_float(raw[sx][d] << 16), b = __uint_as_float(raw[sx][d] & 0xffff0000u); ss = __builtin_fmaf(a, a, ss); ss = __builtin_fmaf(b, b, ss); }
        ss += lane_xor<16>(ss); ss = xsum32(ss);
#pragma unroll
        for (int sx = 0; sx < 32; ++sx) asm volatile("" : "+v"(raw[sx]));
        const float rs = rsqrtf(ss * (1.f / D) + EPS);
        bf16* hr = F.ha() + (size_t)row * D + 8 * q;
        const LAS float* mm = mdl + mr * 2048 + 8 * q;
        const LAS unsigned char* fr = F.lds + F.lane * 16;
        f32x4 acc = {0.f, 0.f, 0.f, 0.f};
#pragma unroll
        for (int sx = 0; sx < 32; ++sx) {
            const f32x4 m0 = *(const LAS f32x4*)(mm + 32 * sx), m1 = *(const LAS f32x4*)(mm + 32 * sx + 4), s0 = *(const LAS f32x4*)(mm + 1024 + 32 * sx), s1 = *(const LAS f32x4*)(mm + 1024 + 32 * sx + 4);
            const bf16x8 ah = *(const LAS bf16x8*)(fr + sx * 1024), al = *(const LAS bf16x8*)(fr + 32768 + sx * 1024);
            float h[8];
#pragma unroll
            for (int d = 0; d < 4; ++d) { const float a = __uint_as_float(raw[sx][d] << 16), b = __uint_as_float(raw[sx][d] & 0xffff0000u);
                const float ma = (d < 2) ? m0[2 * d] : m1[2 * d - 4], mb = (d < 2) ? m0[2 * d + 1] : m1[2 * d - 3], sa = (d < 2) ? s0[2 * d] : s1[2 * d - 4], sb = (d < 2) ? s0[2 * d + 1] : s1[2 * d - 3];
                h[2 * d] = __builtin_fmaf(a, ma * rs, sa); h[2 * d + 1] = __builtin_fmaf(b, mb * rs, sb); }
            u32x4 hb; hb.x = pk2(h[0], h[1]); hb.y = pk2(h[2], h[3]); hb.z = pk2(h[4], h[5]); hb.w = pk2(h[6], h[7]);
            *(u32x4*)(hr + 32 * sx) = hb;
            const bf16x8 bh = __builtin_bit_cast(bf16x8, hb);
            acc = __builtin_amdgcn_mfma_f32_16x16x32_bf16(ah, bh, acc, 0, 0, 0);
            acc = __builtin_amdgcn_mfma_f32_16x16x32_bf16(al, bh, acc, 0, 0, 0);
            if (sx & 1) asm volatile("" ::: "memory");
        }
        float b0 = 0.f, s0 = 0.f, b1 = -3.0e38f, s1 = 0.f; int i0 = 0, i1 = 0;
#pragma unroll
        for (int r = 0; r < 4; ++r) { const float sc = 1.f / (1.f + __expf(-acc[r])), x = sc + rb[r];
            if (r == 0) { b0 = x; s0 = sc; }
            else { const bool g0 = x > b0, g1 = x > b1;
                b1 = g0 ? b0 : (g1 ? x : b1); s1 = g0 ? s0 : (g1 ? sc : s1); i1 = g0 ? i0 : (g1 ? r : i1);
                b0 = g0 ? x : b0; s0 = g0 ? sc : s0; i0 = g0 ? r : i0; } }
        float gs = b0 + b1; int g = q;
        { const float og = lane_xor<16>(gs); const int pg = g ^ 1; const bool take = (og > gs) || (og == gs && pg < g); gs = take ? og : gs; g = take ? pg : g; }
        { const float og = other32(gs); const int pg = __float_as_int(other32(__int_as_float(g))); const bool take = (og > gs) || (og == gs && pg < g); g = take ? pg : g; }
        if (commit && g == q) { const float ws = s0 + s1; i32x4 d; d.x = (4 * q + i0) | ((4 * q + i1) << 8); d.y = __float_as_int(s0 / ws); d.z = __float_as_int(s1 / ws); d.w = row;
            ((LAS i32x4*)(F.lds + P6_DEC_OFF))[(kpass * NWAVES + F.wave) * 16 + n] = d; }
    }
    TMARK(61);
    if (commit) route_commit_wg(F, l);
    __syncthreads();
    TMARK(62);
}

__device__ __forceinline__ void p6b_sort(Frame& F, int l) {
    const volatile LAS int* tab = (const volatile LAS int*)(F.lds + MOETAB_OFF);
    moe_table(F, l);
    for (int pi = F.gw; pi < T / 2; pi += F.ngw) {
        const int r = 2 * pi;
        const i32x4 rt0 = *(const i32x4*)(F.route() + 4 * r), rt1 = *(const i32x4*)(F.route() + 4 * r + 4);
        const u32x4* src = (const u32x4*)(F.ha() + (size_t)r * D) + F.lane;
        const u32x4 a0 = src[0], b0 = src[64], a1 = src[128], b1 = src[192];
        u32x4* d00 = (u32x4*)(F.hs() + (size_t)(tab[rt0.x] * 256 + rt0.y) * D) + F.lane; u32x4* d01 = (u32x4*)(F.hs() + (size_t)(tab[rt0.z] * 256 + rt0.w) * D) + F.lane;
        u32x4* d10 = (u32x4*)(F.hs() + (size_t)(tab[rt1.x] * 256 + rt1.y) * D) + F.lane; u32x4* d11 = (u32x4*)(F.hs() + (size_t)(tab[rt1.z] * 256 + rt1.w) * D) + F.lane;
        d00[0] = a0; d00[64] = b0; d01[0] = a0; d01[64] = b0; d10[0] = a1; d10[64] = b1; d11[0] = a1; d11[64] = b1;
    }
}

__device__ __forceinline__ void p7_moe1_naive(Frame& F, int l) {
    for (long i = F.gt; i < (long)T * 2 * DE; i += F.ngt) {
        const int a = (int)(i >> 8), f = (int)(i & 255), tokr = a >> 1, wh = a & 1;
        const int e = F.route()[4 * tokr + 2 * wh], sl = F.route()[4 * tokr + 2 * wh + 1];
        const bf16* W = F.w1() + (size_t)(l * NE + e) * 512 * D; const int grow = (f >> 7) * 256 + (f & 127);
        const float g = dot_bf16(F.ha() + (size_t)tokr * D, W + (size_t)grow * D, D), u = dot_bf16(F.ha() + (size_t)tokr * D, W + (size_t)(grow + 128) * D, D);
        F.hid()[(size_t)(ybase_of(F, l, e) + sl) * DE + f] = (bf16)f2bf(F.wl()[e * CAP + sl] * silu_f(g) * u);
    }
}
__device__ __forceinline__ void p8_moe2_naive(Frame& F, int l) {
    for (long i = F.gt; i < (long)T * 2 * D; i += F.ngt) {
        const int a = (int)(i >> 10), n = (int)(i & 1023), tokr = a >> 1, wh = a & 1;
        const int e = F.route()[4 * tokr + 2 * wh], sl = F.route()[4 * tokr + 2 * wh + 1]; const size_t pr = (size_t)(ybase_of(F, l, e) + sl);
        F.y()[pr * D + n] = (bf16)f2bf(dot_bf16(F.hid() + pr * DE, F.w2() + ((size_t)(l * NE + e) * D + n) * DE, DE));
    }
}

__device__ __forceinline__ void p9_final(CPR p, Frame& F) {
    const int l = DEPTH - 1;
    const volatile LAS int* tab = (const volatile LAS int*)(F.lds + MOETAB_OFF);
    moe_table(F, l);
    for (int pi = F.gw; pi < TL / 2; pi += F.ngw) {
        int c0 = 4 * F.lane; asm volatile("" : "+v"(c0));
        const int r0 = 2 * pi;
        const bf16* y0[2]; const bf16* y1[2];
#pragma unroll
        for (int k = 0; k < 2; ++k) { const i32x4 rt = *(const i32x4*)(F.route() + 4 * (r0 + k));
            y0[k] = F.y() + (size_t)(tab[rt.x] * 256 + rt.y) * D + c0; y1[k] = F.y() + (size_t)(tab[rt.z] * 256 + rt.w) * D + c0; }
        f32x4 v[2][4]; u32x2 a[2][4], b[2][4];
#pragma unroll
        for (int k = 0; k < 2; ++k)
#pragma unroll
            for (int j = 0; j < 4; ++j) { v[k][j] = ld_bf4(F.xl() + (size_t)(r0 + k) * D + c0 + 256 * j); a[k][j] = *(const u32x2*)(y0[k] + 256 * j); b[k][j] = *(const u32x2*)(y1[k] + 256 * j); }
        const float* g5 = mod_vec(F, l, row_mod(r0), 5) + c0;
        float ss0 = 0.f, ss1 = 0.f;
#pragma unroll
        for (int j = 0; j < 4; ++j) { const f32x4 g = *(const f32x4*)(g5 + 256 * j); add_y4(v[0][j], g, a[0][j], b[0][j]); add_y4(v[1][j], g, a[1][j], b[1][j]); ss0 += sumsq4(v[0][j]); ss1 += sumsq4(v[1][j]); }
        f32x4 gq[4];
#pragma unroll
        for (int j = 0; j < 4; ++j) gq[j] = *(const f32x4*)(p.final_g + c0 + 256 * j);
        __builtin_amdgcn_sched_barrier(0);
        ss0 = wave_sum(ss0); ss1 = wave_sum(ss1);
        const float rs0 = rsqrtf(ss0 * (1.f / D) + EPS), rs1 = rsqrtf(ss1 * (1.f / D) + EPS);
#pragma unroll
        for (int j = 0; j < 4; ++j) { const f32x4 g = gq[j];
            *(f32x4*)(p.out + (size_t)r0 * D + c0 + 256 * j) = v[0][j] * rs0 * g; *(f32x4*)(p.out + (size_t)(r0 + 1) * D + c0 + 256 * j) = v[1][j] * rs1 * g; }
    }
}

template <int NBATCH> __device__ __forceinline__ f32x16 wave_tile_k(const bf16* wrow, const bf16* xrow) {
    f32x16 acc;
#pragma unroll
    for (int i = 0; i < 16; ++i) acc[i] = 0.f;
    bf16x8 a0[8], b0[8], a1[8], b1[8];
#pragma unroll
    for (int j = 0; j < 8; ++j) { a0[j] = *(const bf16x8*)(wrow + 512 * j); b0[j] = *(const bf16x8*)(xrow + 16 * j); }
#pragma unroll 1
    for (int bt = 0; bt < NBATCH; bt += 2) {
#pragma unroll
        for (int j = 0; j < 8; ++j) { a1[j] = *(const bf16x8*)(wrow + 4096 * (bt + 1) + 512 * j); b1[j] = *(const bf16x8*)(xrow + 128 * (bt + 1) + 16 * j); }
        __builtin_amdgcn_sched_barrier(0);
#pragma unroll
        for (int j = 0; j < 8; ++j) acc = __builtin_amdgcn_mfma_f32_32x32x16_bf16(a0[j], b0[j], acc, 0, 0, 0);
        __builtin_amdgcn_sched_barrier(0);
        if (bt + 2 < NBATCH) {
#pragma unroll
            for (int j = 0; j < 8; ++j) { a0[j] = *(const bf16x8*)(wrow + 4096 * (bt + 2) + 512 * j); b0[j] = *(const bf16x8*)(xrow + 128 * (bt + 2) + 16 * j); } }
        __builtin_amdgcn_sched_barrier(0);
#pragma unroll
        for (int j = 0; j < 8; ++j) acc = __builtin_amdgcn_mfma_f32_32x32x16_bf16(a1[j], b1[j], acc, 0, 0, 0);
        __builtin_amdgcn_sched_barrier(0);
    }
    return acc;
}
__device__ __forceinline__ void p2_inproj(CPR p, Frame& F, int l, int lc) {
    pg8::StaticOrder S; S.init(T, INP, D, (int)gridDim.x, (int)blockIdx.x); S.rdy = F.ctl() + CW_RDY2 + lc * 128 * 64; S.pub_from = 6; S.pn_rot = 2;
    pg8::EpiBf16 E{F.pl(), INP, true, T * INP * 2};
    pg8::gemm_phase<pg8::EpiBf16, pg8::StaticOrder, true>(F.lds, F.tid, F.ha(), F.win() + (size_t)l * INP * D, D, S, E);
    TMARK(101);
    if (l + 1 < DEPTH && blockIdx.x >= 32) convert_layer(p, F, l + 1, ((int)blockIdx.x - 32) * NWAVES + F.wave, ((int)gridDim.x - 32) * NWAVES);
    TMARK(102);
    p3_mla_up_queued(F, l, lc);
    TMARK(103);
}
__device__ __forceinline__ void p5_outproj(Frame& F, int l, float gsc = 1.f) {
    pg8::StaticOrder S; S.init(TL, D, D, (int)gridDim.x, (int)blockIdx.x);
    pg8::EpiResid E{F.xl(), D, F.mod() + (size_t)l * 5 * NMOD * D, gsc};
    pg8::gemm_phase<pg8::EpiResid, pg8::StaticOrder, true>(F.lds, F.tid, F.ml(), F.wout() + (size_t)l * D * D, D, S, E);
    TMARK(51);
    if (l + 1 < DEPTH) {
        const int tk = F.lane & 31, hh = F.lane >> 5, half = F.wave >> 2, wp = F.wave & 3;
        LAS float* xch = (LAS float*)(F.lds + wp * 4096);
        __syncthreads();
        for (int it0 = blockIdx.x * 4; it0 < (TC / 32) * (D / 32); it0 += gridDim.x * 4) {
            const int it = it0 + wp, rt = it / (D / 32), nt = it % (D / 32), row = TL + 32 * rt + tk;
            const f32x16 acc = wave_tile_k<4>(F.woutf() + (size_t)l * D * D + ((size_t)nt * 64 * 64 + 32 * half * 64 + F.lane) * 8, F.ml() + (size_t)row * D + 512 * half + 8 * hh);
            if (half) {
#pragma unroll
                for (int i = 0; i < 16; ++i) xch[i * 64 + F.lane] = acc[i]; }
            __syncthreads();
            if (!half) {
                bf16* o = F.xl() + (size_t)row * D + 32 * nt + 4 * hh; const float* gp = mod_vec(F, l, 4, 2) + 32 * nt + 4 * hh;
                f32x4 xv[4], gv[4];
#pragma unroll
                for (int g = 0; g < 4; ++g) { xv[g] = ld_bf4(o + 8 * g); gv[g] = *(const f32x4*)(gp + 8 * g) * gsc; }
#pragma unroll
                for (int g = 0; g < 4; ++g) { f32x4 x = xv[g];
                    x.x += gv[g].x * (acc[4 * g] + xch[(4 * g) * 64 + F.lane]); x.y += gv[g].y * (acc[4 * g + 1] + xch[(4 * g + 1) * 64 + F.lane]);
                    x.z += gv[g].z * (acc[4 * g + 2] + xch[(4 * g + 2) * 64 + F.lane]); x.w += gv[g].w * (acc[4 * g + 3] + xch[(4 * g + 3) * 64 + F.lane]); st_bf4(o + 8 * g, x); }
            }
            __syncthreads();
        }
    }
}
__device__ __forceinline__ void p7_moe1(Frame& F, int l, int lc) {
    moe_table(F, l);
    pg8::MoeOrder<true, 2, D, false, true> S{(const volatile LAS int*)(F.lds + MOETAB_OFF), F.tok(), (int)gridDim.x, (int)blockIdx.x, (size_t)512 * D * 2, (volatile LAS unsigned*)(F.lds + ROWTAB_OFF),
        nullptr, F.ctl() + CW_RDY + lc * 192 * 64, F.ctl() + CW_TMO, nullptr};
    pg8::EpiMoe1 E{F.hid(), F.wl()};
    pg8::gemm_phase<pg8::EpiMoe1, pg8::MoeOrder<true, 2, D, false, true>, true>(F.lds, F.tid, F.ha(), F.w1() + (size_t)l * NE * 512 * D, D, S, E);
}
__device__ __forceinline__ void p8_moe2(Frame& F, int l, int lc) {
    moe_table(F, l);
    pg8::MoeOrder<false, 4, DE, true, false> S{(const volatile LAS int*)(F.lds + MOETAB_OFF), F.tok(), (int)gridDim.x, (int)blockIdx.x, (size_t)D * DE * 2, nullptr,
        F.ctl() + CW_HEAD + lc * 64, F.ctl() + CW_RDY + lc * 192 * 64, F.ctl() + CW_TMO, (volatile LAS int*)(F.lds + DYNQ_OFF)};
    pg8::EpiBf16 E{F.y(), D};
    pg8::gemm_phase<pg8::EpiBf16, pg8::MoeOrder<false, 4, DE, true, false>, true>(F.lds, F.tid, F.hid(), F.w2() + (size_t)l * NE * D * DE, DE, S, E);
}

constexpr int PH_FINAL = 1 + 10 * DEPTH, N_PHASES = PH_FINAL + 1;
__global__ void __launch_bounds__(NTHR, 2) fwd(Params p) {
    extern __shared__ __attribute__((aligned(16))) unsigned char lds_raw[];
    Frame F;
    F.lds = (LAS unsigned char*)lds_raw;
    F.tid = threadIdx.x; F.lane = F.tid & 63; F.wave = __builtin_amdgcn_readfirstlane(F.tid >> 6);
    F.gw = blockIdx.x * NWAVES + F.wave; F.ngw = gridDim.x * NWAVES; F.gt = blockIdx.x * NTHR + F.tid; F.ngt = gridDim.x * NTHR;
    const __attribute__((address_space(4))) Params* KP = (const __attribute__((address_space(4))) Params*)__builtin_amdgcn_kernarg_segment_ptr();
    F.ws = KP->ws;
    volatile LAS unsigned* MISC = (volatile LAS unsigned*)(F.lds + MISC_OFF);
    for (int u = F.tid; u < 32; u += NTHR) MISC[u] = 0u;
    if (F.lane == 0) ((volatile LAS int*)(F.lds + WTAB_OFF))[__builtin_amdgcn_s_getreg((5 << 11) | 4) & 63] = F.wave;
    __syncthreads();
#if MK_ONE_LAUNCH
    (void)xcd_barrier_post(F.ctl() + CW_BAR, MISC + 8);
#define GRID_BAR() do { XcdBarrier b_; b_.bar = (unsigned*)(KP->ws + WS_CTL) + CW_BAR; b_.x = xb_xcc_id(); b_.st = (volatile LAS unsigned*)(F.lds + MISC_OFF) + 8; xcd_barrier(b_); } while (0)
#else
#define GRID_BAR() do {} while (0)
#endif
#define lo (KP->ph_lo)
#define hi (KP->ph_hi)
#define PB() do { asm volatile("" : "+s"(KP)); F.ws = KP->ws; int ln_; asm volatile("v_mbcnt_lo_u32_b32 %0, -1, 0\n\tv_mbcnt_hi_u32_b32 %0, -1, %0" : "=v"(ln_)); \
    F.wave = __builtin_amdgcn_readfirstlane(((volatile LAS int*)(F.lds + WTAB_OFF))[__builtin_amdgcn_s_getreg((5 << 11) | 4) & 63]); F.lane = ln_; const int t_ = F.wave * 64 + ln_; F.tid = t_; \
    F.gw = blockIdx.x * NWAVES + F.wave; F.gt = blockIdx.x * NTHR + t_; F.ngw = gridDim.x * NWAVES; F.ngt = gridDim.x * NTHR; } while (0)
#ifndef PH_MASK
#define PH_MASK 0xFFF
#endif
#define INK(k, kind) (((PH_MASK >> (kind)) & 1) && lo <= (k) && (k) < hi)
#define IN(k) (lo <= (k) && (k) < hi)
#define SEAM(k) do { if (IN((k) + 1)) { GRID_BAR(); if (PROBE_REP & 0x10000) { GRID_BAR(); GRID_BAR(); } } } while (0)
#ifndef PROBE_REP
#define PROBE_REP 0
#endif
#define RUNK(kind, body) do { PB(); body; if ((PROBE_REP >> (kind)) & 1) { PB(); body; } } while (0)
    TMARK(-2);
    if (INK(0, 9)) { RUNK(9, p0_prologue(*KP, F)); SEAM(0); TMARK(9); }
    for (int l = 0; l < DEPTH; ++l) {
        const int pb = 1 + 10 * l;
        if (INK(pb + 0, 0)) { PB(); p1_rows(*KP, F, l); if (PROBE_REP & 1) { GRID_BAR(); PB(); p1_rows(*KP, F, l, 0.f); } SEAM(pb + 0); TMARK(0); }
        if (INK(pb + 1, 1)) { PB(); if (FAST_GEMM & 1) p2_inproj(*KP, F, l, l); else p2_inproj_naive(F, l); if (PROBE_REP & (1 << 25)) { GRID_BAR(); PB(); p2_inproj(*KP, F, l, l + 4); } SEAM(pb + 1); TMARK(1); }
        if (INK(pb + 2, 2)) { if (!(FAST_GEMM & 1)) { PB(); p3_mla_up(F, l); SEAM(pb + 3); } }
        if (INK(pb + 4, 4)) {
#define ATTN_SLOT() do { PB(); if (FAST_MLA) p4_mla_flash<0>(F); else p4_mla_naive(F); TMARK(41); \
                              RUNK(13, { if (FAST_PS & 1) p3_pool_mfma(*KP, F, l); else p3_pool_naive(*KP, F, l); }); TMARK(42); \
                              RUNK(14, { if (FAST_PS & 2) p3_sgu_mfma(*KP, F, l); else p3_sgu1_naive(*KP, F, l); }); TMARK(43); RUNK(15, { if (FAST_NA) p3_na_mfma(*KP, F, l); else p3_na_naive(*KP, F, l); }); TMARK(44); } while (0)
                              ATTN_SLOT();
                              if ((PROBE_REP >> 20) & 15) { PB(); p4_mla_flash<(PROBE_REP >> 20) & 15>(F); }
                              if (PROBE_REP & (1 << 24)) { GRID_BAR(); ATTN_SLOT(); }
                              if (!(FAST_PS & 2)) { GRID_BAR(); PB(); p3_sgu2_naive(*KP, F, l); } SEAM(pb + 4); TMARK(4); }
        if (INK(pb + 5, 5)) { PB(); if (FAST_GEMM & 2) p5_outproj(F, l); else p5_outproj_naive(F, l); if (PROBE_REP & 32) { GRID_BAR(); PB(); p5_outproj(F, l, 0.f); } SEAM(pb + 5); TMARK(5); }
        if (INK(pb + 6, 6)) { PB(); p6_rows(*KP, F, l); if (PROBE_REP & 64) { PB(); p6_rows(*KP, F, l, false); } SEAM(pb + 6); TMARK(6); }
        if (INK(pb + 7, 11)) { if (!(FAST_GEMM & 4)) {} }
        if (INK(pb + 8, 7)) { PB(); p7_moe1(F, l, l); TMARK(71); PB(); p8_moe2(F, l, l); TMARK(72); if (PROBE_REP & (1 << 26)) { GRID_BAR(); PB(); p7_moe1(F, l, l + 4); PB(); p8_moe2(F, l, l + 4); } SEAM(pb + 9); TMARK(7); }
    }
    if (INK(PH_FINAL, 10)) { PB(); p9_final(*KP, F); TMARK(10); }
    if (PROBE_T >= 0 && blockIdx.x == PROBE_BLK && threadIdx.x == 0) {
        volatile LAS unsigned* M_ = (volatile LAS unsigned*)(F.lds + MISC_OFF) + 16; const unsigned t0_ = (unsigned)wall_clock64(), w_ = M_[1] * (unsigned)PROBE_TMUL;
        while ((unsigned)wall_clock64() - t0_ < w_) __builtin_amdgcn_s_sleep(8);
    }
}

extern "C" void kernel_launch(void* const* d_in, const int* in_sizes, int n_in, void* d_out, int out_size, void* d_ws, size_t ws_size, hipStream_t stream) {
    static int grid = 0;
    if (grid == 0) {
        if (n_in != 26 || out_size != TL * D || ws_size < WS_END) { fprintf(stderr, "kernel_launch: unexpected shapes: n_in %d out %d ws %zu (need %zu)\n", n_in, out_size, ws_size, (size_t)WS_END); grid = -1; return; }
        int dev = 0, cus = 0, per_cu = 0;
        if (hipGetDevice(&dev) != hipSuccess || hipDeviceGetAttribute(&cus, hipDeviceAttributeMultiprocessorCount, dev) != hipSuccess) { grid = -1; return; }
        if (hipFuncSetAttribute((const void*)fwd, hipFuncAttributeMaxDynamicSharedMemorySize, LDS_BYTES) != hipSuccess) { fprintf(stderr, "kernel_launch: hipFuncSetAttribute failed\n"); grid = -1; return; }
        if (hipOccupancyMaxActiveBlocksPerMultiprocessor(&per_cu, (const void*)fwd, NTHR, LDS_BYTES) != hipSuccess || per_cu < 1) fprintf(stderr, "kernel_launch: occupancy query says %d\n", per_cu);
        (void)hipGetLastError();
        if (cus < 128) { fprintf(stderr, "kernel_launch: %d CUs: the row phases are sized for at least 128 workgroups\n", cus); grid = -1; return; }
        grid = cus;
    }
    if (grid < 0) return;
    (void)hipMemsetAsync((char*)d_ws + WS_CTL, 0, CTL_ZERO_BYTES, stream);
    Params p{};
    const float** pp = (const float**)&p;
    for (int i = 0; i < 26; ++i) pp[i] = (const float*)d_in[i];
    p.out = (float*)d_out; p.ws = (unsigned char*)d_ws;
#if MK_ONE_LAUNCH
    p.ph_lo = 0; p.ph_hi = N_PHASES;
    hipLaunchKernelGGL(fwd, dim3(grid), dim3(NTHR), LDS_BYTES, stream, p);
#else
    for (int ph = 0; ph < N_PHASES; ++ph) {
        p.ph_lo = ph; p.ph_hi = ph + 1;
        hipLaunchKernelGGL(fwd, dim3(grid), dim3(NTHR), LDS_BYTES, stream, p);
    }
#endif
}
```

```cpp
#include <hip/hip_runtime.h>
#include <cstdio>
#include <cstdint>

#ifndef MK_ONE_LAUNCH
#define MK_ONE_LAUNCH 1
#endif

#ifndef FAST_NA
#define FAST_NA 1
#endif
#ifndef FAST_UP
#define FAST_UP 1
#endif
#ifndef FAST_PS
#define FAST_PS 3
#endif
#ifndef FAST_MLA
#define FAST_MLA 1
#endif
#ifndef FAST_GEMM
#define FAST_GEMM 0xF
#endif

#define GAS __attribute__((address_space(1)))
#define LAS __attribute__((address_space(3)))
typedef unsigned short bf16;
typedef float f32x4 __attribute__((ext_vector_type(4)));
typedef unsigned u32x4 __attribute__((ext_vector_type(4)));
typedef unsigned u32x2 __attribute__((ext_vector_type(2)));
typedef int i32x4 __attribute__((ext_vector_type(4)));
typedef int i32x2 __attribute__((ext_vector_type(2)));
typedef short bf16x8 __attribute__((ext_vector_type(8)));

constexpr int D = 1024, NB = 4, SEQ = 4096, DEPTH = 4, CTX = 256, GW = 64, GH = 64;
constexpr int TL = NB * SEQ, TC = NB * CTX, T = TL + TC;
constexpr int INW = 1952, INP = 2048;
constexpr int OFF_B = 256, OFF_C = 1024, OFF_D = 1536;
constexpr int NE = 16, DE = 256, CAP = T;
constexpr int RPAD = 2 * T + NE * 256;
constexpr int NMOD = 6;
constexpr float EPS = 1e-6f;
constexpr float LOG2E = 1.4426950408889634f;
constexpr float MLA_SCALE = 0.10206207261596575f;
constexpr int NWAVES = 8, NTHR = NWAVES * 64;

constexpr size_t MiB = 1u << 20;
constexpr size_t WS_CTL = 0, CTL_ZERO_BYTES = 1 * MiB;
constexpr size_t WS_MOD = 1 * MiB;
constexpr size_t WS_ROPE = 2 * MiB;
constexpr size_t WS_RWT = 2 * MiB + 768 * 1024;
constexpr size_t WS_ROUTE = 3 * MiB;
constexpr size_t WS_TOK = 4 * MiB;
constexpr size_t WS_WL = 6 * MiB;
constexpr size_t WS_WUQ = 8 * MiB;
constexpr size_t WS_WUKV = 9 * MiB;
constexpr size_t WS_POOLW = 10 * MiB;
constexpr size_t WS_SGUW = 10 * MiB + 512 * 1024;
constexpr size_t WS_WIN = 12 * MiB;
constexpr size_t WS_WOUT = 28 * MiB;
constexpr size_t WS_W1 = 36 * MiB;
constexpr size_t WS_W2 = 100 * MiB;
constexpr size_t WS_XL = 132 * MiB;
constexpr size_t WS_HA = 200 * MiB;
constexpr size_t WS_PL = 234 * MiB;
constexpr size_t WS_Y = 234 * MiB;
constexpr size_t WS_HS = WS_Y;
constexpr size_t WS_QM = 302 * MiB;
constexpr size_t WS_KM = 315 * MiB;
constexpr size_t WS_VM = 328 * MiB;
constexpr size_t WS_ML = 337 * MiB;
constexpr size_t WS_HID = 371 * MiB;
constexpr size_t WS_WOUTF = 390 * MiB;
constexpr size_t WS_END = 398 * MiB;
static_assert(WS_Y + (size_t)RPAD * D * 2 <= WS_KM && WS_HID + (size_t)RPAD * DE * 2 <= WS_END, "ws map");

constexpr int CW_TMO = 0;
constexpr int CW_BAR = 4096;
constexpr int CW_HEAD = 12288;
constexpr int CW_RDY = 131072;
constexpr int CW_HEAD2 = 13312;
constexpr int CW_RDY2 = 32768;
constexpr int CW_CNT = 8192;

constexpr int LDS_BYTES = 147456;
constexpr int MISC_OFF = 131072 + 320;
constexpr int WTAB_OFF = 131072 + 512;
constexpr int DYNQ_OFF = 131072 + 4096;
constexpr int ROWTAB_OFF = 131072 + 2048;
constexpr int MOETAB_OFF = 131072 + 1024;

__device__ __forceinline__ float bf2f(bf16 v) { return __uint_as_float(((unsigned)v) << 16); }
__device__ __forceinline__ unsigned f2bf(float f) { unsigned u = __float_as_uint(f); return (u + 0x7fffu + ((u >> 16) & 1u)) >> 16; }
typedef __bf16 hwbf2 __attribute__((ext_vector_type(2)));
typedef float hwf2 __attribute__((ext_vector_type(2)));
__device__ __forceinline__ unsigned pk2(float lo, float hi) { hwf2 v; v.x = lo; v.y = hi; return __builtin_bit_cast(unsigned, __builtin_convertvector(v, hwbf2)); }
template <int X> __device__ __forceinline__ float lane_xor(float v) {
    static_assert(X >= 1 && X <= 16, "xor 32: xsum32 / xmax32 / other32");
    return __builtin_bit_cast(float, __builtin_amdgcn_ds_swizzle(__builtin_bit_cast(int, v), (X << 10) | 0x1F));
}
__device__ __forceinline__ float xsum32(float v) { const auto rr = __builtin_amdgcn_permlane32_swap(__float_as_uint(v), __float_as_uint(v), false, false); return __uint_as_float(rr[0]) + __uint_as_float(rr[1]); }
__device__ __forceinline__ float xmax32(float v) { const auto rr = __builtin_amdgcn_permlane32_swap(__float_as_uint(v), __float_as_uint(v), false, false); return fmaxf(__uint_as_float(rr[0]), __uint_as_float(rr[1])); }
__device__ __forceinline__ float other32(float v) { const auto rr = __builtin_amdgcn_permlane32_swap(__float_as_uint(v), __float_as_uint(v), false, false);
    const unsigned a = rr[0], b = rr[1]; return __uint_as_float((a ^ b) ^ __float_as_uint(v)); }
__device__ __forceinline__ float wave_sum(float v) { v += lane_xor<1>(v); v += lane_xor<2>(v); v += lane_xor<4>(v); v += lane_xor<8>(v); v += lane_xor<16>(v); return xsum32(v); }
__device__ __forceinline__ float wave_max(float v) { v = fmaxf(v, lane_xor<1>(v)); v = fmaxf(v, lane_xor<2>(v)); v = fmaxf(v, lane_xor<4>(v)); v = fmaxf(v, lane_xor<8>(v)); v = fmaxf(v, lane_xor<16>(v)); return xmax32(v); }
__device__ __forceinline__ float silu_f(float x) { return x / (1.f + __expf(-x)); }
__device__ __forceinline__ float gelu_tanh(float x) { const float u = 1.5957691216057308f * (x + 0.044715f * x * x * x); return x / (1.f + __expf(-u)); }
__device__ __forceinline__ float dot_bf16(const bf16* a, const bf16* b, int K) {
    float s = 0.f;
    for (int k = 0; k < K; k += 8) {
        const u32x4 av = *(const u32x4*)(a + k), bv = *(const u32x4*)(b + k);
#pragma unroll
        for (int j = 0; j < 4; ++j) {
            s += __uint_as_float(av[j] << 16) * __uint_as_float(bv[j] << 16);
            s += __uint_as_float(av[j] & 0xffff0000u) * __uint_as_float(bv[j] & 0xffff0000u);
        }
    }
    return s;
}
#define LDS_WAIT() asm volatile("s_waitcnt lgkmcnt(0)" ::: "memory")

#define XB_TMO      128
#define XB_XCNT(j)  (256  + 64 * (j))
#define XB_XSUB(j)  (1280 + 64 * (j))
#define XB_XGEN(j)  (2304 + 64 * (j))
#define XB_TOP      3328
#define XB_TOPGEN   3392
#define XCD_BAR_WORDS 3456
#define XB_SPIN_CAP (1u << 18)
__device__ __forceinline__ unsigned xb_ld(unsigned* p)              { return __hip_atomic_load(p, __ATOMIC_RELAXED, __HIP_MEMORY_SCOPE_AGENT); }
__device__ __forceinline__ unsigned xb_add(unsigned* p, unsigned v) { return __hip_atomic_fetch_add(p, v, __ATOMIC_RELAXED, __HIP_MEMORY_SCOPE_AGENT); }
__device__ __forceinline__ unsigned xb_xcc_id() { return (unsigned)__builtin_amdgcn_s_getreg((3 << 11) | 20) & 0xFu; }
#define XB_SPIN(cond, bar) do { unsigned _sp = 0; while (cond) { __builtin_amdgcn_s_sleep(1); \
    if ((++_sp & 255u) == 0u) { if (xb_ld(&(bar)[XB_TMO])) break; if (_sp > XB_SPIN_CAP) { atomicAdd(&(bar)[XB_TMO], 1u); break; } } } } while (0)
struct XcdBarrier { unsigned* bar; unsigned x; volatile LAS unsigned* st; };
__device__ __forceinline__ XcdBarrier xcd_barrier_post(unsigned* bar, volatile LAS unsigned* st) {
    XcdBarrier b; b.bar = bar; b.x = xb_xcc_id(); b.st = st;
    if (threadIdx.x == 0) (void)xb_add(&bar[XB_XCNT(b.x)], 1u);
    return b;
}
__device__ __forceinline__ void xcd_barrier_complete(unsigned* bar, unsigned x, unsigned& nloc, unsigned& nx) {
    const unsigned G = gridDim.x * gridDim.y * gridDim.z;
    unsigned sum, cnt, mine, sp = 0u;
    for (;;) {
        sum = 0u; cnt = 0u; mine = 0u;
#pragma unroll
        for (unsigned j = 0; j < 16; ++j) { const unsigned c = xb_ld(&bar[XB_XCNT(j)]); sum += c; cnt += (c > 0u) ? 1u : 0u; mine = (j == x) ? c : mine; }
        if (sum == G) break;
        __builtin_amdgcn_s_sleep(1);
        if ((++sp & 255u) == 0u) { if (xb_ld(&bar[XB_TMO])) break; if (sp > XB_SPIN_CAP) { atomicAdd(&bar[XB_TMO], 1u); break; } }
    }
    nloc = mine > 0u ? mine : 1u; nx = cnt > 0u ? cnt : 1u;
}
__device__ __forceinline__ void xcd_barrier(const XcdBarrier& b) {
    asm volatile("s_waitcnt vmcnt(0)" ::: "memory");
    __syncthreads();
    if (threadIdx.x == 0) {
        unsigned* bar = b.bar;
        __builtin_amdgcn_s_waitcnt(0);
        unsigned nloc = b.st[0], nx = b.st[1];
        if (nloc == 0u) { xcd_barrier_complete(bar, b.x, nloc, nx); b.st[0] = nloc; b.st[1] = nx; }
        const unsigned old = xb_add(&bar[XB_XSUB(b.x)], 1u);
        const unsigned gen = old / nloc;
        if (old + 1u == (gen + 1u) * nloc) {
            __builtin_amdgcn_fence(__ATOMIC_RELEASE, "agent");
            asm volatile("s_waitcnt vmcnt(0)" ::: "memory");
            const unsigned og = xb_add(&bar[XB_TOP], 1u);
            const unsigned tg = og / nx;
            if (og + 1u == (tg + 1u) * nx) xb_add(&bar[XB_TOPGEN], 1u);
            else XB_SPIN(xb_ld(&bar[XB_TOPGEN]) == tg, bar);
            __builtin_amdgcn_fence(__ATOMIC_ACQUIRE, "agent");
            xb_add(&bar[XB_XGEN(b.x)], 1u);
            asm volatile("s_waitcnt vmcnt(0)" ::: "memory");
        } else {
            XB_SPIN(xb_ld(&bar[XB_XGEN(b.x)]) == gen, bar);
            __builtin_amdgcn_fence(__ATOMIC_ACQUIRE, "agent");
            asm volatile("s_waitcnt vmcnt(0)" ::: "memory");
        }
    }
    __syncthreads();
}

struct Params {
    const float *x, *c, *ctx, *c_ctx, *ada_w, *ada_b, *norm1_g, *norm2_g, *w_in, *w_out, *pool_w, *pool_s, *na_rpb,
                *sgu_norm_g, *sgu_w, *sgu_b, *mla_q_norm_g, *mla_w_uq, *mla_kv_norm_g, *mla_w_ukv,
                *router_w, *router_b, *moe_w_gate, *moe_w_up, *moe_w_down, *final_g;
    float* out; unsigned char* ws; int ph_lo, ph_hi;
};
typedef const __attribute__((address_space(4))) Params& CPR;
struct Frame {
    LAS unsigned char* lds; unsigned char* ws;
    int tid, lane, wave, gw, ngw, gt, ngt;
    __device__ __forceinline__ unsigned* ctl() const { return (unsigned*)(ws + WS_CTL); }
    __device__ __forceinline__ float* mod() const { return (float*)(ws + WS_MOD); }
    __device__ __forceinline__ float* ropec() const { return (float*)(ws + WS_ROPE); }
    __device__ __forceinline__ float* ropes() const { return (float*)(ws + WS_ROPE) + SEQ * 16; }
    __device__ __forceinline__ bf16* rwf() const { return (bf16*)(ws + WS_RWT); }
    __device__ __forceinline__ int* route() const { return (int*)(ws + WS_ROUTE); }
    __device__ __forceinline__ int* tok() const { return (int*)(ws + WS_TOK); }
    __device__ __forceinline__ float* wl() const { return (float*)(ws + WS_WL); }
    __device__ __forceinline__ bf16* wuq() const { return (bf16*)(ws + WS_WUQ); }
    __device__ __forceinline__ bf16* wukv() const { return (bf16*)(ws + WS_WUKV); }
    __device__ __forceinline__ bf16* poolw() const { return (bf16*)(ws + WS_POOLW); }
    __device__ __forceinline__ bf16* sguw() const { return (bf16*)(ws + WS_SGUW); }
    __device__ __forceinline__ bf16* win() const { return (bf16*)(ws + WS_WIN); }
    __device__ __forceinline__ bf16* wout() const { return (bf16*)(ws + WS_WOUT); }
    __device__ __forceinline__ bf16* woutf() const { return (bf16*)(ws + WS_WOUTF); }
    __device__ __forceinline__ bf16* w1() const { return (bf16*)(ws + WS_W1); }
    __device__ __forceinline__ bf16* w2() const { return (bf16*)(ws + WS_W2); }
    __device__ __forceinline__ bf16* ha() const { return (bf16*)(ws + WS_HA); }
    __device__ __forceinline__ bf16* pl() const { return (bf16*)(ws + WS_PL); }
    __device__ __forceinline__ bf16* y() const { return (bf16*)(ws + WS_Y); }
    __device__ __forceinline__ bf16* hs() const { return (bf16*)(ws + WS_HS); }
    __device__ __forceinline__ bf16* qm() const { return (bf16*)(ws + WS_QM); }
    __device__ __forceinline__ bf16* km() const { return (bf16*)(ws + WS_KM); }
    __device__ __forceinline__ bf16* vm() const { return (bf16*)(ws + WS_VM); }
    __device__ __forceinline__ bf16* ml() const { return (bf16*)(ws + WS_ML); }
    __device__ __forceinline__ bf16* hid() const { return (bf16*)(ws + WS_HID); }
    __device__ __forceinline__ bf16* xl() const { return (bf16*)(ws + WS_XL); }
};
#ifndef PROBE_T
#define PROBE_T (-1)
#endif
#ifndef PROBE_TMUL
#define PROBE_TMUL 8
#endif
#ifndef PROBE_BLK
#define PROBE_BLK 0
#endif
#define TMARK(kind) do { if (PROBE_T >= 0 && blockIdx.x == PROBE_BLK && threadIdx.x == 0) { volatile LAS unsigned* M_ = (volatile LAS unsigned*)(F.lds + MISC_OFF) + 16; const unsigned now_ = (unsigned)wall_clock64(); \
    if ((kind) == PROBE_T) M_[1] += now_ - M_[0]; M_[0] = now_; } } while (0)
__device__ __forceinline__ int row_batch(int r) { return r < TL ? (r >> 12) : ((r - TL) >> 8); }
__device__ __forceinline__ int row_mod(int r) { return r < TL ? (r >> 12) : 4; }
__device__ __forceinline__ const float* mod_vec(const Frame& F, int l, int mr, int k) { return F.mod() + ((size_t)(l * 5 + mr) * NMOD + k) * D; }

namespace pg8 {
constexpr int BM = 256, BK = 64, HALF = 128, HTB = HALF * BK * 2, NXCD = 8, WGM = 8;
__host__ __device__ __forceinline__ int lds_byte(int r, int c) { const int st = (r >> 4) * 2 + (c >> 5), rr = r & 15, cc = c & 31, ob = rr * 64 + cc * 2; return st * 1024 + (ob ^ (((ob >> 9) & 1) << 5)); }
__host__ __device__ __forceinline__ void stage_rc(int b, int& R, int& C) { const int st = b / 1024, sb = b % 1024, swz = sb ^ (((sb >> 9) & 1) << 5); R = (st >> 1) * 16 + swz / 64; C = (st & 1) * 32 + (swz % 64) / 2; }
__host__ __device__ __forceinline__ int perm32(int rho) { const int n = rho >> 4, i = rho & 15; return 8 * (i >> 2) + 4 * n + (i & 3); }
struct Unit { int pm, pn, ex, slot0, cnt; };
struct StaticOrder {
    static constexpr bool GATHER = false;
    int nM, nN, nwg, G, c, K;
    unsigned* rdy = nullptr; int pub_from = 0;
    int pn_rot = 0;
    __device__ __forceinline__ void init(int M, int N, int K_, int G_, int c_) { nM = M / BM; nN = N / BM; nwg = nM * nN; G = G_; c = c_; K = K_; }
    __device__ __forceinline__ bool next(int i, Unit& u) const {
        const long L = (long)i * G + c; if (L >= nwg) return false;
        int wgid = (int)L; { const int q = nwg / NXCD, r = nwg % NXCD, xcd = wgid % NXCD, off = wgid / NXCD; wgid = (xcd < r ? xcd * (q + 1) : r * (q + 1) + (xcd - r) * q) + off; }
        const int nig = WGM * nN, gid = wgid / nig, fm = gid * WGM, gsz = (nM - fm) < WGM ? (nM - fm) : WGM;
        u.pm = fm + ((wgid % nig) % gsz); u.pn = (wgid % nig) / gsz + pn_rot; if (u.pn >= nN) u.pn -= nN; u.ex = 0; u.slot0 = 0; u.cnt = 256; return true;
    }
    __device__ __forceinline__ size_t a_off(const Unit& u) const { return (size_t)u.pm * 256 * K * 2; }
    __device__ __forceinline__ size_t b_off(const Unit& u) const { return (size_t)u.pn * 256 * K * 2; }
    __device__ __forceinline__ unsigned row_off(const Unit&, int, int) const { return 0u; }
    __device__ __forceinline__ void fill(const Unit&, int, int) const {}
    __device__ __forceinline__ void begin(int) const {}
    __device__ __forceinline__ void a_ready(const Unit&, int) const {}
    __device__ __forceinline__ void done(const Unit& u, int lane) const {
        if (rdy && u.pn >= pub_from) { asm volatile("s_waitcnt vmcnt(0)" ::: "memory"); if (lane == 0) (void)__hip_atomic_fetch_add(rdy + 64 * u.pm, 1u, __ATOMIC_RELAXED, __HIP_MEMORY_SCOPE_AGENT); } }
};
template <bool GATHER_, int NPN, int KK, bool DYN_ = false, bool PUB_ = false>
struct MoeOrder {
    static constexpr bool GATHER = GATHER_;
    const volatile LAS int* tab; const int* tok; int G, c; size_t bstride;
    volatile LAS unsigned* rtab;
    unsigned* head; unsigned* rdy; unsigned* tmo; volatile LAS int* dq;
    __device__ __forceinline__ void begin(int tid) const {
        if constexpr (DYN_) { if (tid == 0) { dq[0] = (int)__hip_atomic_fetch_add(head, 1u, __ATOMIC_RELAXED, __HIP_MEMORY_SCOPE_AGENT); dq[1] = (int)__hip_atomic_fetch_add(head, 1u, __ATOMIC_RELAXED, __HIP_MEMORY_SCOPE_AGENT); }
            __syncthreads(); } }
    __device__ __forceinline__ void a_ready(const Unit& u, int tid) const {
        if constexpr (DYN_) {
            if (tid < 64) { unsigned spins = 0;
                while ((unsigned)__builtin_amdgcn_readfirstlane(__hip_atomic_load(rdy + 64 * u.pm, __ATOMIC_RELAXED, __HIP_MEMORY_SCOPE_AGENT)) < 16u) {
                    __builtin_amdgcn_s_sleep(2);
                    if (++spins > (1u << 20)) { if (tid == 0) __hip_atomic_store(tmo, 1u, __ATOMIC_RELAXED, __HIP_MEMORY_SCOPE_AGENT); break; } }
                __builtin_amdgcn_fence(__ATOMIC_ACQUIRE, "agent");
                asm volatile("s_waitcnt vmcnt(0)" ::: "memory"); }
            asm volatile("" ::: "memory"); __builtin_amdgcn_s_barrier(); asm volatile("" ::: "memory"); } }
    __device__ __forceinline__ void done(const Unit& u, int lane) const {
        if constexpr (PUB_) { asm volatile("s_waitcnt vmcnt(0)" ::: "memory"); if (lane == 0) (void)__hip_atomic_fetch_add(rdy + 64 * u.pm, 1u, __ATOMIC_RELAXED, __HIP_MEMORY_SCOPE_AGENT); } }
    __device__ __forceinline__ bool next(int i, Unit& u) const {
        int L;
        if constexpr (DYN_) { L = dq[i & 1]; if (i >= 1 && threadIdx.x == 0) dq[(i + 1) & 1] = (int)__hip_atomic_fetch_add(head, 1u, __ATOMIC_RELAXED, __HIP_MEMORY_SCOPE_AGENT); }
        else L = i * G + c;
        const int nt = tab[16]; if (L >= nt * NPN) return false;
        const int ti = L / NPN; u.pm = ti; u.pn = L % NPN; const int e = tab[64 + ti];
        u.ex = e; u.slot0 = (ti - tab[e]) * 256; const int rem = tab[32 + e] - u.slot0; u.cnt = rem < 256 ? rem : 256; return true;
    }
    __device__ __forceinline__ size_t a_off(const Unit& u) const { return GATHER_ ? 0 : (size_t)u.pm * 256 * KK * 2; }
    __device__ __forceinline__ size_t b_off(const Unit& u) const { return (size_t)u.ex * bstride + (size_t)u.pn * 256 * KK * 2; }
    __device__ __forceinline__ unsigned row_off(const Unit&, int ui, int R) const { return rtab[(ui & 1) * 256 + R]; }
    __device__ __forceinline__ void fill(const Unit& u, int ui, int tid) const {
        if (GATHER_ && tid < 256) { const int rr = tid < u.cnt ? tid : u.cnt - 1; rtab[(ui & 1) * 256 + tid] = (unsigned)tok[u.ex * CAP + u.slot0 + rr] * (unsigned)(KK * 2); } }
};
__device__ __forceinline__ unsigned cvt_pk_bf16(float lo, float hi) { unsigned r; asm volatile("v_cvt_pk_bf16_f32 %0, %1, %2" : "=v"(r) : "v"(lo), "v"(hi)); return r; }
struct EpiBf16 {
    static constexpr bool PERM = true;
    bf16* O; int ldc; bool wt = false; int nbytes = 0;
    __device__ __forceinline__ void operator()(const f32x4 (&acc)[2][2][4][2], const Unit& u, int wr, int wc, int fr, int fq) const {
        asm volatile("" : "+v"(fr), "+v"(fq));
        const int row0 = u.pm * BM + wr * 64 + fr, col0 = u.pn * BM + wc * 32 + 8 * fq;
        const __amdgpu_buffer_rsrc_t rs = __builtin_amdgcn_make_buffer_rsrc((void*)O, 0, nbytes, 0x00020000);
#pragma unroll
        for (int ai = 0; ai < 2; ++ai)
#pragma unroll
            for (int m = 0; m < 4; ++m) { const size_t eo = (size_t)(row0 + ai * HALF + m * 16) * ldc + col0; bf16* rowp = O + eo;
#pragma unroll
                for (int bj = 0; bj < 2; ++bj) { const f32x4 v0 = acc[ai][bj][m][0], v1 = acc[ai][bj][m][1];
                    u32x4 w; w.x = cvt_pk_bf16(v0[0], v0[1]); w.y = cvt_pk_bf16(v0[2], v0[3]); w.z = cvt_pk_bf16(v1[0], v1[1]); w.w = cvt_pk_bf16(v1[2], v1[3]);
                    if (wt) __builtin_amdgcn_raw_buffer_store_b128(w, rs, (int)((eo + bj * HALF) * 2), 0, 16); else *(u32x4*)(rowp + bj * HALF) = w; } }
    }
};
struct EpiResid {
    static constexpr bool PERM = true;
    bf16* X; int ldc; const float* modl; float gsc;
    __device__ __forceinline__ void operator()(const f32x4 (&acc)[2][2][4][2], const Unit& u, int wr, int wc, int fr, int fq) const {
        asm volatile("" : "+v"(fr), "+v"(fq));
        const int row0 = u.pm * BM + wr * 64 + fr, col0 = u.pn * BM + wc * 32 + 8 * fq;
        const int mr = row_mod(u.pm * BM); const float* gp = modl + (size_t)(mr * NMOD + 2) * D + col0;
        f32x4 gv[2][2];
#pragma unroll
        for (int bj = 0; bj < 2; ++bj)
#pragma unroll
            for (int n = 0; n < 2; ++n) gv[bj][n] = *(const f32x4*)(gp + bj * HALF + n * 4) * gsc;
#pragma unroll
        for (int ai = 0; ai < 2; ++ai)
#pragma unroll
            for (int m = 0; m < 4; ++m) { bf16* rowp = X + (size_t)(row0 + ai * HALF + m * 16) * ldc + col0;
                u32x4 xv[2];
#pragma unroll
                for (int bj = 0; bj < 2; ++bj) xv[bj] = *(const u32x4*)(rowp + bj * HALF);
#pragma unroll
                for (int bj = 0; bj < 2; ++bj) { const f32x4 a0 = acc[ai][bj][m][0], a1 = acc[ai][bj][m][1]; u32x4 w;
                    w.x = cvt_pk_bf16(__uint_as_float(xv[bj].x << 16) + gv[bj][0].x * a0[0], __uint_as_float(xv[bj].x & 0xffff0000u) + gv[bj][0].y * a0[1]);
                    w.y = cvt_pk_bf16(__uint_as_float(xv[bj].y << 16) + gv[bj][0].z * a0[2], __uint_as_float(xv[bj].y & 0xffff0000u) + gv[bj][0].w * a0[3]);
                    w.z = cvt_pk_bf16(__uint_as_float(xv[bj].z << 16) + gv[bj][1].x * a1[0], __uint_as_float(xv[bj].z & 0xffff0000u) + gv[bj][1].y * a1[1]);
                    w.w = cvt_pk_bf16(__uint_as_float(xv[bj].w << 16) + gv[bj][1].z * a1[2], __uint_as_float(xv[bj].w & 0xffff0000u) + gv[bj][1].w * a1[3]);
                    *(u32x4*)(rowp + bj * HALF) = w; } }
    }
};
struct EpiMoe1 {
    static constexpr bool PERM = true;
    bf16* H; const float* wl;
    __device__ __forceinline__ void operator()(const f32x4 (&acc)[2][2][4][2], const Unit& u, int wr, int wc, int fr, int fq) const {
        asm volatile("" : "+v"(fr), "+v"(fq));
        const int lrow0 = wr * 64 + fr, f0 = u.pn * HALF + wc * 32 + 8 * fq;
        const __amdgpu_buffer_rsrc_t rs = __builtin_amdgcn_make_buffer_rsrc((void*)H, 0, RPAD * DE * 2, 0x00020000);
        float wv[2][4];
#pragma unroll
        for (int ai = 0; ai < 2; ++ai)
#pragma unroll
            for (int m = 0; m < 4; ++m) { const int lr = lrow0 + ai * HALF + m * 16; wv[ai][m] = (lr < u.cnt) ? wl[(size_t)u.ex * CAP + u.slot0 + lr] : 0.f; }
        __builtin_amdgcn_sched_barrier(0);
#pragma unroll
        for (int ai = 0; ai < 2; ++ai)
#pragma unroll
            for (int m = 0; m < 4; ++m) { const int lr = lrow0 + ai * HALF + m * 16;
                const float w = wv[ai][m];
                float o[8];
#pragma unroll
                for (int n = 0; n < 2; ++n)
#pragma unroll
                    for (int i = 0; i < 4; ++i) { const float g = acc[ai][0][m][n][i], up = acc[ai][1][m][n][i]; o[4 * n + i] = (lr < u.cnt) ? w * (g / (1.f + __expf(-g))) * up : 0.f; }
                u32x4 pk; pk.x = cvt_pk_bf16(o[0], o[1]); pk.y = cvt_pk_bf16(o[2], o[3]); pk.z = cvt_pk_bf16(o[4], o[5]); pk.w = cvt_pk_bf16(o[6], o[7]);
                __builtin_amdgcn_raw_buffer_store_b128(pk, rs, (int)(((u.pm * BM + lr) * DE + f0) * 2), 0, 16); }
    }
};

template <class Epi, class Sched, bool ALIGN_EPI>
__device__ __forceinline__ void gemm_phase(LAS unsigned char* lds, const int tid, const bf16* Abase, const bf16* Bbase, const int K, const Sched& S, const Epi& E) {
    constexpr bool GA = Sched::GATHER;
    const int wid = __builtin_amdgcn_readfirstlane(tid >> 6), lane = tid & 63, wr = wid >> 2, wc = wid & 3, fr = lane & 15, fq = lane >> 4;
    const int nt = K / BK;
    unsigned voffA[2], voffB[2]; int Rst, Cst;
#pragma unroll
    for (int i = 0; i < 2; ++i) { int R, C; stage_rc(tid * 16 + i * 8192, R, C); const int Rb = Epi::PERM ? ((R & ~31) + perm32(R & 31)) : R;
        voffA[i] = (unsigned)(R * K + C) * 2u; voffB[i] = (unsigned)(Rb * K + C) * 2u; if (i == 0) { Rst = R; Cst = C; } }
    const size_t kstep = (size_t)(BK * 2);
    const size_t hstep = (size_t)HALF * K * 2;
    const size_t hstepA = GA ? 0 : hstep;
    const unsigned ldsw = (unsigned)wid * 1024u;
    const int aoff = lds_byte(wr * 64 + fr, fq * 8), boff = lds_byte(wc * 32 + fr, fq * 8);
#define PG8_SA(b, h) (((b) * 2 + (h)) * HTB)
#define PG8_SB(b, h) ((4 + (b) * 2 + (h)) * HTB)
#define PG8_STAGE(bufoff, gbase, voff) do { _Pragma("unroll") for (int _i = 0; _i < 2; ++_i) \
        __builtin_amdgcn_global_load_lds((const unsigned*)((const char*)(gbase) + (voff)[_i]), (LAS unsigned*)(lds + (bufoff) + ldsw + _i * 8192), 16, 0, 0); } while (0)
#define PG8_LDA(dst, b, h) do { _Pragma("unroll") for (int m = 0; m < 4; ++m) _Pragma("unroll") for (int k = 0; k < 2; ++k) dst[m][k] = *(const LAS bf16x8*)(lds + PG8_SA(b, h) + aoff + m * 2048 + k * 1024); } while (0)
#define PG8_LDB(dst, b, h) do { _Pragma("unroll") for (int n = 0; n < 2; ++n) _Pragma("unroll") for (int k = 0; k < 2; ++k) dst[n][k] = *(const LAS bf16x8*)(lds + PG8_SB(b, h) + boff + n * 2048 + k * 1024); } while (0)
#define PG8_MMA(ai, bj, At, Bt) do { __builtin_amdgcn_s_setprio(1); _Pragma("unroll") for (int m = 0; m < 4; ++m) _Pragma("unroll") for (int n = 0; n < 2; ++n) _Pragma("unroll") for (int k = 0; k < 2; ++k) \
        acc[ai][bj][m][n] = __builtin_amdgcn_mfma_f32_16x16x32_bf16(Bt[n][k], At[m][k], acc[ai][bj][m][n], 0, 0, 0); __builtin_amdgcn_s_setprio(0); } while (0)
#define PG8_WAIT_V(n) asm volatile("s_waitcnt vmcnt(" #n ")" ::: "memory")
#define PG8_WAIT_L(n) asm volatile("s_waitcnt lgkmcnt(" #n ")" ::: "memory")
#define PG8_BAR __builtin_amdgcn_s_barrier()
#define PG8_SCHED __builtin_amdgcn_sched_barrier(0)
    Unit cur, nxt; int ui = 0;
    S.begin(tid);
    if (!S.next(0, cur)) return;
    S.a_ready(cur, tid);
    f32x4 acc[2][2][4][2];
#pragma unroll
    for (int a = 0; a < 2; ++a)
#pragma unroll
        for (int b = 0; b < 2; ++b)
#pragma unroll
            for (int m = 0; m < 4; ++m)
#pragma unroll
                for (int n = 0; n < 2; ++n) acc[a][b][m][n] = (f32x4){0.f, 0.f, 0.f, 0.f};
    bf16x8 At[4][2], B0[2][2], B1[2][2];
    unsigned cv0[2], cv1[2];
    if constexpr (GA) { S.fill(cur, 0, tid); __syncthreads(); }
#pragma unroll
    for (int i = 0; i < 2; ++i) { cv0[i] = GA ? S.row_off(cur, 0, Rst + 64 * i) + (unsigned)Cst * 2u : voffA[i]; cv1[i] = GA ? S.row_off(cur, 0, HALF + Rst + 64 * i) + (unsigned)Cst * 2u : voffA[i]; }
    const char* cA = (const char*)Abase + S.a_off(cur); const char* cB = (const char*)Bbase + S.b_off(cur);
    PG8_STAGE(PG8_SB(0, 0), cB, voffB); PG8_STAGE(PG8_SB(0, 1), cB + hstep, voffB); PG8_STAGE(PG8_SA(0, 0), cA, cv0); PG8_STAGE(PG8_SA(0, 1), cA + hstepA, cv1);
    if (wr == 1) PG8_BAR;
    PG8_WAIT_V(2); PG8_BAR;
    PG8_STAGE(PG8_SB(1, 0), cB + kstep, voffB); PG8_STAGE(PG8_SA(1, 0), cA + kstep, cv0); PG8_STAGE(PG8_SB(1, 1), cB + hstep + kstep, voffB);
    PG8_WAIT_V(6); PG8_BAR;
    for (;;) {
        const bool has_next = S.next(ui + 1, nxt);
        const char* nA = has_next ? (const char*)Abase + S.a_off(nxt) : cA; const char* nB = has_next ? (const char*)Bbase + S.b_off(nxt) : cB;
        if constexpr (GA) { if (has_next) S.fill(nxt, ui + 1, tid); }
#pragma unroll 1
        for (int t = 0; t < nt; t += 2) {
            const bool last = (t == nt - 2);
            if (last && has_next) S.a_ready(nxt, tid);
            const char* a1 = cA + (size_t)(t + 1) * kstep;
            const char* a2 = last ? nA : cA + (size_t)(t + 2) * kstep; const char* b2 = last ? nB : cB + (size_t)(t + 2) * kstep;
            const char* a3 = a2 + kstep; const char* b3 = b2 + kstep;
            if constexpr (GA) { if (last && has_next) {
#pragma unroll
                for (int i = 0; i < 2; ++i) cv0[i] = S.row_off(nxt, ui + 1, Rst + 64 * i) + (unsigned)Cst * 2u; } }
            PG8_LDB(B0, 0, 0); PG8_LDB(B1, 0, 1); PG8_SCHED; PG8_LDA(At, 0, 0); PG8_STAGE(PG8_SA(1, 1), a1 + hstepA, cv1);
            if constexpr (GA) { if (last && has_next) {
#pragma unroll
                for (int i = 0; i < 2; ++i) cv1[i] = S.row_off(nxt, ui + 1, HALF + Rst + 64 * i) + (unsigned)Cst * 2u; } }
            PG8_WAIT_V(8); PG8_WAIT_L(0); PG8_BAR; PG8_MMA(0, 0, At, B0); PG8_MMA(0, 1, At, B1); PG8_BAR; PG8_SCHED;
            PG8_LDA(At, 0, 1); PG8_STAGE(PG8_SB(0, 0), b2, voffB); PG8_STAGE(PG8_SB(0, 1), b2 + hstep, voffB); PG8_STAGE(PG8_SA(0, 0), a2, cv0);
            PG8_WAIT_V(8); PG8_WAIT_L(0); PG8_BAR; PG8_MMA(1, 0, At, B0); PG8_MMA(1, 1, At, B1); PG8_BAR; PG8_SCHED;
            PG8_LDB(B0, 1, 0); PG8_LDB(B1, 1, 1); PG8_SCHED; PG8_LDA(At, 1, 0); PG8_STAGE(PG8_SA(0, 1), a2 + hstepA, cv1);
            PG8_WAIT_V(8); PG8_WAIT_L(0); PG8_BAR; PG8_MMA(0, 0, At, B0); PG8_MMA(0, 1, At, B1); PG8_BAR; PG8_SCHED;
            PG8_LDA(At, 1, 1); PG8_STAGE(PG8_SB(1, 0), b3, voffB); PG8_STAGE(PG8_SB(1, 1), b3 + hstep, voffB); PG8_STAGE(PG8_SA(1, 0), a3, cv0);
            PG8_WAIT_V(8); PG8_WAIT_L(0); PG8_BAR; PG8_MMA(1, 0, At, B0); PG8_MMA(1, 1, At, B1); PG8_BAR; PG8_SCHED;
        }
        if constexpr (ALIGN_EPI) { if (wr == 0) PG8_BAR; }
        E(acc, cur, wr, wc, fr, fq);
        S.done(cur, lane);
        if (!has_next) break;
#pragma unroll
        for (int a = 0; a < 2; ++a)
#pragma unroll
            for (int b = 0; b < 2; ++b)
#pragma unroll
                for (int m = 0; m < 4; ++m)
#pragma unroll
                    for (int n = 0; n < 2; ++n) acc[a][b][m][n] = (f32x4){0.f, 0.f, 0.f, 0.f};
        cur = nxt; cA = nA; cB = nB; ++ui;
        if constexpr (ALIGN_EPI) { if (wr == 1) PG8_BAR; }
    }
    PG8_WAIT_V(0);
    if constexpr (!ALIGN_EPI) { if (wr == 0) PG8_BAR; }
    PG8_BAR;
#undef PG8_SA
#undef PG8_SB
#undef PG8_STAGE
#undef PG8_LDA
#undef PG8_LDB
#undef PG8_MMA
#undef PG8_WAIT_V
#undef PG8_WAIT_L
#undef PG8_BAR
#undef PG8_SCHED
}
}

__device__ __forceinline__ void transpose_item(const float* W, int K, int N, bf16* WT, int kb, int nb, int drow0, LAS float* scr, int lane, const float* kscale = nullptr) {
    const int k0 = 64 * kb, n0 = 32 * nb;
#pragma unroll 8
    for (int i = 0; i < 32; ++i) { const int kk = 2 * i + (lane >> 5); scr[kk * 33 + (lane & 31)] = W[(size_t)(k0 + kk) * N + n0 + (lane & 31)] * (kscale ? kscale[k0 + kk] : 1.f); }
    LDS_WAIT(); asm volatile("" ::: "memory");
    const int c = lane & 7;
#pragma unroll
    for (int j = 0; j < 4; ++j) { const int n = (lane >> 3) + 8 * j; const LAS float* s = scr + (8 * c) * 33 + n;
        u32x4 o; o.x = pk2(s[0 * 33], s[1 * 33]); o.y = pk2(s[2 * 33], s[3 * 33]); o.z = pk2(s[4 * 33], s[5 * 33]); o.w = pk2(s[6 * 33], s[7 * 33]);
        *(u32x4*)(WT + (size_t)(drow0 + n) * K + k0 + 8 * c) = o; }
    LDS_WAIT(); asm volatile("" ::: "memory");
}
__device__ __forceinline__ void transpose_item_fm(const float* W, int K, int N, bf16* FM, int kb, int nb, LAS float* scr, int lane, const float* kscale = nullptr) {
    const int k0 = 64 * kb, n0 = 32 * nb, KS = K / 16;
#pragma unroll 8
    for (int i = 0; i < 32; ++i) { const int kk = 2 * i + (lane >> 5); scr[kk * 33 + (lane & 31)] = W[(size_t)(k0 + kk) * N + n0 + (lane & 31)] * (kscale ? kscale[k0 + kk] : 1.f); }
    LDS_WAIT(); asm volatile("" ::: "memory");
#pragma unroll
    for (int q = 0; q < 4; ++q) { const LAS float* sp = scr + (16 * q + 8 * (lane >> 5)) * 33 + (lane & 31);
        u32x4 o; o.x = pk2(sp[0 * 33], sp[1 * 33]); o.y = pk2(sp[2 * 33], sp[3 * 33]); o.z = pk2(sp[4 * 33], sp[5 * 33]); o.w = pk2(sp[6 * 33], sp[7 * 33]);
        *(u32x4*)(FM + ((size_t)(nb * KS + 4 * kb + q) * 64 + lane) * 8) = o; }
    LDS_WAIT(); asm volatile("" ::: "memory");
}
__device__ __forceinline__ void convert_layer(CPR p, Frame& F, int l, int rank, int nranks) {
    asm volatile("" : "+s"(nranks));
    LAS float* scr = (LAS float*)(F.lds + F.wave * 16384);
    constexpr int I_IN = 16 * 61, I_OUT = 16 * 32, I_G = 128, I_L = I_IN + 2 * I_OUT + 3 * 16 * I_G + 48 + 32 + 8;
    for (int it = rank; it < I_L; it += nranks) {
        int r = it;
        if (r < I_OUT) { transpose_item_fm(p.w_out + (size_t)l * D * D, D, D, F.woutf() + (size_t)l * D * D, r / 32, r % 32, scr, F.lane); continue; } r -= I_OUT;
        if (r < I_IN) { transpose_item(p.w_in + (size_t)l * D * INW, D, INW, F.win() + (size_t)l * INP * D, r / 61, r % 61, 32 * (r % 61), scr, F.lane); continue; } r -= I_IN;
        if (r < I_OUT) { transpose_item(p.w_out + (size_t)l * D * D, D, D, F.wout() + (size_t)l * D * D, r / 32, r % 32, 32 * (r % 32), scr, F.lane); continue; } r -= I_OUT;
        if (r < 16 * I_G) { const int e = r / I_G, q = r % I_G, nb = q % 8, n0 = 32 * nb;
            transpose_item(p.moe_w_gate + (size_t)(l * NE + e) * D * DE, D, DE, F.w1() + (size_t)(l * NE + e) * 512 * D, q / 8, nb, (n0 / 128) * 256 + (n0 % 128), scr, F.lane); continue; } r -= 16 * I_G;
        if (r < 16 * I_G) { const int e = r / I_G, q = r % I_G, nb = q % 8, n0 = 32 * nb;
            transpose_item(p.moe_w_up + (size_t)(l * NE + e) * D * DE, D, DE, F.w1() + (size_t)(l * NE + e) * 512 * D, q / 8, nb, (n0 / 128) * 256 + 128 + (n0 % 128), scr, F.lane); continue; } r -= 16 * I_G;
        if (r < 16 * I_G) { const int e = r / I_G, q = r % I_G;
            transpose_item(p.moe_w_down + (size_t)(l * NE + e) * DE * D, DE, D, F.w2() + (size_t)(l * NE + e) * D * DE, q / 32, q % 32, 32 * (q % 32), scr, F.lane); continue; } r -= 16 * I_G;
        if (r < 48) { transpose_item_fm(p.mla_w_uq + (size_t)l * 256 * 384, 256, 384, F.wuq() + (size_t)l * 384 * 256, r / 12, r % 12, scr, F.lane, p.mla_q_norm_g + l * 256); continue; } r -= 48;
        if (r < 32) { transpose_item_fm(p.mla_w_ukv + (size_t)l * 128 * 512, 128, 512, F.wukv() + (size_t)l * 512 * 128, r / 16, r % 16, scr, F.lane, p.mla_kv_norm_g + l * 128); continue; } r -= 32;
        { const int g = r / 2, nb = r % 2; transpose_item(p.pool_w + (size_t)(l * 4 + g) * 4096, 64, 64, F.poolw() + (size_t)(l * 4 + g) * 4096, 0, nb, 32 * nb, scr, F.lane); }
    }
    for (int i = rank * 64 + F.lane; i < 4 * 128 * 128; i += nranks * 64) F.sguw()[l * 4 * 128 * 128 + i] = (bf16)f2bf(p.sgu_w[l * 4 * 128 * 128 + i]);
    for (int i = rank * 64 + F.lane; i < (INP - INW) * D; i += nranks * 64) F.win()[(size_t)l * INP * D + (size_t)INW * D + i] = 0;
}
__device__ __forceinline__ void p0_prologue(CPR p, Frame& F) {
    convert_layer(p, F, 0, F.gw, F.ngw);
    for (int i = F.gt; i < SEQ * 16; i += F.ngt) {
        const int t = i >> 4, k = i & 15; const float pos = (float)((k < 8) ? (t >> 6) : (t & 63));
        const float inv = __builtin_powf(10000.0f, -(float)(k & 7) / 8.0f);
        const float ang = pos * inv; F.ropec()[i] = cosf(ang); F.ropes()[i] = sinf(ang);
    }
    for (int i = F.gt; i < NE * D; i += F.ngt) { const int sx = i >> 9, ln = (i >> 3) & 63, j = i & 7;
        const float v = p.router_w[(32 * sx + 8 * (ln >> 4) + j) * NE + (ln & 15)]; const unsigned hi = f2bf(v);
        F.rwf()[i] = (bf16)hi; F.rwf()[NE * D + i] = (bf16)f2bf(v - __uint_as_float(hi << 16)); }
    {
        LAS float* sv = (LAS float*)F.lds;
        LAS float* red = sv + 5 * D;
        __syncthreads();
        for (int i = F.tid; i < 5 * D; i += NTHR) { const int r = i >> 10, k = i & 1023; sv[i] = silu_f(r < 4 ? p.c[r * D + k] : p.c_ctx[k]); }
        __syncthreads();
        const int hw = F.tid >> 5, cl = F.tid & 31;
        for (int it = blockIdx.x; it < DEPTH * (NMOD * D / 32); it += gridDim.x) {
            const int l = it / (NMOD * D / 32), n = (it % (NMOD * D / 32)) * 32 + cl;
            const float* w = p.ada_w + (size_t)l * D * NMOD * D + (size_t)(64 * hw) * NMOD * D + n;
            float a0 = 0.f, a1 = 0.f, a2 = 0.f, a3 = 0.f, a4 = 0.f;
#pragma unroll 16
            for (int k = 0; k < 64; ++k) { const float x = w[(size_t)k * NMOD * D]; const int kk = 64 * hw + k;
                a0 += sv[kk] * x; a1 += sv[D + kk] * x; a2 += sv[2 * D + kk] * x; a3 += sv[3 * D + kk] * x; a4 += sv[4 * D + kk] * x; }
            red[(hw * 5 + 0) * 32 + cl] = a0; red[(hw * 5 + 1) * 32 + cl] = a1; red[(hw * 5 + 2) * 32 + cl] = a2; red[(hw * 5 + 3) * 32 + cl] = a3; red[(hw * 5 + 4) * 32 + cl] = a4;
            __syncthreads();
            if (F.tid < 160) { const int r = F.tid >> 5; float acc = p.ada_b[l * NMOD * D + (it % (NMOD * D / 32)) * 32 + cl];
#pragma unroll
                for (int h2 = 0; h2 < 16; ++h2) acc += red[(h2 * 5 + r) * 32 + cl];
                F.mod()[((size_t)(l * 5 + r) * NMOD * D) + (it % (NMOD * D / 32)) * 32 + cl] = acc; }
            __syncthreads();
        }
    }
}

__device__ __forceinline__ int ybase_of(const Frame& F, int l, int e) {
    int b = 0;
    for (int j = 0; j < e; ++j) b += ((int)F.ctl()[CW_CNT + (l * NE + j) * 64] + 255) & ~255;
    return b;
}
__device__ __forceinline__ void moe_table(Frame& F, int l) {
    volatile LAS int* tab = (volatile LAS int*)(F.lds + MOETAB_OFF);
    __syncthreads();
    if (F.tid < NE) tab[32 + F.tid] = (int)F.ctl()[CW_CNT + (l * NE + F.tid) * 64];
    __syncthreads();
    if (F.tid == 0) { int acc = 0;
        for (int e = 0; e < NE; ++e) { tab[e] = acc; acc += (tab[32 + e] + 255) >> 8; }
        tab[16] = acc; }
    __syncthreads();
    if (F.tid < 192) { int e = 0;
        for (int j = 1; j < 16; ++j) e += (tab[j] <= F.tid) ? 1 : 0;
        tab[64 + F.tid] = e; }
    __syncthreads();
}
__device__ __forceinline__ void add_y4(f32x4& v, const f32x4& g, const u32x2& a, const u32x2& b) {
    v.x += g.x * (__uint_as_float(a.x << 16) + __uint_as_float(b.x << 16)); v.y += g.y * (__uint_as_float(a.x & 0xffff0000u) + __uint_as_float(b.x & 0xffff0000u));
    v.z += g.z * (__uint_as_float(a.y << 16) + __uint_as_float(b.y << 16)); v.w += g.w * (__uint_as_float(a.y & 0xffff0000u) + __uint_as_float(b.y & 0xffff0000u));
}
__device__ __forceinline__ f32x4 ld_bf4(const bf16* p) { const u32x2 u = *(const u32x2*)p; f32x4 v; v.x = __uint_as_float(u.x << 16); v.y = __uint_as_float(u.x & 0xffff0000u); v.z = __uint_as_float(u.y << 16); v.w = __uint_as_float(u.y & 0xffff0000u); return v; }
__device__ __forceinline__ void st_bf4(bf16* p, const f32x4& v) { u32x2 u; u.x = pk2(v.x, v.y); u.y = pk2(v.z, v.w); *(u32x2*)p = u; }
__device__ __forceinline__ float sumsq4(const f32x4& v) { return v.x * v.x + v.y * v.y + v.z * v.z + v.w * v.w; }

__device__ __forceinline__ void p1_rows(CPR p, Frame& F, int l, float ysc = 1.f) {
    const volatile LAS int* tab = (const volatile LAS int*)(F.lds + MOETAB_OFF);
    if (l > 0) moe_table(F, l - 1);
    for (int pi = F.gw; pi < T / 2; pi += F.ngw) {
        int c0 = 4 * F.lane; asm volatile("" : "+v"(c0));
        const int r0 = 2 * pi, mr = row_mod(r0);
        f32x4 v[2][4];
        if (l == 0) {
#pragma unroll
            for (int k = 0; k < 2; ++k) { const int r = r0 + k; const float* src = (r < TL) ? p.x + (size_t)r * D : p.ctx + (size_t)(r - TL) * D;
#pragma unroll
                for (int j = 0; j < 4; ++j) v[k][j] = *(const f32x4*)(src + c0 + 256 * j); }
        } else {
            const bf16* y0[2]; const bf16* y1[2];
#pragma unroll
            for (int k = 0; k < 2; ++k) { const i32x4 rt = *(const i32x4*)(F.route() + 4 * (r0 + k));
                y0[k] = F.y() + (size_t)(tab[rt.x] * 256 + rt.y) * D + c0; y1[k] = F.y() + (size_t)(tab[rt.z] * 256 + rt.w) * D + c0; }
            u32x2 a[2][4], b[2][4];
#pragma unroll
            for (int k = 0; k < 2; ++k)
#pragma unroll
                for (int j = 0; j < 4; ++j) { v[k][j] = ld_bf4(F.xl() + (size_t)(r0 + k) * D + c0 + 256 * j); a[k][j] = *(const u32x2*)(y0[k] + 256 * j); b[k][j] = *(const u32x2*)(y1[k] + 256 * j); }
            const float* g5 = mod_vec(F, l - 1, mr, 5) + c0;
#pragma unroll
            for (int j = 0; j < 4; ++j) { const f32x4 g = *(const f32x4*)(g5 + 256 * j) * ysc; add_y4(v[0][j], g, a[0][j], b[0][j]); add_y4(v[1][j], g, a[1][j], b[1][j]); }
        }
        const float* g1 = p.norm1_g + l * D + c0; const float* sh = mod_vec(F, l, mr, 0) + c0; const float* sc = mod_vec(F, l, mr, 1) + c0;
        f32x4 gq[4], sq4[4], qq[4];
#pragma unroll
        for (int j = 0; j < 4; ++j) { gq[j] = *(const f32x4*)(g1 + 256 * j); sq4[j] = *(const f32x4*)(sh + 256 * j); qq[j] = *(const f32x4*)(sc + 256 * j); }
        __builtin_amdgcn_sched_barrier(0);
        float ss0 = 0.f, ss1 = 0.f;
#pragma unroll
        for (int j = 0; j < 4; ++j) { st_bf4(F.xl() + (size_t)r0 * D + c0 + 256 * j, v[0][j]); st_bf4(F.xl() + (size_t)(r0 + 1) * D + c0 + 256 * j, v[1][j]); ss0 += sumsq4(v[0][j]); ss1 += sumsq4(v[1][j]); }
        ss0 = wave_sum(ss0); ss1 = wave_sum(ss1);
        const float rs0 = rsqrtf(ss0 * (1.f / D) + EPS), rs1 = rsqrtf(ss1 * (1.f / D) + EPS);
#pragma unroll
        for (int j = 0; j < 4; ++j) { const f32x4 g = gq[j], s4 = sq4[j], q4 = qq[j];
            const f32x4 mul = g * (q4 + 1.f);
            const f32x4 h0 = v[0][j] * rs0 * mul + s4, h1 = v[1][j] * rs1 * mul + s4;
            u32x2 o0, o1; o0.x = pk2(h0.x, h0.y); o0.y = pk2(h0.z, h0.w); o1.x = pk2(h1.x, h1.y); o1.y = pk2(h1.z, h1.w);
            *(u32x2*)(F.ha() + (size_t)r0 * D + c0 + 256 * j) = o0; *(u32x2*)(F.ha() + (size_t)(r0 + 1) * D + c0 + 256 * j) = o1; }
    }
}

__device__ __forceinline__ void p2_inproj_naive(Frame& F, int l) {
    const bf16* W = F.win() + (size_t)l * INP * D;
    for (long i = F.gt; i < (long)T * INW; i += F.ngt) { const int r = (int)(i / INW), c = (int)(i % INW);
        F.pl()[(size_t)r * INP + c] = (bf16)f2bf(dot_bf16(F.ha() + (size_t)r * D, W + (size_t)c * D, D)); }
}

__device__ __forceinline__ void p3_mla_up_naive(CPR p, Frame& F, int l) {
    for (int r = F.gw; r < T; r += F.ngw) {
        const bf16* pr = F.pl() + (size_t)r * INP + OFF_D;
        float a[4]; { const u32x2 t = *(const u32x2*)(pr + 4 * F.lane); a[0] = __uint_as_float(t.x << 16); a[1] = __uint_as_float(t.x & 0xffff0000u); a[2] = __uint_as_float(t.y << 16); a[3] = __uint_as_float(t.y & 0xffff0000u); }
        const float rq = rsqrtf(wave_sum(a[0] * a[0] + a[1] * a[1] + a[2] * a[2] + a[3] * a[3]) * (1.f / 256.f) + EPS);
        float b2[2]; { const unsigned t = *(const unsigned*)(pr + 256 + 2 * F.lane); b2[0] = __uint_as_float(t << 16); b2[1] = __uint_as_float(t & 0xffff0000u); }
        const float rkv = rsqrtf(wave_sum(b2[0] * b2[0] + b2[1] * b2[1]) * (1.f / 128.f) + EPS);
        LAS float* sq = (LAS float*)(F.lds + F.wave * 4096);
#pragma unroll
        for (int j = 0; j < 4; ++j) sq[4 * F.lane + j] = a[j] * rq;
        sq[256 + 2 * F.lane] = b2[0] * rkv; sq[256 + 2 * F.lane + 1] = b2[1] * rkv;
        LDS_WAIT(); asm volatile("" ::: "memory");
        const bool lat = r < TL; const int t = r & (SEQ - 1);
        for (int f = F.lane; f < 384; f += 64) {
            const int h = f / 96, j = f % 96;
            float val;
            const bf16* wrow = F.wuq() + (size_t)l * 384 * 256;
            auto qdot = [&](int ff) { float s = 0.f; const bf16* w = wrow + (size_t)ff * 256; for (int k = 0; k < 256; ++k) s += sq[k] * bf2f(w[k]); return s; };
            if (j < 64 || !lat) val = qdot(f);
            else { const int i = j - 64; const int base = h * 96 + 64;
                const int q8 = i & 7, half = (i >> 3) & 1, axis = i >> 4;
                const float cs = F.ropec()[t * 16 + axis * 8 + q8], sn = F.ropes()[t * 16 + axis * 8 + q8];
                const float x1 = qdot(base + axis * 16 + q8), x2 = qdot(base + axis * 16 + 8 + q8);
                val = half ? (x1 * sn + x2 * cs) : (x1 * cs - x2 * sn); }
            F.qm()[(size_t)r * 384 + f] = (bf16)f2bf(val * (MLA_SCALE * LOG2E));
        }
        for (int f = F.lane; f < 512; f += 64) {
            const int h = f / 128, j = f % 128; float s = 0.f; const bf16* w = F.wukv() + (size_t)l * 512 * 128 + (size_t)f * 128;
            for (int k = 0; k < 128; ++k) s += sq[256 + k] * bf2f(w[k]);
            if (j < 64) F.km()[(size_t)r * 384 + h * 96 + j] = (bf16)f2bf(s); else F.vm()[(size_t)r * 256 + h * 64 + (j - 64)] = (bf16)f2bf(s);
        }
        if (F.lane < 32) { const int i = F.lane, q8 = i & 7, half = (i >> 3) & 1, axis = i >> 4;
            const float x1 = bf2f(pr[384 + axis * 16 + q8]), x2 = bf2f(pr[384 + axis * 16 + 8 + q8]);
            float val;
            if (lat) { const float cs = F.ropec()[t * 16 + axis * 8 + q8], sn = F.ropes()[t * 16 + axis * 8 + q8]; val = half ? (x1 * sn + x2 * cs) : (x1 * cs - x2 * sn); }
            else val = bf2f(pr[384 + i]);
#pragma unroll
            for (int h = 0; h < 4; ++h) F.km()[(size_t)r * 384 + h * 96 + 64 + i] = (bf16)f2bf(val); }
        LDS_WAIT(); asm volatile("" ::: "memory");
    }
}
__device__ __forceinline__ void p3_pool_naive(CPR p, Frame& F, int l) {
    for (int i = F.gt; i < T * 256; i += F.ngt) {
        const int r = i >> 8, col = i & 255, g = col >> 6, d = col & 63;
        const int L = r < TL ? SEQ : CTX, t = r < TL ? (r & (SEQ - 1)) : ((r - TL) & (CTX - 1)), seg0 = r - t;
        const int win = 2 << g; int lo = t - win / 2, hi = t - win / 2 + win; lo = lo < 0 ? 0 : lo; hi = hi > L ? L : hi;
        const float inv = 1.f / (float)(hi - lo);
        const bf16* wt = F.poolw() + (size_t)(l * 4 + g) * 4096 + d * 64;
        float acc = 0.f;
        for (int c = 0; c < 64; ++c) { float m = 0.f; for (int s = lo; s < hi; ++s) m += bf2f(F.pl()[(size_t)(seg0 + s) * INP + g * 64 + c]);
            const float df = m * inv - bf2f(F.pl()[(size_t)r * INP + g * 64 + c]); acc += df * bf2f(wt[c]); }
        F.ml()[(size_t)r * D + col] = (bf16)f2bf(acc * p.pool_s[l * 256 + col]);
    }
}
__device__ __forceinline__ void p3_sgu1_naive(CPR p, Frame& F, int l) {
    bf16* vg = F.hid();
    for (int r = F.gw; r < T; r += F.ngw) {
        const bf16* pv = F.pl() + (size_t)r * INP + OFF_C + 256;
        float a[4]; { const u32x2 t = *(const u32x2*)(pv + 4 * F.lane); a[0] = gelu_tanh(__uint_as_float(t.x << 16)); a[1] = gelu_tanh(__uint_as_float(t.x & 0xffff0000u)); a[2] = gelu_tanh(__uint_as_float(t.y << 16)); a[3] = gelu_tanh(__uint_as_float(t.y & 0xffff0000u)); }
        float ss = a[0] * a[0] + a[1] * a[1] + a[2] * a[2] + a[3] * a[3];
        ss += lane_xor<1>(ss); ss += lane_xor<2>(ss); ss += lane_xor<4>(ss); ss += lane_xor<8>(ss);
        const float rs = rsqrtf(ss * (1.f / 64.f) + EPS); const float* gn = p.sgu_norm_g + l * 256 + 4 * F.lane;
        u32x2 o; o.x = pk2(a[0] * rs * gn[0], a[1] * rs * gn[1]); o.y = pk2(a[2] * rs * gn[2], a[3] * rs * gn[3]);
        *(u32x2*)(vg + (size_t)r * 256 + 4 * F.lane) = o;
    }
}
__device__ __forceinline__ void p3_sgu2_naive(CPR p, Frame& F, int l) {
    const bf16* vg = F.hid();
    for (int i = F.gt; i < T * 256; i += F.ngt) {
        const int r = i >> 8, col = i & 255, g = col >> 6, pp = r & 127, r0 = r - pp;
        const bf16* w = F.sguw() + ((size_t)(l * 4 + g) * 128 + pp) * 128;
        float acc = p.sgu_b[(l * 4 + g) * 128 + pp];
        for (int q = 0; q < 128; ++q) acc += bf2f(w[q]) * bf2f(vg[(size_t)(r0 + q) * 256 + col]);
        const float u = gelu_tanh(bf2f(F.pl()[(size_t)r * INP + OFF_C + col]));
        F.ml()[(size_t)r * D + 512 + col] = (bf16)f2bf(u * acc);
    }
}
__device__ __forceinline__ void p3_na_naive(CPR p, Frame& F, int l) {
    LAS float* pw = (LAS float*)(F.lds + 65536 + F.wave * 2048);
    for (int it = F.gw; it < T * 4; it += F.ngw) {
        const int r = it >> 2, h = it & 3; const bool lat = r < TL; const int b = row_batch(r);
        float q[64];
        { const bf16* qp = F.pl() + (size_t)r * INP + OFF_B + h * 64;
#pragma unroll
          for (int j = 0; j < 8; ++j) { const u32x4 t = *(const u32x4*)(qp + 8 * j);
#pragma unroll
              for (int k = 0; k < 4; ++k) { q[8 * j + 2 * k] = __uint_as_float(t[k] << 16); q[8 * j + 2 * k + 1] = __uint_as_float(t[k] & 0xffff0000u); } } }
        const int t = r & (SEQ - 1), gr = t >> 6, gc = t & 63, jb = gc >> 4;
        int rs = gr - 4; rs = rs < 0 ? 0 : (rs > GH - 8 ? GH - 8 : rs);
        int wsq = gc - 8; wsq = wsq < 0 ? 0 : (wsq > GW - 16 ? GW - 16 : wsq);
        int cs = 16 * jb - 8; cs = cs < 0 ? 0 : (cs > GW - 16 ? GW - 16 : cs); cs = cs > GW - 32 ? GW - 32 : cs;
        const float* rpb = p.na_rpb + (size_t)(l * 4 + h) * 15 * 31;
        float s[8];
#pragma unroll
        for (int i = 0; i < 8; ++i) {
            const int k = F.lane + 64 * (i & 3); const bool win = i < 4;
            int keyrow; float bias = 0.f; bool valid = true;
            if (win) { const int rr = k >> 5, cc = k & 31, kcol = cs + cc; keyrow = b * SEQ + (rs + rr) * 64 + kcol;
                valid = lat && (kcol >= wsq) && (kcol < wsq + 16);
                int dc = kcol - gc + 15; dc = dc < 0 ? 0 : (dc > 30 ? 30 : dc);
                bias = rpb[(rs + rr - gr + 7) * 31 + dc];
                if (!lat) keyrow = r; }
            else keyrow = TL + b * CTX + k;
            const bf16* kp = F.pl() + (size_t)keyrow * INP + OFF_B + 256 + h * 64;
            float d = 0.f;
#pragma unroll
            for (int j = 0; j < 8; ++j) { const u32x4 tt = *(const u32x4*)(kp + 8 * j);
#pragma unroll
                for (int kk = 0; kk < 4; ++kk) d += q[8 * j + 2 * kk] * __uint_as_float(tt[kk] << 16) + q[8 * j + 2 * kk + 1] * __uint_as_float(tt[kk] & 0xffff0000u); }
            s[i] = valid ? (d * 0.125f + bias) : -1e30f;
        }
        float m = s[0];
#pragma unroll
        for (int i = 1; i < 8; ++i) m = fmaxf(m, s[i]);
        m = wave_max(m);
        float sum = 0.f;
#pragma unroll
        for (int i = 0; i < 8; ++i) { s[i] = __expf(s[i] - m); sum += s[i]; }
        sum = wave_sum(sum); const float inv = 1.f / sum;
#pragma unroll
        for (int i = 0; i < 8; ++i) pw[(i >> 2) * 256 + F.lane + 64 * (i & 3)] = s[i] * inv;
        LDS_WAIT(); asm volatile("" ::: "memory");
        float acc = 0.f;
        if (lat) for (int k = 0; k < 256; ++k) { const int rr = k >> 5, cc = k & 31; const int keyrow = b * SEQ + (rs + rr) * 64 + cs + cc;
            acc += pw[k] * bf2f(F.pl()[(size_t)keyrow * INP + OFF_B + 512 + h * 64 + F.lane]); }
        for (int k = 0; k < 256; ++k) acc += pw[256 + k] * bf2f(F.pl()[(size_t)(TL + b * CTX + k) * INP + OFF_B + 512 + h * 64 + F.lane]);
        F.ml()[(size_t)r * D + 256 + h * 64 + F.lane] = (bf16)f2bf(acc);
        LDS_WAIT(); asm volatile("" ::: "memory");
    }
}
__device__ __forceinline__ void p4_mla_naive(Frame& F) {
    LAS float* pw = (LAS float*)(F.lds + 65536 + F.wave * 2048);
    for (int it = F.gw; it < T * 4; it += F.ngw) {
        const int r = it >> 2, h = it & 3; const bool lat = r < TL; const int b = row_batch(r);
        float q[96];
        { const bf16* qp = F.qm() + (size_t)r * 384 + h * 96;
#pragma unroll
          for (int j = 0; j < 12; ++j) { const u32x4 t = *(const u32x4*)(qp + 8 * j);
#pragma unroll
              for (int k = 0; k < 4; ++k) { q[8 * j + 2 * k] = __uint_as_float(t[k] << 16); q[8 * j + 2 * k + 1] = __uint_as_float(t[k] & 0xffff0000u); } } }
        const int nk = lat ? (CTX + SEQ) : CTX;
        float m = -3.0e38f, lsum = 0.f, acc = 0.f;
        for (int k0 = 0; k0 < nk; k0 += 64) {
            const int k = k0 + F.lane; const int keyrow = (k < CTX) ? (TL + b * CTX + k) : (b * SEQ + k - CTX);
            const bf16* kp = F.km() + (size_t)keyrow * 384 + h * 96;
            float d = 0.f;
#pragma unroll
            for (int j = 0; j < 12; ++j) { const u32x4 tt = *(const u32x4*)(kp + 8 * j);
#pragma unroll
                for (int kk = 0; kk < 4; ++kk) d += q[8 * j + 2 * kk] * __uint_as_float(tt[kk] << 16) + q[8 * j + 2 * kk + 1] * __uint_as_float(tt[kk] & 0xffff0000u); }
            const float mn = fmaxf(m, wave_max(d)); const float alpha = exp2f(m - mn); const float pe = exp2f(d - mn);
            lsum = lsum * alpha + wave_sum(pe); acc *= alpha; m = mn;
            pw[F.lane] = pe; LDS_WAIT(); asm volatile("" ::: "memory");
            for (int kk = 0; kk < 64; ++kk) { const int k2 = k0 + kk; const int kr2 = (k2 < CTX) ? (TL + b * CTX + k2) : (b * SEQ + k2 - CTX);
                acc += pw[kk] * bf2f(F.vm()[(size_t)kr2 * 256 + h * 64 + F.lane]); }
            LDS_WAIT(); asm volatile("" ::: "memory");
        }
        F.ml()[(size_t)r * D + 768 + h * 64 + F.lane] = (bf16)f2bf(acc / lsum);
    }
}

typedef float f32x16 __attribute__((ext_vector_type(16)));
typedef short s16x4 __attribute__((ext_vector_type(4)));
__device__ __forceinline__ s16x4 lds_tr16(const LAS unsigned char* p) { return __builtin_bit_cast(s16x4, __builtin_amdgcn_ds_read_tr16_b64_v4i16((LAS s16x4*)p)); }
__device__ __forceinline__ bf16x8 pack8(const f32x16& v, int o) {
    u32x4 w; w.x = pg8::cvt_pk_bf16(v[o + 0], v[o + 1]); w.y = pg8::cvt_pk_bf16(v[o + 2], v[o + 3]); w.z = pg8::cvt_pk_bf16(v[o + 4], v[o + 5]); w.w = pg8::cvt_pk_bf16(v[o + 6], v[o + 7]);
    return __builtin_bit_cast(bf16x8, w);
}
template <int MODE> __device__ __forceinline__ void p4_mla_flash(Frame& F) {
    constexpr int KP = 208, VP = 144, KB = 64 * KP, VB = 64 * VP, BUF = KB + VB;
    const int tid = F.tid, lane = F.lane, w = F.wave, q = lane & 31, hh = lane >> 5;
    const bf16* qm = F.qm(); const bf16* km = F.km(); const bf16* vm = F.vm(); bf16* ml = (MODE == 0) ? F.ml() : F.hid() - 768;
    const int kc0 = tid, kc1 = 512 + (tid & 255);
    const int k0key = kc0 / 12, k0part = kc0 % 12, k1key = kc1 / 12, k1part = kc1 % 12, vkey = tid >> 3, vpart = tid & 7;
    const int trow = 4 * hh + ((lane & 15) >> 2), tcol = 16 * ((lane >> 4) & 1) + 4 * (lane & 3);
    for (int ui = blockIdx.x; ui < 272; ui += gridDim.x) {
        const int qt = ui < 256 ? (ui >> 2) : 64 + ((ui - 256) >> 2), h = ui & 3;
        const bool lat = qt < 64; const int b = lat ? (qt >> 4) : (qt - 64), ntile = lat ? 68 : 4;
        const int qrow = qt * 256 + w * 32 + q;
        bf16x8 qf[6];
#pragma unroll
        for (int ks = 0; ks < 6; ++ks) qf[ks] = *(const bf16x8*)(qm + (size_t)qrow * 384 + h * 96 + 16 * ks + 8 * hh);
        f32x16 ot0, ot1;
#pragma unroll
        for (int r = 0; r < 16; ++r) { ot0[r] = 0.f; ot1[r] = 0.f; }
        constexpr float THR = 8.f;
        float mref = 0.f, l = 0.f; f32x16 negm;
#pragma unroll
        for (int r = 0; r < 16; ++r) negm[r] = 0.f;
        u32x4 ka0, ka1, va, kb0, kb1, vbr;
#define MLA_LOAD(t, K0, K1, V) do { const int t_ = (t); const int kr_ = (lat && t_ >= 4) ? b * SEQ + 64 * (t_ - 4) : TL + b * CTX + 64 * t_; \
            K0 = *(const u32x4*)(km + (size_t)(kr_ + k0key) * 384 + h * 96 + 8 * k0part); \
            K1 = *(const u32x4*)(km + (size_t)(kr_ + k1key) * 384 + h * 96 + 8 * k1part);     \
            V = *(const u32x4*)(vm + (size_t)(kr_ + vkey) * 256 + h * 64 + 8 * vpart); } while (0)
#define MLA_STORE(bufi, K0, K1, V) do { LAS unsigned char* kb_ = F.lds + (bufi) * BUF; \
            *(LAS u32x4*)(kb_ + k0key * KP + k0part * 16) = K0; *(LAS u32x4*)(kb_ + k1key * KP + k1part * 16) = K1; \
            *(LAS u32x4*)(kb_ + KB + vkey * VP + vpart * 16) = V; } while (0)
#define MLA_TILE(t, bufi) do { \
            const LAS unsigned char* kb = F.lds + (bufi) * BUF; const LAS unsigned char* vb = kb + KB; \
            bf16x8 kf[12]; \
            if (MODE != 4) { _Pragma("unroll") for (int ks = 0; ks < 6; ++ks) { kf[2 * ks] = *(const LAS bf16x8*)(kb + q * KP + (16 * ks + 8 * hh) * 2); kf[2 * ks + 1] = *(const LAS bf16x8*)(kb + (32 + q) * KP + (16 * ks + 8 * hh) * 2); } } \
            __builtin_amdgcn_sched_barrier(0);                            \
            f32x16 s0 = negm, s1 = negm; \
            __builtin_amdgcn_s_setprio(1); \
            if (MODE != 4) { _Pragma("unroll") for (int ks = 0; ks < 6; ++ks) { \
                s0 = __builtin_amdgcn_mfma_f32_32x32x16_bf16(kf[2 * ks], qf[ks], s0, 0, 0, 0); \
                s1 = __builtin_amdgcn_mfma_f32_32x32x16_bf16(kf[2 * ks + 1], qf[ks], s1, 0, 0, 0); } } \
            __builtin_amdgcn_s_setprio(0); \
            __builtin_amdgcn_sched_barrier(0); \
            s16x4 vl[8], vh[8];                                            \
            if (MODE != 5) { _Pragma("unroll") for (int kk = 0; kk < 4; ++kk) { const LAS unsigned char* a0 = vb + (16 * kk + trow) * VP + tcol * 2; \
                vl[2 * kk] = lds_tr16(a0); vh[2 * kk] = lds_tr16(a0 + 8 * VP); vl[2 * kk + 1] = lds_tr16(a0 + 64); vh[2 * kk + 1] = lds_tr16(a0 + 8 * VP + 64); } } \
            __builtin_amdgcn_sched_barrier(0); \
            float mx = __builtin_fmaxf(s0[0], s1[0]); \
            if (MODE != 2) { _Pragma("unroll") for (int r = 1; r < 16; ++r) mx = __builtin_fmaxf(__builtin_fmaxf(mx, s0[r]), s1[r]); \
            mx = xmax32(mx); } \
            if (MODE != 2 && ((t) == 0 || __any(mx > THR))) { \
                const float dl = ((t) == 0) ? mx : __builtin_fmaxf(mx, 0.f), alpha = __builtin_amdgcn_exp2f(-dl); \
                mref += dl; l *= alpha; \
                _Pragma("unroll") for (int r = 0; r < 16; ++r) { ot0[r] *= alpha; ot1[r] *= alpha; s0[r] -= dl; s1[r] -= dl; negm[r] = -mref; } } \
            float rs = 0.f; \
            if (MODE != 2) { _Pragma("unroll") for (int r = 0; r < 16; ++r) { s0[r] = __builtin_amdgcn_exp2f(s0[r]); s1[r] = __builtin_amdgcn_exp2f(s1[r]); rs += s0[r] + s1[r]; } } \
            l += rs + ((MODE == 2) ? mx : 0.f); \
            bf16x8 pb[4]; pb[0] = pack8(s0, 0); pb[1] = pack8(s0, 8); pb[2] = pack8(s1, 0); pb[3] = pack8(s1, 8); \
            _Pragma("unroll") for (int kk = 0; kk < 4; ++kk) { \
                const bf16x8 v0 = (bf16x8){vl[2 * kk][0], vl[2 * kk][1], vl[2 * kk][2], vl[2 * kk][3], vh[2 * kk][0], vh[2 * kk][1], vh[2 * kk][2], vh[2 * kk][3]}; \
                const bf16x8 v1 = (bf16x8){vl[2 * kk + 1][0], vl[2 * kk + 1][1], vl[2 * kk + 1][2], vl[2 * kk + 1][3], vh[2 * kk + 1][0], vh[2 * kk + 1][1], vh[2 * kk + 1][2], vh[2 * kk + 1][3]}; \
                if (MODE != 5) { ot0 = __builtin_amdgcn_mfma_f32_32x32x16_bf16(v0, pb[kk], ot0, 0, 0, 0); \
                ot1 = __builtin_amdgcn_mfma_f32_32x32x16_bf16(v1, pb[kk], ot1, 0, 0, 0); } else { ot0[kk] += __builtin_bit_cast(float, pb[kk][0] | (pb[kk][7] << 16)); } } } while (0)
        MLA_LOAD(0, ka0, ka1, va); MLA_LOAD(1, kb0, kb1, vbr);
        MLA_STORE(0, ka0, ka1, va);
        __syncthreads();
        for (int t = 0; t < ntile; t += 2) {
            if (MODE != 3 && t + 2 < ntile) MLA_LOAD(t + 2, ka0, ka1, va);
            MLA_TILE(t, 0);
            if (MODE != 3) MLA_STORE(1, kb0, kb1, vbr);
            if (MODE != 6) __syncthreads();
            if (MODE != 3 && t + 3 < ntile) MLA_LOAD(t + 3, kb0, kb1, vbr);
            MLA_TILE(t + 1, 1);
            if (MODE != 3 && t + 2 < ntile) MLA_STORE(0, ka0, ka1, va);
            if (MODE != 6) __syncthreads();
        }
        if (MODE == 6) __syncthreads();
#undef MLA_TILE
#undef MLA_LOAD
#undef MLA_STORE
        l = xsum32(l);
        const float il = 1.f / l;
        bf16* orow = ml + (size_t)qrow * D + 768 + h * 64 + 4 * hh;
#pragma unroll
        for (int g = 0; g < 4; ++g) {
            u32x2 o0, o1;
            o0.x = pg8::cvt_pk_bf16(ot0[4 * g] * il, ot0[4 * g + 1] * il); o0.y = pg8::cvt_pk_bf16(ot0[4 * g + 2] * il, ot0[4 * g + 3] * il);
            o1.x = pg8::cvt_pk_bf16(ot1[4 * g] * il, ot1[4 * g + 1] * il); o1.y = pg8::cvt_pk_bf16(ot1[4 * g + 2] * il, ot1[4 * g + 3] * il);
            *(u32x2*)(orow + 8 * g) = o0; *(u32x2*)(orow + 32 + 8 * g) = o1;
        }
    }
}

__device__ __forceinline__ void p3_na_mfma(CPR p, Frame& F, int l) {
    constexpr int TP = 144, KBs = 32 * TP, WB = 2 * KBs, BT_OFF = 8 * WB;
    const int tid = F.tid, lane = F.lane, q = lane & 31, hh = lane >> 5;
    LAS unsigned char* wk = F.lds + F.wave * WB; LAS unsigned char* wv = wk + KBs;
    LAS float* btab = (LAS float*)(F.lds + BT_OFF);
    __syncthreads();
    for (int i = tid; i < 4 * 465; i += NTHR) btab[i] = p.na_rpb[(size_t)l * 1860 + i] * LOG2E;
    __syncthreads();
    const bf16* pl = F.pl(); bf16* ml = F.ml();
    const int skey = lane >> 3, spart = lane & 7;
    const int trow = 4 * hh + ((lane & 15) >> 2), tcol = 16 * ((lane >> 4) & 1) + 4 * (lane & 3);
    constexpr float QS = 0.125f * LOG2E;
    for (int pass = 0, it = F.gw; it < 2176; ++pass, it = F.ngw * pass + (F.ngw - 1 - F.gw)) {
        const bool lat = it < 2048; const int x = lat ? it : it - 2048;
        const int h = x & 3, b = lat ? (x >> 9) : (x >> 5), r = (x >> 3) & 63, jp = (x >> 2) & 1, g8 = (x >> 2) & 7;
        const int qrow = lat ? b * SEQ + r * 64 + 32 * jp + q : TL + b * CTX + 32 * g8 + q;
        const int ntile = lat ? 18 : 8;
        int rs = r - 4; rs = rs < 0 ? 0 : (rs > GH - 8 ? GH - 8 : rs);
        const int cb = jp ? 24 : 0, gc = 32 * jp + q; int wsq = gc - 8; wsq = wsq < 0 ? 0 : (wsq > GW - 16 ? GW - 16 : wsq);
        const int baddr = ((h * 15 + (rs - r + 7)) * 31 + cb - gc + 15 + 4 * hh) * 4;
        const int vk0 = cb + 4 * hh - wsq;
        bf16x8 qf[4];
#pragma unroll
        for (int ks = 0; ks < 4; ++ks) qf[ks] = *(const bf16x8*)(pl + (size_t)qrow * INP + OFF_B + 64 * h + 16 * ks + 8 * hh);
        f32x16 ot0, ot1;
#pragma unroll
        for (int i = 0; i < 16; ++i) { ot0[i] = 0.f; ot1[i] = 0.f; }
        constexpr float THR = 8.f;
        float mref = 0.f, lsum = 0.f;
        u32x4 krA[4], vrA[4], krB[4], vrB[4];
#define NA_LOAD(t, KR, VR) do { const int t_ = (t); _Pragma("unroll") for (int j = 0; j < 4; ++j) { int row_; \
            if (t_ < 8) row_ = TL + b * CTX + 32 * t_ + 8 * j + skey; \
            else { const int x_ = 4 * (t_ - 8) + j, rr_ = (x_ * 205) >> 10, cg_ = x_ - 5 * rr_; row_ = b * SEQ + (rs + rr_) * 64 + cb + 8 * cg_ + skey; } \
            const bf16* src_ = pl + (size_t)row_ * INP + OFF_B + 256 + 64 * h + 8 * spart; KR[j] = *(const u32x4*)src_; VR[j] = *(const u32x4*)(src_ + 256); } } while (0)
#define NA_STORE(KR, VR) do { _Pragma("unroll") for (int j = 0; j < 4; ++j) { *(LAS u32x4*)(wk + (8 * j + skey) * TP + spart * 16) = KR[j]; *(LAS u32x4*)(wv + (8 * j + skey) * TP + spart * 16) = VR[j]; } } while (0)
#define NA_TILE(t) do { \
            bf16x8 kf[4]; \
            _Pragma("unroll") \
            for (int ks = 0; ks < 4; ++ks) kf[ks] = *(const LAS bf16x8*)(wk + q * TP + (16 * ks + 8 * hh) * 2); \
            __builtin_amdgcn_sched_barrier(0); \
            f32x16 sc; \
            _Pragma("unroll") \
            for (int i = 0; i < 16; ++i) sc[i] = 0.f; \
            _Pragma("unroll") \
            for (int ks = 0; ks < 4; ++ks) sc = __builtin_amdgcn_mfma_f32_32x32x16_bf16(kf[ks], qf[ks], sc, 0, 0, 0); \
            __builtin_amdgcn_sched_barrier(0); \
            s16x4 vl[4], vh[4]; \
            _Pragma("unroll") \
            for (int kk = 0; kk < 2; ++kk) { const LAS unsigned char* a0 = wv + (16 * kk + trow) * TP + tcol * 2; \
                vl[2 * kk] = lds_tr16(a0); vh[2 * kk] = lds_tr16(a0 + 8 * TP); vl[2 * kk + 1] = lds_tr16(a0 + 64); vh[2 * kk + 1] = lds_tr16(a0 + 8 * TP + 64); } \
            __builtin_amdgcn_sched_barrier(0); \
            const float nm = -mref; \
            if (t < 8) { \
            _Pragma("unroll") \
                for (int i = 0; i < 16; ++i) sc[i] = fmaf(sc[i], QS, nm); \
            } else { \
                const int wt = t - 8; \
            _Pragma("unroll") \
                for (int g = 0; g < 4; ++g) { \
                    const int x_ = 4 * wt + g, rr_ = (x_ * 205) >> 10, cg_ = x_ - 5 * rr_; \
                    const LAS float* bp = (const LAS float*)((const LAS unsigned char*)btab + baddr + (rr_ * 31 + 8 * cg_) * 4); \
                    const int vk = vk0 + 8 * cg_; \
            _Pragma("unroll") \
                    for (int e = 0; e < 4; ++e) { float bias = bp[e]; asm volatile("" : "+v"(bias));     \
                        const bool ok = (unsigned)(vk + e) < 16u; sc[4 * g + e] = ok ? fmaf(sc[4 * g + e], QS, bias + nm) : -1.0e30f; } \
                } \
            } \
            float mx = sc[0]; \
            _Pragma("unroll") \
            for (int i = 1; i < 16; i += 2) mx = __builtin_fmaxf(__builtin_fmaxf(mx, sc[i]), sc[i + 1 < 16 ? i + 1 : i]); \
            mx = xmax32(mx); \
            if (t == 0 || __any(mx > THR)) { \
                const float dl = (t == 0) ? mx : __builtin_fmaxf(mx, 0.f), alpha = __builtin_amdgcn_exp2f(-dl); \
                mref += dl; lsum *= alpha; \
            _Pragma("unroll") \
                for (int i = 0; i < 16; ++i) { ot0[i] *= alpha; ot1[i] *= alpha; sc[i] -= dl; } \
            } \
            float rsum = 0.f; \
            _Pragma("unroll") \
            for (int i = 0; i < 16; ++i) { sc[i] = __builtin_amdgcn_exp2f(sc[i]); rsum += sc[i]; } \
            lsum += rsum; \
            bf16x8 pb[2]; pb[0] = pack8(sc, 0); pb[1] = pack8(sc, 8); \
            _Pragma("unroll") \
            for (int kk = 0; kk < 2; ++kk) { \
                const bf16x8 v0 = (bf16x8){vl[2 * kk][0], vl[2 * kk][1], vl[2 * kk][2], vl[2 * kk][3], vh[2 * kk][0], vh[2 * kk][1], vh[2 * kk][2], vh[2 * kk][3]}; \
                const bf16x8 v1 = (bf16x8){vl[2 * kk + 1][0], vl[2 * kk + 1][1], vl[2 * kk + 1][2], vl[2 * kk + 1][3], vh[2 * kk + 1][0], vh[2 * kk + 1][1], vh[2 * kk + 1][2], vh[2 * kk + 1][3]}; \
                ot0 = __builtin_amdgcn_mfma_f32_32x32x16_bf16(v0, pb[kk], ot0, 0, 0, 0); \
                ot1 = __builtin_amdgcn_mfma_f32_32x32x16_bf16(v1, pb[kk], ot1, 0, 0, 0); \
            } \
        } while (0)
        NA_LOAD(0, krA, vrA); NA_LOAD(1, krB, vrB); NA_STORE(krA, vrA);
        if (2 < ntile) NA_LOAD(2, krA, vrA);
        for (int t = 0; t < ntile; t += 2) {
            NA_TILE(t);
            NA_STORE(krB, vrB); if (t + 3 < ntile) NA_LOAD(t + 3, krB, vrB);
            NA_TILE(t + 1);
            if (t + 2 < ntile) { NA_STORE(krA, vrA); if (t + 4 < ntile) NA_LOAD(t + 4, krA, vrA); }
        }
#undef NA_TILE
#undef NA_LOAD
#undef NA_STORE
        lsum = xsum32(lsum);
        const float il = 1.f / lsum;
        bf16* orow = ml + (size_t)qrow * D + 256 + h * 64 + 4 * hh;
#pragma unroll
        for (int g = 0; g < 4; ++g) {
            u32x2 o0, o1;
            o0.x = pg8::cvt_pk_bf16(ot0[4 * g] * il, ot0[4 * g + 1] * il); o0.y = pg8::cvt_pk_bf16(ot0[4 * g + 2] * il, ot0[4 * g + 3] * il);
            o1.x = pg8::cvt_pk_bf16(ot1[4 * g] * il, ot1[4 * g + 1] * il); o1.y = pg8::cvt_pk_bf16(ot1[4 * g + 2] * il, ot1[4 * g + 3] * il);
            *(u32x2*)(orow + 8 * g) = o0; *(u32x2*)(orow + 32 + 8 * g) = o1;
        }
    }
    __syncthreads();
}

__device__ __forceinline__ float sumsq8(const bf16x8& v) { const u32x4 u = __builtin_bit_cast(u32x4, v); float s = 0.f;
#pragma unroll
    for (int j = 0; j < 4; ++j) { const float a = __uint_as_float(u[j] << 16), b = __uint_as_float(u[j] & 0xffff0000u); s += a * a + b * b; }
    return s; }
template <int PART> __device__ __forceinline__ void mla_up_item(Frame& F, int l, int it) {
    const int lane = F.lane, tkn = lane & 31, hh = lane >> 5;
    const bf16* pl = F.pl(); const bf16* wq = F.wuq() + (size_t)l * 384 * 256; const bf16* wkv = F.wukv() + (size_t)l * 512 * 128;
    bf16* qm = F.qm(); bf16* km = F.km(); bf16* vm = F.vm();
    {
        const int h = it & 3, row = (it >> 2) * 32 + tkn; const bool lat = row < TL; const int t = row & (SEQ - 1);
        int lnw = lane; asm volatile("" : "+v"(lnw));
        const bf16* pr = pl + (size_t)row * INP + OFF_D;
        bf16x8 bq[16], bk[8]; float sq = 0.f, sk = 0.f;
        if (PART != 1) {
#pragma unroll
            for (int ks = 0; ks < 16; ++ks) { bq[ks] = *(const bf16x8*)(pr + 16 * ks + 8 * hh); sq += sumsq8(bq[ks]); } }
        if (PART != 0) {
#pragma unroll
            for (int ks = 0; ks < 8; ++ks) { bk[ks] = *(const bf16x8*)(pr + 256 + 16 * ks + 8 * hh); sk += sumsq8(bk[ks]); } }
        sq = xsum32(sq); sk = xsum32(sk);
        const float rq = rsqrtf(sq * (1.f / 256.f) + EPS) * (MLA_SCALE * LOG2E), rk = rsqrtf(sk * (1.f / 128.f) + EPS);
        if (PART != 1) {
            bf16x8 wfa[16], wfb[16];
#define UPQ_LOAD(W, q3_) do { const bf16* wr_ = wq + ((size_t)(3 * h + (q3_)) * 16 * 64 + lnw) * 8; _Pragma("unroll") for (int ks = 0; ks < 16; ++ks) W[ks] = *(const bf16x8*)(wr_ + 512 * ks); } while (0)
#define UPQ_TILE(W, q3_) do { const int nt = 3 * h + (q3_); f32x16 acc; _Pragma("unroll") for (int i = 0; i < 16; ++i) acc[i] = 0.f; \
            f32x4 cr = {1.f, 1.f, 1.f, 1.f}, sr = {0.f, 0.f, 0.f, 0.f}, cc = cr, sc = sr;       \
            if ((q3_) == 2 && lat) { cr = *(const f32x4*)(F.ropec() + t * 16 + 4 * hh); sr = *(const f32x4*)(F.ropes() + t * 16 + 4 * hh); cc = *(const f32x4*)(F.ropec() + t * 16 + 8 + 4 * hh); sc = *(const f32x4*)(F.ropes() + t * 16 + 8 + 4 * hh); } \
            __builtin_amdgcn_sched_barrier(0); \
            _Pragma("unroll") for (int ks = 0; ks < 16; ++ks) acc = __builtin_amdgcn_mfma_f32_32x32x16_bf16(W[ks], bq[ks], acc, 0, 0, 0); \
            __builtin_amdgcn_sched_barrier(0); \
            _Pragma("unroll") for (int i = 0; i < 16; ++i) acc[i] *= rq; \
            if ((q3_) == 2) { _Pragma("unroll") for (int e = 0; e < 4; ++e) { const float x1 = acc[e], x2 = acc[4 + e], y1 = acc[8 + e], y2 = acc[12 + e]; \
                    acc[e] = x1 * cr[e] - x2 * sr[e]; acc[4 + e] = x1 * sr[e] + x2 * cr[e]; acc[8 + e] = y1 * cc[e] - y2 * sc[e]; acc[12 + e] = y1 * sc[e] + y2 * cc[e]; } } \
            bf16* o = qm + (size_t)row * 384 + 32 * nt + 4 * hh; \
            _Pragma("unroll") for (int g = 0; g < 4; ++g) { u32x2 w; w.x = pg8::cvt_pk_bf16(acc[4 * g], acc[4 * g + 1]); w.y = pg8::cvt_pk_bf16(acc[4 * g + 2], acc[4 * g + 3]); *(u32x2*)(o + 8 * g) = w; } } while (0)
            UPQ_LOAD(wfa, 0); UPQ_LOAD(wfb, 1); UPQ_TILE(wfa, 0); UPQ_LOAD(wfa, 2); UPQ_TILE(wfb, 1); UPQ_TILE(wfa, 2);
#undef UPQ_LOAD
#undef UPQ_TILE
        }
        if (PART != 0) {
            bf16x8 wka[8], wkb[8];
#define UPK_LOAD(W, sub_) do { const bf16* wr_ = wkv + ((size_t)(4 * h + (sub_)) * 8 * 64 + lnw) * 8; _Pragma("unroll") for (int ks = 0; ks < 8; ++ks) W[ks] = *(const bf16x8*)(wr_ + 512 * ks); } while (0)
#define UPK_TILE(W, sub_) do { f32x16 acc; _Pragma("unroll") for (int i = 0; i < 16; ++i) acc[i] = 0.f; \
            __builtin_amdgcn_sched_barrier(0); \
            _Pragma("unroll") for (int ks = 0; ks < 8; ++ks) acc = __builtin_amdgcn_mfma_f32_32x32x16_bf16(W[ks], bk[ks], acc, 0, 0, 0); \
            __builtin_amdgcn_sched_barrier(0); \
            bf16* o = ((sub_) < 2) ? km + (size_t)row * 384 + 96 * h + 32 * (sub_) + 4 * hh : vm + (size_t)row * 256 + 64 * h + 32 * ((sub_) - 2) + 4 * hh; \
            _Pragma("unroll") for (int g = 0; g < 4; ++g) { u32x2 w; w.x = pg8::cvt_pk_bf16(acc[4 * g] * rk, acc[4 * g + 1] * rk); w.y = pg8::cvt_pk_bf16(acc[4 * g + 2] * rk, acc[4 * g + 3] * rk); *(u32x2*)(o + 8 * g) = w; } } while (0)
            UPK_LOAD(wka, 0); UPK_LOAD(wkb, 1); UPK_TILE(wka, 0); UPK_LOAD(wka, 2); UPK_TILE(wkb, 1); UPK_LOAD(wkb, 3); UPK_TILE(wka, 2); UPK_TILE(wkb, 3);
#undef UPK_LOAD
#undef UPK_TILE
        }
        if (PART != 1) { const u32x4 a = *(const u32x4*)(pr + 384 + 16 * hh), bb = *(const u32x4*)(pr + 384 + 16 * hh + 8);
          float x1[8], x2[8];
#pragma unroll
          for (int j = 0; j < 4; ++j) { x1[2 * j] = __uint_as_float(a[j] << 16); x1[2 * j + 1] = __uint_as_float(a[j] & 0xffff0000u); x2[2 * j] = __uint_as_float(bb[j] << 16); x2[2 * j + 1] = __uint_as_float(bb[j] & 0xffff0000u); }
          float o1[8], o2[8];
#pragma unroll
          for (int j = 0; j < 8; ++j) { float c = 1.f, sn = 0.f; if (lat) { c = F.ropec()[t * 16 + 8 * hh + j]; sn = F.ropes()[t * 16 + 8 * hh + j]; } o1[j] = x1[j] * c - x2[j] * sn; o2[j] = x1[j] * sn + x2[j] * c; }
          u32x4 w1, w2;
#pragma unroll
          for (int j = 0; j < 4; ++j) { w1[j] = pg8::cvt_pk_bf16(o1[2 * j], o1[2 * j + 1]); w2[j] = pg8::cvt_pk_bf16(o2[2 * j], o2[2 * j + 1]); }
          bf16* o = km + (size_t)row * 384 + 96 * h + 64 + 16 * hh; *(u32x4*)o = w1; *(u32x4*)(o + 8) = w2; }
    }
}

__device__ __forceinline__ void p3_mla_up(Frame& F, int l) {
    for (int it = F.gw; it < (T / 32) * 4; it += F.ngw) mla_up_item<2>(F, l, it);
}
__device__ __forceinline__ void p3_mla_up_queued(Frame& F, int l, int lc) {
    volatile LAS int* dq = (volatile LAS int*)(F.lds + DYNQ_OFF);
    unsigned* head = F.ctl() + CW_HEAD2 + lc * 64; unsigned* rdy = F.ctl() + CW_RDY2 + lc * 128 * 64;
    constexpr int NID = (T / 32) * 4 * 2;
    for (;;) {
        __syncthreads();
        if (F.tid == 0) dq[0] = (int)__hip_atomic_fetch_add(head, 16u, __ATOMIC_RELAXED, __HIP_MEMORY_SCOPE_AGENT);
        __syncthreads();
        const int base = dq[0];
        if (base >= NID) break;
        if (F.wave == 0) {
            const int t0 = base >> 6, t1 = (base + 15) >> 6; unsigned spins = 0;
            while ((unsigned)__builtin_amdgcn_readfirstlane(__hip_atomic_load(rdy + 64 * t0, __ATOMIC_RELAXED, __HIP_MEMORY_SCOPE_AGENT)) < 16u ||
                   (unsigned)__builtin_amdgcn_readfirstlane(__hip_atomic_load(rdy + 64 * t1, __ATOMIC_RELAXED, __HIP_MEMORY_SCOPE_AGENT)) < 16u) {
                __builtin_amdgcn_s_sleep(2);
                if (++spins > (1u << 20)) { if (F.lane == 0) __hip_atomic_store(F.ctl() + CW_TMO, 1u, __ATOMIC_RELAXED, __HIP_MEMORY_SCOPE_AGENT); break; } }
            __builtin_amdgcn_fence(__ATOMIC_ACQUIRE, "agent"); asm volatile("s_waitcnt vmcnt(0)" ::: "memory"); }
        __syncthreads();
        { const int id = base + F.wave, it = id >> 1; if (id & 1) mla_up_item<1>(F, l, it); else mla_up_item<0>(F, l, it); }
        { const int id = base + 8 + (F.wave ^ 1), it = id >> 1; if (id & 1) mla_up_item<1>(F, l, it); else mla_up_item<0>(F, l, it); }
    }
}
__device__ __forceinline__ void p3_pool_mfma(CPR p, Frame& F, int l) {
    constexpr int RP = 144, PW = 48 * RP;
    const bf16* pl = F.pl(); bf16* ml = F.ml();
    for (int pass = 0, it = F.gw; it < (T / 32) * 4; ++pass, it = F.ngw * pass + ((F.gw + 256) % F.ngw)) {
        int lane = F.lane; asm volatile("" : "+v"(lane));
        const int tk = lane & 31, hh = lane >> 5, srow = lane >> 3, spart = lane & 7;
        LAS unsigned char* wl = F.lds + F.wave * PW;
        const int g = it & 3, row0 = (it >> 2) * 32, win = 2 << g;
        const int L = row0 < TL ? SEQ : CTX, t0 = row0 < TL ? (row0 & (SEQ - 1)) : ((row0 - TL) & (CTX - 1)), seg0 = row0 - t0;
        u32x4 st[6];
#pragma unroll
        for (int k = 0; k < 6; ++k) { const int r = 8 * k + srow, sidx = t0 - win / 2 + r; const bool ok = r < 32 + win && sidx >= 0 && sidx < L;
            st[k] = *(const u32x4*)(pl + (size_t)(seg0 + (ok ? sidx : t0)) * INP + 64 * g + 8 * spart);
            if (!ok) { st[k].x = 0u; st[k].y = 0u; st[k].z = 0u; st[k].w = 0u; } }
        const bf16* wt = F.poolw() + (size_t)(l * 4 + g) * 4096;
        bf16x8 wf[8]; f32x4 psv[2][4];
#pragma unroll
        for (int i = 0; i < 8; ++i) wf[i] = *(const bf16x8*)(wt + (size_t)(32 * (i >> 2) + tk) * 64 + 16 * (i & 3) + 8 * hh);
#pragma unroll
        for (int i = 0; i < 8; ++i) psv[i >> 2][i & 3] = *(const f32x4*)(p.pool_s + l * 256 + 64 * g + 32 * (i >> 2) + 4 * hh + 8 * (i & 3));
#pragma unroll
        for (int k = 0; k < 6; ++k) *(LAS u32x4*)(wl + (8 * k + srow) * RP + spart * 16) = st[k];
        const int t = t0 + tk; int lo = t - win / 2, hi = t - win / 2 + win; lo = lo < 0 ? 0 : lo; hi = hi > L ? L : hi;
        const float inv = 1.f / (float)(hi - lo);
        float sum[32];
#pragma unroll
        for (int i = 0; i < 32; ++i) sum[i] = 0.f;
        const LAS unsigned char* rl = wl + tk * RP + hh * 16;
        for (int w = 0; w < win; w += 2) {
            u32x4 v[2][4];
#pragma unroll
            for (int d = 0; d < 2; ++d)
#pragma unroll
                for (int ks = 0; ks < 4; ++ks) v[d][ks] = *(const LAS u32x4*)(rl + (w + d) * RP + 32 * ks);
#pragma unroll
            for (int d = 0; d < 2; ++d)
#pragma unroll
                for (int ks = 0; ks < 4; ++ks)
#pragma unroll
                    for (int j = 0; j < 4; ++j) { sum[8 * ks + 2 * j] += __uint_as_float(v[d][ks][j] << 16); sum[8 * ks + 2 * j + 1] += __uint_as_float(v[d][ks][j] & 0xffff0000u); }
        }
        bf16x8 df[4];
#pragma unroll
        for (int ks = 0; ks < 4; ++ks) { const u32x4 v = *(const LAS u32x4*)(rl + (win / 2) * RP + 32 * ks); u32x4 wq;
#pragma unroll
            for (int j = 0; j < 4; ++j) wq[j] = pg8::cvt_pk_bf16(sum[8 * ks + 2 * j] * inv - __uint_as_float(v[j] << 16), sum[8 * ks + 2 * j + 1] * inv - __uint_as_float(v[j] & 0xffff0000u));
            df[ks] = __builtin_bit_cast(bf16x8, wq); }
        const int row = row0 + tk;
#pragma unroll
        for (int dt = 0; dt < 2; ++dt) {
            f32x16 acc;
#pragma unroll
            for (int i = 0; i < 16; ++i) acc[i] = 0.f;
#pragma unroll
            for (int ks = 0; ks < 4; ++ks) acc = __builtin_amdgcn_mfma_f32_32x32x16_bf16(wf[4 * dt + ks], df[ks], acc, 0, 0, 0);
            const int col = 64 * g + 32 * dt + 4 * hh; bf16* o = ml + (size_t)row * D + col;
#pragma unroll
            for (int gg = 0; gg < 4; ++gg) { const f32x4 sc = psv[dt][gg]; u32x2 wq; wq.x = pg8::cvt_pk_bf16(acc[4 * gg] * sc.x, acc[4 * gg + 1] * sc.y); wq.y = pg8::cvt_pk_bf16(acc[4 * gg + 2] * sc.z, acc[4 * gg + 3] * sc.w); *(u32x2*)(o + 8 * gg) = wq; }
        }
    }
}
__device__ __forceinline__ void p3_sgu_mfma(CPR p, Frame& F, int l) {
    constexpr int VP = 144;
    const int tid = F.tid, lane = F.lane, tk = lane & 31, hh = lane >> 5, pt = F.wave >> 1, ct = F.wave & 1;
    const bf16* pl = F.pl(); bf16* ml = F.ml();
    const int trow = 8 * hh + ((lane & 15) >> 2), tcol = 16 * ((lane >> 4) & 1) + 4 * (lane & 3);
    __syncthreads();
    for (int pass = 0, it = blockIdx.x; it < (T / 128) * 4; ++pass, it = (int)gridDim.x * pass + ((pass == 2) ? (((int)blockIdx.x + 64) % (int)gridDim.x) : (int)blockIdx.x)) {
        const int g = it & 3, r0 = (it >> 2) * 128;
        bf16x8 wf[8]; u32x2 uv[4];
        const int orow = r0 + 32 * pt + tk, ocol = 64 * g + 32 * ct + 4 * hh;
        const float obias = p.sgu_b[(l * 4 + g) * 128 + 32 * pt + tk];
        { const bf16* wrow = F.sguw() + ((size_t)(l * 4 + g) * 128 + 32 * pt + tk) * 128 + 8 * hh;
#pragma unroll
          for (int ks = 0; ks < 8; ++ks) wf[ks] = *(const bf16x8*)(wrow + 16 * ks);
#pragma unroll
          for (int gg = 0; gg < 4; ++gg) uv[gg] = *(const u32x2*)(pl + (size_t)orow * INP + OFF_C + ocol + 8 * gg); }
        {
            const int qq = tid >> 2, c0 = 16 * (tid & 3);
            const bf16* src = pl + (size_t)(r0 + qq) * INP + OFF_C + 256 + 64 * g + c0;
            const u32x4 a = *(const u32x4*)src, b = *(const u32x4*)(src + 8);
            const float* gnp = p.sgu_norm_g + l * 256 + 64 * g + c0;
            const f32x4 gn0 = *(const f32x4*)gnp, gn1 = *(const f32x4*)(gnp + 4), gn2 = *(const f32x4*)(gnp + 8), gn3 = *(const f32x4*)(gnp + 12);
            const float gn[16] = {gn0.x, gn0.y, gn0.z, gn0.w, gn1.x, gn1.y, gn1.z, gn1.w, gn2.x, gn2.y, gn2.z, gn2.w, gn3.x, gn3.y, gn3.z, gn3.w};
            float v[16]; float ss = 0.f;
#pragma unroll
            for (int j = 0; j < 4; ++j) { v[2 * j] = gelu_tanh(__uint_as_float(a[j] << 16)); v[2 * j + 1] = gelu_tanh(__uint_as_float(a[j] & 0xffff0000u)); v[8 + 2 * j] = gelu_tanh(__uint_as_float(b[j] << 16)); v[8 + 2 * j + 1] = gelu_tanh(__uint_as_float(b[j] & 0xffff0000u)); }
#pragma unroll
            for (int j = 0; j < 16; ++j) ss += v[j] * v[j];
            ss += lane_xor<1>(ss); ss += lane_xor<2>(ss);
            const float rs = rsqrtf(ss * (1.f / 64.f) + EPS);
            u32x4 w0, w1;
#pragma unroll
            for (int j = 0; j < 4; ++j) { w0[j] = pg8::cvt_pk_bf16(v[2 * j] * rs * gn[2 * j], v[2 * j + 1] * rs * gn[2 * j + 1]); w1[j] = pg8::cvt_pk_bf16(v[8 + 2 * j] * rs * gn[8 + 2 * j], v[8 + 2 * j + 1] * rs * gn[8 + 2 * j + 1]); }
            LAS unsigned char* d = F.lds + qq * VP + c0 * 2; *(LAS u32x4*)d = w0; *(LAS u32x4*)(d + 16) = w1;
        }
        __syncthreads();
        f32x16 acc;
#pragma unroll
        for (int i = 0; i < 16; ++i) acc[i] = 0.f;
        s16x4 vlo[8], vhi[8];
#pragma unroll
        for (int ks = 0; ks < 8; ++ks) { const LAS unsigned char* a0 = F.lds + (16 * ks + trow) * VP + (32 * ct + tcol) * 2; vlo[ks] = lds_tr16(a0); vhi[ks] = lds_tr16(a0 + 4 * VP); }
        __builtin_amdgcn_sched_barrier(0);
#pragma unroll
        for (int ks = 0; ks < 8; ++ks) {
            const bf16x8 va = (bf16x8){vlo[ks][0], vlo[ks][1], vlo[ks][2], vlo[ks][3], vhi[ks][0], vhi[ks][1], vhi[ks][2], vhi[ks][3]};
            acc = __builtin_amdgcn_mfma_f32_32x32x16_bf16(va, wf[ks], acc, 0, 0, 0);
        }
        const int row = orow, col = ocol; const float bias = obias;
#pragma unroll
        for (int gg = 0; gg < 4; ++gg) { const u32x2 uu = uv[gg];
            const float u0 = gelu_tanh(__uint_as_float(uu.x << 16)), u1 = gelu_tanh(__uint_as_float(uu.x & 0xffff0000u)), u2 = gelu_tanh(__uint_as_float(uu.y << 16)), u3 = gelu_tanh(__uint_as_float(uu.y & 0xffff0000u));
            u32x2 w; w.x = pg8::cvt_pk_bf16(u0 * (acc[4 * gg] + bias), u1 * (acc[4 * gg + 1] + bias)); w.y = pg8::cvt_pk_bf16(u2 * (acc[4 * gg + 2] + bias), u3 * (acc[4 * gg + 3] + bias));
            *(u32x2*)(ml + (size_t)row * D + 512 + col + 8 * gg) = w; }
        __syncthreads();
    }
}

__device__ __forceinline__ void p5_outproj_naive(Frame& F, int l) {
    const bf16* W = F.wout() + (size_t)l * D * D;
    for (long i = F.gt; i < (long)T * D; i += F.ngt) { const int r = (int)(i >> 10), c = (int)(i & 1023);
        const float g = mod_vec(F, l, row_mod(r), 2)[c];
        F.xl()[(size_t)r * D + c] = (bf16)f2bf(bf2f(F.xl()[(size_t)r * D + c]) + g * dot_bf16(F.ml() + (size_t)r * D, W + (size_t)c * D, D)); }
}

constexpr int P6_MAXPASS = 2, P6_MAXDEC = P6_MAXPASS * NWAVES * 16;
constexpr int P6_DEC_OFF = 65536, P6_CNT_OFF = P6_DEC_OFF + P6_MAXDEC * 16, P6_MOD_OFF = P6_CNT_OFF + 256;
static_assert(2 * P6_MAXDEC == NTHR && P6_MOD_OFF + 5 * 2 * 1024 * 4 <= 131072, "P6 LDS layout");
__device__ __forceinline__ void route_commit_wg(Frame& F, int l) {
    LAS int* lcnt = (LAS int*)(F.lds + P6_CNT_OFF);
    __syncthreads();
    int e = 0, pos = 0, row = -1; float w = 0.f; const int which = F.tid & 1;
    { const i32x4 d = ((const LAS i32x4*)(F.lds + P6_DEC_OFF))[F.tid >> 1]; row = d.w;
      if (row >= 0) { e = which ? (d.x >> 8) : (d.x & 255); w = __builtin_bit_cast(float, which ? d.z : d.y); pos = __hip_atomic_fetch_add(lcnt + e, 1, __ATOMIC_RELAXED, __HIP_MEMORY_SCOPE_WORKGROUP); } }
    __syncthreads();
    if (F.tid < NE) { const int n = lcnt[F.tid]; lcnt[16 + F.tid] = n ? (int)atomicAdd(F.ctl() + CW_CNT + l * NE * 64 + F.tid * 64, (unsigned)n) : 0; }
    __syncthreads();
    if (row >= 0) { const int slot = lcnt[16 + e] + pos; F.tok()[e * CAP + slot] = row; F.wl()[e * CAP + slot] = w; i32x2 rt; rt.x = e; rt.y = slot; *(i32x2*)(F.route() + 4 * row + 2 * which) = rt; }
}
__device__ __forceinline__ void p6_rows(CPR p, Frame& F, int l, bool commit = true) {
    LAS float* mdl = (LAS float*)(F.lds + P6_MOD_OFF);
    __syncthreads();
    { u32x4 t[8];
#pragma unroll
      for (int k = 0; k < 8; ++k) t[k] = ((const u32x4*)F.rwf())[F.tid + NTHR * k];
#pragma unroll
      for (int k = 0; k < 8; ++k) ((LAS u32x4*)F.lds)[F.tid + NTHR * k] = t[k]; }
    for (int i = F.tid; i < 5 * 256; i += NTHR) { const int mr = i >> 8, c = (i & 255) * 4;
        const f32x4 g = *(const f32x4*)(p.norm2_g + l * D + c), s4 = *(const f32x4*)(mod_vec(F, l, mr, 3) + c), q4 = *(const f32x4*)(mod_vec(F, l, mr, 4) + c);
        *(LAS f32x4*)(mdl + mr * 2048 + c) = g * (q4 + 1.f); *(LAS f32x4*)(mdl + mr * 2048 + 1024 + c) = s4; }
    if (F.tid < P6_MAXDEC) { i32x4 z; z.x = 0; z.y = 0; z.z = 0; z.w = -1; ((LAS i32x4*)(F.lds + P6_DEC_OFF))[F.tid] = z; }
    if (F.tid < 32) ((LAS int*)(F.lds + P6_CNT_OFF))[F.tid] = 0;
    __syncthreads();
    TMARK(60);
    const int nitems = ((l + 1 < DEPTH) ? T : TL) / 16;
    const int q = F.lane >> 4, n = F.lane & 15;
    const f32x4 rb = *(const f32x4*)(p.router_b + 4 * q);
    int kpass = 0;
    for (int it = F.wave * (int)gridDim.x + (int)blockIdx.x; it < nitems && kpass < P6_MAXPASS; it += NWAVES * (int)gridDim.x, ++kpass) {
        const int row = it * 16 + n, mr = row_mod(it * 16);
        const bf16* xr = F.xl() + (size_t)row * D + 8 * q;
        u32x4 raw[32];
#pragma unroll
        for (int sx = 0; sx < 32; ++sx) raw[sx] = *(const u32x4*)(xr + 32 * sx);
        float ss = 0.f;
#pragma unroll
        for (int sx = 0; sx < 32; ++sx)
#pragma unroll
            for (int d = 0; d < 4; ++d) { const float a = __uint_as_float(raw[sx][d] << 16), b = __uint_as_float(raw[sx][d] & 0xffff0000u); ss = __builtin_fmaf(a, a, ss); ss = __builtin_fmaf(b, b, ss); }
        ss += lane_xor<16>(ss); ss = xsum32(ss);
#pragma unroll
        for (int sx = 0; sx < 32; ++sx) asm volatile("" : "+v"(raw[sx]));
        const float rs = rsqrtf(ss * (1.f / D) + EPS);
        bf16* hr = F.ha() + (size_t)row * D + 8 * q;
        const LAS float* mm = mdl + mr * 2048 + 8 * q;
        const LAS unsigned char* fr = F.lds + F.lane * 16;
        f32x4 acc = {0.f, 0.f, 0.f, 0.f};
#pragma unroll
        for (int sx = 0; sx < 32; ++sx) {
            const f32x4 m0 = *(const LAS f32x4*)(mm + 32 * sx), m1 = *(const LAS f32x4*)(mm + 32 * sx + 4), s0 = *(const LAS f32x4*)(mm + 1024 + 32 * sx), s1 = *(const LAS f32x4*)(mm + 1024 + 32 * sx + 4);
            const bf16x8 ah = *(const LAS bf16x8*)(fr + sx * 1024), al = *(const LAS bf16x8*)(fr + 32768 + sx * 1024);
            float h[8];
#pragma unroll
            for (int d = 0; d < 4; ++d) { const float a = __uint_as_float(raw[sx][d] << 16), b = __uint_as_float(raw[sx][d] & 0xffff0000u);
                const float ma = (d < 2) ? m0[2 * d] : m1[2 * d - 4], mb = (d < 2) ? m0[2 * d + 1] : m1[2 * d - 3], sa = (d < 2) ? s0[2 * d] : s1[2 * d - 4], sb = (d < 2) ? s0[2 * d + 1] : s1[2 * d - 3];
                h[2 * d] = __builtin_fmaf(a, ma * rs, sa); h[2 * d + 1] = __builtin_fmaf(b, mb * rs, sb); }
            u32x4 hb; hb.x = pk2(h[0], h[1]); hb.y = pk2(h[2], h[3]); hb.z = pk2(h[4], h[5]); hb.w = pk2(h[6], h[7]);
            *(u32x4*)(hr + 32 * sx) = hb;
            const bf16x8 bh = __builtin_bit_cast(bf16x8, hb);
            acc = __builtin_amdgcn_mfma_f32_16x16x32_bf16(ah, bh, acc, 0, 0, 0);
            acc = __builtin_amdgcn_mfma_f32_16x16x32_bf16(al, bh, acc, 0, 0, 0);
            if (sx & 1) asm volatile("" ::: "memory");
        }
        float b0 = 0.f, s0 = 0.f, b1 = -3.0e38f, s1 = 0.f; int i0 = 0, i1 = 0;
#pragma unroll
        for (int r = 0; r < 4; ++r) { const float sc = 1.f / (1.f + __expf(-acc[r])), x = sc + rb[r];
            if (r == 0) { b0 = x; s0 = sc; }
            else { const bool g0 = x > b0, g1 = x > b1;
                b1 = g0 ? b0 : (g1 ? x : b1); s1 = g0 ? s0 : (g1 ? sc : s1); i1 = g0 ? i0 : (g1 ? r : i1);
                b0 = g0 ? x : b0; s0 = g0 ? sc : s0; i0 = g0 ? r : i0; } }
        float gs = b0 + b1; int g = q;
        { const float og = lane_xor<16>(gs); const int pg = g ^ 1; const bool take = (og > gs) || (og == gs && pg < g); gs = take ? og : gs; g = take ? pg : g; }
        { const float og = other32(gs); const int pg = __float_as_int(other32(__int_as_float(g))); const bool take = (og > gs) || (og == gs && pg < g); g = take ? pg : g; }
        if (commit && g == q) { const float ws = s0 + s1; i32x4 d; d.x = (4 * q + i0) | ((4 * q + i1) << 8); d.y = __float_as_int(s0 / ws); d.z = __float_as_int(s1 / ws); d.w = row;
            ((LAS i32x4*)(F.lds + P6_DEC_OFF))[(kpass * NWAVES + F.wave) * 16 + n] = d; }
    }
    TMARK(61);
    if (commit) route_commit_wg(F, l);
    __syncthreads();
    TMARK(62);
}

__device__ __forceinline__ void p6b_sort(Frame& F, int l) {
    const volatile LAS int* tab = (const volatile LAS int*)(F.lds + MOETAB_OFF);
    moe_table(F, l);
    for (int pi = F.gw; pi < T / 2; pi += F.ngw) {
        const int r = 2 * pi;
        const i32x4 rt0 = *(const i32x4*)(F.route() + 4 * r), rt1 = *(const i32x4*)(F.route() + 4 * r + 4);
        const u32x4* src = (const u32x4*)(F.ha() + (size_t)r * D) + F.lane;
        const u32x4 a0 = src[0], b0 = src[64], a1 = src[128], b1 = src[192];
        u32x4* d00 = (u32x4*)(F.hs() + (size_t)(tab[rt0.x] * 256 + rt0.y) * D) + F.lane; u32x4* d01 = (u32x4*)(F.hs() + (size_t)(tab[rt0.z] * 256 + rt0.w) * D) + F.lane;
        u32x4* d10 = (u32x4*)(F.hs() + (size_t)(tab[rt1.x] * 256 + rt1.y) * D) + F.lane; u32x4* d11 = (u32x4*)(F.hs() + (size_t)(tab[rt1.z] * 256 + rt1.w) * D) + F.lane;
        d00[0] = a0; d00[64] = b0; d01[0] = a0; d01[64] = b0; d10[0] = a1; d10[64] = b1; d11[0] = a1; d11[64] = b1;
    }
}

__device__ __forceinline__ void p7_moe1_naive(Frame& F, int l) {
    for (long i = F.gt; i < (long)T * 2 * DE; i += F.ngt) {
        const int a = (int)(i >> 8), f = (int)(i & 255), tokr = a >> 1, wh = a & 1;
        const int e = F.route()[4 * tokr + 2 * wh], sl = F.route()[4 * tokr + 2 * wh + 1];
        const bf16* W = F.w1() + (size_t)(l * NE + e) * 512 * D; const int grow = (f >> 7) * 256 + (f & 127);
        const float g = dot_bf16(F.ha() + (size_t)tokr * D, W + (size_t)grow * D, D), u = dot_bf16(F.ha() + (size_t)tokr * D, W + (size_t)(grow + 128) * D, D);
        F.hid()[(size_t)(ybase_of(F, l, e) + sl) * DE + f] = (bf16)f2bf(F.wl()[e * CAP + sl] * silu_f(g) * u);
    }
}
__device__ __forceinline__ void p8_moe2_naive(Frame& F, int l) {
    for (long i = F.gt; i < (long)T * 2 * D; i += F.ngt) {
        const int a = (int)(i >> 10), n = (int)(i & 1023), tokr = a >> 1, wh = a & 1;
        const int e = F.route()[4 * tokr + 2 * wh], sl = F.route()[4 * tokr + 2 * wh + 1]; const size_t pr = (size_t)(ybase_of(F, l, e) + sl);
        F.y()[pr * D + n] = (bf16)f2bf(dot_bf16(F.hid() + pr * DE, F.w2() + ((size_t)(l * NE + e) * D + n) * DE, DE));
    }
}

__device__ __forceinline__ void p9_final(CPR p, Frame& F) {
    const int l = DEPTH - 1;
    const volatile LAS int* tab = (const volatile LAS int*)(F.lds + MOETAB_OFF);
    moe_table(F, l);
    for (int pi = F.gw; pi < TL / 2; pi += F.ngw) {
        int c0 = 4 * F.lane; asm volatile("" : "+v"(c0));
        const int r0 = 2 * pi;
        const bf16* y0[2]; const bf16* y1[2];
#pragma unroll
        for (int k = 0; k < 2; ++k) { const i32x4 rt = *(const i32x4*)(F.route() + 4 * (r0 + k));
            y0[k] = F.y() + (size_t)(tab[rt.x] * 256 + rt.y) * D + c0; y1[k] = F.y() + (size_t)(tab[rt.z] * 256 + rt.w) * D + c0; }
        f32x4 v[2][4]; u32x2 a[2][4], b[2][4];
#pragma unroll
        for (int k = 0; k < 2; ++k)
#pragma unroll
            for (int j = 0; j < 4; ++j) { v[k][j] = ld_bf4(F.xl() + (size_t)(r0 + k) * D + c0 + 256 * j); a[k][j] = *(const u32x2*)(y0[k] + 256 * j); b[k][j] = *(const u32x2*)(y1[k] + 256 * j); }
        const float* g5 = mod_vec(F, l, row_mod(r0), 5) + c0;
        float ss0 = 0.f, ss1 = 0.f;
#pragma unroll
        for (int j = 0; j < 4; ++j) { const f32x4 g = *(const f32x4*)(g5 + 256 * j); add_y4(v[0][j], g, a[0][j], b[0][j]); add_y4(v[1][j], g, a[1][j], b[1][j]); ss0 += sumsq4(v[0][j]); ss1 += sumsq4(v[1][j]); }
        f32x4 gq[4];
#pragma unroll
        for (int j = 0; j < 4; ++j) gq[j] = *(const f32x4*)(p.final_g + c0 + 256 * j);
        __builtin_amdgcn_sched_barrier(0);
        ss0 = wave_sum(ss0); ss1 = wave_sum(ss1);
        const float rs0 = rsqrtf(ss0 * (1.f / D) + EPS), rs1 = rsqrtf(ss1 * (1.f / D) + EPS);
#pragma unroll
        for (int j = 0; j < 4; ++j) { const f32x4 g = gq[j];
            *(f32x4*)(p.out + (size_t)r0 * D + c0 + 256 * j) = v[0][j] * rs0 * g; *(f32x4*)(p.out + (size_t)(r0 + 1) * D + c0 + 256 * j) = v[1][j] * rs1 * g; }
    }
}

template <int NBATCH> __device__ __forceinline__ f32x16 wave_tile_k(const bf16* wrow, const bf16* xrow) {
    f32x16 acc;
#pragma unroll
    for (int i = 0; i < 16; ++i) acc[i] = 0.f;
    bf16x8 a0[8], b0[8], a1[8], b1[8];
#pragma unroll
    for (int j = 0; j < 8; ++j) { a0[j] = *(const bf16x8*)(wrow + 512 * j); b0[j] = *(const bf16x8*)(xrow + 16 * j); }
#pragma unroll 1
    for (int bt = 0; bt < NBATCH; bt += 2) {
#pragma unroll
        for (int j = 0; j < 8; ++j) { a1[j] = *(const bf16x8*)(wrow + 4096 * (bt + 1) + 512 * j); b1[j] = *(const bf16x8*)(xrow + 128 * (bt + 1) + 16 * j); }
        __builtin_amdgcn_sched_barrier(0);
#pragma unroll
        for (int j = 0; j < 8; ++j) acc = __builtin_amdgcn_mfma_f32_32x32x16_bf16(a0[j], b0[j], acc, 0, 0, 0);
        __builtin_amdgcn_sched_barrier(0);
        if (bt + 2 < NBATCH) {
#pragma unroll
            for (int j = 0; j < 8; ++j) { a0[j] = *(const bf16x8*)(wrow + 4096 * (bt + 2) + 512 * j); b0[j] = *(const bf16x8*)(xrow + 128 * (bt + 2) + 16 * j); } }
        __builtin_amdgcn_sched_barrier(0);
#pragma unroll
        for (int j = 0; j < 8; ++j) acc = __builtin_amdgcn_mfma_f32_32x32x16_bf16(a1[j], b1[j], acc, 0, 0, 0);
        __builtin_amdgcn_sched_barrier(0);
    }
    return acc;
}
__device__ __forceinline__ void p2_inproj(CPR p, Frame& F, int l, int lc) {
    pg8::StaticOrder S; S.init(T, INP, D, (int)gridDim.x, (int)blockIdx.x); S.rdy = F.ctl() + CW_RDY2 + lc * 128 * 64; S.pub_from = 6; S.pn_rot = 2;
    pg8::EpiBf16 E{F.pl(), INP, true, T * INP * 2};
    pg8::gemm_phase<pg8::EpiBf16, pg8::StaticOrder, true>(F.lds, F.tid, F.ha(), F.win() + (size_t)l * INP * D, D, S, E);
    TMARK(101);
    if (l + 1 < DEPTH && blockIdx.x >= 32) convert_layer(p, F, l + 1, ((int)blockIdx.x - 32) * NWAVES + F.wave, ((int)gridDim.x - 32) * NWAVES);
    TMARK(102);
    p3_mla_up_queued(F, l, lc);
    TMARK(103);
}
__device__ __forceinline__ void p5_outproj(Frame& F, int l, float gsc = 1.f) {
    pg8::StaticOrder S; S.init(TL, D, D, (int)gridDim.x, (int)blockIdx.x);
    pg8::EpiResid E{F.xl(), D, F.mod() + (size_t)l * 5 * NMOD * D, gsc};
    pg8::gemm_phase<pg8::EpiResid, pg8::StaticOrder, true>(F.lds, F.tid, F.ml(), F.wout() + (size_t)l * D * D, D, S, E);
    TMARK(51);
    if (l + 1 < DEPTH) {
        const int tk = F.lane & 31, hh = F.lane >> 5, half = F.wave >> 2, wp = F.wave & 3;
        LAS float* xch = (LAS float*)(F.lds + wp * 4096);
        __syncthreads();
        for (int it0 = blockIdx.x * 4; it0 < (TC / 32) * (D / 32); it0 += gridDim.x * 4) {
            const int it = it0 + wp, rt = it / (D / 32), nt = it % (D / 32), row = TL + 32 * rt + tk;
            const f32x16 acc = wave_tile_k<4>(F.woutf() + (size_t)l * D * D + ((size_t)nt * 64 * 64 + 32 * half * 64 + F.lane) * 8, F.ml() + (size_t)row * D + 512 * half + 8 * hh);
            if (half) {
#pragma unroll
                for (int i = 0; i < 16; ++i) xch[i * 64 + F.lane] = acc[i]; }
            __syncthreads();
            if (!half) {
                bf16* o = F.xl() + (size_t)row * D + 32 * nt + 4 * hh; const float* gp = mod_vec(F, l, 4, 2) + 32 * nt + 4 * hh;
                f32x4 xv[4], gv[4];
#pragma unroll
                for (int g = 0; g < 4; ++g) { xv[g] = ld_bf4(o + 8 * g); gv[g] = *(const f32x4*)(gp + 8 * g) * gsc; }
#pragma unroll
                for (int g = 0; g < 4; ++g) { f32x4 x = xv[g];
                    x.x += gv[g].x * (acc[4 * g] + xch[(4 * g) * 64 + F.lane]); x.y += gv[g].y * (acc[4 * g + 1] + xch[(4 * g + 1) * 64 + F.lane]);
                    x.z += gv[g].z * (acc[4 * g + 2] + xch[(4 * g + 2) * 64 + F.lane]); x.w += gv[g].w * (acc[4 * g + 3] + xch[(4 * g + 3) * 64 + F.lane]); st_bf4(o + 8 * g, x); }
            }
            __syncthreads();
        }
    }
}
__device__ __forceinline__ void p7_moe1(Frame& F, int l, int lc) {
    moe_table(F, l);
    pg8::MoeOrder<true, 2, D, false, true> S{(const volatile LAS int*)(F.lds + MOETAB_OFF), F.tok(), (int)gridDim.x, (int)blockIdx.x, (size_t)512 * D * 2, (volatile LAS unsigned*)(F.lds + ROWTAB_OFF),
        nullptr, F.ctl() + CW_RDY + lc * 192 * 64, F.ctl() + CW_TMO, nullptr};
    pg8::EpiMoe1 E{F.hid(), F.wl()};
    pg8::gemm_phase<pg8::EpiMoe1, pg8::MoeOrder<true, 2, D, false, true>, true>(F.lds, F.tid, F.ha(), F.w1() + (size_t)l * NE * 512 * D, D, S, E);
}
__device__ __forceinline__ void p8_moe2(Frame& F, int l, int lc) {
    moe_table(F, l);
    pg8::MoeOrder<false, 4, DE, true, false> S{(const volatile LAS int*)(F.lds + MOETAB_OFF), F.tok(), (int)gridDim.x, (int)blockIdx.x, (size_t)D * DE * 2, nullptr,
        F.ctl() + CW_HEAD + lc * 64, F.ctl() + CW_RDY + lc * 192 * 64, F.ctl() + CW_TMO, (volatile LAS int*)(F.lds + DYNQ_OFF)};
    pg8::EpiBf16 E{F.y(), D};
    pg8::gemm_phase<pg8::EpiBf16, pg8::MoeOrder<false, 4, DE, true, false>, true>(F.lds, F.tid, F.hid(), F.w2() + (size_t)l * NE * D * DE, DE, S, E);
}

constexpr int PH_FINAL = 1 + 10 * DEPTH, N_PHASES = PH_FINAL + 1;
__global__ void __launch_bounds__(NTHR, 2) fwd(Params p) {
    extern __shared__ __attribute__((aligned(16))) unsigned char lds_raw[];
    Frame F;
    F.lds = (LAS unsigned char*)lds_raw;
    F.tid = threadIdx.x; F.lane = F.tid & 63; F.wave = __builtin_amdgcn_readfirstlane(F.tid >> 6);
    F.gw = blockIdx.x * NWAVES + F.wave; F.ngw = gridDim.x * NWAVES; F.gt = blockIdx.x * NTHR + F.tid; F.ngt = gridDim.x * NTHR;
    const __attribute__((address_space(4))) Params* KP = (const __attribute__((address_space(4))) Params*)__builtin_amdgcn_kernarg_segment_ptr();
    F.ws = KP->ws;
    volatile LAS unsigned* MISC = (volatile LAS unsigned*)(F.lds + MISC_OFF);
    for (int u = F.tid; u < 32; u += NTHR) MISC[u] = 0u;
    if (F.lane == 0) ((volatile LAS int*)(F.lds + WTAB_OFF))[__builtin_amdgcn_s_getreg((5 << 11) | 4) & 63] = F.wave;
    __syncthreads();
#if MK_ONE_LAUNCH
    (void)xcd_barrier_post(F.ctl() + CW_BAR, MISC + 8);
#define GRID_BAR() do { XcdBarrier b_; b_.bar = (unsigned*)(KP->ws + WS_CTL) + CW_BAR; b_.x = xb_xcc_id(); b_.st = (volatile LAS unsigned*)(F.lds + MISC_OFF) + 8; xcd_barrier(b_); } while (0)
#else
#define GRID_BAR() do {} while (0)
#endif
#define lo (KP->ph_lo)
#define hi (KP->ph_hi)
#define PB() do { asm volatile("" : "+s"(KP)); F.ws = KP->ws; int ln_; asm volatile("v_mbcnt_lo_u32_b32 %0, -1, 0\n\tv_mbcnt_hi_u32_b32 %0, -1, %0" : "=v"(ln_)); \
    F.wave = __builtin_amdgcn_readfirstlane(((volatile LAS int*)(F.lds + WTAB_OFF))[__builtin_amdgcn_s_getreg((5 << 11) | 4) & 63]); F.lane = ln_; const int t_ = F.wave * 64 + ln_; F.tid = t_; \
    F.gw = blockIdx.x * NWAVES + F.wave; F.gt = blockIdx.x * NTHR + t_; F.ngw = gridDim.x * NWAVES; F.ngt = gridDim.x * NTHR; } while (0)
#ifndef PH_MASK
#define PH_MASK 0xFFF
#endif
#define INK(k, kind) (((PH_MASK >> (kind)) & 1) && lo <= (k) && (k) < hi)
#define IN(k) (lo <= (k) && (k) < hi)
#define SEAM(k) do { if (IN((k) + 1)) { GRID_BAR(); if (PROBE_REP & 0x10000) { GRID_BAR(); GRID_BAR(); } } } while (0)
#ifndef PROBE_REP
#define PROBE_REP 0
#endif
#define RUNK(kind, body) do { PB(); body; if ((PROBE_REP >> (kind)) & 1) { PB(); body; } } while (0)
    TMARK(-2);
    if (INK(0, 9)) { RUNK(9, p0_prologue(*KP, F)); SEAM(0); TMARK(9); }
    for (int l = 0; l < DEPTH; ++l) {
        const int pb = 1 + 10 * l;
        if (INK(pb + 0, 0)) { PB(); p1_rows(*KP, F, l); if (PROBE_REP & 1) { GRID_BAR(); PB(); p1_rows(*KP, F, l, 0.f); } SEAM(pb + 0); TMARK(0); }
        if (INK(pb + 1, 1)) { PB(); if (FAST_GEMM & 1) p2_inproj(*KP, F, l, l); else p2_inproj_naive(F, l); if (PROBE_REP & (1 << 25)) { GRID_BAR(); PB(); p2_inproj(*KP, F, l, l + 4); } SEAM(pb + 1); TMARK(1); }
        if (INK(pb + 2, 2)) { if (!(FAST_GEMM & 1)) { PB(); p3_mla_up(F, l); SEAM(pb + 3); } }
        if (INK(pb + 4, 4)) {
#define ATTN_SLOT() do { PB(); if (FAST_MLA) p4_mla_flash<0>(F); else p4_mla_naive(F); TMARK(41); \
                              RUNK(13, { if (FAST_PS & 1) p3_pool_mfma(*KP, F, l); else p3_pool_naive(*KP, F, l); }); if (PROBE_T >= 0) __syncthreads(); TMARK(42); \
                              RUNK(14, { if (FAST_PS & 2) p3_sgu_mfma(*KP, F, l); else p3_sgu1_naive(*KP, F, l); }); if (PROBE_T >= 0) __syncthreads(); TMARK(43); RUNK(15, { if (FAST_NA) p3_na_mfma(*KP, F, l); else p3_na_naive(*KP, F, l); }); if (PROBE_T >= 0) __syncthreads(); TMARK(44); } while (0)
                              ATTN_SLOT();
                              if ((PROBE_REP >> 20) & 15) { PB(); p4_mla_flash<(PROBE_REP >> 20) & 15>(F); }
                              if (PROBE_REP & (1 << 24)) { GRID_BAR(); ATTN_SLOT(); }
                              if (!(FAST_PS & 2)) { GRID_BAR(); PB(); p3_sgu2_naive(*KP, F, l); } SEAM(pb + 4); TMARK(4); }
        if (INK(pb + 5, 5)) { PB(); if (FAST_GEMM & 2) p5_outproj(F, l); else p5_outproj_naive(F, l); if (PROBE_REP & 32) { GRID_BAR(); PB(); p5_outproj(F, l, 0.f); } SEAM(pb + 5); TMARK(5); }
        if (INK(pb + 6, 6)) { PB(); p6_rows(*KP, F, l); if (PROBE_REP & 64) { PB(); p6_rows(*KP, F, l, false); } SEAM(pb + 6); TMARK(6); }
        if (INK(pb + 7, 11)) { if (!(FAST_GEMM & 4)) {} }
        if (INK(pb + 8, 7)) { PB(); p7_moe1(F, l, l); TMARK(71); PB(); p8_moe2(F, l, l); TMARK(72); if (PROBE_REP & (1 << 26)) { GRID_BAR(); PB(); p7_moe1(F, l, l + 4); PB(); p8_moe2(F, l, l + 4); } SEAM(pb + 9); TMARK(7); }
    }
    if (INK(PH_FINAL, 10)) { PB(); p9_final(*KP, F); TMARK(10); }
    if (PROBE_T >= 0 && blockIdx.x == PROBE_BLK && threadIdx.x == 0) {
        volatile LAS unsigned* M_ = (volatile LAS unsigned*)(F.lds + MISC_OFF) + 16; const unsigned t0_ = (unsigned)wall_clock64(), w_ = M_[1] * (unsigned)PROBE_TMUL;
        while ((unsigned)wall_clock64() - t0_ < w_) __builtin_amdgcn_s_sleep(8);
    }
}

extern "C" void kernel_launch(void* const* d_in, const int* in_sizes, int n_in, void* d_out, int out_size, void* d_ws, size_t ws_size, hipStream_t stream) {
    static int grid = 0;
    if (grid == 0) {
        if (n_in != 26 || out_size != TL * D || ws_size < WS_END) { fprintf(stderr, "kernel_launch: unexpected shapes: n_in %d out %d ws %zu (need %zu)\n", n_in, out_size, ws_size, (size_t)WS_END); grid = -1; return; }
        int dev = 0, cus = 0, per_cu = 0;
        if (hipGetDevice(&dev) != hipSuccess || hipDeviceGetAttribute(&cus, hipDeviceAttributeMultiprocessorCount, dev) != hipSuccess) { grid = -1; return; }
        if (hipFuncSetAttribute((const void*)fwd, hipFuncAttributeMaxDynamicSharedMemorySize, LDS_BYTES) != hipSuccess) { fprintf(stderr, "kernel_launch: hipFuncSetAttribute failed\n"); grid = -1; return; }
        if (hipOccupancyMaxActiveBlocksPerMultiprocessor(&per_cu, (const void*)fwd, NTHR, LDS_BYTES) != hipSuccess || per_cu < 1) fprintf(stderr, "kernel_launch: occupancy query says %d\n", per_cu);
        (void)hipGetLastError();
        if (cus < 128) { fprintf(stderr, "kernel_launch: %d CUs: the row phases are sized for at least 128 workgroups\n", cus); grid = -1; return; }
        grid = cus;
    }
    if (grid < 0) return;
    (void)hipMemsetAsync((char*)d_ws + WS_CTL, 0, CTL_ZERO_BYTES, stream);
    Params p{};
    const float** pp = (const float**)&p;
    for (int i = 0; i < 26; ++i) pp[i] = (const float*)d_in[i];
    p.out = (float*)d_out; p.ws = (unsigned char*)d_ws;
#if MK_ONE_LAUNCH
    p.ph_lo = 0; p.ph_hi = N_PHASES;
    hipLaunchKernelGGL(fwd, dim3(grid), dim3(NTHR), LDS_BYTES, stream, p);
#else
    for (int ph = 0; ph < N_PHASES; ++ph) {
        p.ph_lo = ph; p.ph_hi = ph + 1;
        hipLaunchKernelGGL(fwd, dim3(grid), dim3(NTHR), LDS_BYTES, stream, p);
    }
#endif
}
```

```cpp
#include <hip/hip_runtime.h>
#include <cstdio>
#include <cstdint>

#ifndef MK_ONE_LAUNCH
#define MK_ONE_LAUNCH 1
#endif

#ifndef FAST_NA
#define FAST_NA 1
#endif
#ifndef FAST_UP
#define FAST_UP 1
#endif
#ifndef FAST_PS
#define FAST_PS 3
#endif
#ifndef FAST_MLA
#define FAST_MLA 1
#endif
#ifndef FAST_GEMM
#define FAST_GEMM 0xF
#endif

#define GAS __attribute__((address_space(1)))
#define LAS __attribute__((address_space(3)))
typedef unsigned short bf16;
typedef float f32x4 __attribute__((ext_vector_type(4)));
typedef unsigned u32x4 __attribute__((ext_vector_type(4)));
typedef unsigned u32x2 __attribute__((ext_vector_type(2)));
typedef int i32x4 __attribute__((ext_vector_type(4)));
typedef int i32x2 __attribute__((ext_vector_type(2)));
typedef short bf16x8 __attribute__((ext_vector_type(8)));

constexpr int D = 1024, NB = 4, SEQ = 4096, DEPTH = 4, CTX = 256, GW = 64, GH = 64;
constexpr int TL = NB * SEQ, TC = NB * CTX, T = TL + TC;
constexpr int INW = 1952, INP = 2048;
constexpr int OFF_B = 256, OFF_C = 1024, OFF_D = 1536;
constexpr int NE = 16, DE = 256, CAP = T;
constexpr int RPAD = 2 * T + NE * 256;
constexpr int NMOD = 6;
constexpr float EPS = 1e-6f;
constexpr float LOG2E = 1.4426950408889634f;
constexpr float MLA_SCALE = 0.10206207261596575f;
constexpr int NWAVES = 8, NTHR = NWAVES * 64;

constexpr size_t MiB = 1u << 20;
constexpr size_t WS_CTL = 0, CTL_ZERO_BYTES = 1 * MiB;
constexpr size_t WS_MOD = 1 * MiB;
constexpr size_t WS_ROPE = 2 * MiB;
constexpr size_t WS_RWT = 2 * MiB + 768 * 1024;
constexpr size_t WS_ROUTE = 3 * MiB;
constexpr size_t WS_TOK = 4 * MiB;
constexpr size_t WS_WL = 6 * MiB;
constexpr size_t WS_WUQ = 8 * MiB;
constexpr size_t WS_WUKV = 9 * MiB;
constexpr size_t WS_POOLW = 10 * MiB;
constexpr size_t WS_SGUW = 10 * MiB + 512 * 1024;
constexpr size_t WS_WIN = 12 * MiB;
constexpr size_t WS_WOUT = 28 * MiB;
constexpr size_t WS_W1 = 36 * MiB;
constexpr size_t WS_W2 = 100 * MiB;
constexpr size_t WS_XL = 132 * MiB;
constexpr size_t WS_HA = 200 * MiB;
constexpr size_t WS_PL = 234 * MiB;
constexpr size_t WS_Y = 234 * MiB;
constexpr size_t WS_HS = WS_Y;
constexpr size_t WS_QM = 302 * MiB;
constexpr size_t WS_KM = 315 * MiB;
constexpr size_t WS_VM = 328 * MiB;
constexpr size_t WS_ML = 337 * MiB;
constexpr size_t WS_HID = 371 * MiB;
constexpr size_t WS_WOUTF = 390 * MiB;
constexpr size_t WS_END = 398 * MiB;
static_assert(WS_Y + (size_t)RPAD * D * 2 <= WS_KM && WS_HID + (size_t)RPAD * DE * 2 <= WS_END, "ws map");

constexpr int CW_TMO = 0;
constexpr int CW_BAR = 4096;
constexpr int CW_HEAD = 12288;
constexpr int CW_RDY = 131072;
constexpr int CW_HEAD2 = 13312;
constexpr int CW_RDY2 = 32768;
constexpr int CW_CNT = 8192;

constexpr int LDS_BYTES = 147456;
constexpr int MISC_OFF = 131072 + 320;
constexpr int WTAB_OFF = 131072 + 512;
constexpr int DYNQ_OFF = 131072 + 4096;
constexpr int ROWTAB_OFF = 131072 + 2048;
constexpr int MOETAB_OFF = 131072 + 1024;

__device__ __forceinline__ float bf2f(bf16 v) { return __uint_as_float(((unsigned)v) << 16); }
__device__ __forceinline__ unsigned f2bf(float f) { unsigned u = __float_as_uint(f); return (u + 0x7fffu + ((u >> 16) & 1u)) >> 16; }
typedef __bf16 hwbf2 __attribute__((ext_vector_type(2)));
typedef float hwf2 __attribute__((ext_vector_type(2)));
__device__ __forceinline__ unsigned pk2(float lo, float hi) { hwf2 v; v.x = lo; v.y = hi; return __builtin_bit_cast(unsigned, __builtin_convertvector(v, hwbf2)); }
template <int X> __device__ __forceinline__ float lane_xor(float v) {
    static_assert(X >= 1 && X <= 16, "xor 32: xsum32 / xmax32 / other32");
    return __builtin_bit_cast(float, __builtin_amdgcn_ds_swizzle(__builtin_bit_cast(int, v), (X << 10) | 0x1F));
}
__device__ __forceinline__ float xsum32(float v) { const auto rr = __builtin_amdgcn_permlane32_swap(__float_as_uint(v), __float_as_uint(v), false, false); return __uint_as_float(rr[0]) + __uint_as_float(rr[1]); }
__device__ __forceinline__ float xmax32(float v) { const auto rr = __builtin_amdgcn_permlane32_swap(__float_as_uint(v), __float_as_uint(v), false, false); return fmaxf(__uint_as_float(rr[0]), __uint_as_float(rr[1])); }
__device__ __forceinline__ float other32(float v) { const auto rr = __builtin_amdgcn_permlane32_swap(__float_as_uint(v), __float_as_uint(v), false, false);
    const unsigned a = rr[0], b = rr[1]; return __uint_as_float((a ^ b) ^ __float_as_uint(v)); }
__device__ __forceinline__ float wave_sum(float v) { v += lane_xor<1>(v); v += lane_xor<2>(v); v += lane_xor<4>(v); v += lane_xor<8>(v); v += lane_xor<16>(v); return xsum32(v); }
__device__ __forceinline__ float wave_max(float v) { v = fmaxf(v, lane_xor<1>(v)); v = fmaxf(v, lane_xor<2>(v)); v = fmaxf(v, lane_xor<4>(v)); v = fmaxf(v, lane_xor<8>(v)); v = fmaxf(v, lane_xor<16>(v)); return xmax32(v); }
__device__ __forceinline__ float silu_f(float x) { return x / (1.f + __expf(-x)); }
__device__ __forceinline__ float gelu_tanh(float x) { const float u = 1.5957691216057308f * (x + 0.044715f * x * x * x); return x / (1.f + __expf(-u)); }
__device__ __forceinline__ float dot_bf16(const bf16* a, const bf16* b, int K) {
    float s = 0.f;
    for (int k = 0; k < K; k += 8) {
        const u32x4 av = *(const u32x4*)(a + k), bv = *(const u32x4*)(b + k);
#pragma unroll
        for (int j = 0; j < 4; ++j) {
            s += __uint_as_float(av[j] << 16) * __uint_as_float(bv[j] << 16);
            s += __uint_as_float(av[j] & 0xffff0000u) * __uint_as_float(bv[j] & 0xffff0000u);
        }
    }
    return s;
}
#define LDS_WAIT() asm volatile("s_waitcnt lgkmcnt(0)" ::: "memory")

#define XB_TMO      128
#define XB_XCNT(j)  (256  + 64 * (j))
#define XB_XSUB(j)  (1280 + 64 * (j))
#define XB_XGEN(j)  (2304 + 64 * (j))
#define XB_TOP      3328
#define XB_TOPGEN   3392
#define XCD_BAR_WORDS 3456
#define XB_SPIN_CAP (1u << 18)
__device__ __forceinline__ unsigned xb_ld(unsigned* p)              { return __hip_atomic_load(p, __ATOMIC_RELAXED, __HIP_MEMORY_SCOPE_AGENT); }
__device__ __forceinline__ unsigned xb_add(unsigned* p, unsigned v) { return __hip_atomic_fetch_add(p, v, __ATOMIC_RELAXED, __HIP_MEMORY_SCOPE_AGENT); }
__device__ __forceinline__ unsigned xb_xcc_id() { return (unsigned)__builtin_amdgcn_s_getreg((3 << 11) | 20) & 0xFu; }
#define XB_SPIN(cond, bar) do { unsigned _sp = 0; while (cond) { __builtin_amdgcn_s_sleep(1); \
    if ((++_sp & 255u) == 0u) { if (xb_ld(&(bar)[XB_TMO])) break; if (_sp > XB_SPIN_CAP) { atomicAdd(&(bar)[XB_TMO], 1u); break; } } } } while (0)
struct XcdBarrier { unsigned* bar; unsigned x; volatile LAS unsigned* st; };
__device__ __forceinline__ XcdBarrier xcd_barrier_post(unsigned* bar, volatile LAS unsigned* st) {
    XcdBarrier b; b.bar = bar; b.x = xb_xcc_id(); b.st = st;
    if (threadIdx.x == 0) (void)xb_add(&bar[XB_XCNT(b.x)], 1u);
    return b;
}
__device__ __forceinline__ void xcd_barrier_complete(unsigned* bar, unsigned x, unsigned& nloc, unsigned& nx) {
    const unsigned G = gridDim.x * gridDim.y * gridDim.z;
    unsigned sum, cnt, mine, sp = 0u;
    for (;;) {
        sum = 0u; cnt = 0u; mine = 0u;
#pragma unroll
        for (unsigned j = 0; j < 16; ++j) { const unsigned c = xb_ld(&bar[XB_XCNT(j)]); sum += c; cnt += (c > 0u) ? 1u : 0u; mine = (j == x) ? c : mine; }
        if (sum == G) break;
        __builtin_amdgcn_s_sleep(1);
        if ((++sp & 255u) == 0u) { if (xb_ld(&bar[XB_TMO])) break; if (sp > XB_SPIN_CAP) { atomicAdd(&bar[XB_TMO], 1u); break; } }
    }
    nloc = mine > 0u ? mine : 1u; nx = cnt > 0u ? cnt : 1u;
}
__device__ __forceinline__ void xcd_barrier_core(const XcdBarrier& b) {
    if (threadIdx.x == 0) {
        unsigned* bar = b.bar;
        __builtin_amdgcn_s_waitcnt(0);
        unsigned nloc = b.st[0], nx = b.st[1];
        if (nloc == 0u) { xcd_barrier_complete(bar, b.x, nloc, nx); b.st[0] = nloc; b.st[1] = nx; }
        const unsigned old = xb_add(&bar[XB_XSUB(b.x)], 1u);
        const unsigned gen = old / nloc;
        if (old + 1u == (gen + 1u) * nloc) {
            __builtin_amdgcn_fence(__ATOMIC_RELEASE, "agent");
            asm volatile("s_waitcnt vmcnt(0)" ::: "memory");
            (void)xb_add(&bar[XB_TOP], 1u);
            { unsigned tgt_ = (unsigned)__builtin_amdgcn_readfirstlane((int)((gen + 1u) * nx)); XB_SPIN(xb_ld(&bar[XB_TOP]) < tgt_, bar); }
            __builtin_amdgcn_fence(__ATOMIC_ACQUIRE, "agent");
            xb_add(&bar[XB_XGEN(b.x)], 1u);
            asm volatile("s_waitcnt vmcnt(0)" ::: "memory");
        } else {
            XB_SPIN(xb_ld(&bar[XB_XGEN(b.x)]) == gen, bar);
            __builtin_amdgcn_fence(__ATOMIC_ACQUIRE, "agent");
            asm volatile("s_waitcnt vmcnt(0)" ::: "memory");
        }
    }
}
__device__ __forceinline__ void xcd_barrier(const XcdBarrier& b) {
    asm volatile("s_waitcnt vmcnt(0)" ::: "memory");
    __syncthreads();
    xcd_barrier_core(b);
    __syncthreads();
}

struct Params {
    const float *x, *c, *ctx, *c_ctx, *ada_w, *ada_b, *norm1_g, *norm2_g, *w_in, *w_out, *pool_w, *pool_s, *na_rpb,
                *sgu_norm_g, *sgu_w, *sgu_b, *mla_q_norm_g, *mla_w_uq, *mla_kv_norm_g, *mla_w_ukv,
                *router_w, *router_b, *moe_w_gate, *moe_w_up, *moe_w_down, *final_g;
    float* out; unsigned char* ws; int ph_lo, ph_hi;
};
typedef const __attribute__((address_space(4))) Params& CPR;
struct Frame {
    LAS unsigned char* lds; unsigned char* ws;
    int tid, lane, wave, gw, ngw, gt, ngt;
    __device__ __forceinline__ unsigned* ctl() const { return (unsigned*)(ws + WS_CTL); }
    __device__ __forceinline__ float* mod() const { return (float*)(ws + WS_MOD); }
    __device__ __forceinline__ float* ropec() const { return (float*)(ws + WS_ROPE); }
    __device__ __forceinline__ float* ropes() const { return (float*)(ws + WS_ROPE) + SEQ * 16; }
    __device__ __forceinline__ bf16* rwf() const { return (bf16*)(ws + WS_RWT); }
    __device__ __forceinline__ int* route() const { return (int*)(ws + WS_ROUTE); }
    __device__ __forceinline__ int* tok() const { return (int*)(ws + WS_TOK); }
    __device__ __forceinline__ float* wl() const { return (float*)(ws + WS_WL); }
    __device__ __forceinline__ bf16* wuq() const { return (bf16*)(ws + WS_WUQ); }
    __device__ __forceinline__ bf16* wukv() const { return (bf16*)(ws + WS_WUKV); }
    __device__ __forceinline__ bf16* poolw() const { return (bf16*)(ws + WS_POOLW); }
    __device__ __forceinline__ bf16* sguw() const { return (bf16*)(ws + WS_SGUW); }
    __device__ __forceinline__ bf16* win() const { return (bf16*)(ws + WS_WIN); }
    __device__ __forceinline__ bf16* wout() const { return (bf16*)(ws + WS_WOUT); }
    __device__ __forceinline__ bf16* woutf() const { return (bf16*)(ws + WS_WOUTF); }
    __device__ __forceinline__ bf16* w1() const { return (bf16*)(ws + WS_W1); }
    __device__ __forceinline__ bf16* w2() const { return (bf16*)(ws + WS_W2); }
    __device__ __forceinline__ bf16* ha() const { return (bf16*)(ws + WS_HA); }
    __device__ __forceinline__ bf16* pl() const { return (bf16*)(ws + WS_PL); }
    __device__ __forceinline__ bf16* y() const { return (bf16*)(ws + WS_Y); }
    __device__ __forceinline__ bf16* hs() const { return (bf16*)(ws + WS_HS); }
    __device__ __forceinline__ bf16* qm() const { return (bf16*)(ws + WS_QM); }
    __device__ __forceinline__ bf16* km() const { return (bf16*)(ws + WS_KM); }
    __device__ __forceinline__ bf16* vm() const { return (bf16*)(ws + WS_VM); }
    __device__ __forceinline__ bf16* ml() const { return (bf16*)(ws + WS_ML); }
    __device__ __forceinline__ bf16* hid() const { return (bf16*)(ws + WS_HID); }
    __device__ __forceinline__ bf16* xl() const { return (bf16*)(ws + WS_XL); }
};
#ifndef PROBE_T
#define PROBE_T (-1)
#endif
#ifndef PROBE_TMUL
#define PROBE_TMUL 8
#endif
#ifndef PROBE_BLK
#define PROBE_BLK 0
#endif
#define TMARK(kind) do { if (PROBE_T >= 0 && blockIdx.x == PROBE_BLK && threadIdx.x == 0) { volatile LAS unsigned* M_ = (volatile LAS unsigned*)(F.lds + MISC_OFF) + 16; const unsigned now_ = (unsigned)wall_clock64(); \
    if ((kind) == PROBE_T || (PROBE_T >= 1000 && ((kind) >= 100 ? 1 : (kind) >= 10 ? (kind) / 10 : (kind)) == PROBE_T - 1000)) M_[1] += now_ - M_[0]; M_[0] = now_; } } while (0)
__device__ __forceinline__ int row_batch(int r) { return r < TL ? (r >> 12) : ((r - TL) >> 8); }
__device__ __forceinline__ int row_mod(int r) { return r < TL ? (r >> 12) : 4; }
__device__ __forceinline__ const float* mod_vec(const Frame& F, int l, int mr, int k) { return F.mod() + ((size_t)(l * 5 + mr) * NMOD + k) * D; }

namespace pg8 {
constexpr int BM = 256, BK = 64, HALF = 128, HTB = HALF * BK * 2, NXCD = 8, WGM = 8;
__host__ __device__ __forceinline__ int lds_byte(int r, int c) { const int st = (r >> 4) * 2 + (c >> 5), rr = r & 15, cc = c & 31, ob = rr * 64 + cc * 2; return st * 1024 + (ob ^ (((ob >> 9) & 1) << 5)); }
__host__ __device__ __forceinline__ void stage_rc(int b, int& R, int& C) { const int st = b / 1024, sb = b % 1024, swz = sb ^ (((sb >> 9) & 1) << 5); R = (st >> 1) * 16 + swz / 64; C = (st & 1) * 32 + (swz % 64) / 2; }
__host__ __device__ __forceinline__ int perm32(int rho) { const int n = rho >> 4, i = rho & 15; return 8 * (i >> 2) + 4 * n + (i & 3); }
struct Unit { int pm, pn, ex, slot0, cnt; };
struct StaticOrder {
    static constexpr bool GATHER = false;
    int nM, nN, nwg, G, c, K;
    unsigned* rdy = nullptr; int pub_from = 0;
    int pn_rot = 0;
    __device__ __forceinline__ void init(int M, int N, int K_, int G_, int c_) { nM = M / BM; nN = N / BM; nwg = nM * nN; G = G_; c = c_; K = K_; }
    __device__ __forceinline__ bool next(int i, Unit& u) const {
        const long L = (long)i * G + c; if (L >= nwg) return false;
        int wgid = (int)L; { const int q = nwg / NXCD, r = nwg % NXCD, xcd = wgid % NXCD, off = wgid / NXCD; wgid = (xcd < r ? xcd * (q + 1) : r * (q + 1) + (xcd - r) * q) + off; }
        const int nig = WGM * nN, gid = wgid / nig, fm = gid * WGM, gsz = (nM - fm) < WGM ? (nM - fm) : WGM;
        u.pm = fm + ((wgid % nig) % gsz); u.pn = (wgid % nig) / gsz + pn_rot; if (u.pn >= nN) u.pn -= nN; u.ex = 0; u.slot0 = 0; u.cnt = 256; return true;
    }
    __device__ __forceinline__ size_t a_off(const Unit& u) const { return (size_t)u.pm * 256 * K * 2; }
    __device__ __forceinline__ size_t b_off(const Unit& u) const { return (size_t)u.pn * 256 * K * 2; }
    __device__ __forceinline__ unsigned row_off(const Unit&, int, int) const { return 0u; }
    __device__ __forceinline__ void fill(const Unit&, int, int) const {}
    __device__ __forceinline__ void begin(int) const {}
    __device__ __forceinline__ void a_ready(const Unit&, int) const {}
    __device__ __forceinline__ void done(const Unit& u, int lane) const {
        if (rdy && u.pn >= pub_from) { asm volatile("s_waitcnt vmcnt(0)" ::: "memory"); if (lane == 0) (void)__hip_atomic_fetch_add(rdy + 64 * u.pm, 1u, __ATOMIC_RELAXED, __HIP_MEMORY_SCOPE_AGENT); } }
};
template <bool GATHER_, int NPN, int KK, bool DYN_ = false, bool PUB_ = false>
struct MoeOrder {
    static constexpr bool GATHER = GATHER_;
    const volatile LAS int* tab; const int* tok; int G, c; size_t bstride;
    volatile LAS unsigned* rtab;
    unsigned* head; unsigned* rdy; unsigned* tmo; volatile LAS int* dq;
    __device__ __forceinline__ void begin(int tid) const {
        if constexpr (DYN_) { if (tid == 0) { dq[0] = (int)__hip_atomic_fetch_add(head, 1u, __ATOMIC_RELAXED, __HIP_MEMORY_SCOPE_AGENT); dq[1] = (int)__hip_atomic_fetch_add(head, 1u, __ATOMIC_RELAXED, __HIP_MEMORY_SCOPE_AGENT); }
            __syncthreads(); } }
    __device__ __forceinline__ void a_ready(const Unit& u, int tid) const {
        if constexpr (DYN_) {
            if (tid < 64) { unsigned spins = 0;
                while ((unsigned)__builtin_amdgcn_readfirstlane(__hip_atomic_load(rdy + 64 * u.pm, __ATOMIC_RELAXED, __HIP_MEMORY_SCOPE_AGENT)) < 16u) {
                    __builtin_amdgcn_s_sleep(2);
                    if (++spins > (1u << 20)) { if (tid == 0) __hip_atomic_store(tmo, 1u, __ATOMIC_RELAXED, __HIP_MEMORY_SCOPE_AGENT); break; } }
                __builtin_amdgcn_fence(__ATOMIC_ACQUIRE, "agent");
                asm volatile("s_waitcnt vmcnt(0)" ::: "memory"); }
            asm volatile("" ::: "memory"); __builtin_amdgcn_s_barrier(); asm volatile("" ::: "memory"); } }
    __device__ __forceinline__ void done(const Unit& u, int lane) const {
        if constexpr (PUB_) { asm volatile("s_waitcnt vmcnt(0)" ::: "memory"); if (lane == 0) (void)__hip_atomic_fetch_add(rdy + 64 * u.pm, 1u, __ATOMIC_RELAXED, __HIP_MEMORY_SCOPE_AGENT); } }
    __device__ __forceinline__ bool next(int i, Unit& u) const {
        int L;
        if constexpr (DYN_) { L = dq[i & 1]; if (i >= 1 && threadIdx.x == 0) dq[(i + 1) & 1] = (int)__hip_atomic_fetch_add(head, 1u, __ATOMIC_RELAXED, __HIP_MEMORY_SCOPE_AGENT); }
        else L = i * G + c;
        const int nt = tab[16]; if (L >= nt * NPN) return false;
        const int ti = L / NPN; u.pm = ti; u.pn = L % NPN; const int e = tab[64 + ti];
        u.ex = e; u.slot0 = (ti - tab[e]) * 256; const int rem = tab[32 + e] - u.slot0; u.cnt = rem < 256 ? rem : 256; return true;
    }
    __device__ __forceinline__ size_t a_off(const Unit& u) const { return GATHER_ ? 0 : (size_t)u.pm * 256 * KK * 2; }
    __device__ __forceinline__ size_t b_off(const Unit& u) const { return (size_t)u.ex * bstride + (size_t)u.pn * 256 * KK * 2; }
    __device__ __forceinline__ unsigned row_off(const Unit&, int ui, int R) const { return rtab[(ui & 1) * 256 + R]; }
    __device__ __forceinline__ void fill(const Unit& u, int ui, int tid) const {
        if (GATHER_ && tid < 256) { const int rr = tid < u.cnt ? tid : u.cnt - 1; rtab[(ui & 1) * 256 + tid] = (unsigned)tok[u.ex * CAP + u.slot0 + rr] * (unsigned)(KK * 2); } }
};
__device__ __forceinline__ unsigned cvt_pk_bf16(float lo, float hi) { unsigned r; asm volatile("v_cvt_pk_bf16_f32 %0, %1, %2" : "=v"(r) : "v"(lo), "v"(hi)); return r; }
struct EpiBf16 {
    static constexpr bool PERM = true;
    bf16* O; int ldc; bool wt = false; int nbytes = 0;
    __device__ __forceinline__ void operator()(const f32x4 (&acc)[2][2][4][2], const Unit& u, int wr, int wc, int fr, int fq) const {
        asm volatile("" : "+v"(fr), "+v"(fq));
        const int row0 = u.pm * BM + wr * 64 + fr, col0 = u.pn * BM + wc * 32 + 8 * fq;
        const __amdgpu_buffer_rsrc_t rs = __builtin_amdgcn_make_buffer_rsrc((void*)O, 0, nbytes, 0x00020000);
#pragma unroll
        for (int ai = 0; ai < 2; ++ai)
#pragma unroll
            for (int m = 0; m < 4; ++m) { const size_t eo = (size_t)(row0 + ai * HALF + m * 16) * ldc + col0; bf16* rowp = O + eo;
#pragma unroll
                for (int bj = 0; bj < 2; ++bj) { const f32x4 v0 = acc[ai][bj][m][0], v1 = acc[ai][bj][m][1];
                    u32x4 w; w.x = cvt_pk_bf16(v0[0], v0[1]); w.y = cvt_pk_bf16(v0[2], v0[3]); w.z = cvt_pk_bf16(v1[0], v1[1]); w.w = cvt_pk_bf16(v1[2], v1[3]);
                    if (wt) __builtin_amdgcn_raw_buffer_store_b128(w, rs, (int)((eo + bj * HALF) * 2), 0, 16); else *(u32x4*)(rowp + bj * HALF) = w; } }
    }
};
struct EpiResid {
    static constexpr bool PERM = true;
    bf16* X; int ldc; const float* modl; float gsc;
    __device__ __forceinline__ void operator()(const f32x4 (&acc)[2][2][4][2], const Unit& u, int wr, int wc, int fr, int fq) const {
        asm volatile("" : "+v"(fr), "+v"(fq));
        const int row0 = u.pm * BM + wr * 64 + fr, col0 = u.pn * BM + wc * 32 + 8 * fq;
        const int mr = row_mod(u.pm * BM); const float* gp = modl + (size_t)(mr * NMOD + 2) * D + col0;
        f32x4 gv[2][2];
#pragma unroll
        for (int bj = 0; bj < 2; ++bj)
#pragma unroll
            for (int n = 0; n < 2; ++n) gv[bj][n] = *(const f32x4*)(gp + bj * HALF + n * 4) * gsc;
        u32x4 xa[2][4][2];
#pragma unroll
        for (int ai = 0; ai < 2; ++ai)
#pragma unroll
            for (int m = 0; m < 4; ++m)
#pragma unroll
                for (int bj = 0; bj < 2; ++bj) xa[ai][m][bj] = *(const u32x4*)(X + (size_t)(row0 + ai * HALF + m * 16) * ldc + col0 + bj * HALF);
        __builtin_amdgcn_sched_barrier(0);
#pragma unroll
        for (int ai = 0; ai < 2; ++ai)
#pragma unroll
            for (int m = 0; m < 4; ++m) { bf16* rowp = X + (size_t)(row0 + ai * HALF + m * 16) * ldc + col0;
#pragma unroll
                for (int bj = 0; bj < 2; ++bj) { const f32x4 a0 = acc[ai][bj][m][0], a1 = acc[ai][bj][m][1]; const u32x4 xv = xa[ai][m][bj]; u32x4 w;
                    w.x = cvt_pk_bf16(__uint_as_float(xv.x << 16) + gv[bj][0].x * a0[0], __uint_as_float(xv.x & 0xffff0000u) + gv[bj][0].y * a0[1]);
                    w.y = cvt_pk_bf16(__uint_as_float(xv.y << 16) + gv[bj][0].z * a0[2], __uint_as_float(xv.y & 0xffff0000u) + gv[bj][0].w * a0[3]);
                    w.z = cvt_pk_bf16(__uint_as_float(xv.z << 16) + gv[bj][1].x * a1[0], __uint_as_float(xv.z & 0xffff0000u) + gv[bj][1].y * a1[1]);
                    w.w = cvt_pk_bf16(__uint_as_float(xv.w << 16) + gv[bj][1].z * a1[2], __uint_as_float(xv.w & 0xffff0000u) + gv[bj][1].w * a1[3]);
                    *(u32x4*)(rowp + bj * HALF) = w; } }
    }
};
struct EpiMoe1 {
    static constexpr bool PERM = true;
    bf16* H; const float* wl;
    __device__ __forceinline__ void operator()(const f32x4 (&acc)[2][2][4][2], const Unit& u, int wr, int wc, int fr, int fq) const {
        asm volatile("" : "+v"(fr), "+v"(fq));
        const int lrow0 = wr * 64 + fr, f0 = u.pn * HALF + wc * 32 + 8 * fq;
        const __amdgpu_buffer_rsrc_t rs = __builtin_amdgcn_make_buffer_rsrc((void*)H, 0, RPAD * DE * 2, 0x00020000);
        float wv[2][4];
#pragma unroll
        for (int ai = 0; ai < 2; ++ai)
#pragma unroll
            for (int m = 0; m < 4; ++m) { const int lr = lrow0 + ai * HALF + m * 16; wv[ai][m] = wl[(size_t)u.ex * CAP + u.slot0 + lr]; }
        __builtin_amdgcn_sched_barrier(0);
#pragma unroll
        for (int ai = 0; ai < 2; ++ai)
#pragma unroll
            for (int m = 0; m < 4; ++m) { const int lr = lrow0 + ai * HALF + m * 16;
                const float w = (lr < u.cnt) ? wv[ai][m] : 0.f;
                float o[8];
#pragma unroll
                for (int n = 0; n < 2; ++n)
#pragma unroll
                    for (int i = 0; i < 4; ++i) { const float g = acc[ai][0][m][n][i], up = acc[ai][1][m][n][i]; o[4 * n + i] = w * (g / (1.f + __expf(-g))) * up; }
                u32x4 pk; pk.x = cvt_pk_bf16(o[0], o[1]); pk.y = cvt_pk_bf16(o[2], o[3]); pk.z = cvt_pk_bf16(o[4], o[5]); pk.w = cvt_pk_bf16(o[6], o[7]);
                __builtin_amdgcn_raw_buffer_store_b128(pk, rs, (int)(((u.pm * BM + lr) * DE + f0) * 2), 0, 16); }
    }
};

template <class Epi, class Sched, bool ALIGN_EPI>
__device__ __forceinline__ void gemm_phase(LAS unsigned char* lds, const int tid, const bf16* Abase, const bf16* Bbase, const int K, const Sched& S, const Epi& E) {
    constexpr bool GA = Sched::GATHER;
    const int wid = __builtin_amdgcn_readfirstlane(tid >> 6), lane = tid & 63, wr = wid >> 2, wc = wid & 3, fr = lane & 15, fq = lane >> 4;
    const int nt = K / BK;
    unsigned voffA[2], voffB[2]; int Rst, Cst;
#pragma unroll
    for (int i = 0; i < 2; ++i) { int R, C; stage_rc(tid * 16 + i * 8192, R, C); const int Rb = Epi::PERM ? ((R & ~31) + perm32(R & 31)) : R;
        voffA[i] = (unsigned)(R * K + C) * 2u; voffB[i] = (unsigned)(Rb * K + C) * 2u; if (i == 0) { Rst = R; Cst = C; } }
    const size_t kstep = (size_t)(BK * 2);
    const size_t hstep = (size_t)HALF * K * 2;
    const size_t hstepA = GA ? 0 : hstep;
    const unsigned ldsw = (unsigned)wid * 1024u;
    const int aoff = lds_byte(wr * 64 + fr, fq * 8), boff = lds_byte(wc * 32 + fr, fq * 8);
#define PG8_SA(b, h) (((b) * 2 + (h)) * HTB)
#define PG8_SB(b, h) ((4 + (b) * 2 + (h)) * HTB)
#define PG8_STAGE(bufoff, gbase, voff) do { _Pragma("unroll") for (int _i = 0; _i < 2; ++_i) \
        __builtin_amdgcn_global_load_lds((const unsigned*)((const char*)(gbase) + (voff)[_i]), (LAS unsigned*)(lds + (bufoff) + ldsw + _i * 8192), 16, 0, 0); } while (0)
#define PG8_LDA(dst, b, h) do { _Pragma("unroll") for (int m = 0; m < 4; ++m) _Pragma("unroll") for (int k = 0; k < 2; ++k) dst[m][k] = *(const LAS bf16x8*)(lds + PG8_SA(b, h) + aoff + m * 2048 + k * 1024); } while (0)
#define PG8_LDB(dst, b, h) do { _Pragma("unroll") for (int n = 0; n < 2; ++n) _Pragma("unroll") for (int k = 0; k < 2; ++k) dst[n][k] = *(const LAS bf16x8*)(lds + PG8_SB(b, h) + boff + n * 2048 + k * 1024); } while (0)
#define PG8_MMA(ai, bj, At, Bt) do { __builtin_amdgcn_s_setprio(1); _Pragma("unroll") for (int m = 0; m < 4; ++m) _Pragma("unroll") for (int n = 0; n < 2; ++n) _Pragma("unroll") for (int k = 0; k < 2; ++k) \
        acc[ai][bj][m][n] = __builtin_amdgcn_mfma_f32_16x16x32_bf16(Bt[n][k], At[m][k], acc[ai][bj][m][n], 0, 0, 0); __builtin_amdgcn_s_setprio(0); } while (0)
#define PG8_WAIT_V(n) asm volatile("s_waitcnt vmcnt(" #n ")" ::: "memory")
#define PG8_WAIT_L(n) asm volatile("s_waitcnt lgkmcnt(" #n ")" ::: "memory")
#define PG8_BAR __builtin_amdgcn_s_barrier()
#define PG8_SCHED __builtin_amdgcn_sched_barrier(0)
    Unit cur, nxt; int ui = 0;
    S.begin(tid);
    if (!S.next(0, cur)) return;
    S.a_ready(cur, tid);
    f32x4 acc[2][2][4][2];
#pragma unroll
    for (int a = 0; a < 2; ++a)
#pragma unroll
        for (int b = 0; b < 2; ++b)
#pragma unroll
            for (int m = 0; m < 4; ++m)
#pragma unroll
                for (int n = 0; n < 2; ++n) acc[a][b][m][n] = (f32x4){0.f, 0.f, 0.f, 0.f};
    bf16x8 At[4][2], B0[2][2], B1[2][2];
    unsigned cv0[2], cv1[2];
    if constexpr (GA) { S.fill(cur, 0, tid); __syncthreads(); }
#pragma unroll
    for (int i = 0; i < 2; ++i) { cv0[i] = GA ? S.row_off(cur, 0, Rst + 64 * i) + (unsigned)Cst * 2u : voffA[i]; cv1[i] = GA ? S.row_off(cur, 0, HALF + Rst + 64 * i) + (unsigned)Cst * 2u : voffA[i]; }
    const char* cA = (const char*)Abase + S.a_off(cur); const char* cB = (const char*)Bbase + S.b_off(cur);
    PG8_STAGE(PG8_SB(0, 0), cB, voffB); PG8_STAGE(PG8_SB(0, 1), cB + hstep, voffB); PG8_STAGE(PG8_SA(0, 0), cA, cv0); PG8_STAGE(PG8_SA(0, 1), cA + hstepA, cv1);
    if (wr == 1) PG8_BAR;
    PG8_WAIT_V(2); PG8_BAR;
    PG8_STAGE(PG8_SB(1, 0), cB + kstep, voffB); PG8_STAGE(PG8_SA(1, 0), cA + kstep, cv0); PG8_STAGE(PG8_SB(1, 1), cB + hstep + kstep, voffB);
    PG8_WAIT_V(6); PG8_BAR;
    for (;;) {
        const bool has_next = S.next(ui + 1, nxt);
        const char* nA = has_next ? (const char*)Abase + S.a_off(nxt) : cA; const char* nB = has_next ? (const char*)Bbase + S.b_off(nxt) : cB;
        if constexpr (GA) { if (has_next) S.fill(nxt, ui + 1, tid); }
#pragma unroll 1
        for (int t = 0; t < nt; t += 2) {
            const bool last = (t == nt - 2);
            if (last && has_next) S.a_ready(nxt, tid);
            const char* a1 = cA + (size_t)(t + 1) * kstep;
            const char* a2 = last ? nA : cA + (size_t)(t + 2) * kstep; const char* b2 = last ? nB : cB + (size_t)(t + 2) * kstep;
            const char* a3 = a2 + kstep; const char* b3 = b2 + kstep;
            if constexpr (GA) { if (last && has_next) {
#pragma unroll
                for (int i = 0; i < 2; ++i) cv0[i] = S.row_off(nxt, ui + 1, Rst + 64 * i) + (unsigned)Cst * 2u; } }
            PG8_LDB(B0, 0, 0); PG8_LDB(B1, 0, 1); PG8_SCHED; PG8_LDA(At, 0, 0); PG8_STAGE(PG8_SA(1, 1), a1 + hstepA, cv1);
            if constexpr (GA) { if (last && has_next) {
#pragma unroll
                for (int i = 0; i < 2; ++i) cv1[i] = S.row_off(nxt, ui + 1, HALF + Rst + 64 * i) + (unsigned)Cst * 2u; } }
            PG8_WAIT_V(8); PG8_WAIT_L(0); PG8_BAR; PG8_MMA(0, 0, At, B0); PG8_MMA(0, 1, At, B1); PG8_BAR; PG8_SCHED;
            PG8_LDA(At, 0, 1); PG8_STAGE(PG8_SB(0, 0), b2, voffB); PG8_STAGE(PG8_SB(0, 1), b2 + hstep, voffB); PG8_STAGE(PG8_SA(0, 0), a2, cv0);
            PG8_WAIT_V(8); PG8_WAIT_L(0); PG8_BAR; PG8_MMA(1, 0, At, B0); PG8_MMA(1, 1, At, B1); PG8_BAR; PG8_SCHED;
            PG8_LDB(B0, 1, 0); PG8_LDB(B1, 1, 1); PG8_SCHED; PG8_LDA(At, 1, 0); PG8_STAGE(PG8_SA(0, 1), a2 + hstepA, cv1);
            PG8_WAIT_V(8); PG8_WAIT_L(0); PG8_BAR; PG8_MMA(0, 0, At, B0); PG8_MMA(0, 1, At, B1); PG8_BAR; PG8_SCHED;
            PG8_LDA(At, 1, 1); PG8_STAGE(PG8_SB(1, 0), b3, voffB); PG8_STAGE(PG8_SB(1, 1), b3 + hstep, voffB); PG8_STAGE(PG8_SA(1, 0), a3, cv0);
            PG8_WAIT_V(8); PG8_WAIT_L(0); PG8_BAR; PG8_MMA(1, 0, At, B0); PG8_MMA(1, 1, At, B1); PG8_BAR; PG8_SCHED;
        }
        if constexpr (ALIGN_EPI) { if (wr == 0) PG8_BAR; }
        E(acc, cur, wr, wc, fr, fq);
        S.done(cur, lane);
        if (!has_next) break;
#pragma unroll
        for (int a = 0; a < 2; ++a)
#pragma unroll
            for (int b = 0; b < 2; ++b)
#pragma unroll
                for (int m = 0; m < 4; ++m)
#pragma unroll
                    for (int n = 0; n < 2; ++n) acc[a][b][m][n] = (f32x4){0.f, 0.f, 0.f, 0.f};
        cur = nxt; cA = nA; cB = nB; ++ui;
        if constexpr (ALIGN_EPI) { if (wr == 1) PG8_BAR; }
    }
    PG8_WAIT_V(0);
    if constexpr (!ALIGN_EPI) { if (wr == 0) PG8_BAR; }
    PG8_BAR;
#undef PG8_SA
#undef PG8_SB
#undef PG8_STAGE
#undef PG8_LDA
#undef PG8_LDB
#undef PG8_MMA
#undef PG8_WAIT_V
#undef PG8_WAIT_L
#undef PG8_BAR
#undef PG8_SCHED
}
}

#define TR_LOAD_TILE() do { f32x4 tv_[8]; float tsc_[8]; \
    _Pragma("unroll") for (int i = 0; i < 8; ++i) { const int kk = 8 * i + (lane >> 3); tv_[i] = *(const f32x4*)(W + (size_t)(k0 + kk) * N + n0 + 4 * (lane & 7)); tsc_[i] = kscale ? kscale[k0 + kk] : 1.f; } \
    __builtin_amdgcn_sched_barrier(0); \
    _Pragma("unroll") for (int i = 0; i < 8; ++i) { const int kk = 8 * i + (lane >> 3); LAS float* d_ = scr + kk * 33 + 4 * (lane & 7); \
        d_[0] = tv_[i].x * tsc_[i]; d_[1] = tv_[i].y * tsc_[i]; d_[2] = tv_[i].z * tsc_[i]; d_[3] = tv_[i].w * tsc_[i]; } } while (0)
__device__ __forceinline__ void transpose_item(const float* W, int K, int N, bf16* WT, const unsigned char* wsb, int kb, int nb, int drow0, LAS float* scr, int lane, const float* kscale = nullptr) {
    const int k0 = 64 * kb, n0 = 32 * nb;
    TR_LOAD_TILE();
    LDS_WAIT(); asm volatile("" ::: "memory");
    const int c = lane & 7;
    const __amdgpu_buffer_rsrc_t rs = __builtin_amdgcn_make_buffer_rsrc((void*)wsb, 0, 0x7fffffff, 0x00020000); const int wb0 = (int)((const unsigned char*)WT - wsb);
#pragma unroll
    for (int j = 0; j < 4; ++j) { const int n = (lane >> 3) + 8 * j; const LAS float* s = scr + (8 * c) * 33 + n;
        u32x4 o; o.x = pk2(s[0 * 33], s[1 * 33]); o.y = pk2(s[2 * 33], s[3 * 33]); o.z = pk2(s[4 * 33], s[5 * 33]); o.w = pk2(s[6 * 33], s[7 * 33]);
        __builtin_amdgcn_raw_buffer_store_b128(o, rs, wb0 + ((drow0 + n) * K + k0 + 8 * c) * 2, 0, 16); }
    LDS_WAIT(); asm volatile("" ::: "memory");
}
__device__ __forceinline__ void transpose_item_fm(const float* W, int K, int N, bf16* FM, const unsigned char* wsb, int kb, int nb, LAS float* scr, int lane, const float* kscale = nullptr) {
    const int k0 = 64 * kb, n0 = 32 * nb, KS = K / 16;
    TR_LOAD_TILE();
    LDS_WAIT(); asm volatile("" ::: "memory");
    const __amdgpu_buffer_rsrc_t rs = __builtin_amdgcn_make_buffer_rsrc((void*)wsb, 0, 0x7fffffff, 0x00020000); const int wb0 = (int)((const unsigned char*)FM - wsb);
#pragma unroll
    for (int q = 0; q < 4; ++q) { const LAS float* sp = scr + (16 * q + 8 * (lane >> 5)) * 33 + (lane & 31);
        u32x4 o; o.x = pk2(sp[0 * 33], sp[1 * 33]); o.y = pk2(sp[2 * 33], sp[3 * 33]); o.z = pk2(sp[4 * 33], sp[5 * 33]); o.w = pk2(sp[6 * 33], sp[7 * 33]);
        __builtin_amdgcn_raw_buffer_store_b128(o, rs, wb0 + (((nb * KS + 4 * kb + q) * 64 + lane) * 8) * 2, 0, 16); }
    LDS_WAIT(); asm volatile("" ::: "memory");
}
__device__ __forceinline__ void convert_layer(CPR p, Frame& F, int l, int rank, int nranks) {
    asm volatile("" : "+s"(nranks));
    LAS float* scr = (LAS float*)(F.lds + F.wave * 16384);
    constexpr int I_IN = 16 * 61, I_OUT = 16 * 32, I_G = 128, I_L = I_IN + 2 * I_OUT + 3 * 16 * I_G + 48 + 32 + 8;
    for (int it = rank; it < I_L; it += nranks) {
        int r = it;
        if (r < I_OUT) { transpose_item_fm(p.w_out + (size_t)l * D * D, D, D, F.woutf() + (size_t)l * D * D, F.ws, r / 32, r % 32, scr, F.lane); continue; } r -= I_OUT;
        if (r < I_IN) { transpose_item(p.w_in + (size_t)l * D * INW, D, INW, F.win() + (size_t)l * INP * D, F.ws, r / 61, r % 61, 32 * (r % 61), scr, F.lane); continue; } r -= I_IN;
        if (r < I_OUT) { transpose_item(p.w_out + (size_t)l * D * D, D, D, F.wout() + (size_t)l * D * D, F.ws, r / 32, r % 32, 32 * (r % 32), scr, F.lane); continue; } r -= I_OUT;
        if (r < 16 * I_G) { const int e = r / I_G, q = r % I_G, nb = q % 8, n0 = 32 * nb;
            transpose_item(p.moe_w_gate + (size_t)(l * NE + e) * D * DE, D, DE, F.w1() + (size_t)(l * NE + e) * 512 * D, F.ws, q / 8, nb, (n0 / 128) * 256 + (n0 % 128), scr, F.lane); continue; } r -= 16 * I_G;
        if (r < 16 * I_G) { const int e = r / I_G, q = r % I_G, nb = q % 8, n0 = 32 * nb;
            transpose_item(p.moe_w_up + (size_t)(l * NE + e) * D * DE, D, DE, F.w1() + (size_t)(l * NE + e) * 512 * D, F.ws, q / 8, nb, (n0 / 128) * 256 + 128 + (n0 % 128), scr, F.lane); continue; } r -= 16 * I_G;
        if (r < 16 * I_G) { const int e = r / I_G, q = r % I_G;
            transpose_item(p.moe_w_down + (size_t)(l * NE + e) * DE * D, DE, D, F.w2() + (size_t)(l * NE + e) * D * DE, F.ws, q / 32, q % 32, 32 * (q % 32), scr, F.lane); continue; } r -= 16 * I_G;
        if (r < 48) { transpose_item_fm(p.mla_w_uq + (size_t)l * 256 * 384, 256, 384, F.wuq() + (size_t)l * 384 * 256, F.ws, r / 12, r % 12, scr, F.lane, p.mla_q_norm_g + l * 256); continue; } r -= 48;
        if (r < 32) { transpose_item_fm(p.mla_w_ukv + (size_t)l * 128 * 512, 128, 512, F.wukv() + (size_t)l * 512 * 128, F.ws, r / 16, r % 16, scr, F.lane, p.mla_kv_norm_g + l * 128); continue; } r -= 32;
        { const int g = r / 2, nb = r % 2; transpose_item(p.pool_w + (size_t)(l * 4 + g) * 4096, 64, 64, F.poolw() + (size_t)(l * 4 + g) * 4096, F.ws, 0, nb, 32 * nb, scr, F.lane); }
    }
    for (int i = rank * 64 + F.lane; i < 4 * 128 * 128; i += nranks * 64) F.sguw()[l * 4 * 128 * 128 + i] = (bf16)f2bf(p.sgu_w[l * 4 * 128 * 128 + i]);
    for (int i = rank * 64 + F.lane; i < (INP - INW) * D; i += nranks * 64) F.win()[(size_t)l * INP * D + (size_t)INW * D + i] = 0;
}
__device__ __forceinline__ void p0_prologue(CPR p, Frame& F) {
    convert_layer(p, F, 0, F.gw, F.ngw);
    for (int i = F.gt; i < SEQ * 16; i += F.ngt) {
        const int t = i >> 4, k = i & 15; const float pos = (float)((k < 8) ? (t >> 6) : (t & 63));
        const float inv = __builtin_powf(10000.0f, -(float)(k & 7) / 8.0f);
        const float ang = pos * inv; F.ropec()[i] = cosf(ang); F.ropes()[i] = sinf(ang);
    }
    for (int i = F.gt; i < NE * D; i += F.ngt) { const int sx = i >> 9, ln = (i >> 3) & 63, j = i & 7;
        const float v = p.router_w[(32 * sx + 8 * (ln >> 4) + j) * NE + (ln & 15)]; const unsigned hi = f2bf(v);
        F.rwf()[i] = (bf16)hi; F.rwf()[NE * D + i] = (bf16)f2bf(v - __uint_as_float(hi << 16)); }
    {
        LAS float* sv = (LAS float*)F.lds;
        LAS float* red = sv + 5 * D;
        __syncthreads();
        for (int i = F.tid; i < 5 * D; i += NTHR) { const int r = i >> 10, k = i & 1023; sv[i] = silu_f(r < 4 ? p.c[r * D + k] : p.c_ctx[k]); }
        __syncthreads();
        const int hw = F.tid >> 5, cl = F.tid & 31;
        for (int it = blockIdx.x; it < DEPTH * (NMOD * D / 32); it += gridDim.x) {
            const int l = it / (NMOD * D / 32), n = (it % (NMOD * D / 32)) * 32 + cl;
            const float* w = p.ada_w + (size_t)l * D * NMOD * D + (size_t)(64 * hw) * NMOD * D + n;
            float a0 = 0.f, a1 = 0.f, a2 = 0.f, a3 = 0.f, a4 = 0.f;
            float xs[64];
#pragma unroll
            for (int k = 0; k < 64; ++k) xs[k] = w[(size_t)k * NMOD * D];
            __builtin_amdgcn_sched_barrier(0);
#pragma unroll
            for (int k = 0; k < 64; ++k) { const float x = xs[k]; const int kk = 64 * hw + k;
                a0 += sv[kk] * x; a1 += sv[D + kk] * x; a2 += sv[2 * D + kk] * x; a3 += sv[3 * D + kk] * x; a4 += sv[4 * D + kk] * x; }
            red[(hw * 5 + 0) * 32 + cl] = a0; red[(hw * 5 + 1) * 32 + cl] = a1; red[(hw * 5 + 2) * 32 + cl] = a2; red[(hw * 5 + 3) * 32 + cl] = a3; red[(hw * 5 + 4) * 32 + cl] = a4;
            __syncthreads();
            if (F.tid < 160) { const int r = F.tid >> 5; float acc = p.ada_b[l * NMOD * D + (it % (NMOD * D / 32)) * 32 + cl];
#pragma unroll
                for (int h2 = 0; h2 < 16; ++h2) acc += red[(h2 * 5 + r) * 32 + cl];
                F.mod()[((size_t)(l * 5 + r) * NMOD * D) + (it % (NMOD * D / 32)) * 32 + cl] = acc; }
            __syncthreads();
        }
    }
}

__device__ __forceinline__ int ybase_of(const Frame& F, int l, int e) {
    int b = 0;
    for (int j = 0; j < e; ++j) b += ((int)F.ctl()[CW_CNT + (l * NE + j) * 64] + 255) & ~255;
    return b;
}
__device__ __forceinline__ void moe_table(Frame& F, int l) {
    volatile LAS int* tab = (volatile LAS int*)(F.lds + MOETAB_OFF);
    __syncthreads();
    if (F.wave == 0) {
        const int e = F.lane & 15;
        const int cnt = (int)F.ctl()[CW_CNT + (l * NE + e) * 64];
        const int nt = (cnt + 255) >> 8;
        int inc = nt;
        inc += __builtin_amdgcn_update_dpp(0, inc, 0x111, 0xf, 0xf, true); inc += __builtin_amdgcn_update_dpp(0, inc, 0x112, 0xf, 0xf, true);
        inc += __builtin_amdgcn_update_dpp(0, inc, 0x114, 0xf, 0xf, true); inc += __builtin_amdgcn_update_dpp(0, inc, 0x118, 0xf, 0xf, true);
        if (F.lane < 16) { tab[e] = inc - nt; tab[32 + e] = cnt; if (e == 15) tab[16] = inc; }
    }
    __syncthreads();
    if (F.tid < 192) { int e = 0;
        for (int j = 1; j < 16; ++j) e += (tab[j] <= F.tid) ? 1 : 0;
        tab[64 + F.tid] = e; }
    __syncthreads();
}
__device__ __forceinline__ void add_y4(f32x4& v, const f32x4& g, const u32x2& a, const u32x2& b) {
    v.x += g.x * (__uint_as_float(a.x << 16) + __uint_as_float(b.x << 16)); v.y += g.y * (__uint_as_float(a.x & 0xffff0000u) + __uint_as_float(b.x & 0xffff0000u));
    v.z += g.z * (__uint_as_float(a.y << 16) + __uint_as_float(b.y << 16)); v.w += g.w * (__uint_as_float(a.y & 0xffff0000u) + __uint_as_float(b.y & 0xffff0000u));
}
__device__ __forceinline__ f32x4 ld_bf4(const bf16* p) { const u32x2 u = *(const u32x2*)p; f32x4 v; v.x = __uint_as_float(u.x << 16); v.y = __uint_as_float(u.x & 0xffff0000u); v.z = __uint_as_float(u.y << 16); v.w = __uint_as_float(u.y & 0xffff0000u); return v; }
__device__ __forceinline__ void st_bf4(bf16* p, const f32x4& v) { u32x2 u; u.x = pk2(v.x, v.y); u.y = pk2(v.z, v.w); *(u32x2*)p = u; }
__device__ __forceinline__ float sumsq4(const f32x4& v) { return v.x * v.x + v.y * v.y + v.z * v.z + v.w * v.w; }

template <int NT> __device__ __forceinline__ void p1_setup(CPR p, Frame& F, int l, int t) {
    LAS float* mdl = (LAS float*)F.lds;
    constexpr int KM = (1280 + NT - 1) / NT;
    f32x4 mg[KM], ms[KM], mq[KM], m5[KM];
#pragma unroll
    for (int k = 0; k < KM; ++k) { const int i = t + NT * k; if (i < 5 * 256) { const int mr = i >> 8, c = (i & 255) * 4;
        mg[k] = *(const f32x4*)(p.norm1_g + l * D + c); ms[k] = *(const f32x4*)(mod_vec(F, l, mr, 0) + c); mq[k] = *(const f32x4*)(mod_vec(F, l, mr, 1) + c);
        m5[k] = *(const f32x4*)(mod_vec(F, l > 0 ? l - 1 : 0, mr, 5) + c); } }
    __builtin_amdgcn_sched_barrier(0);
#pragma unroll
    for (int k = 0; k < KM; ++k) { const int i = t + NT * k; if (i < 5 * 256) { const int mr = i >> 8, c = (i & 255) * 4;
        *(LAS f32x4*)(mdl + mr * 3072 + c) = mg[k] * (mq[k] + 1.f); *(LAS f32x4*)(mdl + mr * 3072 + 1024 + c) = ms[k]; *(LAS f32x4*)(mdl + mr * 3072 + 2048 + c) = m5[k]; } }
}
__device__ __forceinline__ void p1_rows(CPR p, Frame& F, int l, float ysc = 1.f, bool setup = true) {
    const volatile LAS int* tab = (const volatile LAS int*)(F.lds + MOETAB_OFF);
    if (setup) { __syncthreads(); p1_setup<NTHR>(p, F, l, F.tid); __syncthreads(); }
    if (l > 0 && !MK_ONE_LAUNCH) moe_table(F, l - 1);
    for (int pi = F.gw; pi < T / 2; pi += F.ngw) {
        int c0 = 4 * F.lane; asm volatile("" : "+v"(c0));
        const int r0 = 2 * pi, mr = row_mod(r0);
        const __amdgpu_buffer_rsrc_t rsx = __builtin_amdgcn_make_buffer_rsrc((void*)F.xl(), 0, T * D * 2, 0x00020000), rsh = __builtin_amdgcn_make_buffer_rsrc((void*)F.ha(), 0, T * D * 2, 0x00020000);
        f32x4 v[2][4];
        if (l == 0) {
#pragma unroll
            for (int k = 0; k < 2; ++k) { const int r = r0 + k; const float* src = (r < TL) ? p.x + (size_t)r * D : p.ctx + (size_t)(r - TL) * D;
#pragma unroll
                for (int j = 0; j < 4; ++j) v[k][j] = *(const f32x4*)(src + c0 + 256 * j); }
        } else {
            const bf16* y0[2]; const bf16* y1[2];
#pragma unroll
            for (int k = 0; k < 2; ++k) { const i32x4 rt = *(const i32x4*)(F.route() + 4 * (r0 + k));
                y0[k] = F.y() + (size_t)(tab[rt.x] * 256 + rt.y) * D + c0; y1[k] = F.y() + (size_t)(tab[rt.z] * 256 + rt.w) * D + c0; }
            u32x2 a[2][4], b[2][4];
#pragma unroll
            for (int k = 0; k < 2; ++k)
#pragma unroll
                for (int j = 0; j < 4; ++j) { v[k][j] = ld_bf4(F.xl() + (size_t)(r0 + k) * D + c0 + 256 * j); a[k][j] = *(const u32x2*)(y0[k] + 256 * j); b[k][j] = *(const u32x2*)(y1[k] + 256 * j); }
            const LAS float* g5 = (const LAS float*)F.lds + mr * 3072 + 2048 + c0;
#pragma unroll
            for (int j = 0; j < 4; ++j) { const f32x4 g = *(const LAS f32x4*)(g5 + 256 * j) * ysc; add_y4(v[0][j], g, a[0][j], b[0][j]); add_y4(v[1][j], g, a[1][j], b[1][j]); }
        }
        const LAS float* mm = (const LAS float*)F.lds + mr * 3072 + c0;
        float ss0 = 0.f, ss1 = 0.f;
#pragma unroll
        for (int j = 0; j < 4; ++j) { u32x2 u0, u1; u0.x = pk2(v[0][j].x, v[0][j].y); u0.y = pk2(v[0][j].z, v[0][j].w); u1.x = pk2(v[1][j].x, v[1][j].y); u1.y = pk2(v[1][j].z, v[1][j].w);
            __builtin_amdgcn_raw_buffer_store_b64(u0, rsx, (r0 * D + c0 + 256 * j) * 2, 0, 16); __builtin_amdgcn_raw_buffer_store_b64(u1, rsx, ((r0 + 1) * D + c0 + 256 * j) * 2, 0, 16);
            ss0 += sumsq4(v[0][j]); ss1 += sumsq4(v[1][j]); }
        ss0 = wave_sum(ss0); ss1 = wave_sum(ss1);
        const float rs0 = rsqrtf(ss0 * (1.f / D) + EPS), rs1 = rsqrtf(ss1 * (1.f / D) + EPS);
#pragma unroll
        for (int j = 0; j < 4; ++j) { const f32x4 mul = *(const LAS f32x4*)(mm + 256 * j), s4 = *(const LAS f32x4*)(mm + 1024 + 256 * j);
            const f32x4 h0 = v[0][j] * rs0 * mul + s4, h1 = v[1][j] * rs1 * mul + s4;
            u32x2 o0, o1; o0.x = pk2(h0.x, h0.y); o0.y = pk2(h0.z, h0.w); o1.x = pk2(h1.x, h1.y); o1.y = pk2(h1.z, h1.w);
            __builtin_amdgcn_raw_buffer_store_b64(o0, rsh, (r0 * D + c0 + 256 * j) * 2, 0, 16); __builtin_amdgcn_raw_buffer_store_b64(o1, rsh, ((r0 + 1) * D + c0 + 256 * j) * 2, 0, 16); }
    }
}

__device__ __forceinline__ void p2_inproj_naive(Frame& F, int l) {
    const bf16* W = F.win() + (size_t)l * INP * D;
    for (long i = F.gt; i < (long)T * INW; i += F.ngt) { const int r = (int)(i / INW), c = (int)(i % INW);
        F.pl()[(size_t)r * INP + c] = (bf16)f2bf(dot_bf16(F.ha() + (size_t)r * D, W + (size_t)c * D, D)); }
}

__device__ __forceinline__ void p3_mla_up_naive(CPR p, Frame& F, int l) {
    for (int r = F.gw; r < T; r += F.ngw) {
        const bf16* pr = F.pl() + (size_t)r * INP + OFF_D;
        float a[4]; { const u32x2 t = *(const u32x2*)(pr + 4 * F.lane); a[0] = __uint_as_float(t.x << 16); a[1] = __uint_as_float(t.x & 0xffff0000u); a[2] = __uint_as_float(t.y << 16); a[3] = __uint_as_float(t.y & 0xffff0000u); }
        const float rq = rsqrtf(wave_sum(a[0] * a[0] + a[1] * a[1] + a[2] * a[2] + a[3] * a[3]) * (1.f / 256.f) + EPS);
        float b2[2]; { const unsigned t = *(const unsigned*)(pr + 256 + 2 * F.lane); b2[0] = __uint_as_float(t << 16); b2[1] = __uint_as_float(t & 0xffff0000u); }
        const float rkv = rsqrtf(wave_sum(b2[0] * b2[0] + b2[1] * b2[1]) * (1.f / 128.f) + EPS);
        LAS float* sq = (LAS float*)(F.lds + F.wave * 4096);
#pragma unroll
        for (int j = 0; j < 4; ++j) sq[4 * F.lane + j] = a[j] * rq;
        sq[256 + 2 * F.lane] = b2[0] * rkv; sq[256 + 2 * F.lane + 1] = b2[1] * rkv;
        LDS_WAIT(); asm volatile("" ::: "memory");
        const bool lat = r < TL; const int t = r & (SEQ - 1);
        for (int f = F.lane; f < 384; f += 64) {
            const int h = f / 96, j = f % 96;
            float val;
            const bf16* wrow = F.wuq() + (size_t)l * 384 * 256;
            auto qdot = [&](int ff) { float s = 0.f; const bf16* w = wrow + (size_t)ff * 256; for (int k = 0; k < 256; ++k) s += sq[k] * bf2f(w[k]); return s; };
            if (j < 64 || !lat) val = qdot(f);
            else { const int i = j - 64; const int base = h * 96 + 64;
                const int q8 = i & 7, half = (i >> 3) & 1, axis = i >> 4;
                const float cs = F.ropec()[t * 16 + axis * 8 + q8], sn = F.ropes()[t * 16 + axis * 8 + q8];
                const float x1 = qdot(base + axis * 16 + q8), x2 = qdot(base + axis * 16 + 8 + q8);
                val = half ? (x1 * sn + x2 * cs) : (x1 * cs - x2 * sn); }
            F.qm()[(size_t)r * 384 + f] = (bf16)f2bf(val * (MLA_SCALE * LOG2E));
        }
        for (int f = F.lane; f < 512; f += 64) {
            const int h = f / 128, j = f % 128; float s = 0.f; const bf16* w = F.wukv() + (size_t)l * 512 * 128 + (size_t)f * 128;
            for (int k = 0; k < 128; ++k) s += sq[256 + k] * bf2f(w[k]);
            if (j < 64) F.km()[(size_t)r * 384 + h * 96 + j] = (bf16)f2bf(s); else F.vm()[(size_t)r * 256 + h * 64 + (j - 64)] = (bf16)f2bf(s);
        }
        if (F.lane < 32) { const int i = F.lane, q8 = i & 7, half = (i >> 3) & 1, axis = i >> 4;
            const float x1 = bf2f(pr[384 + axis * 16 + q8]), x2 = bf2f(pr[384 + axis * 16 + 8 + q8]);
            float val;
            if (lat) { const float cs = F.ropec()[t * 16 + axis * 8 + q8], sn = F.ropes()[t * 16 + axis * 8 + q8]; val = half ? (x1 * sn + x2 * cs) : (x1 * cs - x2 * sn); }
            else val = bf2f(pr[384 + i]);
#pragma unroll
            for (int h = 0; h < 4; ++h) F.km()[(size_t)r * 384 + h * 96 + 64 + i] = (bf16)f2bf(val); }
        LDS_WAIT(); asm volatile("" ::: "memory");
    }
}
__device__ __forceinline__ void p3_pool_naive(CPR p, Frame& F, int l) {
    for (int i = F.gt; i < T * 256; i += F.ngt) {
        const int r = i >> 8, col = i & 255, g = col >> 6, d = col & 63;
        const int L = r < TL ? SEQ : CTX, t = r < TL ? (r & (SEQ - 1)) : ((r - TL) & (CTX - 1)), seg0 = r - t;
        const int win = 2 << g; int lo = t - win / 2, hi = t - win / 2 + win; lo = lo < 0 ? 0 : lo; hi = hi > L ? L : hi;
        const float inv = 1.f / (float)(hi - lo);
        const bf16* wt = F.poolw() + (size_t)(l * 4 + g) * 4096 + d * 64;
        float acc = 0.f;
        for (int c = 0; c < 64; ++c) { float m = 0.f; for (int s = lo; s < hi; ++s) m += bf2f(F.pl()[(size_t)(seg0 + s) * INP + g * 64 + c]);
            const float df = m * inv - bf2f(F.pl()[(size_t)r * INP + g * 64 + c]); acc += df * bf2f(wt[c]); }
        F.ml()[(size_t)r * D + col] = (bf16)f2bf(acc * p.pool_s[l * 256 + col]);
    }
}
__device__ __forceinline__ void p3_sgu1_naive(CPR p, Frame& F, int l) {
    bf16* vg = F.hid();
    for (int r = F.gw; r < T; r += F.ngw) {
        const bf16* pv = F.pl() + (size_t)r * INP + OFF_C + 256;
        float a[4]; { const u32x2 t = *(const u32x2*)(pv + 4 * F.lane); a[0] = gelu_tanh(__uint_as_float(t.x << 16)); a[1] = gelu_tanh(__uint_as_float(t.x & 0xffff0000u)); a[2] = gelu_tanh(__uint_as_float(t.y << 16)); a[3] = gelu_tanh(__uint_as_float(t.y & 0xffff0000u)); }
        float ss = a[0] * a[0] + a[1] * a[1] + a[2] * a[2] + a[3] * a[3];
        ss += lane_xor<1>(ss); ss += lane_xor<2>(ss); ss += lane_xor<4>(ss); ss += lane_xor<8>(ss);
        const float rs = rsqrtf(ss * (1.f / 64.f) + EPS); const float* gn = p.sgu_norm_g + l * 256 + 4 * F.lane;
        u32x2 o; o.x = pk2(a[0] * rs * gn[0], a[1] * rs * gn[1]); o.y = pk2(a[2] * rs * gn[2], a[3] * rs * gn[3]);
        *(u32x2*)(vg + (size_t)r * 256 + 4 * F.lane) = o;
    }
}
__device__ __forceinline__ void p3_sgu2_naive(CPR p, Frame& F, int l) {
    const bf16* vg = F.hid();
    for (int i = F.gt; i < T * 256; i += F.ngt) {
        const int r = i >> 8, col = i & 255, g = col >> 6, pp = r & 127, r0 = r - pp;
        const bf16* w = F.sguw() + ((size_t)(l * 4 + g) * 128 + pp) * 128;
        float acc = p.sgu_b[(l * 4 + g) * 128 + pp];
        for (int q = 0; q < 128; ++q) acc += bf2f(w[q]) * bf2f(vg[(size_t)(r0 + q) * 256 + col]);
        const float u = gelu_tanh(bf2f(F.pl()[(size_t)r * INP + OFF_C + col]));
        F.ml()[(size_t)r * D + 512 + col] = (bf16)f2bf(u * acc);
    }
}
__device__ __forceinline__ void p3_na_naive(CPR p, Frame& F, int l) {
    LAS float* pw = (LAS float*)(F.lds + 65536 + F.wave * 2048);
    for (int it = F.gw; it < T * 4; it += F.ngw) {
        const int r = it >> 2, h = it & 3; const bool lat = r < TL; const int b = row_batch(r);
        float q[64];
        { const bf16* qp = F.pl() + (size_t)r * INP + OFF_B + h * 64;
#pragma unroll
          for (int j = 0; j < 8; ++j) { const u32x4 t = *(const u32x4*)(qp + 8 * j);
#pragma unroll
              for (int k = 0; k < 4; ++k) { q[8 * j + 2 * k] = __uint_as_float(t[k] << 16); q[8 * j + 2 * k + 1] = __uint_as_float(t[k] & 0xffff0000u); } } }
        const int t = r & (SEQ - 1), gr = t >> 6, gc = t & 63, jb = gc >> 4;
        int rs = gr - 4; rs = rs < 0 ? 0 : (rs > GH - 8 ? GH - 8 : rs);
        int wsq = gc - 8; wsq = wsq < 0 ? 0 : (wsq > GW - 16 ? GW - 16 : wsq);
        int cs = 16 * jb - 8; cs = cs < 0 ? 0 : (cs > GW - 16 ? GW - 16 : cs); cs = cs > GW - 32 ? GW - 32 : cs;
        const float* rpb = p.na_rpb + (size_t)(l * 4 + h) * 15 * 31;
        float s[8];
#pragma unroll
        for (int i = 0; i < 8; ++i) {
            const int k = F.lane + 64 * (i & 3); const bool win = i < 4;
            int keyrow; float bias = 0.f; bool valid = true;
            if (win) { const int rr = k >> 5, cc = k & 31, kcol = cs + cc; keyrow = b * SEQ + (rs + rr) * 64 + kcol;
                valid = lat && (kcol >= wsq) && (kcol < wsq + 16);
                int dc = kcol - gc + 15; dc = dc < 0 ? 0 : (dc > 30 ? 30 : dc);
                bias = rpb[(rs + rr - gr + 7) * 31 + dc];
                if (!lat) keyrow = r; }
            else keyrow = TL + b * CTX + k;
            const bf16* kp = F.pl() + (size_t)keyrow * INP + OFF_B + 256 + h * 64;
            float d = 0.f;
#pragma unroll
            for (int j = 0; j < 8; ++j) { const u32x4 tt = *(const u32x4*)(kp + 8 * j);
#pragma unroll
                for (int kk = 0; kk < 4; ++kk) d += q[8 * j + 2 * kk] * __uint_as_float(tt[kk] << 16) + q[8 * j + 2 * kk + 1] * __uint_as_float(tt[kk] & 0xffff0000u); }
            s[i] = valid ? (d * 0.125f + bias) : -1e30f;
        }
        float m = s[0];
#pragma unroll
        for (int i = 1; i < 8; ++i) m = fmaxf(m, s[i]);
        m = wave_max(m);
        float sum = 0.f;
#pragma unroll
        for (int i = 0; i < 8; ++i) { s[i] = __expf(s[i] - m); sum += s[i]; }
        sum = wave_sum(sum); const float inv = 1.f / sum;
#pragma unroll
        for (int i = 0; i < 8; ++i) pw[(i >> 2) * 256 + F.lane + 64 * (i & 3)] = s[i] * inv;
        LDS_WAIT(); asm volatile("" ::: "memory");
        float acc = 0.f;
        if (lat) for (int k = 0; k < 256; ++k) { const int rr = k >> 5, cc = k & 31; const int keyrow = b * SEQ + (rs + rr) * 64 + cs + cc;
            acc += pw[k] * bf2f(F.pl()[(size_t)keyrow * INP + OFF_B + 512 + h * 64 + F.lane]); }
        for (int k = 0; k < 256; ++k) acc += pw[256 + k] * bf2f(F.pl()[(size_t)(TL + b * CTX + k) * INP + OFF_B + 512 + h * 64 + F.lane]);
        F.ml()[(size_t)r * D + 256 + h * 64 + F.lane] = (bf16)f2bf(acc);
        LDS_WAIT(); asm volatile("" ::: "memory");
    }
}
__device__ __forceinline__ void p4_mla_naive(Frame& F) {
    LAS float* pw = (LAS float*)(F.lds + 65536 + F.wave * 2048);
    for (int it = F.gw; it < T * 4; it += F.ngw) {
        const int r = it >> 2, h = it & 3; const bool lat = r < TL; const int b = row_batch(r);
        float q[96];
        { const bf16* qp = F.qm() + (size_t)r * 384 + h * 96;
#pragma unroll
          for (int j = 0; j < 12; ++j) { const u32x4 t = *(const u32x4*)(qp + 8 * j);
#pragma unroll
              for (int k = 0; k < 4; ++k) { q[8 * j + 2 * k] = __uint_as_float(t[k] << 16); q[8 * j + 2 * k + 1] = __uint_as_float(t[k] & 0xffff0000u); } } }
        const int nk = lat ? (CTX + SEQ) : CTX;
        float m = -3.0e38f, lsum = 0.f, acc = 0.f;
        for (int k0 = 0; k0 < nk; k0 += 64) {
            const int k = k0 + F.lane; const int keyrow = (k < CTX) ? (TL + b * CTX + k) : (b * SEQ + k - CTX);
            const bf16* kp = F.km() + (size_t)keyrow * 384 + h * 96;
            float d = 0.f;
#pragma unroll
            for (int j = 0; j < 12; ++j) { const u32x4 tt = *(const u32x4*)(kp + 8 * j);
#pragma unroll
                for (int kk = 0; kk < 4; ++kk) d += q[8 * j + 2 * kk] * __uint_as_float(tt[kk] << 16) + q[8 * j + 2 * kk + 1] * __uint_as_float(tt[kk] & 0xffff0000u); }
            const float mn = fmaxf(m, wave_max(d)); const float alpha = exp2f(m - mn); const float pe = exp2f(d - mn);
            lsum = lsum * alpha + wave_sum(pe); acc *= alpha; m = mn;
            pw[F.lane] = pe; LDS_WAIT(); asm volatile("" ::: "memory");
            for (int kk = 0; kk < 64; ++kk) { const int k2 = k0 + kk; const int kr2 = (k2 < CTX) ? (TL + b * CTX + k2) : (b * SEQ + k2 - CTX);
                acc += pw[kk] * bf2f(F.vm()[(size_t)kr2 * 256 + h * 64 + F.lane]); }
            LDS_WAIT(); asm volatile("" ::: "memory");
        }
        F.ml()[(size_t)r * D + 768 + h * 64 + F.lane] = (bf16)f2bf(acc / lsum);
    }
}

typedef float f32x16 __attribute__((ext_vector_type(16)));
typedef short s16x4 __attribute__((ext_vector_type(4)));
__device__ __forceinline__ s16x4 lds_tr16(const LAS unsigned char* p) { return __builtin_bit_cast(s16x4, __builtin_amdgcn_ds_read_tr16_b64_v4i16((LAS s16x4*)p)); }
__device__ __forceinline__ bf16x8 pack8(const f32x16& v, int o) {
    u32x4 w; w.x = pg8::cvt_pk_bf16(v[o + 0], v[o + 1]); w.y = pg8::cvt_pk_bf16(v[o + 2], v[o + 3]); w.z = pg8::cvt_pk_bf16(v[o + 4], v[o + 5]); w.w = pg8::cvt_pk_bf16(v[o + 6], v[o + 7]);
    return __builtin_bit_cast(bf16x8, w);
}
__device__ __forceinline__ void glds16(const void* g, unsigned lds_base) {
    unsigned sv; asm volatile("s_mov_b32 %0, m0\n\ts_mov_b32 m0, %2\n\ts_nop 0\n\tglobal_load_lds_dwordx4 %1, off\n\ts_mov_b32 m0, %0" : "=&s"(sv) : "v"(g), "s"(lds_base) : "memory"); }
#define FL_SBAR() __builtin_amdgcn_sched_barrier(0)
#define FL_PIN(x) asm volatile("" : "+v"(x))
#define FL_MFMA(a, b, c) __builtin_amdgcn_mfma_f32_32x32x16_bf16(a, b, c, 0, 0, 0)
template <int MODE> __device__ __forceinline__ void p4_mla_flash(Frame& F) {
    constexpr int KSL = 12288, VSL = 8192, LK = 0, LV = 4 * KSL;
    const int lane = F.lane, w = F.wave, q = lane & 31, hh = lane >> 5;
    const bf16* qm = F.qm(); const bf16* km = F.km(); const bf16* vm = F.vm(); bf16* ml = (MODE == 0) ? F.ml() : F.hid() - 768;
    LAS unsigned char* lds = F.lds; const unsigned lds0 = (unsigned)(size_t)lds;
    const int kc2 = 8 + (w & 3);
    const LAS unsigned char* kp0 = lds + LK + hh * 1024 + q * 16;
    const LAS unsigned char* vp0 = lds + LV + ((lane >> 4) & 1) * 32 + (lane & 3) * 8 + (4 * hh + ((lane & 15) >> 2)) * 64;
    if (w >= 4) __builtin_amdgcn_s_setprio(1);
    for (int ui = blockIdx.x; ui < 272; ui += gridDim.x) {
        const int qt = ui < 256 ? (ui >> 2) : 64 + ((ui - 256) >> 2), h = ui & 3;
        const bool lat = qt < 64; const int b = lat ? (qt >> 4) : (qt - 64), ntile = lat ? 68 : 4;
        const int qrow = qt * 256 + w * 32 + q;
#define FL_KROW(t_) ((lat && (t_) >= 4) ? b * SEQ + 64 * ((t_) - 4) : TL + b * CTX + 64 * (t_))
        const unsigned koff = (unsigned)(lane * 384 + h * 96 + 8 * w);
        const unsigned voff = (unsigned)((16 * (w & 3) + (lane >> 2)) * 256 + h * 64 + 32 * (w >> 2) + 8 * (lane & 3));
#define FL_DMA_K(t_, slot_) do { const size_t ro_ = (size_t)FL_KROW(t_) * 384; \
            glds16(km + ro_ + koff, (unsigned)__builtin_amdgcn_readfirstlane((int)(lds0 + LK + (slot_) + w * 1024))); \
            glds16(km + ro_ + 8 * (kc2 - w) + koff, (unsigned)__builtin_amdgcn_readfirstlane((int)(lds0 + LK + (slot_) + kc2 * 1024))); } while (0)
#define FL_DMA_V(t_, slot_) glds16(vm + (size_t)FL_KROW(t_) * 256 + voff, (unsigned)__builtin_amdgcn_readfirstlane((int)(lds0 + LV + (slot_) + w * 1024)))
#define FL_WAITBAR(N) do { asm volatile("s_waitcnt vmcnt(" #N ") lgkmcnt(0)" ::: "memory"); __builtin_amdgcn_s_barrier(); asm volatile("" ::: "memory"); } while (0)
        int kprev = 3 * KSL, kcur = 0, knext = KSL, kn2 = 2 * KSL, vprev = 0, vcur = 0, vnext = VSL;
#define FL_ROT() do { const int kt_ = kprev; kprev = kcur; kcur = knext; knext = kn2; kn2 = kt_; vprev = vcur; vcur = vnext; vnext = (vnext == 2 * VSL) ? 0 : vnext + VSL; } while (0)
        FL_DMA_K(0, 0); FL_DMA_V(0, 0); FL_DMA_K(1, KSL);
        bf16x8 qf[6];
#pragma unroll
        for (int ks = 0; ks < 6; ++ks) qf[ks] = *(const bf16x8*)(qm + (size_t)qrow * 384 + h * 96 + 16 * ks + 8 * hh);
#define FL_Q(ks) qf[ks]
        f32x16 ot0, ot1, negm;
        { float z0 = 0.f; asm volatile("" : "+v"(z0));
#pragma unroll
          for (int r = 0; r < 16; ++r) { ot0[r] = z0; ot1[r] = z0; negm[r] = z0; } }
        FL_PIN(negm);
        constexpr float THR = 8.f;
        float mref = 0.f, l = 0.f, alpha = 1.f; bool resc = false;
        f32x16 pA0, pA1, pB0, pB1; bf16x8 kf[12]; s16x4 vlo[8], vhi[8]; u32x4 pw0, pw1, pw2, pw3;
        if (2 < ntile) FL_DMA_K(2, 2 * KSL);
        FL_WAITBAR(0);
#define FL_KLOAD2(base_, d0) do { kf[2 * (d0)] = *(const LAS bf16x8*)((base_) + (d0) * 2048); kf[2 * (d0) + 1] = *(const LAS bf16x8*)((base_) + (d0) * 2048 + 512); } while (0)
#pragma unroll
        for (int d0 = 0; d0 < 6; ++d0) FL_KLOAD2(kp0, d0);
        pA0 = FL_MFMA(kf[0], FL_Q(0), negm); pA1 = FL_MFMA(kf[1], FL_Q(0), negm);
#pragma unroll
        for (int d0 = 1; d0 < 6; ++d0) { pA0 = FL_MFMA(kf[2 * d0], FL_Q(d0), pA0); pA1 = FL_MFMA(kf[2 * d0 + 1], FL_Q(d0), pA1); }
        { float mx = __builtin_fmaxf(pA0[0], pA1[0]);
#pragma unroll
          for (int r = 1; r < 16; ++r) mx = __builtin_fmaxf(__builtin_fmaxf(mx, pA0[r]), pA1[r]);
          mx = xmax32(mx); mref = mx;
#pragma unroll
          for (int r = 0; r < 16; ++r) { pA0[r] = __builtin_amdgcn_exp2f(pA0[r] - mx); pA1[r] = __builtin_amdgcn_exp2f(pA1[r] - mx); negm[r] = -mx; } }
        FL_WAITBAR(0);
        if (3 < ntile) FL_DMA_K(3, 3 * KSL);
        if (1 < ntile) FL_DMA_V(1, VSL);
        FL_ROT();
#pragma unroll
        for (int d0 = 0; d0 < 4; ++d0) FL_KLOAD2(kp0 + kcur, d0);
        FL_WAITBAR(3);
#define FL_PK(P, i) pg8::cvt_pk_bf16(P[i], P[(i) + 1])
#define FL_VFR(i) (bf16x8){vlo[i][0], vlo[i][1], vlo[i][2], vlo[i][3], vhi[i][0], vhi[i][1], vhi[i][2], vhi[i][3]}
#define FL_VRD(i) do { vlo[i] = lds_tr16(vp_ + (((i) >> 2) * 4096 + ((i) & 3) * 1024)); vhi[i] = lds_tr16(vp_ + (((i) >> 2) * 4096 + ((i) & 3) * 1024 + 512)); } while (0)
#define FL_KRD(G, d0) do { if (G) { FL_KLOAD2(kp0 + knext, d0); FL_SBAR(); } } while (0)
#define FL_GAPA(MF, a0, a1, a2, a3, W0, W1, PW) do { MF; sacc += a0; sacc += a1; sacc += a2; sacc += a3; W0; W1; FL_PIN(PW); FL_PIN(sacc); FL_SBAR(); } while (0)
#define FL_GAPB(MF, X, i) do { MF; X[i] = __builtin_amdgcn_exp2f(X[i]); X[(i) + 1] = __builtin_amdgcn_exp2f(X[(i) + 1]); X[(i) + 2] = __builtin_amdgcn_exp2f(X[(i) + 2]); X[(i) + 3] = __builtin_amdgcn_exp2f(X[(i) + 3]); FL_PIN(X); FL_SBAR(); } while (0)
#define FL_STEP(C0, C1, P0, P1, t_, GK, GV, GL) do { FL_SBAR(); \
            const LAS unsigned char* vp_ = vp0 + vprev; \
            FL_VRD(0); FL_SBAR(); float sacc = P0[0] + P0[1]; \
                               FL_GAPA(C0 = FL_MFMA(kf[0], FL_Q(0), negm), P0[2], P0[3], P0[4], P0[5],     pw0[0] = FL_PK(P0, 0),  pw0[1] = FL_PK(P0, 2),  pw0); \
            FL_VRD(4); FL_KLOAD2(kp0 + kcur, 4); FL_SBAR(); \
                               FL_GAPA(C1 = FL_MFMA(kf[1], FL_Q(0), negm), P0[6], P0[7], P0[8], P0[9],     pw0[2] = FL_PK(P0, 4),  pw0[3] = FL_PK(P0, 6),  pw0); \
            FL_VRD(1); FL_SBAR(); FL_GAPA(C0 = FL_MFMA(kf[2], FL_Q(1), C0),   P0[10], P0[11], P0[12], P0[13], pw1[0] = FL_PK(P0, 8),  pw1[1] = FL_PK(P0, 10), pw1); \
            FL_VRD(5); FL_KLOAD2(kp0 + kcur, 5); FL_SBAR(); \
                               FL_GAPA(C1 = FL_MFMA(kf[3], FL_Q(1), C1),   P0[14], P0[15], P1[0], P1[1],   pw1[2] = FL_PK(P0, 12), pw1[3] = FL_PK(P0, 14), pw1); \
            FL_VRD(2); FL_SBAR(); FL_GAPA(C0 = FL_MFMA(kf[4], FL_Q(2), C0),   P1[2], P1[3], P1[4], P1[5],     pw2[0] = FL_PK(P1, 0),  pw2[1] = FL_PK(P1, 2),  pw2); \
            FL_VRD(6); FL_SBAR(); \
                               FL_GAPA(C1 = FL_MFMA(kf[5], FL_Q(2), C1),   P1[6], P1[7], P1[8], P1[9],     pw2[2] = FL_PK(P1, 4),  pw2[3] = FL_PK(P1, 6),  pw2); \
            FL_VRD(3); FL_SBAR(); FL_GAPA(C0 = FL_MFMA(kf[6], FL_Q(3), C0),   P1[10], P1[11], P1[12], P1[13], pw3[0] = FL_PK(P1, 8),  pw3[1] = FL_PK(P1, 10), pw3); \
            FL_VRD(7); FL_SBAR(); \
                               FL_GAPA(C1 = FL_MFMA(kf[7], FL_Q(3), C1),   P1[14], P1[15], 0.f, 0.f,       pw3[2] = FL_PK(P1, 12), pw3[3] = FL_PK(P1, 14), pw3); \
            C0 = FL_MFMA(kf[8], FL_Q(4), C0); C1 = FL_MFMA(kf[9], FL_Q(4), C1); C0 = FL_MFMA(kf[10], FL_Q(5), C0); C1 = FL_MFMA(kf[11], FL_Q(5), C1); FL_SBAR(); \
            l += sacc; \
            if (GK) FL_DMA_K((t_) + 3, kprev); if (GV) FL_DMA_V((t_) + 1, vnext);                   \
            { float mx = __builtin_fmaxf(C0[0], C1[0]); \
              _Pragma("unroll") for (int r = 1; r < 16; ++r) mx = __builtin_fmaxf(__builtin_fmaxf(mx, C0[r]), C1[r]); \
              mx = xmax32(mx); resc = false; \
              if (__builtin_expect(__any(mx > THR), 0)) { const float dl = __builtin_fmaxf(mx, 0.f); mref += dl; alpha = __builtin_amdgcn_exp2f(-dl); l *= alpha; resc = true; \
                  _Pragma("unroll") for (int r = 0; r < 16; ++r) { C0[r] -= dl; C1[r] -= dl; negm[r] = -mref; } } } \
            FL_SBAR(); \
            FL_GAPB(ot0 = FL_MFMA(FL_VFR(0), __builtin_bit_cast(bf16x8, pw0), ot0), C0, 0);               FL_GAPB(ot1 = FL_MFMA(FL_VFR(4), __builtin_bit_cast(bf16x8, pw0), ot1), C0, 4); \
            FL_KRD(GL, 0); FL_GAPB(ot0 = FL_MFMA(FL_VFR(1), __builtin_bit_cast(bf16x8, pw1), ot0), C0, 8);  FL_KRD(GL, 1); FL_GAPB(ot1 = FL_MFMA(FL_VFR(5), __builtin_bit_cast(bf16x8, pw1), ot1), C0, 12); \
            FL_KRD(GL, 2); FL_GAPB(ot0 = FL_MFMA(FL_VFR(2), __builtin_bit_cast(bf16x8, pw2), ot0), C1, 0);  FL_KRD(GL, 3); FL_GAPB(ot1 = FL_MFMA(FL_VFR(6), __builtin_bit_cast(bf16x8, pw2), ot1), C1, 4); \
            FL_GAPB(ot0 = FL_MFMA(FL_VFR(3), __builtin_bit_cast(bf16x8, pw3), ot0), C1, 8);               FL_GAPB(ot1 = FL_MFMA(FL_VFR(7), __builtin_bit_cast(bf16x8, pw3), ot1), C1, 12); \
            } while (0)
#define FL_RESC() do { if (resc) { _Pragma("unroll") for (int r = 0; r < 16; ++r) { ot0[r] *= alpha; ot1[r] *= alpha; } } } while (0)
#define FL_ENDW(tt) do { if ((tt) + 3 < ntile) { FL_WAITBAR(3); } else { FL_WAITBAR(0); } } while (0)
        int t = 1;
        for (; t + 5 < ntile; t += 2) {
            FL_STEP(pB0, pB1, pA0, pA1, t, true, true, true);     FL_WAITBAR(3); FL_RESC(); FL_ROT();
            FL_STEP(pA0, pA1, pB0, pB1, t + 1, true, true, true); FL_WAITBAR(3); FL_RESC(); FL_ROT();
        }
        for (; t + 1 < ntile; t += 2) {
            FL_STEP(pB0, pB1, pA0, pA1, t, (t + 3 < ntile), (t + 1 < ntile), (t + 1 < ntile));         FL_ENDW(t);     FL_RESC(); FL_ROT();
            FL_STEP(pA0, pA1, pB0, pB1, t + 1, (t + 4 < ntile), (t + 2 < ntile), (t + 2 < ntile));     FL_ENDW(t + 1); FL_RESC(); FL_ROT();
        }
        FL_STEP(pB0, pB1, pA0, pA1, ntile - 1, false, false, false); FL_RESC();
        { float sacc = 0.f;
#pragma unroll
          for (int r = 0; r < 16; ++r) sacc += pB0[r] + pB1[r];
          l += sacc;
          pw0 = (u32x4){FL_PK(pB0, 0), FL_PK(pB0, 2), FL_PK(pB0, 4), FL_PK(pB0, 6)}; pw1 = (u32x4){FL_PK(pB0, 8), FL_PK(pB0, 10), FL_PK(pB0, 12), FL_PK(pB0, 14)};
          pw2 = (u32x4){FL_PK(pB1, 0), FL_PK(pB1, 2), FL_PK(pB1, 4), FL_PK(pB1, 6)}; pw3 = (u32x4){FL_PK(pB1, 8), FL_PK(pB1, 10), FL_PK(pB1, 12), FL_PK(pB1, 14)};
          const LAS unsigned char* vp_ = vp0 + vcur;
#pragma unroll
          for (int i = 0; i < 8; ++i) FL_VRD(i);
          ot0 = FL_MFMA(FL_VFR(0), __builtin_bit_cast(bf16x8, pw0), ot0); ot1 = FL_MFMA(FL_VFR(4), __builtin_bit_cast(bf16x8, pw0), ot1);
          ot0 = FL_MFMA(FL_VFR(1), __builtin_bit_cast(bf16x8, pw1), ot0); ot1 = FL_MFMA(FL_VFR(5), __builtin_bit_cast(bf16x8, pw1), ot1);
          ot0 = FL_MFMA(FL_VFR(2), __builtin_bit_cast(bf16x8, pw2), ot0); ot1 = FL_MFMA(FL_VFR(6), __builtin_bit_cast(bf16x8, pw2), ot1);
          ot0 = FL_MFMA(FL_VFR(3), __builtin_bit_cast(bf16x8, pw3), ot0); ot1 = FL_MFMA(FL_VFR(7), __builtin_bit_cast(bf16x8, pw3), ot1); }
        l = xsum32(l);
        const float il = 1.f / l;
        int qo_ = lane & 31; asm volatile("" : "+v"(qo_));
        bf16* orow = ml + (size_t)(qt * 256 + w * 32 + qo_) * D + 768 + h * 64 + 4 * hh;
#pragma unroll
        for (int g = 0; g < 4; ++g) {
            u32x2 o0, o1;
            o0.x = pg8::cvt_pk_bf16(ot0[4 * g] * il, ot0[4 * g + 1] * il); o0.y = pg8::cvt_pk_bf16(ot0[4 * g + 2] * il, ot0[4 * g + 3] * il);
            o1.x = pg8::cvt_pk_bf16(ot1[4 * g] * il, ot1[4 * g + 1] * il); o1.y = pg8::cvt_pk_bf16(ot1[4 * g + 2] * il, ot1[4 * g + 3] * il);
            *(u32x2*)(orow + 8 * g) = o0; *(u32x2*)(orow + 32 + 8 * g) = o1;
        }
        FL_WAITBAR(0);
#undef FL_Q
#undef FL_KROW
#undef FL_DMA_K
#undef FL_DMA_V
#undef FL_WAITBAR
#undef FL_ROT
#undef FL_KLOAD2
#undef FL_PK
#undef FL_VFR
#undef FL_VRD
#undef FL_KRD
#undef FL_GAPA
#undef FL_GAPB
#undef FL_STEP
#undef FL_RESC
#undef FL_ENDW
    }
    __builtin_amdgcn_s_setprio(0);
    __syncthreads();
}

constexpr int NA_BT_OFF = 131072 + 8192;
template <int NT> __device__ __forceinline__ void na_bias_setup(CPR p, Frame& F, int l, int t) {
    LAS float* btab = (LAS float*)(F.lds + NA_BT_OFF);
    constexpr int KB = (4 * 465 + NT - 1) / NT;
    float bv[KB];
#pragma unroll
    for (int k = 0; k < KB; ++k) { const int i = t + NT * k; bv[k] = p.na_rpb[(size_t)l * 1860 + (i < 4 * 465 ? i : 0)]; }
    __builtin_amdgcn_sched_barrier(0);
#pragma unroll
    for (int k = 0; k < KB; ++k) { const int i = t + NT * k; if (i < 4 * 465) btab[i] = bv[k] * LOG2E; }
}
static_assert(NA_BT_OFF + 4 * 465 * 4 <= LDS_BYTES, "NA bias table");
__device__ __forceinline__ void p3_na_mfma(CPR p, Frame& F, int l, bool setup = true) {
    constexpr int TP = 144, KBs = 32 * TP, WB = 2 * KBs;
    const int tid = F.tid, lane = F.lane, q = lane & 31, hh = lane >> 5;
    LAS unsigned char* wk = F.lds + F.wave * WB; LAS unsigned char* wv = wk + KBs;
    LAS float* btab = (LAS float*)(F.lds + NA_BT_OFF);
    if (setup) { __syncthreads(); na_bias_setup<NTHR>(p, F, l, tid); __syncthreads(); }
    const bf16* pl = F.pl(); bf16* ml = F.ml();
    const int skey = lane >> 3, spart = lane & 7;
    const int trow = 4 * hh + ((lane & 15) >> 2), tcol = 16 * ((lane >> 4) & 1) + 4 * (lane & 3);
    constexpr float QS = 0.125f * LOG2E;
    for (int pass = 0, it = F.gw; it < 2176; ++pass, it = F.ngw * pass + F.gw) {
        const bool lat = it < 2048; int x = lat ? it : it - 2048;
        if (lat && F.ngw == 2048) { const int blk_ = x >> 3, xc_ = blk_ & 7, sl_ = blk_ >> 3; x = (((xc_ >> 1) * 64 + 32 * (xc_ & 1) + sl_) << 3) | (x & 7); }
        const int h = x & 3, b = lat ? (x >> 9) : (x >> 5), r = (x >> 3) & 63, jp = (x >> 2) & 1, g8 = (x >> 2) & 7;
        const int qrow = lat ? b * SEQ + r * 64 + 32 * jp + q : TL + b * CTX + 32 * g8 + q;
        const int ntile = lat ? 18 : 8;
        int rs = r - 4; rs = rs < 0 ? 0 : (rs > GH - 8 ? GH - 8 : rs);
        const int cb = jp ? 24 : 0, gc = 32 * jp + q; int wsq = gc - 8; wsq = wsq < 0 ? 0 : (wsq > GW - 16 ? GW - 16 : wsq);
        const int baddr = ((h * 15 + (rs - r + 7)) * 31 + cb - gc + 15 + 4 * hh) * 4;
        const int vk0 = cb + 4 * hh - wsq;
        bf16x8 qf[4];
#pragma unroll
        for (int ks = 0; ks < 4; ++ks) qf[ks] = *(const bf16x8*)(pl + (size_t)qrow * INP + OFF_B + 64 * h + 16 * ks + 8 * hh);
        f32x16 ot0, ot1;
#pragma unroll
        for (int i = 0; i < 16; ++i) { ot0[i] = 0.f; ot1[i] = 0.f; }
        constexpr float THR = 8.f;
        float mref = 0.f, lsum = 0.f;
        u32x4 krA[4], vrA[4], krB[4], vrB[4];
#define NA_LOAD(t, KR, VR) do { const int t_ = (t); _Pragma("unroll") for (int j = 0; j < 4; ++j) { int row_; \
            if (t_ < 8) row_ = TL + b * CTX + 32 * t_ + 8 * j + skey; \
            else { const int x_ = 4 * (t_ - 8) + j, rr_ = (x_ * 205) >> 10, cg_ = x_ - 5 * rr_; row_ = b * SEQ + (rs + rr_) * 64 + cb + 8 * cg_ + skey; } \
            const bf16* src_ = pl + (size_t)row_ * INP + OFF_B + 256 + 64 * h + 8 * spart; KR[j] = *(const u32x4*)src_; VR[j] = *(const u32x4*)(src_ + 256); } } while (0)
#define NA_STORE(KR, VR) do { _Pragma("unroll") for (int j = 0; j < 4; ++j) { *(LAS u32x4*)(wk + (8 * j + skey) * TP + spart * 16) = KR[j]; *(LAS u32x4*)(wv + (8 * j + skey) * TP + spart * 16) = VR[j]; } } while (0)
#define NA_TILE(t) do { \
            bf16x8 kf[4]; \
            _Pragma("unroll") \
            for (int ks = 0; ks < 4; ++ks) kf[ks] = *(const LAS bf16x8*)(wk + q * TP + (16 * ks + 8 * hh) * 2); \
            __builtin_amdgcn_sched_barrier(0); \
            f32x16 sc; \
            _Pragma("unroll") \
            for (int i = 0; i < 16; ++i) sc[i] = 0.f; \
            _Pragma("unroll") \
            for (int ks = 0; ks < 4; ++ks) sc = __builtin_amdgcn_mfma_f32_32x32x16_bf16(kf[ks], qf[ks], sc, 0, 0, 0); \
            __builtin_amdgcn_sched_barrier(0); \
            s16x4 vl[4], vh[4]; \
            _Pragma("unroll") \
            for (int kk = 0; kk < 2; ++kk) { const LAS unsigned char* a0 = wv + (16 * kk + trow) * TP + tcol * 2; \
                vl[2 * kk] = lds_tr16(a0); vh[2 * kk] = lds_tr16(a0 + 8 * TP); vl[2 * kk + 1] = lds_tr16(a0 + 64); vh[2 * kk + 1] = lds_tr16(a0 + 8 * TP + 64); } \
            __builtin_amdgcn_sched_barrier(0); \
            const float nm = -mref; \
            if (t < 8) { \
            _Pragma("unroll") \
                for (int i = 0; i < 16; ++i) sc[i] = fmaf(sc[i], QS, nm); \
            } else { \
                const int wt = t - 8; \
                float bias_[16];                                           \
            _Pragma("unroll") \
                for (int g = 0; g < 4; ++g) { \
                    const int x_ = 4 * wt + g, rr_ = (x_ * 205) >> 10, cg_ = x_ - 5 * rr_; \
                    const LAS float* bp = (const LAS float*)((const LAS unsigned char*)btab + baddr + (rr_ * 31 + 8 * cg_) * 4); \
            _Pragma("unroll") \
                    for (int e = 0; e < 4; ++e) bias_[4 * g + e] = bp[e]; } \
                __builtin_amdgcn_sched_barrier(0); \
            _Pragma("unroll") \
                for (int i = 0; i < 16; ++i) asm volatile("" : "+v"(bias_[i]));     \
            _Pragma("unroll") \
                for (int g = 0; g < 4; ++g) { \
                    const int x_ = 4 * wt + g, rr_ = (x_ * 205) >> 10, cg_ = x_ - 5 * rr_; \
                    const int vk = vk0 + 8 * cg_; \
            _Pragma("unroll") \
                    for (int e = 0; e < 4; ++e) { const bool ok = (unsigned)(vk + e) < 16u; sc[4 * g + e] = ok ? fmaf(sc[4 * g + e], QS, bias_[4 * g + e] + nm) : -1.0e30f; } \
                } \
            } \
            float mx = sc[0]; \
            _Pragma("unroll") \
            for (int i = 1; i < 16; i += 2) mx = __builtin_fmaxf(__builtin_fmaxf(mx, sc[i]), sc[i + 1 < 16 ? i + 1 : i]); \
            mx = xmax32(mx); \
            if (t == 0 || __any(mx > THR)) { \
                const float dl = (t == 0) ? mx : __builtin_fmaxf(mx, 0.f), alpha = __builtin_amdgcn_exp2f(-dl); \
                mref += dl; lsum *= alpha; \
            _Pragma("unroll") \
                for (int i = 0; i < 16; ++i) { ot0[i] *= alpha; ot1[i] *= alpha; sc[i] -= dl; } \
            } \
            float rsum = 0.f; \
            _Pragma("unroll") \
            for (int i = 0; i < 16; ++i) { sc[i] = __builtin_amdgcn_exp2f(sc[i]); rsum += sc[i]; } \
            lsum += rsum; \
            bf16x8 pb[2]; pb[0] = pack8(sc, 0); pb[1] = pack8(sc, 8); \
            _Pragma("unroll") \
            for (int kk = 0; kk < 2; ++kk) { \
                const bf16x8 v0 = (bf16x8){vl[2 * kk][0], vl[2 * kk][1], vl[2 * kk][2], vl[2 * kk][3], vh[2 * kk][0], vh[2 * kk][1], vh[2 * kk][2], vh[2 * kk][3]}; \
                const bf16x8 v1 = (bf16x8){vl[2 * kk + 1][0], vl[2 * kk + 1][1], vl[2 * kk + 1][2], vl[2 * kk + 1][3], vh[2 * kk + 1][0], vh[2 * kk + 1][1], vh[2 * kk + 1][2], vh[2 * kk + 1][3]}; \
                ot0 = __builtin_amdgcn_mfma_f32_32x32x16_bf16(v0, pb[kk], ot0, 0, 0, 0); \
                ot1 = __builtin_amdgcn_mfma_f32_32x32x16_bf16(v1, pb[kk], ot1, 0, 0, 0); \
            } \
        } while (0)
        NA_LOAD(0, krA, vrA); NA_LOAD(1, krB, vrB); NA_STORE(krA, vrA);
        if (2 < ntile) NA_LOAD(2, krA, vrA);
        for (int t = 0; t < ntile; t += 2) {
            NA_TILE(t);
            NA_STORE(krB, vrB); if (t + 3 < ntile) NA_LOAD(t + 3, krB, vrB);
            NA_TILE(t + 1);
            if (t + 2 < ntile) { NA_STORE(krA, vrA); if (t + 4 < ntile) NA_LOAD(t + 4, krA, vrA); }
        }
#undef NA_TILE
#undef NA_LOAD
#undef NA_STORE
        lsum = xsum32(lsum);
        const float il = 1.f / lsum;
        bf16* orow = ml + (size_t)qrow * D + 256 + h * 64 + 4 * hh;
#pragma unroll
        for (int g = 0; g < 4; ++g) {
            u32x2 o0, o1;
            o0.x = pg8::cvt_pk_bf16(ot0[4 * g] * il, ot0[4 * g + 1] * il); o0.y = pg8::cvt_pk_bf16(ot0[4 * g + 2] * il, ot0[4 * g + 3] * il);
            o1.x = pg8::cvt_pk_bf16(ot1[4 * g] * il, ot1[4 * g + 1] * il); o1.y = pg8::cvt_pk_bf16(ot1[4 * g + 2] * il, ot1[4 * g + 3] * il);
            *(u32x2*)(orow + 8 * g) = o0; *(u32x2*)(orow + 32 + 8 * g) = o1;
        }
    }
    __syncthreads();
}

__device__ __forceinline__ float sumsq8(const bf16x8& v) { const u32x4 u = __builtin_bit_cast(u32x4, v); float s = 0.f;
#pragma unroll
    for (int j = 0; j < 4; ++j) { const float a = __uint_as_float(u[j] << 16), b = __uint_as_float(u[j] & 0xffff0000u); s += a * a + b * b; }
    return s; }
constexpr int UPW_OFF = 8 * 8704;
static_assert(UPW_OFF + 49152 <= 131072, "up-projection LDS layout");
template <int PART, bool WL = false> __device__ __forceinline__ void mla_up_item(Frame& F, int l, int it) {
    int lane = F.lane; asm volatile("" : "+v"(lane));
    const int tkn = lane & 31, hh = lane >> 5;
    const bf16* pl = F.pl(); const bf16* wq = F.wuq() + (size_t)l * 384 * 256; const bf16* wkv = F.wukv() + (size_t)l * 512 * 128;
    bf16* qm = F.qm(); bf16* km = F.km(); bf16* vm = F.vm();
    {
        const int h = it & 3, row = (it >> 2) * 32 + tkn; const bool lat = row < TL; const int t = row & (SEQ - 1);
        int lnw = lane; asm volatile("" : "+v"(lnw));
        const bf16* pr = pl + (size_t)row * INP + OFF_D;
        bf16x8 bq[16], bk[8]; float sq = 0.f, sk = 0.f;
        bf16x8 wfa[16], wfb[16], wka[8], wkb[8];
#define UPQ_LOAD(W, q3_) do { const bf16* wr_ = wq + ((size_t)(3 * h + (q3_)) * 16 * 64 + lnw) * 8; const LAS unsigned char* wlr_ = F.lds + UPW_OFF + (q3_) * 16384 + lnw * 16; \
        _Pragma("unroll") for (int ks = 0; ks < 16; ++ks) { if (WL) W[ks] = *(const LAS bf16x8*)(wlr_ + 1024 * ks); else W[ks] = *(const bf16x8*)(wr_ + 512 * ks); } } while (0)
#define UPK_LOAD(W, sub_) do { const bf16* wr_ = wkv + ((size_t)(4 * h + (sub_)) * 8 * 64 + lnw) * 8; const LAS unsigned char* wlr_ = F.lds + UPW_OFF + (sub_) * 8192 + lnw * 16; \
        _Pragma("unroll") for (int ks = 0; ks < 8; ++ks) { if (WL) W[ks] = *(const LAS bf16x8*)(wlr_ + 1024 * ks); else W[ks] = *(const bf16x8*)(wr_ + 512 * ks); } } while (0)
        LAS unsigned char* wl = F.lds + F.wave * 8704;
        const bf16* gb = pl + (size_t)((it >> 2) * 32) * INP + OFF_D + (size_t)(lane >> 4) * INP + 8 * (lane & 15);
        LAS unsigned char* swr = wl + (lane >> 4) * 272 + (lane & 15) * 16; const LAS unsigned char* srd = wl + tkn * 272 + hh * 16;
        if (PART == 0) {
            u32x4 s0[8];
#pragma unroll
            for (int k = 0; k < 8; ++k) s0[k] = *(const u32x4*)(gb + (size_t)(4 * k) * INP);
            UPQ_LOAD(wfa, 0);
            __builtin_amdgcn_sched_barrier(0);
#pragma unroll
            for (int k = 0; k < 8; ++k) *(LAS u32x4*)(swr + k * 1088) = s0[k];
            __builtin_amdgcn_sched_barrier(0);
#pragma unroll
            for (int k = 0; k < 8; ++k) s0[k] = *(const u32x4*)(gb + (size_t)(4 * k) * INP + 128);
            UPQ_LOAD(wfb, 1);
            __builtin_amdgcn_sched_barrier(0);
#pragma unroll
            for (int ks = 0; ks < 8; ++ks) { bq[ks] = *(const LAS bf16x8*)(srd + 32 * ks); sq += sumsq8(bq[ks]); }
            __builtin_amdgcn_sched_barrier(0);
#pragma unroll
            for (int k = 0; k < 8; ++k) *(LAS u32x4*)(swr + k * 1088) = s0[k];
#pragma unroll
            for (int ks = 0; ks < 8; ++ks) { bq[8 + ks] = *(const LAS bf16x8*)(srd + 32 * ks); sq += sumsq8(bq[8 + ks]); }
        } else if (PART == 2) {
#pragma unroll
            for (int ks = 0; ks < 16; ++ks) { bq[ks] = *(const bf16x8*)(pr + 16 * ks + 8 * hh); sq += sumsq8(bq[ks]); }
            UPQ_LOAD(wfa, 0); UPQ_LOAD(wfb, 1); }
        if (PART == 1) {
            u32x4 s0[8];
#pragma unroll
            for (int k = 0; k < 8; ++k) s0[k] = *(const u32x4*)(gb + (size_t)(4 * k) * INP + 256);
            UPK_LOAD(wka, 0); UPK_LOAD(wkb, 1);
            __builtin_amdgcn_sched_barrier(0);
#pragma unroll
            for (int k = 0; k < 8; ++k) *(LAS u32x4*)(swr + k * 1088) = s0[k];
#pragma unroll
            for (int ks = 0; ks < 8; ++ks) { bk[ks] = *(const LAS bf16x8*)(srd + 32 * ks); sk += sumsq8(bk[ks]); }
        } else if (PART == 2) {
#pragma unroll
            for (int ks = 0; ks < 8; ++ks) { bk[ks] = *(const bf16x8*)(pr + 256 + 16 * ks + 8 * hh); sk += sumsq8(bk[ks]); } }
        sq = xsum32(sq); sk = xsum32(sk);
        const float rq = rsqrtf(sq * (1.f / 256.f) + EPS) * (MLA_SCALE * LOG2E), rk = rsqrtf(sk * (1.f / 128.f) + EPS);
        if (PART != 1) {
#define UPQ_TILE(W, q3_) do { const int nt = 3 * h + (q3_); f32x16 acc; _Pragma("unroll") for (int i = 0; i < 16; ++i) acc[i] = 0.f; \
            f32x4 cr = {1.f, 1.f, 1.f, 1.f}, sr = {0.f, 0.f, 0.f, 0.f}, cc = cr, sc = sr;       \
            if ((q3_) == 2 && lat) { cr = *(const f32x4*)(F.ropec() + t * 16 + 4 * hh); sr = *(const f32x4*)(F.ropes() + t * 16 + 4 * hh); cc = *(const f32x4*)(F.ropec() + t * 16 + 8 + 4 * hh); sc = *(const f32x4*)(F.ropes() + t * 16 + 8 + 4 * hh); } \
            __builtin_amdgcn_sched_barrier(0); \
            _Pragma("unroll") for (int ks = 0; ks < 16; ++ks) acc = __builtin_amdgcn_mfma_f32_32x32x16_bf16(W[ks], bq[ks], acc, 0, 0, 0); \
            __builtin_amdgcn_sched_barrier(0); \
            _Pragma("unroll") for (int i = 0; i < 16; ++i) acc[i] *= rq; \
            if ((q3_) == 2) { _Pragma("unroll") for (int e = 0; e < 4; ++e) { const float x1 = acc[e], x2 = acc[4 + e], y1 = acc[8 + e], y2 = acc[12 + e]; \
                    acc[e] = x1 * cr[e] - x2 * sr[e]; acc[4 + e] = x1 * sr[e] + x2 * cr[e]; acc[8 + e] = y1 * cc[e] - y2 * sc[e]; acc[12 + e] = y1 * sc[e] + y2 * cc[e]; } } \
            bf16* o = qm + (size_t)row * 384 + 32 * nt + 4 * hh; LAS unsigned char* ob_ = wl + tkn * 208 + 64 * (q3_) + 8 * hh; \
            _Pragma("unroll") for (int g = 0; g < 4; ++g) { u32x2 w; w.x = pg8::cvt_pk_bf16(acc[4 * g], acc[4 * g + 1]); w.y = pg8::cvt_pk_bf16(acc[4 * g + 2], acc[4 * g + 3]); \
                if (PART == 0) *(LAS u32x2*)(ob_ + 16 * g) = w; else *(u32x2*)(o + 8 * g) = w; } } while (0)
            UPQ_TILE(wfa, 0); UPQ_LOAD(wfa, 2); UPQ_TILE(wfb, 1); UPQ_TILE(wfa, 2);
            if (PART == 0) { const int row0 = (it >> 2) * 32; int ln_ = lane; asm volatile("" : "+v"(ln_));
#pragma unroll
                for (int i = 0; i < 6; ++i) { const int c = 64 * i + ln_, r = c / 12, cc = c - 12 * r;
                    const u32x4 v = *(const LAS u32x4*)(wl + r * 208 + cc * 16);
                    *(u32x4*)(qm + (size_t)(row0 + r) * 384 + 96 * h + 8 * cc) = v; } }
#undef UPQ_LOAD
#undef UPQ_TILE
        }
        if (PART != 0) {
#define UPK_TILE(W, sub_) do { f32x16 acc; _Pragma("unroll") for (int i = 0; i < 16; ++i) acc[i] = 0.f; \
            __builtin_amdgcn_sched_barrier(0); \
            _Pragma("unroll") for (int ks = 0; ks < 8; ++ks) acc = __builtin_amdgcn_mfma_f32_32x32x16_bf16(W[ks], bk[ks], acc, 0, 0, 0); \
            __builtin_amdgcn_sched_barrier(0); \
            bf16* o = ((sub_) < 2) ? km + (size_t)row * 384 + 96 * h + 32 * (sub_) + 4 * hh : vm + (size_t)row * 256 + 64 * h + 32 * ((sub_) - 2) + 4 * hh; \
            LAS unsigned char* ob_ = wl + tkn * 144 + 64 * ((sub_) & 1) + 8 * hh; \
            _Pragma("unroll") for (int g = 0; g < 4; ++g) { u32x2 w; w.x = pg8::cvt_pk_bf16(acc[4 * g] * rk, acc[4 * g + 1] * rk); w.y = pg8::cvt_pk_bf16(acc[4 * g + 2] * rk, acc[4 * g + 3] * rk); \
                if (PART == 1) *(LAS u32x2*)(ob_ + 16 * g) = w; else *(u32x2*)(o + 8 * g) = w; } } while (0)
#define UPK_FLUSH(dst_, ld_, coff_) do { if (PART == 1) { const int row0 = (it >> 2) * 32; int ln_ = lane; asm volatile("" : "+v"(ln_)); \
            _Pragma("unroll") for (int i = 0; i < 4; ++i) { const int c = 64 * i + ln_, r = c >> 3, cc = c & 7; \
                const u32x4 v = *(const LAS u32x4*)(wl + r * 144 + cc * 16); \
                *(u32x4*)((dst_) + (size_t)(row0 + r) * (ld_) + (coff_) + 8 * cc) = v; } } } while (0)
            if (PART == 2) { UPK_LOAD(wka, 0); UPK_LOAD(wkb, 1); }
            UPK_TILE(wka, 0); UPK_LOAD(wka, 2); UPK_TILE(wkb, 1); UPK_LOAD(wkb, 3); UPK_FLUSH(km, 384, 96 * h); UPK_TILE(wka, 2); UPK_TILE(wkb, 3); UPK_FLUSH(vm, 256, 64 * h);
#undef UPK_FLUSH
#undef UPK_LOAD
#undef UPK_TILE
        }
        if (PART != 1) { const u32x4 a = *(const u32x4*)(pr + 384 + 16 * hh), bb = *(const u32x4*)(pr + 384 + 16 * hh + 8);
          float x1[8], x2[8];
#pragma unroll
          for (int j = 0; j < 4; ++j) { x1[2 * j] = __uint_as_float(a[j] << 16); x1[2 * j + 1] = __uint_as_float(a[j] & 0xffff0000u); x2[2 * j] = __uint_as_float(bb[j] << 16); x2[2 * j + 1] = __uint_as_float(bb[j] & 0xffff0000u); }
          float o1[8], o2[8];
#pragma unroll
          for (int j = 0; j < 8; ++j) { float c = 1.f, sn = 0.f; if (lat) { c = F.ropec()[t * 16 + 8 * hh + j]; sn = F.ropes()[t * 16 + 8 * hh + j]; } o1[j] = x1[j] * c - x2[j] * sn; o2[j] = x1[j] * sn + x2[j] * c; }
          u32x4 w1, w2;
#pragma unroll
          for (int j = 0; j < 4; ++j) { w1[j] = pg8::cvt_pk_bf16(o1[2 * j], o1[2 * j + 1]); w2[j] = pg8::cvt_pk_bf16(o2[2 * j], o2[2 * j + 1]); }
          bf16* o = km + (size_t)row * 384 + 96 * h + 64 + 16 * hh; *(u32x4*)o = w1; *(u32x4*)(o + 8) = w2; }
    }
}

__device__ __forceinline__ void p3_mla_up(Frame& F, int l) {
    for (int it = F.gw; it < (T / 32) * 4; it += F.ngw) mla_up_item<2>(F, l, it);
}
__device__ __forceinline__ void p3_mla_up_queued(Frame& F, int l, int lc) {
    volatile LAS int* dq = (volatile LAS int*)(F.lds + DYNQ_OFF);
    unsigned* head = F.ctl() + CW_HEAD2 + lc * 64; unsigned* rdy = F.ctl() + CW_RDY2 + lc * 128 * 64;
    constexpr int NID = (T / 32) * 4 * 2;
    const int nstat = (int)gridDim.x > 32 ? (int)gridDim.x - 32 : 0;
    for (int iter = 0;; ++iter) {
        int base;
        if (iter == 0 && (int)blockIdx.x >= 32) base = ((int)blockIdx.x - 32) * 8;
        else { __syncthreads();
            if (F.tid == 0) dq[0] = (int)__hip_atomic_fetch_add(head, 8u, __ATOMIC_RELAXED, __HIP_MEMORY_SCOPE_AGENT) + 8 * nstat;
            __syncthreads();
            base = dq[0]; }
        if (base >= NID) break;
        const int bi = (base >> 3) & 7;
        u32x4 wst[6];
        { const bf16* src = (bi & 1) ? F.wukv() + (size_t)l * 512 * 128 + (size_t)(bi >> 1) * 4 * 4096 : F.wuq() + (size_t)l * 384 * 256 + (size_t)(bi >> 1) * 3 * 8192;
          const int nch = (bi & 1) ? 2048 : 3072;
#pragma unroll
          for (int k = 0; k < 6; ++k) { const int i = F.tid + NTHR * k; wst[k] = *(const u32x4*)(src + 8 * (i < nch ? i : 0)); } }
        if (F.wave == 0) {
            const int t0 = base >> 6, t1 = (base + 7) >> 6; unsigned spins = 0;
            while ((unsigned)__builtin_amdgcn_readfirstlane(__hip_atomic_load(rdy + 64 * t0, __ATOMIC_RELAXED, __HIP_MEMORY_SCOPE_AGENT)) < 16u ||
                   (unsigned)__builtin_amdgcn_readfirstlane(__hip_atomic_load(rdy + 64 * t1, __ATOMIC_RELAXED, __HIP_MEMORY_SCOPE_AGENT)) < 16u) {
                __builtin_amdgcn_s_sleep(2);
                if (++spins > (1u << 20)) { if (F.lane == 0) __hip_atomic_store(F.ctl() + CW_TMO, 1u, __ATOMIC_RELAXED, __HIP_MEMORY_SCOPE_AGENT); break; } }
            __builtin_amdgcn_fence(__ATOMIC_ACQUIRE, "agent"); asm volatile("s_waitcnt vmcnt(0)" ::: "memory"); }
        __syncthreads();
        { const int nch = (bi & 1) ? 2048 : 3072;
#pragma unroll
          for (int k = 0; k < 6; ++k) { const int i = F.tid + NTHR * k; if (i < nch) *(LAS u32x4*)(F.lds + UPW_OFF + 16 * i) = wst[k]; } }
        __syncthreads();
        { const int it = (((base >> 6) * 8 + F.wave) << 2) | (bi >> 1); if (bi & 1) mla_up_item<1, true>(F, l, it); else mla_up_item<0, true>(F, l, it); }
    }
}
__device__ __forceinline__ void p3_pool_mfma(CPR p, Frame& F, int l) {
    constexpr int RP = 144, PW = 48 * RP;
    const bf16* pl = F.pl(); bf16* ml = F.ml();
    for (int pass = 0, it = F.gw; it < (T / 32) * 4; ++pass, it = F.ngw * pass + ((F.gw + 256) % F.ngw)) {
        int lane = F.lane; asm volatile("" : "+v"(lane));
        const int tk = lane & 31, hh = lane >> 5, srow = lane >> 3, spart = lane & 7;
        LAS unsigned char* wl = F.lds + F.wave * PW;
        const int g = it & 3, row0 = (it >> 2) * 32, win = 2 << g;
        const int L = row0 < TL ? SEQ : CTX, t0 = row0 < TL ? (row0 & (SEQ - 1)) : ((row0 - TL) & (CTX - 1)), seg0 = row0 - t0;
        u32x4 st[6];
#pragma unroll
        for (int k = 0; k < 6; ++k) { const int r = 8 * k + srow, sidx = t0 - win / 2 + r; const bool ok = r < 32 + win && sidx >= 0 && sidx < L;
            st[k] = *(const u32x4*)(pl + (size_t)(seg0 + (ok ? sidx : t0)) * INP + 64 * g + 8 * spart); }
        const bf16* wt = F.poolw() + (size_t)(l * 4 + g) * 4096;
        bf16x8 wf[8]; f32x4 psv[2][4];
#pragma unroll
        for (int i = 0; i < 8; ++i) wf[i] = *(const bf16x8*)(wt + (size_t)(32 * (i >> 2) + tk) * 64 + 16 * (i & 3) + 8 * hh);
#pragma unroll
        for (int i = 0; i < 8; ++i) psv[i >> 2][i & 3] = *(const f32x4*)(p.pool_s + l * 256 + 64 * g + 32 * (i >> 2) + 4 * hh + 8 * (i & 3));
        __builtin_amdgcn_sched_barrier(0);
#pragma unroll
        for (int k = 0; k < 6; ++k) { const int r = 8 * k + srow, sidx = t0 - win / 2 + r; const bool ok = r < 32 + win && sidx >= 0 && sidx < L;
            u32x4 v = st[k]; if (!ok) { v.x = 0u; v.y = 0u; v.z = 0u; v.w = 0u; }
            *(LAS u32x4*)(wl + r * RP + spart * 16) = v; }
        const int t = t0 + tk; int lo = t - win / 2, hi = t - win / 2 + win; lo = lo < 0 ? 0 : lo; hi = hi > L ? L : hi;
        const float inv = 1.f / (float)(hi - lo);
        float sum[32];
#pragma unroll
        for (int i = 0; i < 32; ++i) sum[i] = 0.f;
        const LAS unsigned char* rl = wl + tk * RP + hh * 16;
        for (int w = 0; w < win; w += 2) {
            u32x4 v[2][4];
#pragma unroll
            for (int d = 0; d < 2; ++d)
#pragma unroll
                for (int ks = 0; ks < 4; ++ks) v[d][ks] = *(const LAS u32x4*)(rl + (w + d) * RP + 32 * ks);
#pragma unroll
            for (int d = 0; d < 2; ++d)
#pragma unroll
                for (int ks = 0; ks < 4; ++ks)
#pragma unroll
                    for (int j = 0; j < 4; ++j) { sum[8 * ks + 2 * j] += __uint_as_float(v[d][ks][j] << 16); sum[8 * ks + 2 * j + 1] += __uint_as_float(v[d][ks][j] & 0xffff0000u); }
        }
        bf16x8 df[4];
#pragma unroll
        for (int ks = 0; ks < 4; ++ks) { const u32x4 v = *(const LAS u32x4*)(rl + (win / 2) * RP + 32 * ks); u32x4 wq;
#pragma unroll
            for (int j = 0; j < 4; ++j) wq[j] = pg8::cvt_pk_bf16(sum[8 * ks + 2 * j] * inv - __uint_as_float(v[j] << 16), sum[8 * ks + 2 * j + 1] * inv - __uint_as_float(v[j] & 0xffff0000u));
            df[ks] = __builtin_bit_cast(bf16x8, wq); }
        const int row = row0 + tk;
#pragma unroll
        for (int dt = 0; dt < 2; ++dt) {
            f32x16 acc;
#pragma unroll
            for (int i = 0; i < 16; ++i) acc[i] = 0.f;
#pragma unroll
            for (int ks = 0; ks < 4; ++ks) acc = __builtin_amdgcn_mfma_f32_32x32x16_bf16(wf[4 * dt + ks], df[ks], acc, 0, 0, 0);
            const int col = 64 * g + 32 * dt + 4 * hh; bf16* o = ml + (size_t)row * D + col;
#pragma unroll
            for (int gg = 0; gg < 4; ++gg) { const f32x4 sc = psv[dt][gg]; u32x2 wq; wq.x = pg8::cvt_pk_bf16(acc[4 * gg] * sc.x, acc[4 * gg + 1] * sc.y); wq.y = pg8::cvt_pk_bf16(acc[4 * gg + 2] * sc.z, acc[4 * gg + 3] * sc.w); *(u32x2*)(o + 8 * gg) = wq; }
        }
    }
}
__device__ __forceinline__ void p3_sgu_mfma(CPR p, Frame& F, int l) {
    constexpr int VP = 144;
    const int tid = F.tid, lane = F.lane, tk = lane & 31, hh = lane >> 5, pt = F.wave >> 1, ct = F.wave & 1;
    const bf16* pl = F.pl(); bf16* ml = F.ml();
    const int trow = 8 * hh + ((lane & 15) >> 2), tcol = 16 * ((lane >> 4) & 1) + 4 * (lane & 3);
    __syncthreads();
    const int nblk = (int)gridDim.x, blk = (int)blockIdx.x; constexpr int NIT = (T / 128) * 4;
    const bool remap = nblk == 256; const int npass = remap ? 3 : (NIT + nblk - 1) / nblk;
    for (int pass = 0; pass < npass; ++pass) {
        int it;
        if (remap) { if (pass < 2) it = blk < 16 ? -1 : 256 * pass + blk; else { const int e = blk - 128; it = (e < 0 || e >= 64) ? -1 : e < 16 ? e : e < 32 ? 256 + (e - 16) : 512 + (e - 32); } }
        else it = nblk * pass + blk;
        if (it < 0 || it >= NIT) continue;
        const int g = it & 3, r0 = (it >> 2) * 128;
        bf16x8 wf[8]; u32x2 uv[4];
        const int orow = r0 + 32 * pt + tk, ocol = 64 * g + 32 * ct + 4 * hh;
        const float obias = p.sgu_b[(l * 4 + g) * 128 + 32 * pt + tk];
        { const bf16* wrow = F.sguw() + ((size_t)(l * 4 + g) * 128 + 32 * pt + tk) * 128 + 8 * hh;
#pragma unroll
          for (int ks = 0; ks < 8; ++ks) wf[ks] = *(const bf16x8*)(wrow + 16 * ks);
#pragma unroll
          for (int gg = 0; gg < 4; ++gg) uv[gg] = *(const u32x2*)(pl + (size_t)orow * INP + OFF_C + ocol + 8 * gg); }
        {
            const int qq = tid >> 2, c0 = 16 * (tid & 3);
            const bf16* src = pl + (size_t)(r0 + qq) * INP + OFF_C + 256 + 64 * g + c0;
            const u32x4 a = *(const u32x4*)src, b = *(const u32x4*)(src + 8);
            const float* gnp = p.sgu_norm_g + l * 256 + 64 * g + c0;
            const f32x4 gn0 = *(const f32x4*)gnp, gn1 = *(const f32x4*)(gnp + 4), gn2 = *(const f32x4*)(gnp + 8), gn3 = *(const f32x4*)(gnp + 12);
            const float gn[16] = {gn0.x, gn0.y, gn0.z, gn0.w, gn1.x, gn1.y, gn1.z, gn1.w, gn2.x, gn2.y, gn2.z, gn2.w, gn3.x, gn3.y, gn3.z, gn3.w};
            float v[16]; float ss = 0.f;
#pragma unroll
            for (int j = 0; j < 4; ++j) { v[2 * j] = gelu_tanh(__uint_as_float(a[j] << 16)); v[2 * j + 1] = gelu_tanh(__uint_as_float(a[j] & 0xffff0000u)); v[8 + 2 * j] = gelu_tanh(__uint_as_float(b[j] << 16)); v[8 + 2 * j + 1] = gelu_tanh(__uint_as_float(b[j] & 0xffff0000u)); }
#pragma unroll
            for (int j = 0; j < 16; ++j) ss += v[j] * v[j];
            ss += lane_xor<1>(ss); ss += lane_xor<2>(ss);
            const float rs = rsqrtf(ss * (1.f / 64.f) + EPS);
            u32x4 w0, w1;
#pragma unroll
            for (int j = 0; j < 4; ++j) { w0[j] = pg8::cvt_pk_bf16(v[2 * j] * rs * gn[2 * j], v[2 * j + 1] * rs * gn[2 * j + 1]); w1[j] = pg8::cvt_pk_bf16(v[8 + 2 * j] * rs * gn[8 + 2 * j], v[8 + 2 * j + 1] * rs * gn[8 + 2 * j + 1]); }
            LAS unsigned char* d = F.lds + qq * VP + c0 * 2; *(LAS u32x4*)d = w0; *(LAS u32x4*)(d + 16) = w1;
        }
        __syncthreads();
        f32x16 acc;
#pragma unroll
        for (int i = 0; i < 16; ++i) acc[i] = 0.f;
        s16x4 vlo[8], vhi[8];
#pragma unroll
        for (int ks = 0; ks < 8; ++ks) { const LAS unsigned char* a0 = F.lds + (16 * ks + trow) * VP + (32 * ct + tcol) * 2; vlo[ks] = lds_tr16(a0); vhi[ks] = lds_tr16(a0 + 4 * VP); }
        __builtin_amdgcn_sched_barrier(0);
#pragma unroll
        for (int ks = 0; ks < 8; ++ks) {
            const bf16x8 va = (bf16x8){vlo[ks][0], vlo[ks][1], vlo[ks][2], vlo[ks][3], vhi[ks][0], vhi[ks][1], vhi[ks][2], vhi[ks][3]};
            acc = __builtin_amdgcn_mfma_f32_32x32x16_bf16(va, wf[ks], acc, 0, 0, 0);
        }
        const int row = orow, col = ocol; const float bias = obias;
#pragma unroll
        for (int gg = 0; gg < 4; ++gg) { const u32x2 uu = uv[gg];
            const float u0 = gelu_tanh(__uint_as_float(uu.x << 16)), u1 = gelu_tanh(__uint_as_float(uu.x & 0xffff0000u)), u2 = gelu_tanh(__uint_as_float(uu.y << 16)), u3 = gelu_tanh(__uint_as_float(uu.y & 0xffff0000u));
            u32x2 w; w.x = pg8::cvt_pk_bf16(u0 * (acc[4 * gg] + bias), u1 * (acc[4 * gg + 1] + bias)); w.y = pg8::cvt_pk_bf16(u2 * (acc[4 * gg + 2] + bias), u3 * (acc[4 * gg + 3] + bias));
            *(u32x2*)(ml + (size_t)row * D + 512 + col + 8 * gg) = w; }
        __syncthreads();
    }
}

__device__ __forceinline__ void p5_outproj_naive(Frame& F, int l) {
    const bf16* W = F.wout() + (size_t)l * D * D;
    for (long i = F.gt; i < (long)T * D; i += F.ngt) { const int r = (int)(i >> 10), c = (int)(i & 1023);
        const float g = mod_vec(F, l, row_mod(r), 2)[c];
        F.xl()[(size_t)r * D + c] = (bf16)f2bf(bf2f(F.xl()[(size_t)r * D + c]) + g * dot_bf16(F.ml() + (size_t)r * D, W + (size_t)c * D, D)); }
}

constexpr int P6_MAXPASS = 2, P6_MAXDEC = P6_MAXPASS * NWAVES * 16;
constexpr int P6_DEC_OFF = 65536, P6_CNT_OFF = P6_DEC_OFF + P6_MAXDEC * 16, P6_MOD_OFF = P6_CNT_OFF + 256;
static_assert(2 * P6_MAXDEC == NTHR && P6_MOD_OFF + 5 * 2 * 1024 * 4 <= 131072, "P6 LDS layout");
__device__ __forceinline__ void route_commit_wg(Frame& F, int l) {
    LAS int* lcnt = (LAS int*)(F.lds + P6_CNT_OFF);
    __syncthreads();
    int e = 0, pos = 0, row = -1; float w = 0.f; const int which = F.tid & 1;
    { const i32x4 d = ((const LAS i32x4*)(F.lds + P6_DEC_OFF))[F.tid >> 1]; row = d.w;
      if (row >= 0) { e = which ? (d.x >> 8) : (d.x & 255); w = __builtin_bit_cast(float, which ? d.z : d.y); pos = __hip_atomic_fetch_add(lcnt + e, 1, __ATOMIC_RELAXED, __HIP_MEMORY_SCOPE_WORKGROUP); } }
    __syncthreads();
    if (F.tid < NE) { const int n = lcnt[F.tid]; lcnt[16 + F.tid] = n ? (int)atomicAdd(F.ctl() + CW_CNT + l * NE * 64 + F.tid * 64, (unsigned)n) : 0; }
    __syncthreads();
    if (row >= 0) { const int slot = lcnt[16 + e] + pos; F.tok()[e * CAP + slot] = row; F.wl()[e * CAP + slot] = w; i32x2 rt; rt.x = e; rt.y = slot; *(i32x2*)(F.route() + 4 * row + 2 * which) = rt; }
}
template <int NT> __device__ __forceinline__ void p6_setup(CPR p, Frame& F, int l, int t) {
    LAS float* mdl = (LAS float*)(F.lds + P6_MOD_OFF);
    constexpr int KF = (4096 + NT - 1) / NT, KM = (1280 + NT - 1) / NT;
    { u32x4 tv[KF];
#pragma unroll
      for (int k = 0; k < KF; ++k) { const int i = t + NT * k; if (i < 4096) tv[k] = ((const u32x4*)F.rwf())[i]; }
      f32x4 mg[KM], ms[KM], mq[KM];
#pragma unroll
      for (int k = 0; k < KM; ++k) { const int i = t + NT * k; if (i < 5 * 256) { const int mr = i >> 8, c = (i & 255) * 4;
          mg[k] = *(const f32x4*)(p.norm2_g + l * D + c); ms[k] = *(const f32x4*)(mod_vec(F, l, mr, 3) + c); mq[k] = *(const f32x4*)(mod_vec(F, l, mr, 4) + c); } }
      __builtin_amdgcn_sched_barrier(0);
#pragma unroll
      for (int k = 0; k < KF; ++k) { const int i = t + NT * k; if (i < 4096) ((LAS u32x4*)F.lds)[i] = tv[k]; }
#pragma unroll
      for (int k = 0; k < KM; ++k) { const int i = t + NT * k; if (i < 5 * 256) { const int mr = i >> 8, c = (i & 255) * 4;
          *(LAS f32x4*)(mdl + mr * 2048 + c) = mg[k] * (mq[k] + 1.f); *(LAS f32x4*)(mdl + mr * 2048 + 1024 + c) = ms[k]; } } }
    if (t < P6_MAXDEC) { int zz = 0; asm volatile("" : "+v"(zz));
        i32x4 z; z.x = zz; z.y = zz; z.z = zz; z.w = ~zz; ((LAS i32x4*)(F.lds + P6_DEC_OFF))[t] = z; }
    if (t < 32) ((LAS int*)(F.lds + P6_CNT_OFF))[t] = 0;
}
__device__ __forceinline__ void p6_rows(CPR p, Frame& F, int l, bool commit = true, bool setup = true) {
    LAS float* mdl = (LAS float*)(F.lds + P6_MOD_OFF);
    if (setup) { __syncthreads(); p6_setup<NTHR>(p, F, l, F.tid); __syncthreads(); }
    TMARK(60);
    const int nitems = ((l + 1 < DEPTH) ? T : TL) / 16;
    const int q = F.lane >> 4, n = F.lane & 15;
    const f32x4 rb = *(const f32x4*)(p.router_b + 4 * q);
    int kpass = 0;
    for (int it = F.wave * (int)gridDim.x + (int)blockIdx.x; it < nitems && kpass < P6_MAXPASS; it += NWAVES * (int)gridDim.x, ++kpass) {
        const int row = it * 16 + n, mr = row_mod(it * 16);
        const bf16* xr = F.xl() + (size_t)row * D + 8 * q;
        u32x4 raw[32];
#pragma unroll
        for (int sx = 0; sx < 32; ++sx) raw[sx] = *(const u32x4*)(xr + 32 * sx);
        float ss = 0.f;
#pragma unroll
        for (int sx = 0; sx < 32; ++sx)
#pragma unroll
            for (int d = 0; d < 4; ++d) { const float a = __uint_as_float(raw[sx][d] << 16), b = __uint_as_float(raw[sx][d] & 0xffff0000u); ss = __builtin_fmaf(a, a, ss); ss = __builtin_fmaf(b, b, ss); }
        ss += lane_xor<16>(ss); ss = xsum32(ss);
#pragma unroll
        for (int sx = 0; sx < 32; ++sx) asm volatile("" : "+v"(raw[sx]));
        const float rs = rsqrtf(ss * (1.f / D) + EPS);
        bf16* hr = F.ha() + (size_t)row * D + 8 * q;
        const LAS float* mm = mdl + mr * 2048 + 8 * q;
        const LAS unsigned char* fr = F.lds + F.lane * 16;
        f32x4 acc = {0.f, 0.f, 0.f, 0.f};
#pragma unroll
        for (int sx = 0; sx < 32; ++sx) {
            const f32x4 m0 = *(const LAS f32x4*)(mm + 32 * sx), m1 = *(const LAS f32x4*)(mm + 32 * sx + 4), s0 = *(const LAS f32x4*)(mm + 1024 + 32 * sx), s1 = *(const LAS f32x4*)(mm + 1024 + 32 * sx + 4);
            const bf16x8 ah = *(const LAS bf16x8*)(fr + sx * 1024), al = *(const LAS bf16x8*)(fr + 32768 + sx * 1024);
            float h[8];
#pragma unroll
            for (int d = 0; d < 4; ++d) { const float a = __uint_as_float(raw[sx][d] << 16), b = __uint_as_float(raw[sx][d] & 0xffff0000u);
                const float ma = (d < 2) ? m0[2 * d] : m1[2 * d - 4], mb = (d < 2) ? m0[2 * d + 1] : m1[2 * d - 3], sa = (d < 2) ? s0[2 * d] : s1[2 * d - 4], sb = (d < 2) ? s0[2 * d + 1] : s1[2 * d - 3];
                h[2 * d] = __builtin_fmaf(a, ma * rs, sa); h[2 * d + 1] = __builtin_fmaf(b, mb * rs, sb); }
            u32x4 hb; hb.x = pk2(h[0], h[1]); hb.y = pk2(h[2], h[3]); hb.z = pk2(h[4], h[5]); hb.w = pk2(h[6], h[7]);
            *(u32x4*)(hr + 32 * sx) = hb;
            const bf16x8 bh = __builtin_bit_cast(bf16x8, hb);
            acc = __builtin_amdgcn_mfma_f32_16x16x32_bf16(ah, bh, acc, 0, 0, 0);
            acc = __builtin_amdgcn_mfma_f32_16x16x32_bf16(al, bh, acc, 0, 0, 0);
            if (sx & 1) asm volatile("" ::: "memory");
        }
        float b0 = 0.f, s0 = 0.f, b1 = -3.0e38f, s1 = 0.f; int i0 = 0, i1 = 0;
#pragma unroll
        for (int r = 0; r < 4; ++r) { const float sc = 1.f / (1.f + __expf(-acc[r])), x = sc + rb[r];
            if (r == 0) { b0 = x; s0 = sc; }
            else { const bool g0 = x > b0, g1 = x > b1;
                b1 = g0 ? b0 : (g1 ? x : b1); s1 = g0 ? s0 : (g1 ? sc : s1); i1 = g0 ? i0 : (g1 ? r : i1);
                b0 = g0 ? x : b0; s0 = g0 ? sc : s0; i0 = g0 ? r : i0; } }
        float gs = b0 + b1; int g = q;
        { const float og = lane_xor<16>(gs); const int pg = g ^ 1; const bool take = (og > gs) || (og == gs && pg < g); gs = take ? og : gs; g = take ? pg : g; }
        { const float og = other32(gs); const int pg = __float_as_int(other32(__int_as_float(g))); const bool take = (og > gs) || (og == gs && pg < g); g = take ? pg : g; }
        if (commit && g == q) { const float ws = s0 + s1; i32x4 d; d.x = (4 * q + i0) | ((4 * q + i1) << 8); d.y = __float_as_int(s0 / ws); d.z = __float_as_int(s1 / ws); d.w = row;
            ((LAS i32x4*)(F.lds + P6_DEC_OFF))[(kpass * NWAVES + F.wave) * 16 + n] = d; }
    }
    TMARK(61);
    if (commit) route_commit_wg(F, l);
    __syncthreads();
    TMARK(62);
}

__device__ __forceinline__ void p6b_sort(Frame& F, int l) {
    const volatile LAS int* tab = (const volatile LAS int*)(F.lds + MOETAB_OFF);
    moe_table(F, l);
    for (int pi = F.gw; pi < T / 2; pi += F.ngw) {
        const int r = 2 * pi;
        const i32x4 rt0 = *(const i32x4*)(F.route() + 4 * r), rt1 = *(const i32x4*)(F.route() + 4 * r + 4);
        const u32x4* src = (const u32x4*)(F.ha() + (size_t)r * D) + F.lane;
        const u32x4 a0 = src[0], b0 = src[64], a1 = src[128], b1 = src[192];
        u32x4* d00 = (u32x4*)(F.hs() + (size_t)(tab[rt0.x] * 256 + rt0.y) * D) + F.lane; u32x4* d01 = (u32x4*)(F.hs() + (size_t)(tab[rt0.z] * 256 + rt0.w) * D) + F.lane;
        u32x4* d10 = (u32x4*)(F.hs() + (size_t)(tab[rt1.x] * 256 + rt1.y) * D) + F.lane; u32x4* d11 = (u32x4*)(F.hs() + (size_t)(tab[rt1.z] * 256 + rt1.w) * D) + F.lane;
        d00[0] = a0; d00[64] = b0; d01[0] = a0; d01[64] = b0; d10[0] = a1; d10[64] = b1; d11[0] = a1; d11[64] = b1;
    }
}

__device__ __forceinline__ void p7_moe1_naive(Frame& F, int l) {
    for (long i = F.gt; i < (long)T * 2 * DE; i += F.ngt) {
        const int a = (int)(i >> 8), f = (int)(i & 255), tokr = a >> 1, wh = a & 1;
        const int e = F.route()[4 * tokr + 2 * wh], sl = F.route()[4 * tokr + 2 * wh + 1];
        const bf16* W = F.w1() + (size_t)(l * NE + e) * 512 * D; const int grow = (f >> 7) * 256 + (f & 127);
        const float g = dot_bf16(F.ha() + (size_t)tokr * D, W + (size_t)grow * D, D), u = dot_bf16(F.ha() + (size_t)tokr * D, W + (size_t)(grow + 128) * D, D);
        F.hid()[(size_t)(ybase_of(F, l, e) + sl) * DE + f] = (bf16)f2bf(F.wl()[e * CAP + sl] * silu_f(g) * u);
    }
}
__device__ __forceinline__ void p8_moe2_naive(Frame& F, int l) {
    for (long i = F.gt; i < (long)T * 2 * D; i += F.ngt) {
        const int a = (int)(i >> 10), n = (int)(i & 1023), tokr = a >> 1, wh = a & 1;
        const int e = F.route()[4 * tokr + 2 * wh], sl = F.route()[4 * tokr + 2 * wh + 1]; const size_t pr = (size_t)(ybase_of(F, l, e) + sl);
        F.y()[pr * D + n] = (bf16)f2bf(dot_bf16(F.hid() + pr * DE, F.w2() + ((size_t)(l * NE + e) * D + n) * DE, DE));
    }
}

template <int NT> __device__ __forceinline__ void p9_setup(CPR p, Frame& F, int t) {
    LAS float* mdl = (LAS float*)F.lds;
    constexpr int KM = (1280 + NT - 1) / NT;
    f32x4 mv[KM];
#pragma unroll
    for (int k = 0; k < KM; ++k) { const int i = t + NT * k; if (i < 5 * 256) { const int mr = i >> 8, c = (i & 255) * 4;
        mv[k] = *(const f32x4*)((mr < 4 ? mod_vec(F, DEPTH - 1, mr, 5) : p.final_g) + c); } }
    __builtin_amdgcn_sched_barrier(0);
#pragma unroll
    for (int k = 0; k < KM; ++k) { const int i = t + NT * k; if (i < 5 * 256) *(LAS f32x4*)(mdl + 4 * i) = mv[k]; }
}
__device__ __forceinline__ void p9_final(CPR p, Frame& F, bool setup = true) {
    const int l = DEPTH - 1;
    const volatile LAS int* tab = (const volatile LAS int*)(F.lds + MOETAB_OFF);
    if (setup) { __syncthreads(); p9_setup<NTHR>(p, F, F.tid); __syncthreads(); }
    if (!MK_ONE_LAUNCH) moe_table(F, l);
    for (int pi = F.gw; pi < TL / 2; pi += F.ngw) {
        int c0 = 4 * F.lane; asm volatile("" : "+v"(c0));
        const int r0 = 2 * pi;
        const bf16* y0[2]; const bf16* y1[2];
#pragma unroll
        for (int k = 0; k < 2; ++k) { const i32x4 rt = *(const i32x4*)(F.route() + 4 * (r0 + k));
            y0[k] = F.y() + (size_t)(tab[rt.x] * 256 + rt.y) * D + c0; y1[k] = F.y() + (size_t)(tab[rt.z] * 256 + rt.w) * D + c0; }
        f32x4 v[2][4]; u32x2 a[2][4], b[2][4];
#pragma unroll
        for (int k = 0; k < 2; ++k)
#pragma unroll
            for (int j = 0; j < 4; ++j) { v[k][j] = ld_bf4(F.xl() + (size_t)(r0 + k) * D + c0 + 256 * j); a[k][j] = *(const u32x2*)(y0[k] + 256 * j); b[k][j] = *(const u32x2*)(y1[k] + 256 * j); }
        const LAS float* g5 = (const LAS float*)F.lds + row_mod(r0) * 1024 + c0;
        float ss0 = 0.f, ss1 = 0.f;
#pragma unroll
        for (int j = 0; j < 4; ++j) { const f32x4 g = *(const LAS f32x4*)(g5 + 256 * j); add_y4(v[0][j], g, a[0][j], b[0][j]); add_y4(v[1][j], g, a[1][j], b[1][j]); ss0 += sumsq4(v[0][j]); ss1 += sumsq4(v[1][j]); }
        ss0 = wave_sum(ss0); ss1 = wave_sum(ss1);
        const float rs0 = rsqrtf(ss0 * (1.f / D) + EPS), rs1 = rsqrtf(ss1 * (1.f / D) + EPS);
#pragma unroll
        for (int j = 0; j < 4; ++j) { const f32x4 g = *(const LAS f32x4*)((const LAS float*)F.lds + 4096 + c0 + 256 * j);
            *(f32x4*)(p.out + (size_t)r0 * D + c0 + 256 * j) = v[0][j] * rs0 * g; *(f32x4*)(p.out + (size_t)(r0 + 1) * D + c0 + 256 * j) = v[1][j] * rs1 * g; }
    }
}

template <int NBATCH> __device__ __forceinline__ f32x16 wave_tile_k(const bf16* wrow, const bf16* xrow) {
    f32x16 acc;
#pragma unroll
    for (int i = 0; i < 16; ++i) acc[i] = 0.f;
    bf16x8 a0[8], b0[8], a1[8], b1[8];
#pragma unroll
    for (int j = 0; j < 8; ++j) { a0[j] = *(const bf16x8*)(wrow + 512 * j); b0[j] = *(const bf16x8*)(xrow + 16 * j); }
#pragma unroll 1
    for (int bt = 0; bt < NBATCH; bt += 2) {
#pragma unroll
        for (int j = 0; j < 8; ++j) { a1[j] = *(const bf16x8*)(wrow + 4096 * (bt + 1) + 512 * j); b1[j] = *(const bf16x8*)(xrow + 128 * (bt + 1) + 16 * j); }
        __builtin_amdgcn_sched_barrier(0);
#pragma unroll
        for (int j = 0; j < 8; ++j) acc = __builtin_amdgcn_mfma_f32_32x32x16_bf16(a0[j], b0[j], acc, 0, 0, 0);
        __builtin_amdgcn_sched_barrier(0);
        if (bt + 2 < NBATCH) {
#pragma unroll
            for (int j = 0; j < 8; ++j) { a0[j] = *(const bf16x8*)(wrow + 4096 * (bt + 2) + 512 * j); b0[j] = *(const bf16x8*)(xrow + 128 * (bt + 2) + 16 * j); } }
        __builtin_amdgcn_sched_barrier(0);
#pragma unroll
        for (int j = 0; j < 8; ++j) acc = __builtin_amdgcn_mfma_f32_32x32x16_bf16(a1[j], b1[j], acc, 0, 0, 0);
        __builtin_amdgcn_sched_barrier(0);
    }
    return acc;
}
#define CVT_RANKS(G) (((G) - 32) * NWAVES + ((G) - 48) * NWAVES)
__device__ __forceinline__ void p2_inproj(CPR p, Frame& F, int l, int lc) {
    pg8::StaticOrder S; S.init(T, INP, D, (int)gridDim.x, (int)blockIdx.x); S.rdy = F.ctl() + CW_RDY2 + lc * 128 * 64; S.pub_from = 6; S.pn_rot = 2;
    pg8::EpiBf16 E{F.pl(), INP, true, T * INP * 2};
    pg8::gemm_phase<pg8::EpiBf16, pg8::StaticOrder, true>(F.lds, F.tid, F.ha(), F.win() + (size_t)l * INP * D, D, S, E);
    TMARK(101);
    if (l + 1 < DEPTH && blockIdx.x >= 32) convert_layer(p, F, l + 1, ((int)blockIdx.x - 32) * NWAVES + F.wave, CVT_RANKS((int)gridDim.x));
    TMARK(102);
    p3_mla_up_queued(F, l, lc);
    TMARK(103);
}
__device__ __forceinline__ void p5_outproj(Frame& F, int l, float gsc = 1.f) {
    pg8::StaticOrder S; S.init(TL, D, D, (int)gridDim.x, (int)blockIdx.x);
    pg8::EpiResid E{F.xl(), D, F.mod() + (size_t)l * 5 * NMOD * D, gsc};
    pg8::gemm_phase<pg8::EpiResid, pg8::StaticOrder, true>(F.lds, F.tid, F.ml(), F.wout() + (size_t)l * D * D, D, S, E);
    TMARK(51);
    if (l + 1 < DEPTH) {
        constexpr int XROW = 2 * D + 16, XOFF = 16384;
        const int tk = F.lane & 31, hh = F.lane >> 5, half = F.wave >> 2, wp = F.wave & 3;
        LAS float* xch = (LAS float*)(F.lds + wp * 4096);
        __syncthreads();
        for (int it0 = blockIdx.x * 4; it0 < (TC / 32) * (D / 32); it0 += gridDim.x * 4) {
            const int it = it0 + wp, rt = it / (D / 32), nt = it % (D / 32), row = TL + 32 * rt + tk;
            const bf16* wrow = F.woutf() + (size_t)l * D * D + ((size_t)nt * 64 * 64 + 32 * half * 64 + F.lane) * 8;
            bf16x8 aw[32];
#pragma unroll
            for (int j = 0; j < 32; ++j) aw[j] = *(const bf16x8*)(wrow + 512 * j);
            { u32x4 st[8]; const bf16* src = F.ml() + (size_t)(TL + 32 * (it0 / (D / 32))) * D;
#pragma unroll
              for (int k = 0; k < 8; ++k) { const int c = F.tid + NTHR * k; st[k] = *(const u32x4*)(src + (size_t)(c >> 7) * D + 8 * (c & 127)); }
              __builtin_amdgcn_sched_barrier(0);
#pragma unroll
              for (int k = 0; k < 8; ++k) { const int c = F.tid + NTHR * k; *(LAS u32x4*)(F.lds + XOFF + (c >> 7) * XROW + 16 * (c & 127)) = st[k]; } }
            __syncthreads();
            f32x16 acc;
#pragma unroll
            for (int i = 0; i < 16; ++i) acc[i] = 0.f;
            { const LAS unsigned char* xb = F.lds + XOFF + tk * XROW + (512 * half + 8 * hh) * 2;
#pragma unroll
              for (int jb = 0; jb < 4; ++jb) { bf16x8 bx[8];
#pragma unroll
                  for (int j = 0; j < 8; ++j) bx[j] = *(const LAS bf16x8*)(xb + 32 * (8 * jb + j));
                  __builtin_amdgcn_sched_barrier(0);
#pragma unroll
                  for (int j = 0; j < 8; ++j) acc = __builtin_amdgcn_mfma_f32_32x32x16_bf16(aw[8 * jb + j], bx[j], acc, 0, 0, 0); } }
            if (half) {
#pragma unroll
                for (int i = 0; i < 16; ++i) xch[i * 64 + F.lane] = acc[i]; }
            __syncthreads();
            if (!half) {
                bf16* o = F.xl() + (size_t)row * D + 32 * nt + 4 * hh; const float* gp = mod_vec(F, l, 4, 2) + 32 * nt + 4 * hh;
                f32x4 xv[4], gv[4];
#pragma unroll
                for (int g = 0; g < 4; ++g) { xv[g] = ld_bf4(o + 8 * g); gv[g] = *(const f32x4*)(gp + 8 * g) * gsc; }
#pragma unroll
                for (int g = 0; g < 4; ++g) { f32x4 x = xv[g];
                    x.x += gv[g].x * (acc[4 * g] + xch[(4 * g) * 64 + F.lane]); x.y += gv[g].y * (acc[4 * g + 1] + xch[(4 * g + 1) * 64 + F.lane]);
                    x.z += gv[g].z * (acc[4 * g + 2] + xch[(4 * g + 2) * 64 + F.lane]); x.w += gv[g].w * (acc[4 * g + 3] + xch[(4 * g + 3) * 64 + F.lane]); st_bf4(o + 8 * g, x); }
            }
            __syncthreads();
        }
    }
}
__device__ __forceinline__ void p7_moe1(Frame& F, int l, int lc) {
    moe_table(F, l);
    pg8::MoeOrder<true, 2, D, false, true> S{(const volatile LAS int*)(F.lds + MOETAB_OFF), F.tok(), (int)gridDim.x, (int)blockIdx.x, (size_t)512 * D * 2, (volatile LAS unsigned*)(F.lds + ROWTAB_OFF),
        nullptr, F.ctl() + CW_RDY + lc * 192 * 64, F.ctl() + CW_TMO, nullptr};
    pg8::EpiMoe1 E{F.hid(), F.wl()};
    pg8::gemm_phase<pg8::EpiMoe1, pg8::MoeOrder<true, 2, D, false, true>, true>(F.lds, F.tid, F.ha(), F.w1() + (size_t)l * NE * 512 * D, D, S, E);
}
__device__ __forceinline__ void p8_moe2(Frame& F, int l, int lc) {
    __syncthreads();
    pg8::MoeOrder<false, 4, DE, true, false> S{(const volatile LAS int*)(F.lds + MOETAB_OFF), F.tok(), (int)gridDim.x, (int)blockIdx.x, (size_t)D * DE * 2, nullptr,
        F.ctl() + CW_HEAD + lc * 64, F.ctl() + CW_RDY + lc * 192 * 64, F.ctl() + CW_TMO, (volatile LAS int*)(F.lds + DYNQ_OFF)};
    pg8::EpiBf16 E{F.y(), D};
    pg8::gemm_phase<pg8::EpiBf16, pg8::MoeOrder<false, 4, DE, true, false>, true>(F.lds, F.tid, F.hid(), F.w2() + (size_t)l * NE * D * DE, DE, S, E);
}

constexpr int PH_FINAL = 1 + 10 * DEPTH, N_PHASES = PH_FINAL + 1;
__global__ void __launch_bounds__(NTHR, 2) fwd(Params p) {
    extern __shared__ __attribute__((aligned(16))) unsigned char lds_raw[];
    Frame F;
    F.lds = (LAS unsigned char*)lds_raw;
    F.tid = threadIdx.x; F.lane = F.tid & 63; F.wave = __builtin_amdgcn_readfirstlane(F.tid >> 6);
    F.gw = blockIdx.x * NWAVES + F.wave; F.ngw = gridDim.x * NWAVES; F.gt = blockIdx.x * NTHR + F.tid; F.ngt = gridDim.x * NTHR;
    const __attribute__((address_space(4))) Params* KP = (const __attribute__((address_space(4))) Params*)__builtin_amdgcn_kernarg_segment_ptr();
    F.ws = KP->ws;
    volatile LAS unsigned* MISC = (volatile LAS unsigned*)(F.lds + MISC_OFF);
    for (int u = F.tid; u < 32; u += NTHR) MISC[u] = 0u;
    if (F.lane == 0) ((volatile LAS int*)(F.lds + WTAB_OFF))[__builtin_amdgcn_s_getreg((5 << 11) | 4) & 63] = F.wave;
    __syncthreads();
#if MK_ONE_LAUNCH
    (void)xcd_barrier_post(F.ctl() + CW_BAR, MISC + 8);
#define GRID_BAR() do { XcdBarrier b_; b_.bar = (unsigned*)(KP->ws + WS_CTL) + CW_BAR; b_.x = xb_xcc_id(); b_.st = (volatile LAS unsigned*)(F.lds + MISC_OFF) + 8; xcd_barrier(b_); } while (0)
#define GRID_BAR_HOOK(hook) do { XcdBarrier b_; b_.bar = (unsigned*)(KP->ws + WS_CTL) + CW_BAR; b_.x = xb_xcc_id(); b_.st = (volatile LAS unsigned*)(F.lds + MISC_OFF) + 8; \
    asm volatile("s_waitcnt vmcnt(0)" ::: "memory"); __syncthreads(); if (F.wave == 0) xcd_barrier_core(b_); else { hook; } __syncthreads(); } while (0)
#define P6_IN_BARRIER 1
#else
#define P6_IN_BARRIER 0
#define GRID_BAR() do {} while (0)
#endif
#define lo (KP->ph_lo)
#define hi (KP->ph_hi)
#define PB() do { asm volatile("" : "+s"(KP)); F.ws = KP->ws; int ln_; asm volatile("v_mbcnt_lo_u32_b32 %0, -1, 0\n\tv_mbcnt_hi_u32_b32 %0, -1, %0" : "=v"(ln_)); \
    F.wave = __builtin_amdgcn_readfirstlane(((volatile LAS int*)(F.lds + WTAB_OFF))[__builtin_amdgcn_s_getreg((5 << 11) | 4) & 63]); F.lane = ln_; const int t_ = F.wave * 64 + ln_; F.tid = t_; \
    F.gw = blockIdx.x * NWAVES + F.wave; F.gt = blockIdx.x * NTHR + t_; F.ngw = gridDim.x * NWAVES; F.ngt = gridDim.x * NTHR; } while (0)
#ifndef PH_MASK
#define PH_MASK 0xFFF
#endif
#define INK(k, kind) (((PH_MASK >> (kind)) & 1) && lo <= (k) && (k) < hi)
#define IN(k) (lo <= (k) && (k) < hi)
#define SEAM(k) do { if (IN((k) + 1)) { GRID_BAR(); if (PROBE_REP & 0x10000) { GRID_BAR(); GRID_BAR(); } } } while (0)
#ifndef PROBE_REP
#define PROBE_REP 0
#endif
#define RUNK(kind, body) do { PB(); body; if ((PROBE_REP >> (kind)) & 1) { PB(); body; } } while (0)
    TMARK(-2);
    if (INK(0, 9)) { RUNK(9, p0_prologue(*KP, F)); SEAM(0); TMARK(9); }
    for (int l = 0; l < DEPTH; ++l) {
        const int pb = 1 + 10 * l;
        if (INK(pb + 0, 0)) { PB(); p1_rows(*KP, F, l, 1.f, !(P6_IN_BARRIER && l > 0 && INK(pb - 2, 7))); if (PROBE_REP & 1) { GRID_BAR(); PB(); p1_rows(*KP, F, l, 0.f); } SEAM(pb + 0); TMARK(0); }
        if (INK(pb + 1, 1)) { PB(); if (FAST_GEMM & 1) p2_inproj(*KP, F, l, l); else p2_inproj_naive(F, l); if (PROBE_REP & (1 << 25)) { GRID_BAR(); PB(); p2_inproj(*KP, F, l, l + 4); }
            if (P6_IN_BARRIER) { if (IN(pb + 2)) { PB(); GRID_BAR_HOOK(na_bias_setup<NTHR - 64>(*KP, F, l, F.tid - 64)); } } else SEAM(pb + 1);
            TMARK(1); }
        if (INK(pb + 2, 2)) { if (!(FAST_GEMM & 1)) { PB(); p3_mla_up(F, l); SEAM(pb + 3); } }
        if (INK(pb + 4, 4)) {
#define ATTN_SLOT() do { PB(); if (FAST_MLA) p4_mla_flash<0>(F); else p4_mla_naive(F); TMARK(41); \
                              RUNK(13, { if (FAST_PS & 1) p3_pool_mfma(*KP, F, l); else p3_pool_naive(*KP, F, l); }); if (PROBE_T >= 0) __syncthreads(); TMARK(42); \
                              RUNK(14, { if (FAST_PS & 2) p3_sgu_mfma(*KP, F, l); else p3_sgu1_naive(*KP, F, l); }); if (PROBE_T >= 0) __syncthreads(); TMARK(43); RUNK(15, { if (FAST_NA) p3_na_mfma(*KP, F, l, !(P6_IN_BARRIER && INK(pb + 1, 1))); else p3_na_naive(*KP, F, l); }); if (PROBE_T >= 0) __syncthreads(); TMARK(44); } while (0)
                              ATTN_SLOT();
                              if ((PROBE_REP >> 20) & 15) { PB(); p4_mla_flash<(PROBE_REP >> 20) & 15>(F); }
                              if (PROBE_REP & (1 << 24)) { GRID_BAR(); ATTN_SLOT(); }
                              if (!(FAST_PS & 2)) { GRID_BAR(); PB(); p3_sgu2_naive(*KP, F, l); } SEAM(pb + 4); TMARK(4); }
        if (INK(pb + 5, 5)) { PB(); if (FAST_GEMM & 2) p5_outproj(F, l); else p5_outproj_naive(F, l); if (PROBE_REP & 32) { GRID_BAR(); PB(); p5_outproj(F, l, 0.f); }
            if (P6_IN_BARRIER) { if (IN(pb + 6)) { PB(); GRID_BAR_HOOK(p6_setup<NTHR - 64>(*KP, F, l, F.tid - 64)); } } else SEAM(pb + 5);
            TMARK(5); }
        if (INK(pb + 6, 6)) { PB(); p6_rows(*KP, F, l, true, !(P6_IN_BARRIER && INK(pb + 5, 5))); if (PROBE_REP & 64) { PB(); p6_rows(*KP, F, l, false); } SEAM(pb + 6); TMARK(6); }
        if (INK(pb + 7, 11)) { if (!(FAST_GEMM & 4)) {} }
        if (INK(pb + 8, 7)) { PB(); p7_moe1(F, l, l); TMARK(71); \
            if (l + 1 < DEPTH && blockIdx.x >= 48) { PB(); __syncthreads(); convert_layer(*KP, F, l + 1, ((int)gridDim.x - 32) * NWAVES + ((int)blockIdx.x - 48) * NWAVES + F.wave, CVT_RANKS((int)gridDim.x)); } \
            PB(); p8_moe2(F, l, l); TMARK(72); if (PROBE_REP & (1 << 26)) { GRID_BAR(); PB(); p7_moe1(F, l, l + 4); PB(); p8_moe2(F, l, l + 4); }
            if (P6_IN_BARRIER && l + 1 < DEPTH) { if (IN(pb + 10)) { PB(); GRID_BAR_HOOK(p1_setup<NTHR - 64>(*KP, F, l + 1, F.tid - 64)); } }
            else if (P6_IN_BARRIER) { if (IN(pb + 10)) { PB(); GRID_BAR_HOOK(p9_setup<NTHR - 64>(*KP, F, F.tid - 64)); } }
            else SEAM(pb + 9);
            TMARK(7); }
    }
    if (INK(PH_FINAL, 10)) { PB(); p9_final(*KP, F, !(P6_IN_BARRIER && INK(PH_FINAL - 2, 7))); TMARK(8); }
    if (PROBE_T >= 0 && blockIdx.x == PROBE_BLK && threadIdx.x == 0) {
        volatile LAS unsigned* M_ = (volatile LAS unsigned*)(F.lds + MISC_OFF) + 16; const unsigned t0_ = (unsigned)wall_clock64(), w_ = M_[1] * (unsigned)PROBE_TMUL;
        while ((unsigned)wall_clock64() - t0_ < w_) __builtin_amdgcn_s_sleep(8);
    }
}

extern "C" void kernel_launch(void* const* d_in, const int* in_sizes, int n_in, void* d_out, int out_size, void* d_ws, size_t ws_size, hipStream_t stream) {
    static int grid = 0;
    if (grid == 0) {
        if (n_in != 26 || out_size != TL * D || ws_size < WS_END) { fprintf(stderr, "kernel_launch: unexpected shapes: n_in %d out %d ws %zu (need %zu)\n", n_in, out_size, ws_size, (size_t)WS_END); grid = -1; return; }
        int dev = 0, cus = 0, per_cu = 0;
        if (hipGetDevice(&dev) != hipSuccess || hipDeviceGetAttribute(&cus, hipDeviceAttributeMultiprocessorCount, dev) != hipSuccess) { grid = -1; return; }
        if (hipFuncSetAttribute((const void*)fwd, hipFuncAttributeMaxDynamicSharedMemorySize, LDS_BYTES) != hipSuccess) { fprintf(stderr, "kernel_launch: hipFuncSetAttribute failed\n"); grid = -1; return; }
        if (hipOccupancyMaxActiveBlocksPerMultiprocessor(&per_cu, (const void*)fwd, NTHR, LDS_BYTES) != hipSuccess || per_cu < 1) fprintf(stderr, "kernel_launch: occupancy query says %d\n", per_cu);
        (void)hipGetLastError();
        if (cus < 128) { fprintf(stderr, "kernel_launch: %d CUs: the row phases are sized for at least 128 workgroups\n", cus); grid = -1; return; }
        grid = cus;
    }
    if (grid < 0) return;
    (void)hipMemsetAsync((char*)d_ws + WS_CTL, 0, CTL_ZERO_BYTES, stream);
    Params p{};
    const float** pp = (const float**)&p;
    for (int i = 0; i < 26; ++i) pp[i] = (const float*)d_in[i];
    p.out = (float*)d_out; p.ws = (unsigned char*)d_ws;
#if MK_ONE_LAUNCH
    p.ph_lo = 0; p.ph_hi = N_PHASES;
    hipLaunchKernelGGL(fwd, dim3(grid), dim3(NTHR), LDS_BYTES, stream, p);
#else
    for (int ph = 0; ph < N_PHASES; ++ph) {
        p.ph_lo = ph; p.ph_hi = ph + 1;
        hipLaunchKernelGGL(fwd, dim3(grid), dim3(NTHR), LDS_BYTES, stream, p);
    }
#endif
}
```
